# Optimizing an MI355X kernel written in HIP

```python
import math
import jax, jax.numpy as jnp
from jax import lax
import numpy as np

D_MODEL = 2048
BATCH = 4
SEQ = 4096
DEPTH = 2

N_SUBLAYERS = 3
N_BRANCHES = 4
MIX_WIDTH = D_MODEL // 4
HEAD_DIM = 64
ROPE_THETA = 10000.0
NORM_EPS = 1e-6
Q_BLOCK = 128
NEG_INF = -1e30
FORCE_SCORE = 1e30
D_FF = ((8 * D_MODEL // 3 + 255) // 256) * 256
MACARON_WEIGHT = 0.5

NSA_HEADS = MIX_WIDTH // HEAD_DIM
NSA_KV_HEADS = 2
NSA_GROUP = NSA_HEADS // NSA_KV_HEADS
CMP_BLOCK = 32
CMP_STRIDE = 16
CMP_HIDDEN = 256
SLC_BLOCK = 64
SLC_TOPK = 16
WIN_SIZE = 512
NSA_SPLITS = (NSA_HEADS * HEAD_DIM,) + (NSA_KV_HEADS * HEAD_DIM,) * 6 + (3 * NSA_HEADS,)

RWKV_HEADS = MIX_WIDTH // HEAD_DIM
RWKV_WIDTH = MIX_WIDTH
RWKV_DECAY_LORA = 64
RWKV_AAA_LORA = 64
RWKV_GATE_LORA = 128
RWKV_GN_EPS = 64e-5
RWKV_SPLITS = (RWKV_WIDTH, RWKV_DECAY_LORA, RWKV_WIDTH, RWKV_WIDTH, RWKV_AAA_LORA, RWKV_GATE_LORA)

GLA_HEADS = 4
GLA_DK = MIX_WIDTH // 2
GLA_DV = MIX_WIDTH
GLA_DK_HEAD = GLA_DK // GLA_HEADS
GLA_DV_HEAD = GLA_DV // GLA_HEADS
GLA_GATE_LORA = 16
GLA_TAU = 16.0
GLA_CHUNK = 64
GLA_SPLITS = (GLA_DK, GLA_DK, GLA_DV, GLA_GATE_LORA, GLA_DV)

MLA_HEADS = MIX_WIDTH // 64
MLA_Q_RANK = 384
MLA_KV_RANK = 128
MLA_NOPE = 64
MLA_ROPE = 32
MLA_V = MIX_WIDTH // MLA_HEADS
MLA_SPLITS = (MLA_Q_RANK, MLA_KV_RANK, MLA_ROPE)

BRANCH_SPLITS = (sum(NSA_SPLITS), sum(RWKV_SPLITS), sum(GLA_SPLITS), sum(MLA_SPLITS), N_BRANCHES * D_MODEL)
PROJ_IN = sum(BRANCH_SPLITS)

kernel_name = 'hybrid_nsa_rwkv7_gla_mla_macaron'


def _split(t, sizes):
    return jnp.split(t, np.cumsum(sizes)[:-1].tolist(), axis=-1)


def _rmsnorm(x, g):
    xf = x.astype(jnp.float32)
    y = xf * lax.rsqrt(jnp.mean(xf * xf, axis=-1, keepdims=True) + NORM_EPS)
    return (y * g.astype(jnp.float32)).astype(x.dtype)


def _rope(x, positions):
    d = x.shape[-1]
    inv = ROPE_THETA ** (-jnp.arange(0, d, 2, dtype=jnp.float32) / d)
    ang = positions.astype(jnp.float32)[:, None] * inv[None, :]
    cos, sin = jnp.cos(ang)[:, None, :], jnp.sin(ang)[:, None, :]
    x1, x2 = jnp.split(x.astype(jnp.float32), 2, axis=-1)
    return jnp.concatenate([x1 * cos - x2 * sin, x1 * sin + x2 * cos], axis=-1).astype(x.dtype)


def _modulation(c, w, b):
    m = jax.nn.silu(c) @ w + b
    shift, scale, gate = jnp.split(m[:, None, :], 3, axis=-1)
    return shift, scale, gate


def _sandwich(x, c, fn, w_mod, b_mod, g_pre, g_post, res_weight):
    shift, scale, gate = _modulation(c, w_mod, b_mod)
    u = _rmsnorm(x, g_pre) * (1.0 + scale) + shift
    y = _rmsnorm(fn(u), g_post)
    return x + res_weight * gate * y


def _swiglu(u, wg, wu, wd):
    return (jax.nn.silu(u @ wg) * (u @ wu)) @ wd


def _causal_attention_blocked(q, k, v, scale):
    B, H, S, dq = q.shape
    nb = S // Q_BLOCK
    qb = q.reshape(B, H, nb, Q_BLOCK, dq).transpose(2, 0, 1, 3, 4)
    k_pos = jnp.arange(S)

    def one_block(args):
        q_i, i = args
        s = jnp.einsum('bhqd,bhkd->bhqk', q_i, k).astype(jnp.float32) * scale
        q_pos = i * Q_BLOCK + jnp.arange(Q_BLOCK)
        s = jnp.where(k_pos[None, :] <= q_pos[:, None], s, NEG_INF)
        p = jax.nn.softmax(s, axis=-1)
        return jnp.einsum('bhqk,bhkd->bhqd', p.astype(v.dtype), v)

    o = lax.map(one_block, (qb, jnp.arange(nb)))
    return o.transpose(1, 2, 0, 3, 4).reshape(B, H, S, v.shape[-1])


def _nsa(q, k_cmp, v_cmp, k_slc, v_slc, k_win, v_win, gate_logits, cmp_pos, cmp_w1, cmp_w2, positions):
    B, S = q.shape[0], q.shape[1]
    Hk, G, d = NSA_KV_HEADS, NSA_GROUP, HEAD_DIM
    scale = d ** -0.5
    nq = S // Q_BLOCK
    t_pos = np.arange(S)
    qg = _rope(q, positions).reshape(B, S, Hk, G, d).transpose(0, 2, 3, 1, 4)
    heads_first = lambda t: t.transpose(0, 2, 1, 3)
    kc_in, vc_in = heads_first(_rope(k_cmp, positions)), heads_first(v_cmp)
    ks, vs = heads_first(_rope(k_slc, positions)), heads_first(v_slc)
    kw, vw = heads_first(_rope(k_win, positions)), heads_first(v_win)

    n_cmp = (S - CMP_BLOCK) // CMP_STRIDE + 1
    cmp_idx = np.arange(n_cmp)[:, None] * CMP_STRIDE + np.arange(CMP_BLOCK)[None, :]

    def compress(t, pos_emb, w1, w2):
        blocks = (t[:, :, cmp_idx] + pos_emb).reshape(B, Hk, n_cmp, CMP_BLOCK * d)
        return jax.nn.gelu(blocks @ w1) @ w2

    kc = compress(kc_in, cmp_pos[0], cmp_w1[0], cmp_w2[0])
    vc = compress(vc_in, cmp_pos[1], cmp_w1[1], cmp_w2[1])
    cmp_mask = cmp_idx[:, -1][None, :] <= t_pos[:, None]
    s_cmp = jnp.einsum('bhgsd,bhnd->bhgsn', qg, kc).astype(jnp.float32) * scale
    p_cmp = jax.nn.softmax(jnp.where(cmp_mask, s_cmp, NEG_INF), axis=-1) * cmp_mask
    o_cmp = jnp.einsum('bhgsn,bhnd->bhgsd', p_cmp.astype(vc.dtype), vc)

    n_sel = S // SLC_BLOCK
    blk = np.arange(n_sel)
    overlap = ((cmp_idx[:, :1] < (blk[None, :] + 1) * SLC_BLOCK) &
               (cmp_idx[:, -1:] >= blk[None, :] * SLC_BLOCK)).astype(np.float32)
    imp = jnp.einsum('bhgsn,nj->bhsj', p_cmp, overlap)
    cur = (t_pos // SLC_BLOCK)[:, None]
    valid = blk[None, :] <= cur
    forced = valid & ((blk[None, :] == 0) | (blk[None, :] >= cur - 1))
    imp = jnp.where(forced, FORCE_SCORE, jnp.where(valid, imp, NEG_INF))
    k_top = min(SLC_TOPK, n_sel)
    _, sel_idx = lax.top_k(imp, k_top)

    k_blocks = ks.reshape(B, Hk, n_sel, SLC_BLOCK, d)
    v_blocks = vs.reshape(B, Hk, n_sel, SLC_BLOCK, d)
    q_chunks = qg.reshape(B, Hk, G, nq, Q_BLOCK, d).transpose(3, 0, 1, 2, 4, 5)
    idx_chunks = sel_idx.reshape(B, Hk, nq, Q_BLOCK, k_top).transpose(2, 0, 1, 3, 4)
    b_ix = jnp.arange(B)[:, None, None, None]
    h_ix = jnp.arange(Hk)[None, :, None, None]

    def selected_block(args):
        q_c, idx_c, blk_id = args
        kb = k_blocks[b_ix, h_ix, idx_c]
        vb = v_blocks[b_ix, h_ix, idx_c]
        s = jnp.einsum('bhgqd,bhqnld->bhgqnl', q_c, kb).astype(jnp.float32) * scale
        q_pos = blk_id * Q_BLOCK + jnp.arange(Q_BLOCK)
        k_pos = idx_c[..., None] * SLC_BLOCK + jnp.arange(SLC_BLOCK)
        mask = (k_pos <= q_pos[:, None, None])[:, :, None]
        s = jnp.where(mask, s, NEG_INF).reshape(B, Hk, G, Q_BLOCK, k_top * SLC_BLOCK)
        p = jax.nn.softmax(s, axis=-1).reshape(B, Hk, G, Q_BLOCK, k_top, SLC_BLOCK)
        return jnp.einsum('bhgqnl,bhqnld->bhgqd', p.astype(vb.dtype), vb)

    o_slc = lax.map(selected_block, (q_chunks, idx_chunks, jnp.arange(nq)))
    o_slc = o_slc.transpose(1, 2, 3, 0, 4, 5).reshape(B, Hk, G, S, d)

    n_wb = WIN_SIZE // Q_BLOCK

    def band(t):
        tp = jnp.pad(t, ((0, 0), (0, 0), (WIN_SIZE, 0), (0, 0))).reshape(B, Hk, nq + n_wb, Q_BLOCK, d)
        return jnp.concatenate([tp[:, :, i:i + nq] for i in range(n_wb + 1)], axis=3)

    kwb, vwb = band(kw), band(vw)
    q_pos = t_pos.reshape(nq, Q_BLOCK, 1)
    k_pos = ((np.arange(nq)[:, None] - n_wb) * Q_BLOCK + np.arange((n_wb + 1) * Q_BLOCK)[None, :])[:, None, :]
    win_mask = (k_pos >= 0) & (k_pos <= q_pos) & (k_pos > q_pos - WIN_SIZE)
    s_win = jnp.einsum('bhgnqd,bhnkd->bhgnqk', qg.reshape(B, Hk, G, nq, Q_BLOCK, d), kwb).astype(jnp.float32) * scale
    p_win = jax.nn.softmax(jnp.where(win_mask, s_win, NEG_INF), axis=-1)
    o_win = jnp.einsum('bhgnqk,bhnkd->bhgnqd', p_win.astype(vwb.dtype), vwb).reshape(B, Hk, G, S, d)

    gates = jax.nn.sigmoid(gate_logits.reshape(B, S, Hk, G, 3).transpose(0, 2, 3, 1, 4))
    o = gates[..., 0:1] * o_cmp + gates[..., 1:2] * o_slc + gates[..., 2:3] * o_win
    return o.transpose(0, 3, 1, 2, 4).reshape(B, S, NSA_HEADS * d)


def _rwkv7(p_rwkv, mu, w0, w_w2, a0, a_w2, g_w2, k_k, k_a, r_k, ln_w, ln_b):
    B, S, _ = p_rwkv.shape
    H, N = RWKV_HEADS, HEAD_DIM
    prev = jnp.pad(p_rwkv, ((0, 0), (1, 0), (0, 0)))[:, :-1]
    xs = p_rwkv + (prev - p_rwkv) * mu
    r, w_lo, k, v, a_lo, g_lo = [t.astype(jnp.float32) for t in _split(xs, RWKV_SPLITS)]
    log_w = -math.exp(-0.5) * jax.nn.sigmoid(w0 + jnp.tanh(w_lo) @ w_w2)
    a = jax.nn.sigmoid(a0 + a_lo @ a_w2)
    g = jax.nn.sigmoid(g_lo) @ g_w2
    heads = lambda t: t.reshape(B, S, H, N)
    kk = heads(k * k_k)
    kk = kk / jnp.maximum(jnp.sqrt(jnp.sum(kk * kk, axis=-1, keepdims=True)), 1e-12)
    k = k * (1.0 + (a - 1.0) * k_a)
    r, log_w, k, v, a = heads(r), heads(log_w), heads(k), heads(v), heads(a)

    def step(state, inp):
        r_t, w_t, k_t, v_t, kk_t, a_t = inp
        s_kk = jnp.einsum('bhvk,bhk->bhv', state, kk_t)
        state = (state * w_t[:, :, None, :] - s_kk[..., None] * (kk_t * a_t)[:, :, None, :]
                 + v_t[..., None] * k_t[:, :, None, :])
        return state, jnp.einsum('bhvk,bhk->bhv', state, r_t)

    tm = lambda t: t.transpose(1, 0, 2, 3)
    state0 = jnp.zeros((B, H, N, N), jnp.float32)
    _, y = lax.scan(step, state0, (tm(r), tm(jnp.exp(log_w)), tm(k), tm(v), tm(kk), tm(a)))
    y = y.transpose(1, 0, 2, 3)
    mean = jnp.mean(y, axis=-1, keepdims=True)
    var = jnp.mean(jnp.square(y - mean), axis=-1, keepdims=True)
    y = ((y - mean) * lax.rsqrt(var + RWKV_GN_EPS)).reshape(B, S, H * N) * ln_w + ln_b
    bonus = jnp.sum(r * k * r_k.reshape(H, N), axis=-1, keepdims=True) * v
    y = (y + bonus.reshape(B, S, H * N)) * g
    return y.astype(p_rwkv.dtype)


def _gla(q, k, v, alpha_lo, r, alpha_w2, alpha_b, norm_g):
    B, S, _ = q.shape
    H, dk, dv, C = GLA_HEADS, GLA_DK_HEAD, GLA_DV_HEAD, GLA_CHUNK
    nc = S // C
    log_a = jax.nn.log_sigmoid((alpha_lo @ alpha_w2 + alpha_b).astype(jnp.float32)) / GLA_TAU

    def chunks(t, dh):
        return t.astype(jnp.float32).reshape(B, nc, C, H, dh).transpose(1, 0, 3, 2, 4)

    qc, kc, vc, gc = chunks(q, dk) * dk ** -0.5, chunks(k, dk), chunks(v, dv), chunks(log_a, dk)
    causal = np.tril(np.ones((C, C), dtype=bool))[:, :, None]

    def step(state, inp):
        q_t, k_t, v_t, g_t = inp
        b = jnp.cumsum(g_t, axis=2)
        decay = jnp.exp(jnp.where(causal, b[:, :, :, None, :] - b[:, :, None, :, :], -jnp.inf))
        attn = jnp.einsum('bhid,bhjd,bhijd->bhij', q_t, k_t, decay)
        b_last = b[:, :, -1:, :]
        o = attn @ v_t + (q_t * jnp.exp(b)) @ state
        state = (state * jnp.exp(b_last).transpose(0, 1, 3, 2)
                 + jnp.einsum('bhjd,bhje->bhde', k_t * jnp.exp(b_last - b), v_t))
        return state, o

    _, o = lax.scan(step, jnp.zeros((B, H, dk, dv), jnp.float32), (qc, kc, vc, gc))
    o = o.transpose(1, 0, 3, 2, 4).reshape(B, S, H, dv)
    o = o * lax.rsqrt(jnp.mean(o * o, axis=-1, keepdims=True) + NORM_EPS)
    o = o.reshape(B, S, H * dv) * norm_g * jax.nn.silu(r.astype(jnp.float32))
    return o.astype(q.dtype)


def _mla(c_q, c_kv, k_rope, q_norm, w_uq, kv_norm, w_ukv, positions):
    B, S, _ = c_q.shape
    H = MLA_HEADS
    q = (_rmsnorm(c_q, q_norm) @ w_uq).reshape(B, S, H, MLA_NOPE + MLA_ROPE)
    q = jnp.concatenate([q[..., :MLA_NOPE], _rope(q[..., MLA_NOPE:], positions)], axis=-1)
    kv = (_rmsnorm(c_kv, kv_norm) @ w_ukv).reshape(B, S, H, MLA_NOPE + MLA_V)
    k_pe = jnp.broadcast_to(_rope(k_rope[:, :, None, :], positions), (B, S, H, MLA_ROPE))
    k = jnp.concatenate([kv[..., :MLA_NOPE], k_pe], axis=-1)
    v = kv[..., MLA_NOPE:]
    o = _causal_attention_blocked(q.transpose(0, 2, 1, 3), k.transpose(0, 2, 1, 3), v.transpose(0, 2, 1, 3),
                                  (MLA_NOPE + MLA_ROPE) ** -0.5)
    return o.transpose(0, 2, 1, 3).reshape(B, S, H * MLA_V)


def _token_mixing(u, w_in, w_branch, w_out, cmp_pos, cmp_w1, cmp_w2,
                  rwkv_mu, rwkv_w0, rwkv_w_w2, rwkv_a0, rwkv_a_w2, rwkv_g_w2, rwkv_k_k, rwkv_k_a,
                  rwkv_r_k, rwkv_ln_w, rwkv_ln_b, gla_alpha_w2, gla_alpha_b, gla_norm_g,
                  mla_q_norm, mla_w_uq, mla_kv_norm, mla_w_ukv):
    B, S, _ = u.shape
    positions = jnp.arange(S)
    proj = u @ w_in
    p_nsa, p_rwkv, p_gla, p_mla, p_gate = _split(proj, BRANCH_SPLITS)
    nq_, kc_, vc_, ks_, vs_, kw_, vw_, gl_ = _split(p_nsa, NSA_SPLITS)
    kvh = lambda t: t.reshape(B, S, NSA_KV_HEADS, HEAD_DIM)
    y_nsa = _nsa(nq_.reshape(B, S, NSA_HEADS, HEAD_DIM), kvh(kc_), kvh(vc_), kvh(ks_), kvh(vs_),
                 kvh(kw_), kvh(vw_), gl_, cmp_pos, cmp_w1, cmp_w2, positions)
    y_rwkv = _rwkv7(p_rwkv, rwkv_mu, rwkv_w0, rwkv_w_w2, rwkv_a0, rwkv_a_w2, rwkv_g_w2,
                    rwkv_k_k, rwkv_k_a, rwkv_r_k, rwkv_ln_w, rwkv_ln_b)
    gq, gk, gv, ga, gr = _split(p_gla, GLA_SPLITS)
    y_gla = _gla(gq, gk, gv, ga, gr, gla_alpha_w2, gla_alpha_b, gla_norm_g)
    mq, mkv, mkr = _split(p_mla, MLA_SPLITS)
    y_mla = _mla(mq, mkv, mkr, mla_q_norm, mla_w_uq, mla_kv_norm, mla_w_ukv, positions)
    gates = jax.nn.sigmoid(p_gate.reshape(B, S, N_BRANCHES, D_MODEL))
    ys = (y_nsa, y_rwkv, y_gla, y_mla)
    merged = gates[:, :, 0] * (ys[0] @ w_branch[0])
    for i in range(1, N_BRANCHES):
        merged = merged + gates[:, :, i] * (ys[i] @ w_branch[i])
    return merged @ w_out


def setup_inputs(seed: int = 0) -> dict:
    key = jax.random.key(seed)
    ks = iter(jax.random.split(key, 40))
    nrm = lambda shape, s: jax.random.normal(next(ks), shape, jnp.float32) * s
    gain = lambda shape: 1.0 + nrm(shape, 0.02)
    L, D = DEPTH, D_MODEL
    return {
        'x': nrm((BATCH, SEQ, D), 1.0),
        'c': nrm((BATCH, D), 1.0),
        'ada_w': nrm((L, N_SUBLAYERS, D, 3 * D), 0.5 * D ** -0.5),
        'ada_b': nrm((L, N_SUBLAYERS, 3 * D), 0.01),
        'pre_g': gain((L, N_SUBLAYERS, D)),
        'post_g': gain((L, N_SUBLAYERS, D)),
        'ffn_wg': nrm((L, 2, D, D_FF), D ** -0.5),
        'ffn_wu': nrm((L, 2, D, D_FF), D ** -0.5),
        'ffn_wd': nrm((L, 2, D_FF, D), D_FF ** -0.5),
        'mix_w_in': nrm((L, D, PROJ_IN), D ** -0.5),
        'mix_w_branch': nrm((L, N_BRANCHES, MIX_WIDTH, D), MIX_WIDTH ** -0.5),
        'mix_w_out': nrm((L, D, D), D ** -0.5),
        'nsa_cmp_pos': nrm((L, 2, CMP_BLOCK, HEAD_DIM), 0.02),
        'nsa_cmp_w1': nrm((L, 2, CMP_BLOCK * HEAD_DIM, CMP_HIDDEN), (CMP_BLOCK * HEAD_DIM) ** -0.5),
        'nsa_cmp_w2': nrm((L, 2, CMP_HIDDEN, HEAD_DIM), CMP_HIDDEN ** -0.5),
        'rwkv_mu': jax.random.uniform(next(ks), (L, sum(RWKV_SPLITS)), jnp.float32),
        'rwkv_w0': nrm((L, RWKV_WIDTH), 0.5),
        'rwkv_w_w2': nrm((L, RWKV_DECAY_LORA, RWKV_WIDTH), RWKV_DECAY_LORA ** -0.5),
        'rwkv_a0': nrm((L, RWKV_WIDTH), 0.1),
        'rwkv_a_w2': nrm((L, RWKV_AAA_LORA, RWKV_WIDTH), 0.5 * RWKV_AAA_LORA ** -0.5),
        'rwkv_g_w2': nrm((L, RWKV_GATE_LORA, RWKV_WIDTH), RWKV_GATE_LORA ** -0.5),
        'rwkv_k_k': 0.85 + nrm((L, RWKV_WIDTH), 0.02),
        'rwkv_k_a': gain((L, RWKV_WIDTH)),
        'rwkv_r_k': nrm((L, RWKV_WIDTH), 0.1),
        'rwkv_ln_w': gain((L, RWKV_WIDTH)),
        'rwkv_ln_b': nrm((L, RWKV_WIDTH), 0.01),
        'gla_alpha_w2': nrm((L, GLA_GATE_LORA, GLA_DK), GLA_GATE_LORA ** -0.5),
        'gla_alpha_b': 1.0 + nrm((L, GLA_DK), 0.5),
        'gla_norm_g': gain((L, GLA_DV)),
        'mla_q_norm': gain((L, MLA_Q_RANK)),
        'mla_w_uq': nrm((L, MLA_Q_RANK, MLA_HEADS * (MLA_NOPE + MLA_ROPE)), MLA_Q_RANK ** -0.5),
        'mla_kv_norm': gain((L, MLA_KV_RANK)),
        'mla_w_ukv': nrm((L, MLA_KV_RANK, MLA_HEADS * (MLA_NOPE + MLA_V)), MLA_KV_RANK ** -0.5),
    }


def reference(x, c, ada_w, ada_b, pre_g, post_g, ffn_wg, ffn_wu, ffn_wd, mix_w_in, mix_w_branch,
              mix_w_out, nsa_cmp_pos, nsa_cmp_w1, nsa_cmp_w2, rwkv_mu, rwkv_w0, rwkv_w_w2, rwkv_a0,
              rwkv_a_w2, rwkv_g_w2, rwkv_k_k, rwkv_k_a, rwkv_r_k, rwkv_ln_w, rwkv_ln_b, gla_alpha_w2,
              gla_alpha_b, gla_norm_g, mla_q_norm, mla_w_uq, mla_kv_norm, mla_w_ukv):
    for l in range(DEPTH):
        x = _sandwich(x, c, lambda u: _swiglu(u, ffn_wg[l, 0], ffn_wu[l, 0], ffn_wd[l, 0]),
                      ada_w[l, 0], ada_b[l, 0], pre_g[l, 0], post_g[l, 0], MACARON_WEIGHT)
        x = _sandwich(x, c, lambda u: _token_mixing(
            u, mix_w_in[l], mix_w_branch[l], mix_w_out[l], nsa_cmp_pos[l], nsa_cmp_w1[l], nsa_cmp_w2[l],
            rwkv_mu[l], rwkv_w0[l], rwkv_w_w2[l], rwkv_a0[l], rwkv_a_w2[l], rwkv_g_w2[l], rwkv_k_k[l],
            rwkv_k_a[l], rwkv_r_k[l], rwkv_ln_w[l], rwkv_ln_b[l], gla_alpha_w2[l], gla_alpha_b[l],
            gla_norm_g[l], mla_q_norm[l], mla_w_uq[l], mla_kv_norm[l], mla_w_ukv[l]),
            ada_w[l, 1], ada_b[l, 1], pre_g[l, 1], post_g[l, 1], 1.0)
        x = _sandwich(x, c, lambda u: _swiglu(u, ffn_wg[l, 1], ffn_wu[l, 1], ffn_wd[l, 1]),
                      ada_w[l, 2], ada_b[l, 2], pre_g[l, 2], post_g[l, 2], MACARON_WEIGHT)
    return x
```

```cpp
#include <hip/hip_runtime.h>
#include <stdint.h>
#include <stdio.h>

#define LAS __attribute__((address_space(3)))
#define DI __device__ __forceinline__
typedef unsigned short bf16_t;
typedef short bf16x8 __attribute__((ext_vector_type(8)));
typedef float f32x4 __attribute__((ext_vector_type(4)));
typedef float f32x2 __attribute__((ext_vector_type(2)));
typedef unsigned u32x4 __attribute__((ext_vector_type(4)));
typedef unsigned u32x2 __attribute__((ext_vector_type(2)));

constexpr int NB = 4, SEQ = 4096, T = NB * SEQ, D = 2048, DFF = 5632;
constexpr int NP1 = 5192, NP1P = 5376, NGATE = 8192, PROJ_IN = 13384;
constexpr int C_NSA_Q = 0, C_NSA_KC = 512, C_NSA_VC = 640, C_NSA_KS = 768, C_NSA_VS = 896, C_NSA_KW = 1024, C_NSA_VW = 1152, C_NSA_GL = 1280;
constexpr int C_RW = 1304, C_RW_R = 1304, C_RW_WLO = 1816, C_RW_K = 1880, C_RW_V = 2392, C_RW_ALO = 2904, C_RW_GLO = 2968;
constexpr int C_GLA_Q = 3096, C_GLA_K = 3352, C_GLA_V = 3608, C_GLA_ALO = 4120, C_GLA_R = 4136;
constexpr int C_MLA_CQ = 4648, C_MLA_CKV = 5032, C_MLA_KR = 5160;
constexpr float NORM_EPS = 1e-6f;

DI float bf2f(bf16_t v) { return __uint_as_float(((unsigned)v) << 16); }
DI bf16_t f2bf(float f) { unsigned u = __float_as_uint(f); u += 0x7FFFu + ((u >> 16) & 1u); return (bf16_t)(u >> 16); }
typedef __bf16 bf16x2_t_ __attribute__((ext_vector_type(2)));
DI unsigned pk2(float lo, float hi) { const f32x2 v = {lo, hi}; return __builtin_bit_cast(unsigned, __builtin_convertvector(v, bf16x2_t_)); }
DI float sigmoidf_(float x) { return 1.0f / (1.0f + __expf(-x)); }
DI float wsum(float v) {
#pragma unroll
    for (int o = 32; o >= 1; o >>= 1) v += __shfl_xor(v, o);
    return v;
}
DI float wmax(float v) {
#pragma unroll
    for (int o = 32; o >= 1; o >>= 1) v = fmaxf(v, __shfl_xor(v, o));
    return v;
}

DI int TIDX() { int t = (int)threadIdx.x; asm volatile("" : "+v"(t)); return t; }
DI int BIDX() { int t = (int)blockIdx.x; asm volatile("" : "+s"(t)); return t; }
DI int NBLK() { int t = (int)gridDim.x; asm volatile("" : "+s"(t)); return t; }

struct Params {
    const float *x, *c, *ada_w, *ada_b, *pre_g, *post_g, *ffn_wg, *ffn_wu, *ffn_wd, *mix_w_in, *mix_w_branch, *mix_w_out;
    const float *cmp_pos, *cmp_w1, *cmp_w2;
    const float *rw_mu, *rw_w0, *rw_w_w2, *rw_a0, *rw_a_w2, *rw_g_w2, *rw_k_k, *rw_k_a, *rw_r_k, *rw_ln_w, *rw_ln_b;
    const float *gla_w2, *gla_b, *gla_g;
    const float *mla_qn, *mla_wuq, *mla_kvn, *mla_wukv;
    float* out;
    unsigned* bar;
    float *mod, *cos64, *sin64, *cos32, *sin32;
    bf16_t *Wup0, *Wup1, *Wdn0, *Wdn1, *Win1, *Wg, *Wbr, *Wout, *Wuq, *Wukv;
    bf16_t *u, *P1, *G;
    float* y;
    bf16_t *nsa_q, *nsa_kc_in, *nsa_vc_in, *nsa_ks, *nsa_vs, *nsa_kw, *nsa_vw;
    float *nsa_gate, *nsa_kc, *nsa_vc, *nsa_ocmp;
    unsigned long long* nsa_sel;
    bf16_t *rw_r, *rw_k, *rw_v, *rw_g;
    float *rw_w, *rw_kk, *rw_b, *rw_y;
    float *gla_la, *gla_o;
    bf16_t *mla_cqn, *mla_ckvn, *mla_kpe, *mla_q, *mla_kv;
    bf16_t* ys;
    bf16_t* mg;
};
typedef const __attribute__((address_space(4))) Params* KParamsPtr;
#define XB_TMO      128
#define XB_XCNT(j)  (256  + 64 * (j))
#define XB_XSUB(j)  (1280 + 64 * (j))
#define XB_XGEN(j)  (2304 + 64 * (j))
#define XB_TOP      3328
#define XB_TOPGEN   3392
#define XCD_BAR_WORDS 3456
#define XB_SPIN_CAP (1u << 18)

__device__ __forceinline__ unsigned xb_ld(unsigned* p)              { return __hip_atomic_load(p, __ATOMIC_RELAXED, __HIP_MEMORY_SCOPE_AGENT); }
__device__ __forceinline__ unsigned xb_add(unsigned* p, unsigned v) { return __hip_atomic_fetch_add(p, v, __ATOMIC_RELAXED, __HIP_MEMORY_SCOPE_AGENT); }
__device__ __forceinline__ unsigned xb_xcc_id() { return (unsigned)__builtin_amdgcn_s_getreg((3 << 11) | 20) & 0xFu; }
#define XB_SPIN(cond, bar) do { unsigned _sp = 0; while (cond) { __builtin_amdgcn_s_sleep(1); \
    if ((++_sp & 255u) == 0u) { if (xb_ld(&(bar)[XB_TMO])) break; if (_sp > XB_SPIN_CAP) { atomicAdd(&(bar)[XB_TMO], 1u); break; } } } } while (0)

struct XcdBarrier {
    unsigned* bar; unsigned x;
    volatile LAS unsigned* st;
};

__device__ __forceinline__ XcdBarrier xcd_barrier_post(unsigned* bar, volatile LAS unsigned* st) {
    XcdBarrier b; b.bar = bar; b.x = xb_xcc_id(); b.st = st;
    if (threadIdx.x == 0) (void)xb_add(&bar[XB_XCNT(b.x)], 1u);
    return b;
}
__device__ __forceinline__ void xcd_barrier_complete(unsigned* bar, unsigned x, unsigned& nloc, unsigned& nx) {
    const unsigned G = gridDim.x * gridDim.y * gridDim.z;
    unsigned sum, cnt, mine, sp = 0u;
    for (;;) {
        sum = 0u; cnt = 0u; mine = 0u;
#pragma unroll
        for (unsigned j = 0; j < 16; ++j) { const unsigned c = xb_ld(&bar[XB_XCNT(j)]); sum += c; cnt += (c > 0u) ? 1u : 0u; mine = (j == x) ? c : mine; }
        if (sum == G) break;
        __builtin_amdgcn_s_sleep(1);
        if ((++sp & 255u) == 0u) { if (xb_ld(&bar[XB_TMO])) break; if (sp > XB_SPIN_CAP) { atomicAdd(&bar[XB_TMO], 1u); break; } }
    }
    nloc = mine > 0u ? mine : 1u; nx = cnt > 0u ? cnt : 1u;
}

__device__ __forceinline__ void xcd_barrier(const XcdBarrier& b) {
    asm volatile("s_waitcnt vmcnt(0)" ::: "memory");
    __syncthreads();
    if (threadIdx.x == 0) {
        unsigned* bar = b.bar;
        __builtin_amdgcn_s_waitcnt(0);
        unsigned nloc = b.st[0], nx = b.st[1];
        if (nloc == 0u) { xcd_barrier_complete(bar, b.x, nloc, nx); b.st[0] = nloc; b.st[1] = nx; }
        const unsigned old = xb_add(&bar[XB_XSUB(b.x)], 1u);
        const unsigned gen = old / nloc;
        if (old + 1u == (gen + 1u) * nloc) {
            __builtin_amdgcn_fence(__ATOMIC_RELEASE, "agent");
            asm volatile("s_waitcnt vmcnt(0)" ::: "memory");
            const unsigned og = xb_add(&bar[XB_TOP], 1u);
            const unsigned tg = og / nx;
            if (og + 1u == (tg + 1u) * nx) xb_add(&bar[XB_TOPGEN], 1u);
            else XB_SPIN(xb_ld(&bar[XB_TOPGEN]) == tg, bar);
            __builtin_amdgcn_fence(__ATOMIC_ACQUIRE, "agent");
            xb_add(&bar[XB_XGEN(b.x)], 1u);
            asm volatile("s_waitcnt vmcnt(0)" ::: "memory");
        } else {
            XB_SPIN(xb_ld(&bar[XB_XGEN(b.x)]) == gen, bar);
            __builtin_amdgcn_fence(__ATOMIC_ACQUIRE, "agent");
            asm volatile("s_waitcnt vmcnt(0)" ::: "memory");
        }
    }
    __syncthreads();
}

namespace pg8 {
#define PG8_LAS __attribute__((address_space(3)))
constexpr int BM = 256, BK = 64, HALF = 128, HTB = HALF * BK * 2  , STAGE_BYTES = 8 * HTB, NXCD = 8, WGM = 8;

__host__ __device__ __forceinline__ int lds_byte(int r, int c) { const int st = (r >> 4) * 2 + (c >> 5), rr = r & 15, cc = c & 31, ob = rr * 64 + cc * 2; return st * 1024 + (ob ^ (((ob >> 9) & 1) << 5)); }
__host__ __device__ __forceinline__ void stage_rc(int b, int& R, int& C) { const int st = b / 1024, sb = b % 1024, swz = sb ^ (((sb >> 9) & 1) << 5); R = (st >> 1) * 16 + swz / 64; C = (st & 1) * 32 + (swz % 64) / 2; }
__host__ __device__ __forceinline__ int perm32(int rho) { const int n = rho >> 4, i = rho & 15; return 8 * (i >> 2) + 4 * n + (i & 3); }

struct Unit { int pm, pn; };
struct Gemm { const bf16_t* A; const bf16_t* Bt; int M, N, K, lda, ldb; };

struct StaticOrder {
    int nM, nN, nwg, G, c;
    __host__ __device__ void init(int M, int N, int G_, int c_) { nM = M / BM; nN = N / BM; nwg = nM * nN; G = G_; c = c_; }
    __host__ __device__ bool next(int i, Unit& u) const {
        const long L = (long)i * G + c; if (L >= nwg) return false;
        int wgid = (int)L; { const int q = nwg / NXCD, r = nwg % NXCD, xcd = wgid % NXCD, off = wgid / NXCD; wgid = (xcd < r ? xcd * (q + 1) : r * (q + 1) + (xcd - r) * q) + off; }
        const int nig = WGM * nN, gid = wgid / nig, fm = gid * WGM, gsz = (nM - fm) < WGM ? (nM - fm) : WGM;
        u.pm = fm + ((wgid % nig) % gsz); u.pn = (wgid % nig) / gsz; return true;
    }
    __device__ __forceinline__ void a_ready(const Unit&) const {}
    __device__ __forceinline__ void done(const Unit&) const {}
};
struct CountedOrder : StaticOrder {
    const unsigned* ready; unsigned need; unsigned* tmo;
    __device__ __forceinline__ void a_ready(const Unit& u) const {
        if (TIDX() < 64) {
            const unsigned long long t0 = __builtin_amdgcn_s_memrealtime(); unsigned polls = 0;
            while ((unsigned)__builtin_amdgcn_readfirstlane(__hip_atomic_load(ready + 64 * u.pm, __ATOMIC_RELAXED, __HIP_MEMORY_SCOPE_AGENT)) < need) {
                if ((++polls & 255u) == 0u && __builtin_amdgcn_readfirstlane(__hip_atomic_load(tmo, __ATOMIC_RELAXED, __HIP_MEMORY_SCOPE_AGENT)) != 0u) break;
                if (__builtin_amdgcn_s_memrealtime() - t0 > 2000000ull) {
                    if (TIDX() == 0) { unsigned expect = 0u; __hip_atomic_compare_exchange_strong(tmo + 1, &expect, 0x600u | (unsigned)(u.pm & 0xff), __ATOMIC_RELAXED, __ATOMIC_RELAXED, __HIP_MEMORY_SCOPE_AGENT); __hip_atomic_store(tmo, 1u, __ATOMIC_RELAXED, __HIP_MEMORY_SCOPE_AGENT); }
                    break; }
                __builtin_amdgcn_s_sleep(2); }
            __builtin_amdgcn_fence(__ATOMIC_ACQUIRE, "agent");
            asm volatile("s_waitcnt vmcnt(0)" ::: "memory");
        }
#if !defined(BROKEN_HOOK_NO_BARRIER)
        asm volatile("" ::: "memory"); __builtin_amdgcn_s_barrier(); asm volatile("" ::: "memory");
#endif
    }
};


template <class Epi, class Sched, bool STAMP = false>
__device__ __forceinline__ void gemm_phase(PG8_LAS unsigned char* lds, const Gemm g, const Sched& S, const Epi& E, unsigned long long* stamps) {
    const int tid = TIDX(), wid = __builtin_amdgcn_readfirstlane(tid >> 6), lane = tid & 63, wr = wid >> 2, wc = wid & 3, fr = lane & 15, fq = lane >> 4;
    const int K = g.K, nt = K / BK;
    int ts_lo = 0, ts_hi = 0, nts = 0; const unsigned long long rt_entry = STAMP ? (unsigned long long)wall_clock64() : 0ull;
#define PG8_STAMP() do { if (STAMP && wid == 0 && nts < 64) { const unsigned long long _c = (unsigned long long)clock64(); \
        ts_lo = (lane == nts) ? (int)(unsigned)_c : ts_lo; ts_hi = (lane == nts) ? (int)(unsigned)(_c >> 32) : ts_hi; ++nts; } } while (0)
    PG8_STAMP();
    unsigned voffA[2], voffB[2];
#pragma unroll
    for (int i = 0; i < 2; ++i) { int R, C; stage_rc(tid * 16 + i * 8192, R, C); const int Rb = Epi::PERM ? ((R & ~31) + perm32(R & 31)) : R;
        voffA[i] = (unsigned)(R * g.lda + C) * 2u; voffB[i] = (unsigned)(Rb * g.ldb + C) * 2u; }
    const size_t kstep = (size_t)(BK * 2);
    const size_t hstepA = (size_t)HALF * g.lda * 2, hstepB = (size_t)HALF * g.ldb * 2;
    const size_t tstepA = 2 * hstepA, tstepB = 2 * hstepB;
    const unsigned ldsw = (unsigned)wid * 1024u;
    const int aoff = lds_byte(wr * 64 + fr, fq * 8), boff = lds_byte(wc * 32 + fr, fq * 8);
#define PG8_SA(b, h) (((b) * 2 + (h)) * HTB)
#define PG8_SB(b, h) ((4 + (b) * 2 + (h)) * HTB)
#define PG8_STAGE(bufoff, gbase, voff) do { _Pragma("unroll") for (int _i = 0; _i < 2; ++_i) \
        __builtin_amdgcn_global_load_lds((const unsigned*)((const char*)(gbase) + (voff)[_i]), (PG8_LAS unsigned*)(lds + (bufoff) + ldsw + _i * 8192), 16, 0, 0); } while (0)
#define PG8_LDA(dst, b, h) do { _Pragma("unroll") for (int m = 0; m < 4; ++m) _Pragma("unroll") for (int k = 0; k < 2; ++k) dst[m][k] = *(const PG8_LAS bf16x8*)(lds + PG8_SA(b, h) + aoff + m * 2048 + k * 1024); } while (0)
#define PG8_LDB(dst, b, h) do { _Pragma("unroll") for (int n = 0; n < 2; ++n) _Pragma("unroll") for (int k = 0; k < 2; ++k) dst[n][k] = *(const PG8_LAS bf16x8*)(lds + PG8_SB(b, h) + boff + n * 2048 + k * 1024); } while (0)
#define PG8_MMA(ai, bj, At, Bt) do { __builtin_amdgcn_s_setprio(1); _Pragma("unroll") for (int m = 0; m < 4; ++m) _Pragma("unroll") for (int n = 0; n < 2; ++n) _Pragma("unroll") for (int k = 0; k < 2; ++k) \
        acc[ai][bj][m][n] = __builtin_amdgcn_mfma_f32_16x16x32_bf16(Bt[n][k], At[m][k], acc[ai][bj][m][n], 0, 0, 0); __builtin_amdgcn_s_setprio(0); } while (0)
#define PG8_WAIT_V(n) asm volatile("s_waitcnt vmcnt(" #n ")" ::: "memory")
#define PG8_WAIT_L(n) asm volatile("s_waitcnt lgkmcnt(" #n ")" ::: "memory")
#define PG8_BAR __builtin_amdgcn_s_barrier()
#define PG8_SCHED __builtin_amdgcn_sched_barrier(0)
    Unit cur, nxt; int ui = 0;
    if (!S.next(0, cur)) return;
    f32x4 acc[2][2][4][2];
#pragma unroll
    for (int a = 0; a < 2; ++a)
#pragma unroll
        for (int b = 0; b < 2; ++b)
#pragma unroll
            for (int m = 0; m < 4; ++m)
#pragma unroll
                for (int n = 0; n < 2; ++n) acc[a][b][m][n] = (f32x4){0.f, 0.f, 0.f, 0.f};
    bf16x8 At[4][2], B0[2][2], B1[2][2];
    const char* cA = (const char*)g.A + (size_t)cur.pm * tstepA; const char* cB = (const char*)g.Bt + (size_t)cur.pn * tstepB;
    S.a_ready(cur);
    PG8_STAGE(PG8_SB(0, 0), cB, voffB); PG8_STAGE(PG8_SA(0, 0), cA, voffA); PG8_STAGE(PG8_SB(0, 1), cB + hstepB, voffB); PG8_STAGE(PG8_SA(0, 1), cA + hstepA, voffA);
    if (wr == 1) PG8_BAR;
    PG8_WAIT_V(4); PG8_BAR;
    PG8_STAGE(PG8_SB(1, 0), cB + kstep, voffB); PG8_STAGE(PG8_SA(1, 0), cA + kstep, voffA); PG8_STAGE(PG8_SB(1, 1), cB + hstepB + kstep, voffB);
    PG8_WAIT_V(6); PG8_BAR;
    PG8_STAMP();
    for (;;) {
        const bool has_next = S.next(ui + 1, nxt);
        const char* nA = has_next ? (const char*)g.A + (size_t)nxt.pm * tstepA : cA; const char* nB = has_next ? (const char*)g.Bt + (size_t)nxt.pn * tstepB : cB;
        for (int t = 0; t < nt; t += 2) {
            const bool last = (t == nt - 2);
            const char* a1 = cA + (size_t)(t + 1) * kstep;
            const char* a2 = last ? nA : cA + (size_t)(t + 2) * kstep; const char* b2 = last ? nB : cB + (size_t)(t + 2) * kstep;
            const char* a3 = a2 + kstep; const char* b3 = b2 + kstep;
            if (last && has_next) S.a_ready(nxt);
            PG8_LDB(B0, 0, 0); PG8_SCHED; PG8_LDA(At, 0, 0); PG8_STAGE(PG8_SA(1, 1), a1 + hstepA, voffA);
            PG8_WAIT_L(8); PG8_BAR; PG8_WAIT_L(0); PG8_MMA(0, 0, At, B0); PG8_BAR; PG8_SCHED;
            PG8_LDB(B1, 0, 1); PG8_STAGE(PG8_SB(0, 0), b2, voffB);
            PG8_BAR; PG8_WAIT_L(0); PG8_MMA(0, 1, At, B1); PG8_BAR;
            PG8_LDA(At, 0, 1); PG8_STAGE(PG8_SA(0, 0), a2, voffA);
            PG8_BAR; PG8_WAIT_L(0); PG8_MMA(1, 0, At, B0); PG8_BAR; PG8_SCHED;
            PG8_STAGE(PG8_SB(0, 1), b2 + hstepB, voffB);
            PG8_WAIT_V(6); PG8_BAR; PG8_MMA(1, 1, At, B1); PG8_BAR;
            PG8_LDB(B0, 1, 0); PG8_SCHED; PG8_LDA(At, 1, 0); PG8_STAGE(PG8_SA(0, 1), a2 + hstepA, voffA);
            PG8_WAIT_L(8); PG8_BAR; PG8_WAIT_L(0); PG8_MMA(0, 0, At, B0); PG8_BAR; PG8_SCHED;
            PG8_LDB(B1, 1, 1); PG8_STAGE(PG8_SB(1, 0), b3, voffB);
            PG8_BAR; PG8_WAIT_L(0); PG8_MMA(0, 1, At, B1); PG8_BAR;
            PG8_LDA(At, 1, 1); PG8_STAGE(PG8_SA(1, 0), a3, voffA);
            PG8_BAR; PG8_WAIT_L(0); PG8_MMA(1, 0, At, B0); PG8_BAR; PG8_SCHED;
            PG8_STAGE(PG8_SB(1, 1), b3 + hstepB, voffB);
            PG8_WAIT_V(6); PG8_BAR; PG8_MMA(1, 1, At, B1); PG8_BAR;
        }
        PG8_STAMP();
        if constexpr (!Epi::AFTER_DRAIN) { E(acc, cur, wr, wc, fr, fq); S.done(cur); }
        PG8_STAMP();
        if (!has_next) break;
#pragma unroll
        for (int a = 0; a < 2; ++a)
#pragma unroll
            for (int b = 0; b < 2; ++b)
#pragma unroll
                for (int m = 0; m < 4; ++m)
#pragma unroll
                    for (int n = 0; n < 2; ++n) acc[a][b][m][n] = (f32x4){0.f, 0.f, 0.f, 0.f};
        cur = nxt; cA = nA; cB = nB; ++ui;
    }
    PG8_WAIT_V(0);
    if (wr == 0) PG8_BAR;
    PG8_BAR;
    if constexpr (Epi::AFTER_DRAIN) { E.fused(acc, cur, wr, wc, fr, fq, lds, wid, lane); S.done(cur); }
    PG8_STAMP();
    if (STAMP && wid == 0) { stamps[lane] = lane < nts ? (((unsigned long long)(unsigned)ts_hi << 32) | (unsigned)ts_lo) : 0ull;
        if (lane == 62) stamps[62] = rt_entry; if (lane == 63) stamps[63] = (unsigned long long)wall_clock64(); }
#undef PG8_STAMP
#undef PG8_SA
#undef PG8_SB
#undef PG8_STAGE
#undef PG8_LDA
#undef PG8_LDB
#undef PG8_MMA
#undef PG8_WAIT_V
#undef PG8_WAIT_L
#undef PG8_BAR
#undef PG8_SCHED
}
}
typedef __bf16 bf16x2_n __attribute__((ext_vector_type(2)));
DI unsigned cvt_pk_bf16(float lo, float hi) { const f32x2 v = {lo, hi}; return __builtin_bit_cast(unsigned, __builtin_convertvector(v, bf16x2_n)); }
DI float fast_sigmoid(float x) { return __builtin_amdgcn_rcpf(1.0f + __expf(-x)); }

struct EpiF32 {
    static constexpr bool PERM = false, AFTER_DRAIN = false;
    float* C; int ldc;
    DI void operator()(const f32x4 (&acc)[2][2][4][2], const pg8::Unit& u, int wr, int wc, int fr, int fq) const {
        const int row0 = u.pm * 256 + wr * 64 + fr, col0 = u.pn * 256 + wc * 32 + 4 * fq;
#pragma unroll
        for (int ai = 0; ai < 2; ++ai)
#pragma unroll
            for (int m = 0; m < 4; ++m) { float* rowp = C + (size_t)(row0 + ai * 128 + m * 16) * ldc + col0;
#pragma unroll
                for (int bj = 0; bj < 2; ++bj)
#pragma unroll
                    for (int n = 0; n < 2; ++n) *(f32x4*)(rowp + bj * 128 + n * 16) = acc[ai][bj][m][n]; }
    }
};
template <int ACT  > struct EpiBf16 {
    static constexpr bool PERM = true, AFTER_DRAIN = false;
    bf16_t* O; int ldc;
    DI void operator()(const f32x4 (&acc)[2][2][4][2], const pg8::Unit& u, int wr, int wc, int fr, int fq) const {
        const int row0 = u.pm * 256 + wr * 64 + fr, col0 = u.pn * 256 + wc * 32 + 8 * fq;
#pragma unroll
        for (int ai = 0; ai < 2; ++ai)
#pragma unroll
            for (int m = 0; m < 4; ++m) { bf16_t* rowp = O + (size_t)(row0 + ai * 128 + m * 16) * ldc + col0;
#pragma unroll
                for (int bj = 0; bj < 2; ++bj) { f32x4 v0 = acc[ai][bj][m][0], v1 = acc[ai][bj][m][1];
#if defined(NOISE_P1)
                    if (ACT == 0) { unsigned hsh = (unsigned)(row0 + ai * 128 + m * 16) * 2654435761u ^ (unsigned)(col0 + bj * 128) * 40503u;
#pragma unroll
                        for (int j = 0; j < 4; ++j) { hsh = hsh * 1664525u + 1013904223u; v0[j] *= 1.0f + NOISE_P1 * ((float)(hsh >> 8) * (1.0f / 8388608.0f) - 1.0f); hsh = hsh * 1664525u + 1013904223u; v1[j] *= 1.0f + NOISE_P1 * ((float)(hsh >> 8) * (1.0f / 8388608.0f) - 1.0f); } }
#endif
                    if (ACT == 1) {
#pragma unroll
                        for (int j = 0; j < 4; ++j) { v0[j] = fast_sigmoid(v0[j]); v1[j] = fast_sigmoid(v1[j]); } }
                    u32x4 w; w.x = cvt_pk_bf16(v0[0], v0[1]); w.y = cvt_pk_bf16(v0[2], v0[3]); w.z = cvt_pk_bf16(v1[0], v1[1]); w.w = cvt_pk_bf16(v1[2], v1[3]);
                    *(u32x4*)(rowp + bj * 128) = w; } }
    }
};
struct EpiSwiglu {
    static constexpr bool PERM = true, AFTER_DRAIN = false;
    bf16_t* H; int ldc;
    DI void operator()(const f32x4 (&acc)[2][2][4][2], const pg8::Unit& u, int wr, int wc, int fr, int fq) const {
        const int row0 = u.pm * 256 + wr * 64 + fr, col0 = u.pn * 128 + wc * 32 + 8 * fq;
#pragma unroll
        for (int ai = 0; ai < 2; ++ai)
#pragma unroll
            for (int m = 0; m < 4; ++m) { bf16_t* rowp = H + (size_t)(row0 + ai * 128 + m * 16) * ldc + col0;
                float h[8];
#pragma unroll
                for (int n = 0; n < 2; ++n)
#pragma unroll
                    for (int j = 0; j < 4; ++j) { const float g = acc[ai][0][m][n][j], up = acc[ai][1][m][n][j]; h[n * 4 + j] = g * fast_sigmoid(g) * up; }
                u32x4 w; w.x = cvt_pk_bf16(h[0], h[1]); w.y = cvt_pk_bf16(h[2], h[3]); w.z = cvt_pk_bf16(h[4], h[5]); w.w = cvt_pk_bf16(h[6], h[7]);
                *(u32x4*)rowp = w; }
    }
};
struct EpiPart {
    static constexpr bool PERM = true, AFTER_DRAIN = false;
    bf16_t* part01; bf16_t* part23;
    DI void operator()(const f32x4 (&acc)[2][2][4][2], const pg8::Unit& u, int wr, int wc, int fr, int fq) const {
        const int br = u.pm >> 6, pm = u.pm & 63, pn = u.pn & 7;
        bf16_t* O = (br < 2 ? part01 : part23) + (size_t)(br & 1) * T * 2048;
        const int row0 = pm * 256 + wr * 64 + fr, col0 = pn * 256 + wc * 32 + 8 * fq;
#pragma unroll
        for (int ai = 0; ai < 2; ++ai)
#pragma unroll
            for (int m = 0; m < 4; ++m) { bf16_t* rowp = O + (size_t)(row0 + ai * 128 + m * 16) * 2048 + col0;
#pragma unroll
                for (int bj = 0; bj < 2; ++bj) { const f32x4 v0 = acc[ai][bj][m][0], v1 = acc[ai][bj][m][1];
                    u32x4 w; w.x = cvt_pk_bf16(v0[0], v0[1]); w.y = cvt_pk_bf16(v0[2], v0[3]); w.z = cvt_pk_bf16(v1[0], v1[1]); w.w = cvt_pk_bf16(v1[2], v1[3]);
                    *(u32x4*)(rowp + bj * 128) = w; } }
    }
};
struct MergeOrder {
    int G, c;
    DI bool next(int i, pg8::Unit& u) const {
        const int ti = i >> 2, br = i & 3; const int tile = ti * G + c; if (tile >= 512) return false;
        u.pm = br * 64 + (tile >> 3); u.pn = br * 8 + (tile & 7); return true;
    }
    DI void a_ready(const pg8::Unit&) const {}
    DI void done(const pg8::Unit&) const {}
};

template <class Epi>
DI void run_gemm(LAS unsigned char* lds, const bf16_t* A, int lda, const bf16_t* Bt, int ldb, int M, int N, int K, const Epi& E) {
    pg8::Gemm g; g.A = A; g.Bt = Bt; g.M = M; g.N = N; g.K = K; g.lda = lda; g.ldb = ldb;
    pg8::StaticOrder S; S.init(M, N, NBLK(), BIDX());
    pg8::gemm_phase<Epi, pg8::StaticOrder, false>((PG8_LAS unsigned char*)lds, g, S, E, nullptr);
}
#ifndef ZRWKV
#define ZRWKV 1.0f
#endif
#ifndef ZGLA
#define ZGLA 1.0f
#endif
DI void phase_setup(KParamsPtr p, LAS unsigned char* lds) {
    const int tid = TIDX(), bid = BIDX(), nb = NBLK();
    for (int i = bid * 512 + tid; i < SEQ * 48; i += nb * 512) {
        const int pos = i / 48, j = i % 48;
        const bool big = j < 32; const int jj = big ? j : j - 32;
        const double inv = exp2(-(double)jj * (13.287712379549449 / (big ? 32.0 : 16.0)));
        const double a = (double)pos * inv;
        const double r = a - 6.283185307179586 * floor(a / 6.283185307179586);
        const float cs = (float)cos(r), sn = (float)sin(r);
        if (big) { p->cos64[pos * 32 + jj] = cs; p->sin64[pos * 32 + jj] = sn; } else { p->cos32[pos * 16 + jj] = cs; p->sin32[pos * 16 + jj] = sn; }
    }
    LAS float* sc = (LAS float*)lds;
    LAS float* red = (LAS float*)(lds + 32768);
    for (int i = tid; i < NB * D; i += 512) { const float c = p->c[i]; sc[i] = c / (1.0f + __expf(-c)); }
    __syncthreads();
    const int cg = tid & 15, ks = tid >> 4;
    for (int chunk = bid; chunk < 576; chunk += nb) {
        const int ls = chunk / 96, col0 = (chunk % 96) * 64;
        const float* W = p->ada_w + (size_t)ls * D * 6144 + col0 + cg * 4;
        float acc[4][4];
#pragma unroll
        for (int b = 0; b < 4; ++b)
#pragma unroll
            for (int j = 0; j < 4; ++j) acc[b][j] = 0.f;
#pragma unroll 4
        for (int kk = 0; kk < 64; ++kk) {
            const int k = ks * 64 + kk;
            const f32x4 w = *(const f32x4*)(W + (size_t)k * 6144);
#pragma unroll
            for (int b = 0; b < 4; ++b) { const float s = sc[b * D + k];
#pragma unroll
                for (int j = 0; j < 4; ++j) acc[b][j] += s * w[j]; }
        }
#pragma unroll
        for (int b = 0; b < 4; ++b)
#pragma unroll
            for (int j = 0; j < 4; ++j) red[(ks * 4 + b) * 64 + cg * 4 + j] = acc[b][j];
        __syncthreads();
        if (tid < 256) { const int b = tid >> 6, col = tid & 63; float s = 0.f;
            for (int q = 0; q < 32; ++q) s += red[(q * 4 + b) * 64 + col];
            p->mod[(size_t)(ls * 4 + b) * 6144 + col0 + col] = s + p->ada_b[ls * 6144 + col0 + col]; }
        __syncthreads();
    }
}

template <class Map>
DI void conv_job(const float* src, int Ks, int Ns, const float* kscale, bf16_t* dst, int ldd, Map map, LAS float* tl) {
    const int tid = TIDX(), bid = BIDX(), nb = NBLK();
    const int ntk = Ks / 64, ntn = (Ns + 63) / 64, nt = ntk * ntn;
    for (int tile = bid; tile < nt; tile += nb) {
        const int k0 = (tile % ntk) * 64, n0 = (tile / ntk) * 64;
#pragma unroll
        for (int it = 0; it < 2; ++it) {
            const int kr = (tid >> 4) + 32 * it, n = n0 + 4 * (tid & 15);
            f32x4 v = (f32x4){0.f, 0.f, 0.f, 0.f};
            if (n < Ns) v = *(const f32x4*)(src + (size_t)(k0 + kr) * Ns + n);
            if (kscale) v *= kscale[k0 + kr];
#pragma unroll
            for (int j = 0; j < 4; ++j) tl[kr * 65 + 4 * (tid & 15) + j] = v[j];
        }
        __syncthreads();
        { const int nn = tid >> 3, k8 = tid & 7, n = n0 + nn;
            if (n < Ns) { float f[8];
#pragma unroll
                for (int i = 0; i < 8; ++i) f[i] = tl[(k8 * 8 + i) * 65 + nn];
                u32x4 w; w.x = pk2(f[0], f[1]); w.y = pk2(f[2], f[3]); w.z = pk2(f[4], f[5]); w.w = pk2(f[6], f[7]);
                *(u32x4*)(dst + (size_t)map(n) * ldd + k0 + k8 * 8) = w; } }
        __syncthreads();
    }
}
DI void phase_convert(KParamsPtr p, int l, LAS unsigned char* lds) {
    LAS float* tl = (LAS float*)lds;
    const int tid = TIDX(), bid = BIDX(), nb = NBLK();
    const size_t fsz = (size_t)D * DFF;
    for (int f = 0; f < 2; ++f) {
        bf16_t* Wup = f ? p->Wup1 : p->Wup0; bf16_t* Wdn = f ? p->Wdn1 : p->Wdn0;
        conv_job(p->ffn_wg + (size_t)(l * 2 + f) * fsz, D, DFF, nullptr, Wup, D, [](int n) { return 256 * (n >> 7) + (n & 127); }, tl);
        conv_job(p->ffn_wu + (size_t)(l * 2 + f) * fsz, D, DFF, nullptr, Wup, D, [](int n) { return 256 * (n >> 7) + 128 + (n & 127); }, tl);
        conv_job(p->ffn_wd + (size_t)(l * 2 + f) * fsz, DFF, D, nullptr, Wdn, DFF, [](int n) { return n; }, tl);
    }
    conv_job(p->mix_w_in + (size_t)l * D * PROJ_IN, D, PROJ_IN, nullptr, p->Win1, D, [](int n) { return n < NP1 ? n : n - NP1 + NP1P; }, tl);
    for (int i = 0; i < 4; ++i)
        conv_job(p->mix_w_branch + (size_t)(l * 4 + i) * 512 * D, 512, D, nullptr, p->Wbr + (size_t)i * D * 512, 512, [](int n) { return n; }, tl);
    conv_job(p->mix_w_out + (size_t)l * D * D, D, D, nullptr, p->Wout, D, [](int n) { return n; }, tl);
    conv_job(p->mla_wuq + (size_t)l * 384 * 768, 384, 768, p->mla_qn + l * 384, p->Wuq, 384, [](int n) { return n; }, tl);
    conv_job(p->mla_wukv + (size_t)l * 128 * 1024, 128, 1024, p->mla_kvn + l * 128, p->Wukv, 256, [](int n) { return n; }, tl);
    for (int i = bid * 512 + tid; i < (NP1P - NP1) * D / 8; i += nb * 512) ((u32x4*)(p->Win1 + (size_t)NP1 * D))[i] = (u32x4){0u, 0u, 0u, 0u};
    for (int i = bid * 512 + tid; i < 1024 * 16; i += nb * 512) { const int r = i >> 4, c8 = i & 15; *(u32x4*)(p->Wukv + (size_t)r * 256 + 128 + c8 * 8) = (u32x4){0u, 0u, 0u, 0u}; }
}

template <bool HAS_Y, bool HAS_U>
DI void phase_norm(const float* xin, const float* y, float* xout, bf16_t* u, const float* g_post, const float* modPrev, float rw, const float* g_pre, const float* modNext) {
    const int tid = TIDX(), lane = tid & 63, wave = tid >> 6;
    for (int row = BIDX() * 8 + wave; row < T; row += NBLK() * 8) {
        const int b = row >> 12;
        f32x4 xv[8];
#pragma unroll
        for (int i = 0; i < 8; ++i) xv[i] = *(const f32x4*)(xin + (size_t)row * D + i * 256 + lane * 4);
        if (HAS_Y) {
            f32x4 yv[8]; float ss = 0.f;
#pragma unroll
            for (int i = 0; i < 8; ++i) { yv[i] = *(const f32x4*)(y + (size_t)row * D + i * 256 + lane * 4); ss += yv[i][0] * yv[i][0] + yv[i][1] * yv[i][1] + yv[i][2] * yv[i][2] + yv[i][3] * yv[i][3]; }
            ss = wsum(ss);
            const float rs = rsqrtf(ss * (1.0f / D) + NORM_EPS) * rw;
#pragma unroll
            for (int i = 0; i < 8; ++i) { const int col = i * 256 + lane * 4;
                const f32x4 gp = *(const f32x4*)(g_post + col), gt = *(const f32x4*)(modPrev + (size_t)b * 6144 + 4096 + col);
                xv[i] += gt * (yv[i] * rs * gp);
                *(f32x4*)(xout + (size_t)row * D + col) = xv[i]; }
        }
        if (HAS_U) {
            float ss = 0.f;
#pragma unroll
            for (int i = 0; i < 8; ++i) ss += xv[i][0] * xv[i][0] + xv[i][1] * xv[i][1] + xv[i][2] * xv[i][2] + xv[i][3] * xv[i][3];
            ss = wsum(ss);
            const float rs = rsqrtf(ss * (1.0f / D) + NORM_EPS);
#pragma unroll
            for (int i = 0; i < 8; ++i) { const int col = i * 256 + lane * 4;
                const f32x4 gp = *(const f32x4*)(g_pre + col), sh = *(const f32x4*)(modNext + (size_t)b * 6144 + col), scl = *(const f32x4*)(modNext + (size_t)b * 6144 + 2048 + col);
                const f32x4 uu = (xv[i] * rs * gp) * (scl + 1.0f) + sh;
                u32x2 w; w.x = pk2(uu[0], uu[1]); w.y = pk2(uu[2], uu[3]);
                *(u32x2*)(u + (size_t)row * D + col) = w; }
        }
    }
}

DI float ldP(const bf16_t* P1, int t, int col) { return bf2f(P1[(size_t)t * NP1P + col]); }
DI void phase_prep(KParamsPtr p, int l, LAS unsigned char* lds) {
    constexpr int TT = 8;
    const int tid = TIDX(), lane = tid & 63, wave = tid >> 6;
    LAS float* wl = (LAS float*)lds;
    LAS float* al = wl + TT * 64;
    LAS float* gl = al + TT * 64;
    LAS float* ga = gl + TT * 128;
    LAS float* rsq = ga + TT * 16;
    const bf16_t* P1 = p->P1;
    const float* mu = p->rw_mu + l * 1792;
    const float* w_w2 = p->rw_w_w2 + l * 64 * 512; const float* a_w2 = p->rw_a_w2 + l * 64 * 512; const float* g_w2 = p->rw_g_w2 + l * 128 * 512;
    for (int tile = BIDX(); tile < T / TT; tile += NBLK()) {
        const int t0 = tile * TT;
        for (int i = tid; i < TT * 256; i += 512) {
            const int tt = i >> 8, c = i & 255, t = t0 + tt, s = t & (SEQ - 1);
            const int col = c < 64 ? C_RW_WLO + c : (c < 128 ? C_RW_ALO + (c - 64) : C_RW_GLO + (c - 128));
            const float pv = ldP(P1, t, col), pp = s > 0 ? ldP(P1, t - 1, col) : 0.f;
            const float xs = pv + (pp - pv) * mu[col - C_RW];
            if (c < 64) wl[tt * 64 + c] = tanhf(xs); else if (c < 128) al[tt * 64 + c - 64] = xs; else gl[tt * 128 + c - 128] = sigmoidf_(xs);
        }
        if (tid < TT * 16) ga[tid] = ldP(P1, t0 + (tid >> 4), C_GLA_ALO + (tid & 15));
        { const int t = t0 + wave; float sq = 0.f, skv = 0.f;
#pragma unroll
            for (int i = 0; i < 6; ++i) { const float v = ldP(P1, t, C_MLA_CQ + i * 64 + lane); sq += v * v; }
#pragma unroll
            for (int i = 0; i < 2; ++i) { const float v = ldP(P1, t, C_MLA_CKV + i * 64 + lane); skv += v * v; }
            sq = wsum(sq); skv = wsum(skv);
            if (lane == 0) { rsq[wave * 2] = rsqrtf(sq * (1.0f / 384.0f) + NORM_EPS); rsq[wave * 2 + 1] = rsqrtf(skv * (1.0f / 128.0f) + NORM_EPS); } }
        __syncthreads();
        { const int j = tid;
            float aw[TT], aa[TT], ag[TT];
            const float w0 = p->rw_w0[l * 512 + j], a0 = p->rw_a0[l * 512 + j];
#pragma unroll
            for (int tt = 0; tt < TT; ++tt) { aw[tt] = w0; aa[tt] = a0; ag[tt] = 0.f; }
            for (int i = 0; i < 64; ++i) { const float ww = w_w2[i * 512 + j], wa = a_w2[i * 512 + j];
#pragma unroll
                for (int tt = 0; tt < TT; ++tt) { aw[tt] += wl[tt * 64 + i] * ww; aa[tt] += al[tt * 64 + i] * wa; } }
            for (int i = 0; i < 128; ++i) { const float wg = g_w2[i * 512 + j];
#pragma unroll
                for (int tt = 0; tt < TT; ++tt) ag[tt] += gl[tt * 128 + i] * wg; }
            const float k_k = p->rw_k_k[l * 512 + j], k_a = p->rw_k_a[l * 512 + j];
            const float mur = mu[C_RW_R - C_RW + j], muk = mu[C_RW_K - C_RW + j], muv = mu[C_RW_V - C_RW + j];
#pragma unroll
            for (int tt = 0; tt < TT; ++tt) {
                const int t = t0 + tt, s = t & (SEQ - 1);
                float xr = ldP(P1, t, C_RW_R + j), xk = ldP(P1, t, C_RW_K + j), xv = ldP(P1, t, C_RW_V + j);
                const float pr = s > 0 ? ldP(P1, t - 1, C_RW_R + j) : 0.f, pk = s > 0 ? ldP(P1, t - 1, C_RW_K + j) : 0.f, pvv = s > 0 ? ldP(P1, t - 1, C_RW_V + j) : 0.f;
                xr += (pr - xr) * mur; xk += (pk - xk) * muk; xv += (pvv - xv) * muv;
                const float w = __expf(-0.6065306597126334f * sigmoidf_(aw[tt]));
                const float a = sigmoidf_(aa[tt]);
                const float kkr = xk * k_k;
                const float ss = wsum(kkr * kkr);
                const float kk = kkr / fmaxf(sqrtf(ss), 1e-12f);
                const float k2 = xk * (1.0f + (a - 1.0f) * k_a);
                const size_t o = (size_t)t * 512 + j;
                p->rw_r[o] = f2bf(xr); p->rw_w[o] = w; p->rw_k[o] = f2bf(k2); p->rw_v[o] = f2bf(xv); p->rw_kk[o] = kk; p->rw_b[o] = kk * a; p->rw_g[o] = f2bf(ag[tt]);
            } }
        for (int tt = 0; tt < TT; ++tt) {
            const int t = t0 + tt, s = t & (SEQ - 1), b = t >> 12;
            if (tid < 256) { const int h = tid >> 5, i = tid & 31;
                const float x1 = ldP(P1, t, C_NSA_Q + h * 64 + i), x2 = ldP(P1, t, C_NSA_Q + h * 64 + 32 + i), cs = p->cos64[s * 32 + i], sn = p->sin64[s * 32 + i];
                p->nsa_q[(size_t)t * 512 + h * 64 + i] = f2bf(x1 * cs - x2 * sn); p->nsa_q[(size_t)t * 512 + h * 64 + 32 + i] = f2bf(x1 * sn + x2 * cs);
            } else if (tid < 448) { const int r = tid - 256, which = r >> 6, hk = (r >> 5) & 1, i = r & 31;
                const int sc = (which == 0 ? C_NSA_KC : (which == 1 ? C_NSA_KS : C_NSA_KW)) + hk * 64;
                bf16_t* dst = which == 0 ? p->nsa_kc_in : (which == 1 ? p->nsa_ks : p->nsa_kw);
                const float x1 = ldP(P1, t, sc + i), x2 = ldP(P1, t, sc + 32 + i), cs = p->cos64[s * 32 + i], sn = p->sin64[s * 32 + i];
                const size_t o = ((size_t)(b * 2 + hk) * SEQ + s) * 64;
                dst[o + i] = f2bf(x1 * cs - x2 * sn); dst[o + 32 + i] = f2bf(x1 * sn + x2 * cs);
            } else if (tid < 472) { const int g = tid - 448; p->nsa_gate[(size_t)t * 24 + g] = sigmoidf_(ldP(P1, t, C_NSA_GL + g)); }
            if (tid < 384) { const int which = tid >> 7, hk = (tid >> 6) & 1, d = tid & 63;
                const int sc = (which == 0 ? C_NSA_VC : (which == 1 ? C_NSA_VS : C_NSA_VW)) + hk * 64;
                bf16_t* dst = which == 0 ? p->nsa_vc_in : (which == 1 ? p->nsa_vs : p->nsa_vw);
                dst[((size_t)(b * 2 + hk) * SEQ + s) * 64 + d] = P1[(size_t)t * NP1P + sc + d]; }
        }
        for (int i = tid; i < TT * 256; i += 512) {
            const int tt = i >> 8, d = i & 255;
            float z = p->gla_b[l * 256 + d];
#pragma unroll
            for (int q = 0; q < 16; ++q) z += ga[tt * 16 + q] * p->gla_w2[(l * 16 + q) * 256 + d];
            const float ls = z >= 0.f ? -log1pf(__expf(-z)) : z - log1pf(__expf(z));
            p->gla_la[(size_t)(t0 + tt) * 256 + d] = ls * (1.0f / 16.0f);
        }
        for (int i = tid; i < TT * 384; i += 512) { const int tt = i / 384, c = i % 384; p->mla_cqn[(size_t)(t0 + tt) * 384 + c] = f2bf(ldP(P1, t0 + tt, C_MLA_CQ + c) * rsq[tt * 2]); }
        for (int i = tid; i < TT * 256; i += 512) { const int tt = i >> 8, c = i & 255; p->mla_ckvn[(size_t)(t0 + tt) * 256 + c] = c < 128 ? f2bf(ldP(P1, t0 + tt, C_MLA_CKV + c) * rsq[tt * 2 + 1]) : (bf16_t)0; }
        if (tid < TT * 16) { const int tt = tid >> 4, i = tid & 15, t = t0 + tt, s = t & (SEQ - 1);
            const float x1 = ldP(P1, t, C_MLA_KR + i), x2 = ldP(P1, t, C_MLA_KR + 16 + i), cs = p->cos32[s * 16 + i], sn = p->sin32[s * 16 + i];
            p->mla_kpe[(size_t)t * 32 + i] = f2bf(x1 * cs - x2 * sn); p->mla_kpe[(size_t)t * 32 + 16 + i] = f2bf(x1 * sn + x2 * cs); }
        __syncthreads();
    }
}

DI float gelu_tanh(float x) { return 0.5f * x * (1.0f + tanhf(0.7978845608028654f * (x + 0.044715f * x * x * x))); }
DI void phase_compress(KParamsPtr p, int l, LAS unsigned char* lds) {
    const int tid = TIDX();
    LAS float* A = (LAS float*)lds;
    LAS float* Hd = A + 8 * 2048;
    for (int task = BIDX(); task < 512; task += NBLK()) {
        const int which = task >> 8, bh = (task >> 5) & 7, n0 = (task & 31) * 8;
        const bf16_t* base = (which ? p->nsa_vc_in : p->nsa_kc_in) + (size_t)bh * SEQ * 64;
        const float* pos = p->cmp_pos + (l * 2 + which) * 2048;
        for (int i = tid; i < 8 * 2048; i += 512) { const int r = i >> 11, k = i & 2047, n = n0 + r;
            A[i] = n < 255 ? bf2f(base[(size_t)n * 1024 + k]) + pos[k] : 0.f; }
        __syncthreads();
        const float* w1 = p->cmp_w1 + (size_t)(l * 2 + which) * 2048 * 256;
        { const int j = tid & 255, half = tid >> 8;
            float acc[4] = {0.f, 0.f, 0.f, 0.f};
            for (int k = 0; k < 2048; ++k) { const float w = w1[(size_t)k * 256 + j];
#pragma unroll
                for (int r = 0; r < 4; ++r) acc[r] += A[(half * 4 + r) * 2048 + k] * w; }
#pragma unroll
            for (int r = 0; r < 4; ++r) Hd[(half * 4 + r) * 256 + j] = gelu_tanh(acc[r]); }
        __syncthreads();
        const float* w2 = p->cmp_w2 + (size_t)(l * 2 + which) * 256 * 64;
        { const int r = tid >> 6, d = tid & 63; float o = 0.f;
            for (int j = 0; j < 256; ++j) o += Hd[r * 256 + j] * w2[j * 64 + d];
            (which ? p->nsa_vc : p->nsa_kc)[((size_t)bh * 256 + n0 + r) * 64 + d] = o; }
        __syncthreads();
    }
}

DI void phase_nsa_cmp(KParamsPtr p, LAS unsigned char* lds) {
    const int tid = TIDX(), lane = tid & 63, wave = tid >> 6;
    LAS float* qs = (LAS float*)lds + wave * (256 + 1024);
    LAS float* pl = qs + 256;
    const float scale = 0.125f;
    for (int item_ = BIDX() * 8 + wave; item_ < NB * 2 * SEQ; item_ += NBLK() * 8) {
        const int item = __builtin_amdgcn_readfirstlane(item_);
        const int s = item & (SEQ - 1), hk = (item >> 12) & 1, b = item >> 13, t = b * SEQ + s, bh = b * 2 + hk;
        const int nvalid = s >= 31 ? min(255, (s - 31) / 16 + 1) : 0;
#pragma unroll
        for (int g = 0; g < 4; ++g) qs[g * 64 + lane] = bf2f(p->nsa_q[(size_t)t * 512 + (hk * 4 + g) * 64 + lane]);
        asm volatile("s_waitcnt lgkmcnt(0)" ::: "memory");
        float sc[4][4];
#pragma unroll
        for (int c = 0; c < 4; ++c) { const int n = lane + 64 * c;
#pragma unroll
            for (int g = 0; g < 4; ++g) sc[c][g] = -1e30f;
            if (n < nvalid) { const float* kr = p->nsa_kc + ((size_t)bh * 256 + n) * 64;
                float d0 = 0.f, d1 = 0.f, d2 = 0.f, d3 = 0.f;
#pragma unroll 4
                for (int k4 = 0; k4 < 16; ++k4) { const f32x4 kv = *(const f32x4*)(kr + k4 * 4);
                    const f32x4 q0 = *(const LAS f32x4*)(qs + k4 * 4), q1 = *(const LAS f32x4*)(qs + 64 + k4 * 4), q2 = *(const LAS f32x4*)(qs + 128 + k4 * 4), q3 = *(const LAS f32x4*)(qs + 192 + k4 * 4);
                    d0 += kv[0] * q0[0] + kv[1] * q0[1] + kv[2] * q0[2] + kv[3] * q0[3]; d1 += kv[0] * q1[0] + kv[1] * q1[1] + kv[2] * q1[2] + kv[3] * q1[3];
                    d2 += kv[0] * q2[0] + kv[1] * q2[1] + kv[2] * q2[2] + kv[3] * q2[3]; d3 += kv[0] * q3[0] + kv[1] * q3[1] + kv[2] * q3[2] + kv[3] * q3[3]; }
                sc[c][0] = d0 * scale; sc[c][1] = d1 * scale; sc[c][2] = d2 * scale; sc[c][3] = d3 * scale; } }
#pragma unroll
        for (int g = 0; g < 4; ++g) {
            float mx = fmaxf(fmaxf(sc[0][g], sc[1][g]), fmaxf(sc[2][g], sc[3][g])); mx = wmax(mx);
            float e[4], sm = 0.f;
#pragma unroll
            for (int c = 0; c < 4; ++c) { e[c] = (lane + 64 * c < nvalid) ? __expf(sc[c][g] - mx) : 0.f; sm += e[c]; }
            sm = wsum(sm);
            const float inv = sm > 0.f ? 1.0f / sm : 0.f;
#pragma unroll
            for (int c = 0; c < 4; ++c) pl[g * 256 + lane + 64 * c] = e[c] * inv;
        }
        asm volatile("s_waitcnt lgkmcnt(0)" ::: "memory");
        { float o[4] = {0.f, 0.f, 0.f, 0.f};
            const float* vr = p->nsa_vc + (size_t)bh * 256 * 64 + lane;
            for (int n = 0; n < nvalid; ++n) { const float v = vr[(size_t)n * 64];
#pragma unroll
                for (int g = 0; g < 4; ++g) o[g] += pl[g * 256 + n] * v; }
#pragma unroll
            for (int g = 0; g < 4; ++g) p->nsa_ocmp[(size_t)t * 512 + (hk * 4 + g) * 64 + lane] = o[g]; }
        float imp = 0.f;
#pragma unroll
        for (int dn = -1; dn <= 3; ++dn) { const int n = 4 * lane + dn;
            if (n >= 0 && n < 255) imp += pl[n] + pl[256 + n] + pl[512 + n] + pl[768 + n]; }
        const int cur = s >> 6;
        const bool valid = lane <= cur, forced = valid && (lane == 0 || lane >= cur - 1);
        const float val = forced ? 1e30f : (valid ? imp : -1e30f);
        int rank = 0;
        for (int jj = 0; jj < 64; ++jj) { const float o = __shfl(val, jj); rank += (o > val || (o == val && jj < lane)) ? 1 : 0; }
        const unsigned long long mask = __ballot(rank < 16);
        if (lane == 0) p->nsa_sel[(size_t)bh * SEQ + s] = mask;
        asm volatile("s_waitcnt lgkmcnt(0)" ::: "memory");
    }
}

DI void dot8(const u32x4 w, LAS const float* q0, int DQ, float (&s)[4]) {
    float kf[8];
    kf[0] = __uint_as_float(w.x << 16); kf[1] = __uint_as_float(w.x & 0xffff0000u); kf[2] = __uint_as_float(w.y << 16); kf[3] = __uint_as_float(w.y & 0xffff0000u);
    kf[4] = __uint_as_float(w.z << 16); kf[5] = __uint_as_float(w.z & 0xffff0000u); kf[6] = __uint_as_float(w.w << 16); kf[7] = __uint_as_float(w.w & 0xffff0000u);
#pragma unroll
    for (int g = 0; g < 4; ++g) { const f32x4 qa = *(const LAS f32x4*)(q0 + g * DQ), qb = *(const LAS f32x4*)(q0 + g * DQ + 4);
        s[g] += kf[0] * qa[0] + kf[1] * qa[1] + kf[2] * qa[2] + kf[3] * qa[3] + kf[4] * qb[0] + kf[5] * qb[1] + kf[6] * qb[2] + kf[7] * qb[3]; }
}
template <int DQ, class KPtr, class VLoad, class Mask>
DI void naive_attn_block(int lane, LAS float* qs  , LAS float* ps  , float scale, KPtr kptr, VLoad vload, Mask mask, float (&m)[4], float (&l)[4], float (&o)[4]) {
    float s[4] = {0.f, 0.f, 0.f, 0.f};
#pragma unroll 4
    for (int c8 = 0; c8 < DQ / 8; ++c8) { const u32x4 w = *(const u32x4*)kptr(c8); dot8(w, qs + c8 * 8, DQ, s); if ((c8 & 3) == 3) asm volatile("" ::: "memory"); }
    float pr[4];
#pragma unroll
    for (int g = 0; g < 4; ++g) {
        const bool ok = mask(g, lane);
        const float sv = ok ? s[g] * scale : -1e30f;
        const float bm = wmax(sv), mn = fmaxf(m[g], bm), corr = __expf(m[g] - mn);
        pr[g] = ok ? __expf(sv - mn) : 0.f;
        l[g] = l[g] * corr + pr[g]; o[g] *= corr; m[g] = mn;
    }
    *(LAS f32x4*)(ps + lane * 4) = (f32x4){pr[0], pr[1], pr[2], pr[3]};
    asm volatile("s_waitcnt lgkmcnt(0)" ::: "memory");
#pragma unroll 4
    for (int key = 0; key < 64; ++key) { const f32x4 pv = *(const LAS f32x4*)(ps + key * 4); const float v = vload(key, lane);
        o[0] += pv[0] * v; o[1] += pv[1] * v; o[2] += pv[2] * v; o[3] += pv[3] * v; if ((key & 3) == 3) asm volatile("" ::: "memory"); }
    asm volatile("s_waitcnt lgkmcnt(0)" ::: "memory");
}

DI void phase_nsa_attn(KParamsPtr p, LAS unsigned char* lds) {
    const int tid = TIDX(), lane = tid & 63, wave = tid >> 6;
    LAS float* qs = (LAS float*)lds + wave * 512;
    LAS float* ps = qs + 256;
    for (int item_ = BIDX() * 8 + wave; item_ < NB * 2 * SEQ; item_ += NBLK() * 8) {
        const int item = __builtin_amdgcn_readfirstlane(item_);
        const int s = item & (SEQ - 1), hk = (item >> 12) & 1, b = item >> 13, t = b * SEQ + s, bh = b * 2 + hk, cur = s >> 6;
#pragma unroll
        for (int g = 0; g < 4; ++g) qs[g * 64 + lane] = bf2f(p->nsa_q[(size_t)t * 512 + (hk * 4 + g) * 64 + lane]);
        asm volatile("s_waitcnt lgkmcnt(0)" ::: "memory");
        float res[4];
        { float m[4] = {-1e30f, -1e30f, -1e30f, -1e30f}, l[4] = {0.f, 0.f, 0.f, 0.f}, o[4] = {0.f, 0.f, 0.f, 0.f};
#if defined(NSA_NO_CMP)
            unsigned long long sel = NSA_SEL0;
#else
            unsigned long long sel = p->nsa_sel[(size_t)bh * SEQ + s];
#endif
            sel &= (cur >= 63) ? ~0ull : ((1ull << (cur + 1)) - 1ull);
            sel = ((unsigned long long)(unsigned)__builtin_amdgcn_readfirstlane((int)(sel >> 32)) << 32) | (unsigned)__builtin_amdgcn_readfirstlane((int)sel);
            const bf16_t* K = p->nsa_ks + (size_t)bh * SEQ * 64; const bf16_t* V = p->nsa_vs + (size_t)bh * SEQ * 64;
#if defined(NSA_NO_SLC)
            sel &= 1ull;
#endif
            while (sel) { const int j = __builtin_ctzll(sel); sel &= sel - 1;
                const int k0 = j * 64;
                naive_attn_block<64>(lane, qs, ps, 0.125f,
                    [&](int c8) { return K + (size_t)(k0 + lane) * 64 + c8 * 8; },
                    [&](int key, int d) { return bf2f(V[(size_t)(k0 + key) * 64 + d]); },
                    [&](int, int key) { return k0 + key <= s; }, m, l, o); }
#pragma unroll
            for (int g = 0; g < 4; ++g) { const float lt = wsum(l[g]); res[g] = p->nsa_gate[(size_t)t * 24 + (hk * 4 + g) * 3 + 1] * (o[g] / lt); } }
        { float m[4] = {-1e30f, -1e30f, -1e30f, -1e30f}, l[4] = {0.f, 0.f, 0.f, 0.f}, o[4] = {0.f, 0.f, 0.f, 0.f};
#if defined(NSA_WIN_USE_S)
            const bf16_t* K = p->nsa_ks + (size_t)bh * SEQ * 64; const bf16_t* V = p->nsa_vs + (size_t)bh * SEQ * 64;
#else
            const bf16_t* K = p->nsa_kw + (size_t)bh * SEQ * 64; const bf16_t* V = p->nsa_vw + (size_t)bh * SEQ * 64;
#endif
            const int lo = s - 511 > 0 ? s - 511 : 0;
#if defined(NSA_NO_WIN)
            for (int j = cur; j <= cur; ++j) { const int k0 = j * 64;
#else
            for (int j = lo >> 6; j <= cur; ++j) { const int k0 = j * 64;
#endif
                naive_attn_block<64>(lane, qs, ps, 0.125f,
                    [&](int c8) { return K + (size_t)(k0 + lane) * 64 + c8 * 8; },
                    [&](int key, int d) { return bf2f(V[(size_t)(k0 + key) * 64 + d]); },
                    [&](int, int key) { return k0 + key <= s && k0 + key >= lo; }, m, l, o); }
#pragma unroll
            for (int g = 0; g < 4; ++g) { const float lt = wsum(l[g]); res[g] += p->nsa_gate[(size_t)t * 24 + (hk * 4 + g) * 3 + 2] * (o[g] / lt); } }
#pragma unroll
        for (int g = 0; g < 4; ++g) { const size_t oi = (size_t)t * 512 + (hk * 4 + g) * 64 + lane;
#if !defined(NSA_NO_CMP)
            res[g] += p->nsa_gate[(size_t)t * 24 + (hk * 4 + g) * 3] * p->nsa_ocmp[oi];
#endif
            p->ys[oi] = f2bf(res[g]); }
    }
}

DI void phase_mla_rope(KParamsPtr p) {
    for (int i = BIDX() * 512 + TIDX(); i < T * 128; i += NBLK() * 512) {
        const int t = i >> 7, h = (i >> 4) & 7, j = i & 15, s = t & (SEQ - 1);
        bf16_t* q = p->mla_q + (size_t)t * 768 + h * 96 + 64;
        const float x1 = bf2f(q[j]), x2 = bf2f(q[16 + j]), cs = p->cos32[s * 16 + j], sn = p->sin32[s * 16 + j];
        q[j] = f2bf(x1 * cs - x2 * sn); q[16 + j] = f2bf(x1 * sn + x2 * cs);
    }
}
DI void phase_mla_attn(KParamsPtr p, LAS unsigned char* lds) {
    const int tid = TIDX(), lane = tid & 63, wave = tid >> 6;
    LAS float* qs = (LAS float*)lds + wave * 640;
    LAS float* ps = qs + 384;
    const float scale = 0.10206207261596577f;
    for (int item_ = BIDX() * 8 + wave; item_ < NB * 8 * (SEQ / 4); item_ += NBLK() * 8) {
        const int item = __builtin_amdgcn_readfirstlane(item_);
        const int s0 = (item & 1023) * 4, h = (item >> 10) & 7, b = item >> 13, t0 = b * SEQ + s0;
        for (int i = lane; i < 384; i += 64) { const int g = i / 96, c = i % 96; qs[i] = bf2f(p->mla_q[(size_t)(t0 + g) * 768 + h * 96 + c]); }
        asm volatile("s_waitcnt lgkmcnt(0)" ::: "memory");
        float m[4] = {-1e30f, -1e30f, -1e30f, -1e30f}, l[4] = {0.f, 0.f, 0.f, 0.f}, o[4] = {0.f, 0.f, 0.f, 0.f};
        const bf16_t* KV = p->mla_kv + (size_t)b * SEQ * 1024 + h * 128; const bf16_t* PE = p->mla_kpe + (size_t)b * SEQ * 32;
        for (int j = 0; j <= (s0 + 3) >> 6; ++j) { const int k0 = j * 64;
            naive_attn_block<96>(lane, qs, ps, scale,
                [&](int c8) { return c8 < 8 ? KV + (size_t)(k0 + lane) * 1024 + c8 * 8 : PE + (size_t)(k0 + lane) * 32 + (c8 - 8) * 8; },
                [&](int key, int d) { return bf2f(KV[(size_t)(k0 + key) * 1024 + 64 + d]); },
                [&](int g, int key) { return k0 + key <= s0 + g; }, m, l, o); }
#pragma unroll
        for (int g = 0; g < 4; ++g) { const float lt = wsum(l[g]); p->ys[(size_t)3 * T * 512 + (size_t)(t0 + g) * 512 + h * 64 + lane] = f2bf(o[g] / lt); }
    }
}

DI void phase_scan_rwkv(KParamsPtr p, LAS unsigned char* lds) {
    const int tid = TIDX(), bid = BIDX();
    if (bid < 32) {
        if (tid >= 64) return;
        const int b = bid >> 3, h = bid & 7, lane = tid;
        LAS float* L = (LAS float*)lds;
        float st[64];
#pragma unroll
        for (int j = 0; j < 64; ++j) st[j] = 0.f;
        size_t o = (size_t)b * SEQ * 512 + h * 64 + lane;
        float nkk = p->rw_kk[o], nw = p->rw_w[o], nk = bf2f(p->rw_k[o]), nb = p->rw_b[o], nr = bf2f(p->rw_r[o]), nv = bf2f(p->rw_v[o]);
        for (int s = 0; s < SEQ; ++s) {
            L[lane] = nkk; L[64 + lane] = nw; L[128 + lane] = nk; L[192 + lane] = nb; L[256 + lane] = nr;
            const float v = nv; const size_t oc = o;
            if (s + 1 < SEQ) { o += 512; nkk = p->rw_kk[o]; nw = p->rw_w[o]; nk = bf2f(p->rw_k[o]); nb = p->rw_b[o]; nr = bf2f(p->rw_r[o]); nv = bf2f(p->rw_v[o]); }
            asm volatile("s_waitcnt lgkmcnt(0)" ::: "memory");
            float skk = 0.f;
#pragma unroll
            for (int j4 = 0; j4 < 16; ++j4) { const f32x4 kk = *(const LAS f32x4*)(L + j4 * 4);
                skk += st[j4 * 4] * kk[0] + st[j4 * 4 + 1] * kk[1] + st[j4 * 4 + 2] * kk[2] + st[j4 * 4 + 3] * kk[3]; }
            float y = 0.f;
#pragma unroll
            for (int j4 = 0; j4 < 16; ++j4) { const f32x4 w = *(const LAS f32x4*)(L + 64 + j4 * 4), k = *(const LAS f32x4*)(L + 128 + j4 * 4), bb = *(const LAS f32x4*)(L + 192 + j4 * 4), r = *(const LAS f32x4*)(L + 256 + j4 * 4);
#pragma unroll
                for (int q = 0; q < 4; ++q) { const float ns = st[j4 * 4 + q] * w[q] - skk * bb[q] + v * k[q]; st[j4 * 4 + q] = ns; y += ns * r[q]; }
                if ((j4 & 3) == 3) asm volatile("" ::: "memory"); }
            p->rw_y[oc] = y;
            asm volatile("s_waitcnt lgkmcnt(0)" ::: "memory");
        }
    }
}
DI void phase_scan_gla(KParamsPtr p, LAS unsigned char* lds) {
    const int tid = TIDX(), bid = BIDX();
    if (bid >= 32 && bid < 48) {
        if (tid >= 128) return;
        const int bh = bid - 32, b = bh >> 2, h = bh & 3, e = tid, lane = tid & 63, wave = tid >> 6;
        LAS float* L = (LAS float*)lds + wave * 192;
        float st[64];
#pragma unroll
        for (int j = 0; j < 64; ++j) st[j] = 0.f;
        const bf16_t* P1 = p->P1;
        for (int s = 0; s < SEQ; ++s) {
            const int t = b * SEQ + s;
            L[lane] = __expf(p->gla_la[(size_t)t * 256 + h * 64 + lane]); L[64 + lane] = ldP(P1, t, C_GLA_K + h * 64 + lane); L[128 + lane] = ldP(P1, t, C_GLA_Q + h * 64 + lane) * 0.125f;
            const float v = ldP(P1, t, C_GLA_V + h * 128 + e);
            asm volatile("s_waitcnt lgkmcnt(0)" ::: "memory");
            float y = 0.f;
#pragma unroll
            for (int j4 = 0; j4 < 16; ++j4) { const f32x4 dc = *(const LAS f32x4*)(L + j4 * 4), k = *(const LAS f32x4*)(L + 64 + j4 * 4), q = *(const LAS f32x4*)(L + 128 + j4 * 4);
#pragma unroll
                for (int qq = 0; qq < 4; ++qq) { const float ns = st[j4 * 4 + qq] * dc[qq] + k[qq] * v; st[j4 * 4 + qq] = ns; y += ns * q[qq]; }
                if ((j4 & 3) == 3) asm volatile("" ::: "memory"); }
            p->gla_o[(size_t)t * 512 + h * 128 + e] = y;
            asm volatile("s_waitcnt lgkmcnt(0)" ::: "memory");
        }
    }
}

DI void phase_scans(KParamsPtr p, LAS unsigned char* lds) { phase_scan_rwkv(p, lds); phase_scan_gla(p, lds); }

DI void phase_post(KParamsPtr p, int l, LAS unsigned char* lds) {
    const int tid = TIDX(), lane = tid & 63, wave = tid >> 6;
    LAS float* red = (LAS float*)lds;
    const float ln_w = p->rw_ln_w[l * 512 + tid], ln_b = p->rw_ln_b[l * 512 + tid], r_k = p->rw_r_k[l * 512 + tid], gg = p->gla_g[l * 512 + tid];
    int it = 0;
    for (int t = BIDX(); t < T; t += NBLK(), ++it) {
        const size_t o = (size_t)t * 512 + tid;
        { const float y = p->rw_y[o];
            const float mean = wsum(y) * (1.0f / 64.0f), dlt = y - mean, var = wsum(dlt * dlt) * (1.0f / 64.0f);
            const float yn = dlt * rsqrtf(var + 64e-5f) * ln_w + ln_b;
            const float r = bf2f(p->rw_r[o]), k = bf2f(p->rw_k[o]), v = bf2f(p->rw_v[o]), g = bf2f(p->rw_g[o]);
            const float bonus = wsum(r * k * r_k) * v;
            p->ys[(size_t)1 * T * 512 + o] = f2bf((yn + bonus) * g * ZRWKV); }
        { const float ov = p->gla_o[o]; const float ss = wsum(ov * ov);
            LAS float* rb = red + (it & 1) * 8;
            if (lane == 0) rb[wave] = ss;
            asm volatile("s_waitcnt lgkmcnt(0)" ::: "memory"); __builtin_amdgcn_s_barrier(); asm volatile("" ::: "memory");
            const float tot = rb[wave & ~1] + rb[wave | 1];
            const float rs = rsqrtf(tot * (1.0f / 128.0f) + NORM_EPS);
            const float r = ldP(p->P1, t, C_GLA_R + tid);
            p->ys[(size_t)2 * T * 512 + o] = f2bf(ov * rs * gg * (r * sigmoidf_(r)) * ZGLA); }
    }
}

DI void unpack8(const u32x4 w, float (&f)[8]) {
    f[0] = __uint_as_float(w.x << 16); f[1] = __uint_as_float(w.x & 0xffff0000u); f[2] = __uint_as_float(w.y << 16); f[3] = __uint_as_float(w.y & 0xffff0000u);
    f[4] = __uint_as_float(w.z << 16); f[5] = __uint_as_float(w.z & 0xffff0000u); f[6] = __uint_as_float(w.w << 16); f[7] = __uint_as_float(w.w & 0xffff0000u);
}
DI void phase_mergesum(const bf16_t* G, const bf16_t* part01, const bf16_t* part23, bf16_t* merged) {
    const size_t n8 = (size_t)T * 2048 / 8;
    for (size_t i = (size_t)BIDX() * 512 + TIDX(); i < n8; i += (size_t)NBLK() * 512) {
        const size_t t = i >> 8, c = (i & 255) * 8;
        float acc[8] = {0.f, 0.f, 0.f, 0.f, 0.f, 0.f, 0.f, 0.f};
#pragma unroll
        for (int br = 0; br < 4; ++br) {
            const u32x4 gw = *(const u32x4*)(G + t * NGATE + br * 2048 + c);
            const u32x4 pw = *(const u32x4*)((br < 2 ? part01 : part23) + (size_t)(br & 1) * T * 2048 + t * 2048 + c);
            float g[8], q[8]; unpack8(gw, g); unpack8(pw, q);
#pragma unroll
            for (int j = 0; j < 8; ++j) acc[j] += g[j] * q[j];
        }
        u32x4 w; w.x = pk2(acc[0], acc[1]); w.y = pk2(acc[2], acc[3]); w.z = pk2(acc[4], acc[5]); w.w = pk2(acc[6], acc[7]);
        *(u32x4*)(merged + t * 2048 + c) = w;
    }
}
#ifndef ZSLC
#define ZSLC 1.0f
#endif
#ifndef ZWIN
#define ZWIN 1.0f
#endif
#ifndef ZCMP
#define ZCMP 1.0f
#endif
#ifndef ZMLA
#define ZMLA 1.0f
#endif
template <int DQ> struct FlashGeo {
    static constexpr int KS = (DQ + 8) * 2;
    static constexpr int VS = 144;
    static constexpr int KBYTES = 64 * KS, VBYTES = 64 * VS, BUF = KBYTES + VBYTES;
};
struct FlashAcc { f32x4 O[2][4]; float m[2], l[2]; };
DI void flash_reset(FlashAcc& a) {
#pragma unroll
    for (int rg = 0; rg < 2; ++rg) { a.m[rg] = -1e30f; a.l[rg] = 0.f;
#pragma unroll
        for (int d = 0; d < 4; ++d) a.O[rg][d] = (f32x4){0.f, 0.f, 0.f, 0.f}; }
}
template <int DQ> struct FlashStage { u32x4 k, k2, v; };
template <int DQ, class KRow, class PRow, class VRow>
DI void flash_stage_load(FlashStage<DQ>& st, int tid, KRow krow, PRow prow, VRow vrow) {
    const int r = tid >> 3, c = tid & 7;
    st.k = *(const u32x4*)(krow(r) + c * 8);
    if (DQ == 96) { if (c < 4) st.k2 = *(const u32x4*)(prow(r) + c * 8); }
    st.v = *(const u32x4*)(vrow(r) + c * 8);
}
template <int DQ>
DI void flash_stage_write(const FlashStage<DQ>& st, int tid, LAS unsigned char* buf) {
    typedef FlashGeo<DQ> G;
    const int r = tid >> 3, c = tid & 7;
    *(LAS u32x4*)(buf + r * G::KS + c * 16) = st.k;
    if (DQ == 96) { if (c < 4) *(LAS u32x4*)(buf + r * G::KS + 128 + c * 16) = st.k2; }
    LAS unsigned char* vt = buf + G::KBYTES + (c * 8) * G::VS + r * 2;
    *(LAS bf16_t*)(vt + 0 * G::VS) = (bf16_t)(st.v.x & 0xffffu); *(LAS bf16_t*)(vt + 1 * G::VS) = (bf16_t)(st.v.x >> 16);
    *(LAS bf16_t*)(vt + 2 * G::VS) = (bf16_t)(st.v.y & 0xffffu); *(LAS bf16_t*)(vt + 3 * G::VS) = (bf16_t)(st.v.y >> 16);
    *(LAS bf16_t*)(vt + 4 * G::VS) = (bf16_t)(st.v.z & 0xffffu); *(LAS bf16_t*)(vt + 5 * G::VS) = (bf16_t)(st.v.z >> 16);
    *(LAS bf16_t*)(vt + 6 * G::VS) = (bf16_t)(st.v.w & 0xffffu); *(LAS bf16_t*)(vt + 7 * G::VS) = (bf16_t)(st.v.w >> 16);
}
template <int DQ, class Mask>
DI void flash_tile(LAS const unsigned char* buf, const bf16x8 (&Q)[2][DQ / 32], FlashAcc& a, float sc2, int lane, Mask mask) {
    typedef FlashGeo<DQ> G;
    const int fr = lane & 15, q4 = lane >> 4;
    f32x4 S[2][4];
#pragma unroll
    for (int rg = 0; rg < 2; ++rg)
#pragma unroll
        for (int kb = 0; kb < 4; ++kb) S[rg][kb] = (f32x4){0.f, 0.f, 0.f, 0.f};
#pragma unroll
    for (int kb = 0; kb < 4; ++kb)
#pragma unroll
        for (int ks = 0; ks < DQ / 32; ++ks) {
            const bf16x8 kf = *(const LAS bf16x8*)(buf + (kb * 16 + fr) * G::KS + (ks * 32 + q4 * 8) * 2);
#pragma unroll
            for (int rg = 0; rg < 2; ++rg) S[rg][kb] = __builtin_amdgcn_mfma_f32_16x16x32_bf16(kf, Q[rg][ks], S[rg][kb], 0, 0, 0);
        }
    bf16x8 P[2][2];
#pragma unroll
    for (int rg = 0; rg < 2; ++rg) {
        float mx = -1e30f; unsigned okm = 0u;
#pragma unroll
        for (int kb = 0; kb < 4; ++kb)
#pragma unroll
            for (int j = 0; j < 4; ++j) { const bool ok = mask(rg, kb * 16 + q4 * 4 + j); okm |= ok ? (1u << (kb * 4 + j)) : 0u;
                const float sv = ok ? S[rg][kb][j] * sc2 : -1e30f; S[rg][kb][j] = sv; mx = fmaxf(mx, sv); }
        mx = fmaxf(mx, __shfl_xor(mx, 16)); mx = fmaxf(mx, __shfl_xor(mx, 32));
        const float mn = fmaxf(a.m[rg], mx), corr = __builtin_amdgcn_exp2f(a.m[rg] - mn);
        a.m[rg] = mn;
        float ps = 0.f;
#pragma unroll
        for (int kb = 0; kb < 4; ++kb)
#pragma unroll
            for (int j = 0; j < 4; ++j) { const float pv = ((okm >> (kb * 4 + j)) & 1u) ? __builtin_amdgcn_exp2f(S[rg][kb][j] - mn) : 0.f; S[rg][kb][j] = pv; ps += pv; }
        a.l[rg] = a.l[rg] * corr + ps;
#pragma unroll
        for (int d = 0; d < 4; ++d) a.O[rg][d] *= corr;
#pragma unroll
        for (int pb = 0; pb < 2; ++pb) { u32x4 w;
            w.x = cvt_pk_bf16(S[rg][2 * pb][0], S[rg][2 * pb][1]); w.y = cvt_pk_bf16(S[rg][2 * pb][2], S[rg][2 * pb][3]);
            w.z = cvt_pk_bf16(S[rg][2 * pb + 1][0], S[rg][2 * pb + 1][1]); w.w = cvt_pk_bf16(S[rg][2 * pb + 1][2], S[rg][2 * pb + 1][3]);
            P[rg][pb] = __builtin_bit_cast(bf16x8, w); }
    }
    LAS const unsigned char* vt = buf + G::KBYTES;
#pragma unroll
    for (int pb = 0; pb < 2; ++pb)
#pragma unroll
        for (int dvb = 0; dvb < 4; ++dvb) {
            const u32x2 lo = *(const LAS u32x2*)(vt + (dvb * 16 + fr) * G::VS + (32 * pb + 4 * q4) * 2);
            const u32x2 hi = *(const LAS u32x2*)(vt + (dvb * 16 + fr) * G::VS + (32 * pb + 16 + 4 * q4) * 2);
            const u32x4 w = (u32x4){lo.x, lo.y, hi.x, hi.y};
            const bf16x8 vf = __builtin_bit_cast(bf16x8, w);
#pragma unroll
            for (int rg = 0; rg < 2; ++rg) a.O[rg][dvb] = __builtin_amdgcn_mfma_f32_16x16x32_bf16(vf, P[rg][pb], a.O[rg][dvb], 0, 0, 0);
        }
}
DI float flash_lsum(float l) { l += __shfl_xor(l, 16); l += __shfl_xor(l, 32); return l; }

DI void phase_mla_flash(KParamsPtr p, LAS unsigned char* lds) {
    typedef FlashGeo<96> G;
    const int tid = TIDX(), lane = tid & 63, wave = __builtin_amdgcn_readfirstlane(tid >> 6), fr = lane & 15, q4 = lane >> 4;
    const float sc2 = 0.10206207261596577f * 1.4426950408889634f;
    const bf16_t* mq = p->mla_q; const bf16_t* mkv = p->mla_kv; const bf16_t* mpe = p->mla_kpe; bf16_t* yo = p->ys + (size_t)3 * T * 512;
    for (int c = BIDX(); c < 256; c += NBLK()) {
        const int bh = c >> 3, b = bh >> 3, h = bh & 7;
#pragma unroll 1
        for (int half = 0; half < 2; ++half) {
            const int qt = half ? 15 - (c & 7) : (c & 7), q0 = qt * 256;
            const int tok0 = q0 + wave * 32 + fr;
            bf16x8 Q[2][3];
#pragma unroll
            for (int rg = 0; rg < 2; ++rg)
#pragma unroll
                for (int ks = 0; ks < 3; ++ks) Q[rg][ks] = *(const bf16x8*)(mq + (size_t)(b * SEQ + tok0 + rg * 16) * 768 + h * 96 + ks * 32 + q4 * 8);
            FlashAcc a; flash_reset(a);
            const int nt = (q0 + 256) / 64;
            const bf16_t* kvb = mkv + (size_t)b * SEQ * 1024 + h * 128; const bf16_t* peb = mpe + (size_t)b * SEQ * 32;
            FlashStage<96> st;
            flash_stage_load<96>(st, tid, [&](int r) { return kvb + (size_t)r * 1024; }, [&](int r) { return peb + (size_t)r * 32; }, [&](int r) { return kvb + (size_t)r * 1024 + 64; });
            __syncthreads();
            flash_stage_write<96>(st, tid, lds);
            __syncthreads();
            for (int i = 0; i < nt; ++i) {
                const int k0 = i * 64;
                if (i + 1 < nt) flash_stage_load<96>(st, tid, [&](int r) { return kvb + (size_t)(k0 + 64 + r) * 1024; }, [&](int r) { return peb + (size_t)(k0 + 64 + r) * 32; }, [&](int r) { return kvb + (size_t)(k0 + 64 + r) * 1024 + 64; });
                if (k0 <= q0 + wave * 32 + 31) {
                    const int d0 = tok0 - k0;
                    flash_tile<96>(lds + (i & 1) * G::BUF, Q, a, sc2, lane, [&](int rg, int kidx) { return kidx <= d0 + rg * 16; });
                }
                if (i + 1 < nt) flash_stage_write<96>(st, tid, lds + ((i + 1) & 1) * G::BUF);
                __syncthreads();
            }
#pragma unroll
            for (int rg = 0; rg < 2; ++rg) { const float inv = 1.0f / flash_lsum(a.l[rg]);
                bf16_t* op = yo + (size_t)(b * SEQ + tok0 + rg * 16) * 512 + h * 64 + q4 * 4;
#pragma unroll
                for (int d = 0; d < 4; ++d) { u32x2 w; w.x = cvt_pk_bf16(a.O[rg][d][0] * inv * ZMLA, a.O[rg][d][1] * inv * ZMLA); w.y = cvt_pk_bf16(a.O[rg][d][2] * inv * ZMLA, a.O[rg][d][3] * inv * ZMLA);
                    *(u32x2*)(op + d * 16) = w; } }
        }
    }
}

DI void phase_nsa_flash(KParamsPtr p, LAS unsigned char* lds) {
    typedef FlashGeo<64> G;
    const int tid = TIDX(), lane = tid & 63, wave = __builtin_amdgcn_readfirstlane(tid >> 6), fr = lane & 15, q4 = lane >> 4;
    const float sc2 = 0.125f * 1.4426950408889634f;
    LAS unsigned* um = (LAS unsigned*)(lds + 2 * G::BUF);
    const bf16_t* nq = p->nsa_q; const unsigned long long* selp = p->nsa_sel; const float* gat = p->nsa_gate; const float* ocmp = p->nsa_ocmp; bf16_t* yo = p->ys;
    for (int c = BIDX(); c < 256; c += NBLK()) {
        const int bh = c >> 5, b = bh >> 1, hk = bh & 1;
        const bf16_t* Ks = p->nsa_ks + (size_t)bh * SEQ * 64; const bf16_t* Vs = p->nsa_vs + (size_t)bh * SEQ * 64;
        const bf16_t* Kw = p->nsa_kw + (size_t)bh * SEQ * 64; const bf16_t* Vw = p->nsa_vw + (size_t)bh * SEQ * 64;
#pragma unroll 1
        for (int half = 0; half < 2; ++half) {
            const int cur = half ? 63 - (c & 31) : (c & 31), s0 = cur * 64, g = wave >> 1, head = hk * 4 + g;
            const int qi0 = (wave & 1) * 32 + fr;
            const size_t t0 = (size_t)b * SEQ + s0 + qi0;
            bf16x8 Q[2][2];
#pragma unroll
            for (int rg = 0; rg < 2; ++rg)
#pragma unroll
                for (int ks = 0; ks < 2; ++ks) Q[rg][ks] = *(const bf16x8*)(nq + (t0 + rg * 16) * 512 + head * 64 + ks * 32 + q4 * 8);
            unsigned long long sel[2];
#pragma unroll
            for (int rg = 0; rg < 2; ++rg) sel[rg] = selp[(size_t)bh * SEQ + s0 + qi0 + rg * 16];
            if (wave == 0) {
                unsigned long long u = selp[(size_t)bh * SEQ + s0 + lane];
                unsigned lo = (unsigned)u, hi = (unsigned)(u >> 32);
#pragma unroll
                for (int o = 32; o >= 1; o >>= 1) { lo |= (unsigned)__shfl_xor((int)lo, o); hi |= (unsigned)__shfl_xor((int)hi, o); }
                if (lane == 0) { um[0] = lo; um[1] = hi; }
            }
            __syncthreads();
            unsigned long long uni = ((unsigned long long)um[1] << 32) | um[0];
            uni &= (cur >= 63) ? ~0ull : ((1ull << (cur + 1)) - 1ull);
            uni = ((unsigned long long)(unsigned)__builtin_amdgcn_readfirstlane((int)(uni >> 32)) << 32) | (unsigned)__builtin_amdgcn_readfirstlane((int)uni);
            float res[2][4][4];
            {
                FlashAcc a; flash_reset(a);
                FlashStage<64> st;
                unsigned long long rem = uni;
                int j = __builtin_ctzll(rem); rem &= rem - 1;
                flash_stage_load<64>(st, tid, [&](int r) { return Ks + (size_t)(j * 64 + r) * 64; }, [&](int r) { return Ks; }, [&](int r) { return Vs + (size_t)(j * 64 + r) * 64; });
                flash_stage_write<64>(st, tid, lds);
                __syncthreads();
                int i = 0;
                for (;;) {
                    const bool more = rem != 0ull;
                    int jn = 0;
                    if (more) { jn = __builtin_ctzll(rem); rem &= rem - 1;
                        flash_stage_load<64>(st, tid, [&](int r) { return Ks + (size_t)(jn * 64 + r) * 64; }, [&](int r) { return Ks; }, [&](int r) { return Vs + (size_t)(jn * 64 + r) * 64; }); }
                    { const bool diag = (j == cur);
                      const bool in0 = (sel[0] >> j) & 1ull, in1 = (sel[1] >> j) & 1ull;
                      flash_tile<64>(lds + (i & 1) * G::BUF, Q, a, sc2, lane, [&](int rg, int kidx) { return (rg ? in1 : in0) && (!diag || kidx <= qi0 + rg * 16); }); }
                    if (more) flash_stage_write<64>(st, tid, lds + ((i + 1) & 1) * G::BUF);
                    __syncthreads();
                    if (!more) break;
                    j = jn; ++i;
                }
#pragma unroll
                for (int rg = 0; rg < 2; ++rg) { const float gt = gat[(t0 + rg * 16) * 24 + head * 3 + 1] / flash_lsum(a.l[rg]);
#pragma unroll
                    for (int d = 0; d < 4; ++d)
#pragma unroll
                        for (int e = 0; e < 4; ++e) res[rg][d][e] = a.O[rg][d][e] * gt * ZSLC; }
            }
            {
                FlashAcc a; flash_reset(a);
                FlashStage<64> st;
                const int jlo = cur >= 8 ? cur - 8 : 0;
                flash_stage_load<64>(st, tid, [&](int r) { return Kw + (size_t)(jlo * 64 + r) * 64; }, [&](int r) { return Kw; }, [&](int r) { return Vw + (size_t)(jlo * 64 + r) * 64; });
                flash_stage_write<64>(st, tid, lds);
                __syncthreads();
                for (int j = jlo, i = 0; j <= cur; ++j, ++i) {
                    if (j < cur) flash_stage_load<64>(st, tid, [&](int r) { return Kw + (size_t)((j + 1) * 64 + r) * 64; }, [&](int r) { return Kw; }, [&](int r) { return Vw + (size_t)((j + 1) * 64 + r) * 64; });
                    { const bool diag = (j == cur), tail = (j == cur - 8);
                      flash_tile<64>(lds + (i & 1) * G::BUF, Q, a, sc2, lane, [&](int rg, int kidx) { const int qi = qi0 + rg * 16; return (!diag || kidx <= qi) && (!tail || kidx > qi); }); }
                    if (j < cur) flash_stage_write<64>(st, tid, lds + ((i + 1) & 1) * G::BUF);
                    __syncthreads();
                }
#pragma unroll
                for (int rg = 0; rg < 2; ++rg) { const float gt = gat[(t0 + rg * 16) * 24 + head * 3 + 2] / flash_lsum(a.l[rg]);
#pragma unroll
                    for (int d = 0; d < 4; ++d)
#pragma unroll
                        for (int e = 0; e < 4; ++e) res[rg][d][e] += a.O[rg][d][e] * gt * ZWIN; }
            }
#pragma unroll
            for (int rg = 0; rg < 2; ++rg) { const float g0 = gat[(t0 + rg * 16) * 24 + head * 3] * ZCMP;
                const size_t ob = (t0 + rg * 16) * 512 + head * 64 + q4 * 4;
#pragma unroll
                for (int d = 0; d < 4; ++d) { const f32x4 oc = *(const f32x4*)(ocmp + ob + d * 16);
                    u32x2 w; w.x = cvt_pk_bf16(res[rg][d][0] + g0 * oc[0], res[rg][d][1] + g0 * oc[1]); w.y = cvt_pk_bf16(res[rg][d][2] + g0 * oc[2], res[rg][d][3] + g0 * oc[3]);
                    *(u32x2*)(yo + ob + d * 16) = w; } }
            __syncthreads();
        }
    }
}
constexpr int LDS_BYTES = 147456;
constexpr int LDS_XB_OFF = 131072;


#if defined(KFENCE)
#define KFENCE_IN  do { __builtin_amdgcn_fence(__ATOMIC_ACQUIRE, "agent"); asm volatile("s_waitcnt vmcnt(0)" ::: "memory"); } while (0)
#define KFENCE_OUT do { asm volatile("s_waitcnt vmcnt(0)" ::: "memory"); __builtin_amdgcn_fence(__ATOMIC_RELEASE, "agent"); asm volatile("s_waitcnt vmcnt(0)" ::: "memory"); } while (0)
#else
#define KFENCE_IN do {} while (0)
#define KFENCE_OUT do {} while (0)
#endif
#define KERNEL(name, ...) __global__ void __launch_bounds__(512, 2) name(Params p_arg, int l) { extern __shared__ __attribute__((aligned(16))) unsigned char lds_raw[]; LAS unsigned char* lds = (LAS unsigned char*)lds_raw; KParamsPtr p = (KParamsPtr)__builtin_amdgcn_kernarg_segment_ptr(); KFENCE_IN; __VA_ARGS__; KFENCE_OUT; }
#define modA (p->mod + (size_t)(l * 3 + 0) * 4 * 6144)
#define modB (p->mod + (size_t)(l * 3 + 1) * 4 * 6144)
#define modC (p->mod + (size_t)(l * 3 + 2) * 4 * 6144)
KERNEL(k_setup, phase_setup(p, lds))
KERNEL(k_convert, phase_convert(p, l, lds))
KERNEL(k_norm0, (phase_norm<false, true>(p->x, nullptr, nullptr, p->u, nullptr, nullptr, 0.f, p->pre_g, p->mod)))
KERNEL(k_up0, { EpiSwiglu E; E.H = p->P1; E.ldc = DFF; run_gemm(lds, p->u, D, p->Wup0, D, T, 2 * DFF, D, E); })
KERNEL(k_dn0, { EpiF32 E; E.C = p->y; E.ldc = D; run_gemm(lds, p->P1, DFF, p->Wdn0, DFF, T, D, DFF, E); })
KERNEL(k_normA, (phase_norm<true, true>(l == 0 ? p->x : p->out, p->y, p->out, p->u, p->post_g + (l * 3 + 0) * D, modA, 0.5f, p->pre_g + (l * 3 + 1) * D, modB)))
KERNEL(k_proj1, { EpiBf16<0> E; E.O = p->P1; E.ldc = NP1P; run_gemm(lds, p->u, D, p->Win1, D, T, NP1P, D, E); })
KERNEL(k_prep, phase_prep(p, l, lds))
KERNEL(k_compress, phase_compress(p, l, lds))
KERNEL(k_mla_up, { { EpiBf16<0> E; E.O = p->mla_q; E.ldc = 768; run_gemm(lds, p->mla_cqn, 384, p->Wuq, 384, T, 768, 384, E); } __syncthreads();
                   { EpiBf16<0> E; E.O = p->mla_kv; E.ldc = 1024; run_gemm(lds, p->mla_ckvn, 256, p->Wukv, 256, T, 1024, 256, E); } })
KERNEL(k_mla_rope, phase_mla_rope(p))
KERNEL(k_nsa_cmp, phase_nsa_cmp(p, lds))
#if defined(NAIVE_NSA)
KERNEL(k_nsa_attn, phase_nsa_attn(p, lds))
#else
KERNEL(k_nsa_attn, phase_nsa_flash(p, lds))
#endif
#if defined(NAIVE_MLA)
KERNEL(k_mla_attn, phase_mla_attn(p, lds))
#else
KERNEL(k_mla_attn, phase_mla_flash(p, lds))
#endif
KERNEL(k_scans, phase_scans(p, lds))
KERNEL(k_post, phase_post(p, l, lds))
KERNEL(k_gate, { EpiBf16<1> E; E.O = p->G; E.ldc = NGATE; run_gemm(lds, p->u, D, p->Wg, D, T, NGATE, D, E); })
KERNEL(k_merge, { EpiPart E; E.part01 = p->P1; E.part23 = (bf16_t*)p->y;
            pg8::Gemm g; g.A = p->ys; g.Bt = p->Wbr; g.M = 4 * T; g.N = 4 * D; g.K = 512; g.lda = 512; g.ldb = 512;
            MergeOrder S; S.G = NBLK(); S.c = BIDX();
            pg8::gemm_phase<EpiPart, MergeOrder, false>((PG8_LAS unsigned char*)lds, g, S, E, nullptr); })
KERNEL(k_mergesum, phase_mergesum(p->G, p->P1, (const bf16_t*)p->y, p->mg))
KERNEL(k_mergesum2, phase_mergesum(p->G, p->P1, (const bf16_t*)p->y, p->u))
KERNEL(k_out, { EpiF32 E; E.C = p->y; E.ldc = D; run_gemm(lds, p->mg, D, p->Wout, D, T, D, D, E); })
KERNEL(k_normB, (phase_norm<true, true>(p->out, p->y, p->out, p->u, p->post_g + (l * 3 + 1) * D, modB, 1.0f, p->pre_g + (l * 3 + 2) * D, modC)))
KERNEL(k_up1, { EpiSwiglu E; E.H = p->P1; E.ldc = DFF; run_gemm(lds, p->u, D, p->Wup1, D, T, 2 * DFF, D, E); })
KERNEL(k_dn1, { EpiF32 E; E.C = p->y; E.ldc = D; run_gemm(lds, p->P1, DFF, p->Wdn1, DFF, T, D, DFF, E); })
KERNEL(k_normC, (phase_norm<true, true>(p->out, p->y, p->out, p->u, p->post_g + (l * 3 + 2) * D, modC, 0.5f, p->pre_g + ((l + 1) * 3) * D, p->mod + (size_t)((l + 1) * 3) * 4 * 6144)))
KERNEL(k_normEnd, (phase_norm<true, false>(p->out, p->y, p->out, nullptr, p->post_g + (l * 3 + 2) * D, modC, 0.5f, nullptr, nullptr)))
#if defined(DIAG_IDENT_LO)
__global__ void k_diag_ident(Params p_arg, int l) { KParamsPtr p = (KParamsPtr)__builtin_amdgcn_kernarg_segment_ptr();
    for (size_t i = (size_t)blockIdx.x * blockDim.x + threadIdx.x; i < (size_t)T * D; i += (size_t)gridDim.x * blockDim.x) { const int t = (int)(i / D), s = t & (SEQ - 1);
        const int col = (int)(i % D); (void)s;
        if (DIAG_COND) p->out[i] = p->x[i]; } }
#endif
#ifndef DUMP_GBR
#define DUMP_GBR 0
#endif
#if defined(DUMP_WHICH)
__global__ void k_dump(Params p_arg, int which) { KParamsPtr p = (KParamsPtr)__builtin_amdgcn_kernarg_segment_ptr(); KFENCE_IN;
    const size_t N = (size_t)T * D;
    for (size_t i = (size_t)blockIdx.x * blockDim.x + threadIdx.x; i < N; i += (size_t)gridDim.x * blockDim.x) {
        float v = 0.f;
        if (which == 0) { if (i < (size_t)T * 512) v = bf2f(p->nsa_q[i]); else if (i < (size_t)T * 640) v = bf2f(p->nsa_ks[i - (size_t)T * 512]); else if (i < (size_t)T * 768) v = bf2f(p->nsa_vs[i - (size_t)T * 640]);
                          else if (i < (size_t)T * 896) v = bf2f(p->nsa_kw[i - (size_t)T * 768]); else if (i < (size_t)T * 1024) v = bf2f(p->nsa_vw[i - (size_t)T * 896]); else if (i < (size_t)T * 1048) v = p->nsa_gate[i - (size_t)T * 1024]; }
        else if (which == 1) { if (i < (size_t)T * 512) v = p->nsa_ocmp[i]; else if (i < (size_t)T * 512 + (size_t)8 * SEQ * 4) { const size_t k = i - (size_t)T * 512; const unsigned long long s = p->nsa_sel[k >> 2]; v = (float)((s >> (16 * (k & 3))) & 0xffffull); }
                               else if (i < (size_t)T * 512 + (size_t)8 * SEQ * 4 + 8 * 256 * 64) v = p->nsa_kc[i - ((size_t)T * 512 + (size_t)8 * SEQ * 4)]; }
        else if (which == 2) { if (i < (size_t)T * 512) v = bf2f(p->ys[i]); }
        else if (which == 3) { if (i < (size_t)T * 512) v = bf2f(p->ys[(size_t)3 * T * 512 + i]); else if (i < (size_t)T * 1024) v = bf2f(p->ys[(size_t)1 * T * 512 + i - (size_t)T * 512]); else if (i < (size_t)T * 1536) v = bf2f(p->ys[(size_t)2 * T * 512 + i - (size_t)T * 1024]); }
        else if (which == 4) { const bf16_t* g = p->G + (i / 2048) * 8192 + (i % 2048); v = bf2f(g[0]) + 2.f * bf2f(g[2048]) + 4.f * bf2f(g[4096]) + 8.f * bf2f(g[6144]); }
        else if (which == 5) { v = bf2f(p->mg[i]); }
        else if (which == 10) { v = 1e6f * (bf2f(p->mg[i]) - bf2f(p->u[i])); }
        else if (which == 9) { const bf16_t* g = p->G + (i / 2048) * 8192 + (i % 2048); v = bf2f(g[0]) + 2.f * bf2f(g[2048]) + 4.f * bf2f(g[4096]) + 8.f * bf2f(g[6144]); }
        else if (which == 6) { v = p->y[i]; }
        else if (which == 7) { v = bf2f(p->P1[i]) + 2.f * bf2f(p->P1[i + (size_t)T * 2048]) + 4.f * bf2f(((const bf16_t*)p->y)[i]) + 8.f * bf2f(((const bf16_t*)p->y)[i + (size_t)T * 2048]); }
        else if (which == 8) { v = bf2f(((const bf16_t*)p->y)[i + (size_t)DUMP_GBR * T * 2048]); }
        p->out[i] = v; } }
#endif

#if defined(DIAGS)
__global__ void k_diag(Params p_arg, int lm) { KParamsPtr p = (KParamsPtr)__builtin_amdgcn_kernarg_segment_ptr(); const int l = lm / 1000, mode = lm % 1000;
    __shared__ float red[256];
    const int li = threadIdx.x; const int i = blockIdx.x * 256 + li; const int t = (int)(((size_t)i * 997 + 13) % T); bool active = true;
    float got = 0.f, ref = 0.f;
if (mode == 1 || mode == 11)
    { active = (i & 31) == 0; if (active) { const int n = (int)((((unsigned)i * 2654435761u) >> 8) % D); const size_t fo = (size_t)(l * 2 + (mode == 11 ? 1 : 0)) * D * DFF; const float* wg = p->ffn_wg + fo; const float* wu = p->ffn_wu + fo; const float* wd = p->ffn_wd + fo;
      for (int f = 0; f < DFF; ++f) { float a = 0.f, b = 0.f;
          for (int k = 0; k < D; ++k) { const float uv = bf2f(p->u[(size_t)t * D + k]); a += uv * wg[(size_t)k * DFF + f]; b += uv * wu[(size_t)k * DFF + f]; }
          ref += (a / (1.f + __expf(-a))) * b * wd[(size_t)f * D + n]; }
      got = p->y[(size_t)t * D + n]; } }
else if (mode == 2)
    { const int c = (int)((((unsigned)i * 2654435761u) >> 8) % NP1); for (int k = 0; k < D; ++k) ref += bf2f(p->u[(size_t)t * D + k]) * p->mix_w_in[(size_t)l * D * PROJ_IN + (size_t)k * PROJ_IN + c]; got = bf2f(p->P1[(size_t)t * NP1P + c]); }
else if (mode == 3)
    { const int c = (int)((((unsigned)i * 2654435761u) >> 8) % NGATE); for (int k = 0; k < D; ++k) ref += bf2f(p->u[(size_t)t * D + k]) * p->mix_w_in[(size_t)l * D * PROJ_IN + (size_t)k * PROJ_IN + NP1 + c]; ref = 1.f / (1.f + __expf(-ref)); got = bf2f(p->G[(size_t)t * NGATE + c]);
#if defined(DIAG3_COND)
      active = DIAG3_COND;
#endif
    }
else if (mode == 4)
    { const int br = i & 3, n = (int)((((unsigned)i * 2654435761u) >> 8) % D); for (int k = 0; k < 512; ++k) ref += bf2f(p->ys[((size_t)br * T + t) * 512 + k]) * p->mix_w_branch[((size_t)(l * 4 + br) * 512 + k) * D + n];
      got = bf2f(((br < 2) ? p->P1 : (const bf16_t*)p->y)[(size_t)(br & 1) * T * 2048 + (size_t)t * 2048 + n]); }
else if (mode == 5)
    { const int n = (int)((((unsigned)i * 2654435761u) >> 8) % D); for (int k = 0; k < D; ++k) ref += bf2f(p->mg[(size_t)t * D + k]) * p->mix_w_out[(size_t)l * D * D + (size_t)k * D + n]; got = p->y[(size_t)t * D + n]; }
else if (mode == 6)
    { if (i & 1) { const int c = (i * 37 + 5) % 768; for (int k = 0; k < 384; ++k) ref += bf2f(p->mla_cqn[(size_t)t * 384 + k]) * p->mla_qn[l * 384 + k] * p->mla_wuq[(size_t)l * 384 * 768 + (size_t)k * 768 + c]; got = bf2f(p->mla_q[(size_t)t * 768 + c]); }
      else { const int c = (i * 37 + 5) % 1024; for (int k = 0; k < 128; ++k) ref += bf2f(p->mla_ckvn[(size_t)t * 256 + k]) * p->mla_kvn[l * 128 + k] * p->mla_wukv[(size_t)l * 128 * 1024 + (size_t)k * 1024 + c]; got = bf2f(p->mla_kv[(size_t)t * 1024 + c]); } }
else if (mode == 8)
    { const int ls = i % 6, b = (i / 6) & 3, col = (i * 977 + 3) % 6144; const float* W = p->ada_w + (size_t)ls * D * 6144;
      for (int k = 0; k < D; ++k) { const float c = p->c[b * D + k]; ref += (c / (1.f + expf(-c))) * W[(size_t)k * 6144 + col]; }
      ref += p->ada_b[ls * 6144 + col]; got = p->mod[(size_t)(ls * 4 + b) * 6144 + col]; }
else if (mode == 9)
    {
      const int j = (i * 37 + 1) % 512, s = t & (SEQ - 1), hh = j >> 6; const bf16_t* P = p->P1; const float* mu = p->rw_mu + l * 1792;
      auto xs = [&](int tt, int col) { const float pv = bf2f(P[(size_t)tt * NP1P + col]); const float pp = (tt & (SEQ - 1)) > 0 ? bf2f(P[(size_t)(tt - 1) * NP1P + col]) : 0.f; return pv + (pp - pv) * mu[col - C_RW]; };
      float lw = p->rw_w0[l * 512 + j], la = p->rw_a0[l * 512 + j], lg = 0.f;
      for (int q = 0; q < 64; ++q) { lw += tanhf(xs(t, C_RW_WLO + q)) * p->rw_w_w2[(l * 64 + q) * 512 + j]; la += xs(t, C_RW_ALO + q) * p->rw_a_w2[(l * 64 + q) * 512 + j]; }
      for (int q = 0; q < 128; ++q) lg += (1.f / (1.f + expf(-xs(t, C_RW_GLO + q)))) * p->rw_g_w2[(l * 128 + q) * 512 + j];
      const float w = expf(-0.6065306597f / (1.f + expf(-lw))), a = 1.f / (1.f + expf(-la));
      float nn = 0.f; for (int q = 0; q < 64; ++q) { const float kq = xs(t, C_RW_K + hh * 64 + q) * p->rw_k_k[l * 512 + hh * 64 + q]; nn += kq * kq; }
      const float kj = xs(t, C_RW_K + j), kk = kj * p->rw_k_k[l * 512 + j] / fmaxf(sqrtf(nn), 1e-12f), k2 = kj * (1.f + (a - 1.f) * p->rw_k_a[l * 512 + j]);
      const size_t o = (size_t)t * 512 + j; const int sel = i % 7;
      if (sel == 0) { ref = w; got = p->rw_w[o]; } else if (sel == 1) { ref = kk; got = p->rw_kk[o]; } else if (sel == 2) { ref = kk * a; got = p->rw_b[o]; } else if (sel == 3) { ref = k2; got = bf2f(p->rw_k[o]); }
      else if (sel == 4) { ref = lg; got = bf2f(p->rw_g[o]); } else if (sel == 5) { ref = xs(t, C_RW_R + j); got = bf2f(p->rw_r[o]); } else { ref = xs(t, C_RW_V + j); got = bf2f(p->rw_v[o]); } (void)s; }
else if (mode == 12)
    { const int n = (int)((((unsigned)i * 2654435761u) >> 8) % D); for (int br = 0; br < 4; ++br) ref += bf2f(p->G[(size_t)t * NGATE + br * 2048 + n]) * bf2f(((br < 2) ? p->P1 : (const bf16_t*)p->y)[(size_t)(br & 1) * T * 2048 + (size_t)t * 2048 + n]); got = bf2f(p->mg[(size_t)t * D + n]); }
else if (mode == 13 || mode == 14 || mode == 15 || mode == 16)
    {
      const int sub = mode == 13 ? 1 : (mode == 16 ? 0 : 2); const float rw = mode == 13 ? 1.0f : 0.5f; const int ls = l * 3 + sub; const bool has_u = !(mode == 15);
      const int n = (int)((((unsigned)i * 2654435761u) >> 8) % D), b = t >> 12; const float* snap = (const float*)p->G; const float* mP = p->mod + (size_t)ls * 4 * 6144; const float* mN = p->mod + (size_t)(ls + 1) * 4 * 6144;
      double ss = 0.0; for (int k = 0; k < D; ++k) { const float yv = p->y[(size_t)t * D + k]; ss += (double)yv * yv; }
      const float rs = rsqrtf((float)(ss / D) + NORM_EPS);
      auto xnew = [&](int k) { return snap[(size_t)t * D + k] + rw * mP[(size_t)b * 6144 + 4096 + k] * (p->y[(size_t)t * D + k] * rs * p->post_g[ls * D + k]); };
      if (!(i & 1) || !has_u) { ref = xnew(n); got = p->out[(size_t)t * D + n]; }
      else { double sx = 0.0; for (int k = 0; k < D; ++k) { const float v = xnew(k); sx += (double)v * v; } const float rx = rsqrtf((float)(sx / D) + NORM_EPS);
          ref = xnew(n) * rx * p->pre_g[(ls + 1) * D + n] * (1.f + mN[(size_t)b * 6144 + 2048 + n]) + mN[(size_t)b * 6144 + n]; got = bf2f(p->u[(size_t)t * D + n]); } }
else if (mode == 7)
    { const int n = (int)((((unsigned)i * 2654435761u) >> 8) % D), b = t >> 12; double ss = 0.0, sx = 0.0; const float* mA = p->mod + (size_t)(l * 3) * 4 * 6144; const float* mB = p->mod + (size_t)(l * 3 + 1) * 4 * 6144; const float* xin = l == 0 ? p->x : p->out; (void)xin;
      for (int k = 0; k < D; ++k) { const float yv = p->y[(size_t)t * D + k]; ss += (double)yv * yv; }
      const float rs = rsqrtf((float)(ss / D) + NORM_EPS);
      for (int k = 0; k < D; ++k) { const float xn = p->x[(size_t)t * D + k] + 0.5f * mA[(size_t)b * 6144 + 4096 + k] * (p->y[(size_t)t * D + k] * rs * p->post_g[k]); sx += (double)xn * xn; }
      const float rx = rsqrtf((float)(sx / D) + NORM_EPS);
      const float xn = p->x[(size_t)t * D + n] + 0.5f * mA[(size_t)b * 6144 + 4096 + n] * (p->y[(size_t)t * D + n] * rs * p->post_g[n]);
      ref = xn * rx * p->pre_g[D + n] * (1.f + mB[(size_t)b * 6144 + 2048 + n]) + mB[(size_t)b * 6144 + n]; got = bf2f(p->u[(size_t)t * D + n]); }
    __shared__ float red2[256]; __shared__ float red3[256];
    red[li] = active ? fabsf(got - ref) : 0.f; red2[li] = active ? ref * ref : 0.f; red3[li] = active ? 1.f : 0.f;
    __syncthreads();
    for (int s = 128; s > 0; s >>= 1) { if (li < s) { red[li] = fmaxf(red[li], red[li + s]); red2[li] += red2[li + s]; red3[li] += red3[li + s]; } __syncthreads(); }
    if (li == 0) { float* db = (float*)p->bar + 1024 + mode * 4; atomicMax((unsigned*)db, __float_as_uint(red[0])); atomicAdd(db + 1, red2[0]); atomicAdd(db + 2, red3[0]); }
}
__global__ void k_diag_final(Params p_arg, int l) { KParamsPtr p = (KParamsPtr)__builtin_amdgcn_kernarg_segment_ptr();
    for (size_t j = (size_t)blockIdx.x * blockDim.x + threadIdx.x; j < (size_t)T * D; j += (size_t)gridDim.x * blockDim.x) { float v = 0.f;
        if (j == 0) { for (int k = 0; k < 64; ++k) { const float* db = (const float*)p->bar + 1024 + k * 4; if (db[2] > 0.f) { const float q = 1e4f * db[0] / sqrtf(db[1] / db[2] + 1e-20f);
#if defined(DIAG_SHOW)
            if (k == DIAG_SHOW) v = q;
#elif defined(DIAG_ARGMAX)
            if (q > DIAG_ARGMAX) v = fmaxf(v, 1000.f * k);
#else
            v = fmaxf(v, q);
#endif
        } } } p->out[j] = v; } }
#ifndef DIAG_L
#define DIAG_L 0
#endif
#define DIAG_AT(mode) do { if (l == DIAG_L) hipLaunchKernelGGL(k_diag, dim3(64), dim3(256), 0, stream, p, l * 1000 + (mode)); } while (0)
#else
#define DIAG_AT(mode) do {} while (0)
#endif
#if defined(DIAGS)
__global__ void __launch_bounds__(256) k_diag2(Params p_arg, int lm) { KParamsPtr p = (KParamsPtr)__builtin_amdgcn_kernarg_segment_ptr(); const int l = lm / 1000, mode = lm % 1000;
    __shared__ float red[256]; __shared__ float red2[256]; __shared__ float stl[128 * 65];
    const int li = threadIdx.x; const int i = blockIdx.x * 256 + li;
    float got = 0.f, ref = 0.f; bool active = true;
    const float* cs64 = p->cos64; const float* sn64 = p->sin64; const float* cs32 = p->cos32; const float* sn32 = p->sin32; const bf16_t* P = p->P1;
if (mode == 10)
    { const int t = (int)(((size_t)i * 997 + 13) % T), s = t & (SEQ - 1), b = t >> 12, sel = i % 8;
      if (sel == 0) { const int h = (i >> 3) & 7, d = (i * 5) & 63, ii = d & 31; const float x1 = bf2f(P[(size_t)t * NP1P + C_NSA_Q + h * 64 + ii]), x2 = bf2f(P[(size_t)t * NP1P + C_NSA_Q + h * 64 + 32 + ii]);
          ref = d < 32 ? x1 * cs64[s * 32 + ii] - x2 * sn64[s * 32 + ii] : x1 * sn64[s * 32 + ii] + x2 * cs64[s * 32 + ii]; got = bf2f(p->nsa_q[(size_t)t * 512 + h * 64 + d]); }
      else if (sel == 1) { const int hk = (i >> 3) & 1, d = (i * 5) & 63, ii = d & 31; const float x1 = bf2f(P[(size_t)t * NP1P + C_NSA_KW + hk * 64 + ii]), x2 = bf2f(P[(size_t)t * NP1P + C_NSA_KW + hk * 64 + 32 + ii]);
          ref = d < 32 ? x1 * cs64[s * 32 + ii] - x2 * sn64[s * 32 + ii] : x1 * sn64[s * 32 + ii] + x2 * cs64[s * 32 + ii]; got = bf2f(p->nsa_kw[((size_t)(b * 2 + hk) * SEQ + s) * 64 + d]); }
      else if (sel == 2) { const int hk = (i >> 3) & 1, d = (i * 5) & 63; ref = bf2f(P[(size_t)t * NP1P + C_NSA_VS + hk * 64 + d]); got = bf2f(p->nsa_vs[((size_t)(b * 2 + hk) * SEQ + s) * 64 + d]); }
      else if (sel == 3) { const int g = (i >> 3) % 24; ref = 1.f / (1.f + expf(-bf2f(P[(size_t)t * NP1P + C_NSA_GL + g]))); got = p->nsa_gate[(size_t)t * 24 + g]; }
      else if (sel == 4) { const int d = (i * 7) & 255; float z = p->gla_b[l * 256 + d]; for (int q = 0; q < 16; ++q) z += bf2f(P[(size_t)t * NP1P + C_GLA_ALO + q]) * p->gla_w2[(l * 16 + q) * 256 + d];
          ref = (z >= 0.f ? -log1pf(expf(-z)) : z - log1pf(expf(z))) / 16.f; got = p->gla_la[(size_t)t * 256 + d]; }
      else if (sel == 5) { const int c = (i * 11) % 384; float ss = 0.f; for (int q = 0; q < 384; ++q) { const float v = bf2f(P[(size_t)t * NP1P + C_MLA_CQ + q]); ss += v * v; }
          ref = bf2f(P[(size_t)t * NP1P + C_MLA_CQ + c]) * rsqrtf(ss / 384.f + NORM_EPS); got = bf2f(p->mla_cqn[(size_t)t * 384 + c]); }
      else if (sel == 6) { const int c = (i * 11) % 128; float ss = 0.f; for (int q = 0; q < 128; ++q) { const float v = bf2f(P[(size_t)t * NP1P + C_MLA_CKV + q]); ss += v * v; }
          ref = bf2f(P[(size_t)t * NP1P + C_MLA_CKV + c]) * rsqrtf(ss / 128.f + NORM_EPS); got = bf2f(p->mla_ckvn[(size_t)t * 256 + c]); }
      else { const int d = (i * 3) & 31, ii = d & 15; const float x1 = bf2f(P[(size_t)t * NP1P + C_MLA_KR + ii]), x2 = bf2f(P[(size_t)t * NP1P + C_MLA_KR + 16 + ii]);
          ref = d < 16 ? x1 * cs32[s * 16 + ii] - x2 * sn32[s * 16 + ii] : x1 * sn32[s * 16 + ii] + x2 * cs32[s * 16 + ii]; got = bf2f(p->mla_kpe[(size_t)t * 32 + d]); } }
else if (mode == 20)
    { active = li < 128; if (active) { const int b = i & 3, c = (i * 37 + 5) % 512, h = c >> 6, tq = (i * 61 + 17) % SEQ, t0 = tq > 320 ? tq - 320 : 0; float* st = stl + li * 65;
        for (int k = 0; k < 64; ++k) st[k] = 0.f;
        float y = 0.f;
        for (int t = t0; t <= tq; ++t) { const size_t o = ((size_t)b * SEQ + t) * 512 + h * 64; const float v = bf2f(p->rw_v[o + (c & 63)]);
            float skk = 0.f; for (int k = 0; k < 64; ++k) skk += st[k] * p->rw_kk[o + k];
            y = 0.f; for (int k = 0; k < 64; ++k) { const float ns = st[k] * p->rw_w[o + k] - skk * p->rw_b[o + k] + v * bf2f(p->rw_k[o + k]); st[k] = ns; y += ns * bf2f(p->rw_r[o + k]); } }
        ref = y; got = p->rw_y[((size_t)b * SEQ + tq) * 512 + c]; } }
else if (mode == 21)
    { const int t = (int)(((size_t)i * 997 + 13) % T), c = (i * 37 + 5) % 512, h = c >> 6; const size_t o = (size_t)t * 512 + h * 64;
      float mean = 0.f; for (int k = 0; k < 64; ++k) mean += p->rw_y[o + k]; mean /= 64.f; float var = 0.f; for (int k = 0; k < 64; ++k) { const float d = p->rw_y[o + k] - mean; var += d * d; } var /= 64.f;
      float bon = 0.f; for (int k = 0; k < 64; ++k) bon += bf2f(p->rw_r[o + k]) * bf2f(p->rw_k[o + k]) * p->rw_r_k[l * 512 + h * 64 + k];
      const size_t oc = (size_t)t * 512 + c;
      ref = ((p->rw_y[oc] - mean) * rsqrtf(var + 64e-5f) * p->rw_ln_w[l * 512 + c] + p->rw_ln_b[l * 512 + c] + bon * bf2f(p->rw_v[oc])) * bf2f(p->rw_g[oc]); got = bf2f(p->ys[(size_t)1 * T * 512 + oc]); }
else if (mode == 22)
    { active = li < 128; if (active) { const int b = i & 3, c = (i * 37 + 5) % 512, h = c >> 7, e = c & 127, tq = (i * 61 + 17) % SEQ; float* st = stl + li * 65;
        for (int k = 0; k < 64; ++k) st[k] = 0.f;
        float y = 0.f;
        for (int t = 0; t <= tq; ++t) { const size_t tt = (size_t)b * SEQ + t; const float v = bf2f(P[tt * NP1P + C_GLA_V + h * 128 + e]);
            y = 0.f; for (int k = 0; k < 64; ++k) { const float ns = st[k] * expf(p->gla_la[tt * 256 + h * 64 + k]) + bf2f(P[tt * NP1P + C_GLA_K + h * 64 + k]) * v; st[k] = ns; y += ns * bf2f(P[tt * NP1P + C_GLA_Q + h * 64 + k]) * 0.125f; } }
        ref = y; got = p->gla_o[((size_t)b * SEQ + tq) * 512 + c]; } }
else if (mode == 23)
    { const int t = (int)(((size_t)i * 997 + 13) % T), c = (i * 37 + 5) % 512, h = c >> 7; const size_t o = (size_t)t * 512 + h * 128;
      float ss = 0.f; for (int k = 0; k < 128; ++k) ss += p->gla_o[o + k] * p->gla_o[o + k];
      const float r = bf2f(P[(size_t)t * NP1P + C_GLA_R + c]);
      ref = p->gla_o[(size_t)t * 512 + c] * rsqrtf(ss / 128.f + NORM_EPS) * p->gla_g[l * 512 + c] * (r / (1.f + expf(-r))); got = bf2f(p->ys[(size_t)2 * T * 512 + (size_t)t * 512 + c]); }
else if (mode == 24)
    { const int t = (int)(((size_t)i * 997 + 13) % T), s = t & (SEQ - 1), b = t >> 12, h = i & 7, d = (i * 5) & 63;
      const bf16_t* q = p->mla_q + (size_t)t * 768 + h * 96; const float sc = 0.10206207261596577f;
      float mx = -1e30f;
      for (int k = 0; k <= s; ++k) { const size_t tk = (size_t)b * SEQ + k; float dt = 0.f; for (int e = 0; e < 64; ++e) dt += bf2f(q[e]) * bf2f(p->mla_kv[tk * 1024 + h * 128 + e]); for (int e = 0; e < 32; ++e) dt += bf2f(q[64 + e]) * bf2f(p->mla_kpe[tk * 32 + e]); mx = fmaxf(mx, dt * sc); }
      float sm = 0.f, acc = 0.f;
      for (int k = 0; k <= s; ++k) { const size_t tk = (size_t)b * SEQ + k; float dt = 0.f; for (int e = 0; e < 64; ++e) dt += bf2f(q[e]) * bf2f(p->mla_kv[tk * 1024 + h * 128 + e]); for (int e = 0; e < 32; ++e) dt += bf2f(q[64 + e]) * bf2f(p->mla_kpe[tk * 32 + e]);
          const float pr = expf(dt * sc - mx); sm += pr; acc += pr * bf2f(p->mla_kv[tk * 1024 + h * 128 + 64 + d]); }
      ref = acc / sm; got = bf2f(p->ys[(size_t)3 * T * 512 + (size_t)t * 512 + h * 64 + d]); }
else if (mode == 25 || mode == 251 || mode == 252 || mode == 253)
    { const int t = (int)(((size_t)i * 997 + 13) % T), s = t & (SEQ - 1), b = t >> 12, head = i & 7, hk = head >> 2, d = (i * 5) & 63, bh = b * 2 + hk, cur = s >> 6;
      const bf16_t* q = p->nsa_q + (size_t)t * 512 + head * 64;
      float ocmp = 0.f, oslc = 0.f, owin = 0.f;
      { const int nv = s >= 31 ? min(255, (s - 31) / 16 + 1) : 0; float mx = -1e30f;
        for (int n = 0; n < nv; ++n) { float dt = 0.f; for (int e = 0; e < 64; ++e) dt += bf2f(q[e]) * p->nsa_kc[((size_t)bh * 256 + n) * 64 + e]; mx = fmaxf(mx, dt * 0.125f); }
        float sm = 0.f, acc = 0.f;
        for (int n = 0; n < nv; ++n) { float dt = 0.f; for (int e = 0; e < 64; ++e) dt += bf2f(q[e]) * p->nsa_kc[((size_t)bh * 256 + n) * 64 + e]; const float pr = expf(dt * 0.125f - mx); sm += pr; acc += pr * p->nsa_vc[((size_t)bh * 256 + n) * 64 + d]; }
        ocmp = nv > 0 ? acc / sm : 0.f; }
      { const unsigned long long sel = p->nsa_sel[(size_t)bh * SEQ + s]; float mx = -1e30f;
        for (int pass = 0; pass < 2; ++pass) { float sm = 0.f, acc = 0.f;
          for (int j = 0; j <= cur; ++j) if ((sel >> j) & 1ull) for (int kk = 0; kk < 64; ++kk) { const int k = j * 64 + kk; if (k > s) break;
              float dt = 0.f; for (int e = 0; e < 64; ++e) dt += bf2f(q[e]) * bf2f(p->nsa_ks[((size_t)bh * SEQ + k) * 64 + e]); dt *= 0.125f;
              if (pass == 0) mx = fmaxf(mx, dt); else { const float pr = expf(dt - mx); sm += pr; acc += pr * bf2f(p->nsa_vs[((size_t)bh * SEQ + k) * 64 + d]); } }
          if (pass == 1) oslc = acc / sm; } }
      { float mx = -1e30f; const int lo = s - 511 > 0 ? s - 511 : 0;
        for (int pass = 0; pass < 2; ++pass) { float sm = 0.f, acc = 0.f;
          for (int k = lo; k <= s; ++k) { float dt = 0.f; for (int e = 0; e < 64; ++e) dt += bf2f(q[e]) * bf2f(p->nsa_kw[((size_t)bh * SEQ + k) * 64 + e]); dt *= 0.125f;
              if (pass == 0) mx = fmaxf(mx, dt); else { const float pr = expf(dt - mx); sm += pr; acc += pr * bf2f(p->nsa_vw[((size_t)bh * SEQ + k) * 64 + d]); } }
          if (pass == 1) owin = acc / sm; } }
      const float* g = p->nsa_gate + (size_t)t * 24 + head * 3;
      const size_t oi = (size_t)t * 512 + head * 64 + d;
      if (mode == 25) { ref = g[0] * ocmp + g[1] * oslc + g[2] * owin; got = bf2f(p->ys[oi]); }
      else if (mode == 251) { ref = ocmp; got = p->nsa_ocmp[oi]; }
      else if (mode == 252) { ref = g[0] * ocmp + g[1] * oslc; got = bf2f(p->ys[oi]) - g[2] * owin; }
      else { ref = g[0] * ocmp + g[2] * owin; got = bf2f(p->ys[oi]) - g[1] * oslc; }
    }
else if (mode == 26)
    { active = li < 128; if (active) { const int bh = i & 7, s = (i * 251 + 77) % SEQ, b = bh >> 1, hk = bh & 1, cur = s >> 6; float* imp = stl + li * 65;
        for (int j = 0; j < 64; ++j) imp[j] = 0.f;
        const int nv = s >= 31 ? min(255, (s - 31) / 16 + 1) : 0;
        for (int g = 0; g < 4; ++g) { const bf16_t* q = p->nsa_q + ((size_t)b * SEQ + s) * 512 + (hk * 4 + g) * 64; float mx = -1e30f, sm = 0.f;
            for (int n = 0; n < nv; ++n) { float dt = 0.f; for (int e = 0; e < 64; ++e) dt += bf2f(q[e]) * p->nsa_kc[((size_t)bh * 256 + n) * 64 + e]; mx = fmaxf(mx, dt * 0.125f); }
            for (int n = 0; n < nv; ++n) { float dt = 0.f; for (int e = 0; e < 64; ++e) dt += bf2f(q[e]) * p->nsa_kc[((size_t)bh * 256 + n) * 64 + e]; sm += expf(dt * 0.125f - mx); }
            for (int n = 0; n < nv; ++n) { float dt = 0.f; for (int e = 0; e < 64; ++e) dt += bf2f(q[e]) * p->nsa_kc[((size_t)bh * 256 + n) * 64 + e]; const float pr = expf(dt * 0.125f - mx) / sm;
                for (int j = 0; j < 64; ++j) if (16 * n < 64 * (j + 1) && 16 * n + 31 >= 64 * j) imp[j] += pr; } }
        unsigned long long mask = 0ull;
        for (int j = 0; j < 64; ++j) { const bool valid = j <= cur, forced = valid && (j == 0 || j >= cur - 1); imp[j] = forced ? 1e30f : (valid ? imp[j] : -1e30f); }
        for (int j = 0; j < 64; ++j) { int rank = 0; for (int jj = 0; jj < 64; ++jj) rank += (imp[jj] > imp[j] || (imp[jj] == imp[j] && jj < j)) ? 1 : 0; if (rank < 16) mask |= 1ull << j; }
        const unsigned long long vm = cur >= 63 ? ~0ull : ((1ull << (cur + 1)) - 1ull);
        ref = 1.f; got = 1.f + (float)__builtin_popcountll((mask ^ p->nsa_sel[(size_t)bh * SEQ + s]) & vm); } }
else if (mode == 27)
    { const int which = i & 1, bh = (i >> 1) & 7, n = (i * 53 + 9) % 255, d = (i * 5) & 63; const bf16_t* base = (which ? p->nsa_vc_in : p->nsa_kc_in) + (size_t)bh * SEQ * 64;
      const float* pos = p->cmp_pos + (l * 2 + which) * 2048; const float* w1 = p->cmp_w1 + (size_t)(l * 2 + which) * 2048 * 256; const float* w2 = p->cmp_w2 + (size_t)(l * 2 + which) * 256 * 64;
      float o = 0.f;
      for (int j = 0; j < 256; ++j) { float a = 0.f; for (int k = 0; k < 2048; ++k) a += (bf2f(base[(size_t)n * 1024 + k]) + pos[k]) * w1[(size_t)k * 256 + j];
          o += 0.5f * a * (1.f + tanhf(0.7978845608f * (a + 0.044715f * a * a * a))) * w2[j * 64 + d]; }
      ref = o; got = (which ? p->nsa_vc : p->nsa_kc)[((size_t)bh * 256 + n) * 64 + d]; }
else if (mode == 28)
    { const int t = (int)(((size_t)i * 997 + 13) % T), s = t & (SEQ - 1), h = i & 7, d = (i * 3) & 31, ii = d & 15;
      float x1 = 0.f, x2 = 0.f; for (int k = 0; k < 384; ++k) { const float a = bf2f(p->mla_cqn[(size_t)t * 384 + k]) * p->mla_qn[l * 384 + k]; x1 += a * p->mla_wuq[(size_t)l * 384 * 768 + (size_t)k * 768 + h * 96 + 64 + ii]; x2 += a * p->mla_wuq[(size_t)l * 384 * 768 + (size_t)k * 768 + h * 96 + 80 + ii]; }
      ref = d < 16 ? x1 * cs32[s * 16 + ii] - x2 * sn32[s * 16 + ii] : x1 * sn32[s * 16 + ii] + x2 * cs32[s * 16 + ii]; got = bf2f(p->mla_q[(size_t)t * 768 + h * 96 + 64 + d]); }
    __shared__ float red3[256];
    red[li] = active ? fabsf(got - ref) : 0.f; red2[li] = active ? ref * ref : 0.f; red3[li] = active ? 1.f : 0.f;
    __syncthreads();
    for (int s = 128; s > 0; s >>= 1) { if (li < s) { red[li] = fmaxf(red[li], red[li + s]); red2[li] += red2[li + s]; red3[li] += red3[li + s]; } __syncthreads(); }
    if (li == 0) { float* db = (float*)p->bar + 1024 + (mode > 250 ? mode - 200 : mode) * 4; atomicMax((unsigned*)db, __float_as_uint(red[0])); atomicAdd(db + 1, red2[0]); atomicAdd(db + 2, red3[0]); }
}
#define DIAG2_HERE() do { if (l != DIAG_L) break; const int md_[] = {DIAG2_LIST}; for (int q_ = 0; q_ < (int)(sizeof(md_) / sizeof(int)); ++q_) hipLaunchKernelGGL(k_diag2, dim3(64), dim3(256), 0, stream, p, l * 1000 + md_[q_]); } while (0)
#else
#define DIAG2_HERE() do {} while (0)
#endif
typedef void (*kern_t)(Params, int);
static kern_t const g_kernels[] = { k_setup, k_convert, k_norm0, k_up0, k_dn0, k_normA, k_proj1, k_prep, k_compress, k_mla_up, k_mla_rope, k_nsa_cmp, k_nsa_attn, k_mla_attn, k_scans, k_post, k_gate, k_merge, k_mergesum, k_mergesum2, k_out, k_normB, k_up1, k_dn1, k_normC, k_normEnd };
extern "C" void kernel_launch(void* const* d_in, const int* in_sizes, int n_in, void* d_out, int out_size, void* d_ws, size_t ws_size, hipStream_t stream) {
    static int grid = 0;
    if (grid == 0) {
        int dev = 0, cus = 0;
        if (hipGetDevice(&dev) != hipSuccess || hipDeviceGetAttribute(&cus, hipDeviceAttributeMultiprocessorCount, dev) != hipSuccess) { fprintf(stderr, "kernel_launch: device query failed\n"); grid = -1; return; }
        for (size_t i = 0; i < sizeof(g_kernels) / sizeof(g_kernels[0]); ++i)
            if (hipFuncSetAttribute((const void*)g_kernels[i], hipFuncAttributeMaxDynamicSharedMemorySize, LDS_BYTES) != hipSuccess) { fprintf(stderr, "kernel_launch: hipFuncSetAttribute failed\n"); grid = -1; return; }
        grid = cus;
    }
    if (grid < 0) return;
    Params p{};
    const float* const* in = (const float* const*)d_in;
    p.x = in[0]; p.c = in[1]; p.ada_w = in[2]; p.ada_b = in[3]; p.pre_g = in[4]; p.post_g = in[5]; p.ffn_wg = in[6]; p.ffn_wu = in[7]; p.ffn_wd = in[8];
    p.mix_w_in = in[9]; p.mix_w_branch = in[10]; p.mix_w_out = in[11]; p.cmp_pos = in[12]; p.cmp_w1 = in[13]; p.cmp_w2 = in[14];
    p.rw_mu = in[15]; p.rw_w0 = in[16]; p.rw_w_w2 = in[17]; p.rw_a0 = in[18]; p.rw_a_w2 = in[19]; p.rw_g_w2 = in[20]; p.rw_k_k = in[21]; p.rw_k_a = in[22];
    p.rw_r_k = in[23]; p.rw_ln_w = in[24]; p.rw_ln_b = in[25]; p.gla_w2 = in[26]; p.gla_b = in[27]; p.gla_g = in[28];
    p.mla_qn = in[29]; p.mla_wuq = in[30]; p.mla_kvn = in[31]; p.mla_wukv = in[32];
    p.out = (float*)d_out;
    unsigned char* ws = (unsigned char*)d_ws; size_t off = 0;
    auto take = [&](size_t bytes) { unsigned char* r = ws + off; off += (bytes + 255) & ~(size_t)255; return r; };
    p.bar = (unsigned*)take(16384);
    p.mod = (float*)take((size_t)6 * 4 * 6144 * 4);
    p.cos64 = (float*)take((size_t)SEQ * 32 * 4); p.sin64 = (float*)take((size_t)SEQ * 32 * 4); p.cos32 = (float*)take((size_t)SEQ * 16 * 4); p.sin32 = (float*)take((size_t)SEQ * 16 * 4);
    p.Wup0 = (bf16_t*)take((size_t)2 * DFF * D * 2); p.Wup1 = (bf16_t*)take((size_t)2 * DFF * D * 2);
    p.Wdn0 = (bf16_t*)take((size_t)D * DFF * 2); p.Wdn1 = (bf16_t*)take((size_t)D * DFF * 2);
    p.Win1 = (bf16_t*)take((size_t)(NP1P + NGATE) * D * 2); p.Wg = p.Win1 + (size_t)NP1P * D;
    p.Wbr = (bf16_t*)take((size_t)4 * D * 512 * 2); p.Wout = (bf16_t*)take((size_t)D * D * 2);
    p.Wuq = (bf16_t*)take((size_t)768 * 384 * 2); p.Wukv = (bf16_t*)take((size_t)1024 * 256 * 2);
    p.u = (bf16_t*)take((size_t)T * D * 2);
    p.P1 = (bf16_t*)take((size_t)T * DFF * 2);
    p.y = (float*)take((size_t)T * D * 4);
    p.G = (bf16_t*)take((size_t)T * NGATE * 2);
    { unsigned char* yb = (unsigned char*)p.y; size_t yo = 0;
      auto ytake = [&](size_t bytes) { unsigned char* r = yb + yo; yo += (bytes + 255) & ~(size_t)255; return r; };
      p.mla_q = (bf16_t*)ytake((size_t)T * 768 * 2); p.mla_kv = (bf16_t*)ytake((size_t)T * 1024 * 2); p.gla_o = (float*)ytake((size_t)T * 512 * 4); p.nsa_ocmp = (float*)ytake((size_t)T * 512 * 4);
      if (yo > (size_t)T * D * 4) { fprintf(stderr, "kernel_launch: y aliases overflow\n"); return; } }
    p.nsa_q = (bf16_t*)take((size_t)T * 512 * 2);
    p.nsa_kc_in = (bf16_t*)take((size_t)T * 128 * 2 + 4096); p.nsa_vc_in = (bf16_t*)take((size_t)T * 128 * 2 + 4096);
    p.nsa_ks = (bf16_t*)take((size_t)T * 128 * 2); p.nsa_vs = (bf16_t*)take((size_t)T * 128 * 2); p.nsa_kw = (bf16_t*)take((size_t)T * 128 * 2); p.nsa_vw = (bf16_t*)take((size_t)T * 128 * 2);
    p.nsa_gate = (float*)take((size_t)T * 24 * 4); p.nsa_kc = (float*)take((size_t)8 * 256 * 64 * 4); p.nsa_vc = (float*)take((size_t)8 * 256 * 64 * 4);
    p.nsa_sel = (unsigned long long*)take((size_t)8 * SEQ * 8);
    p.rw_r = (bf16_t*)take((size_t)T * 512 * 2); p.rw_k = (bf16_t*)take((size_t)T * 512 * 2); p.rw_v = (bf16_t*)take((size_t)T * 512 * 2); p.rw_g = (bf16_t*)take((size_t)T * 512 * 2);
    p.rw_w = (float*)take((size_t)T * 512 * 4); p.rw_kk = (float*)take((size_t)T * 512 * 4); p.rw_b = (float*)take((size_t)T * 512 * 4); p.rw_y = (float*)take((size_t)T * 512 * 4);
    p.gla_la = (float*)take((size_t)T * 256 * 4);
    p.mla_cqn = (bf16_t*)take((size_t)T * 384 * 2); p.mla_ckvn = (bf16_t*)take((size_t)T * 256 * 2); p.mla_kpe = (bf16_t*)take((size_t)T * 32 * 2);
    p.ys = (bf16_t*)take((size_t)4 * T * 512 * 2);
    p.mg = (bf16_t*)take((size_t)T * D * 2);
    if (off > ws_size) { fprintf(stderr, "kernel_launch: workspace too small: need %zu, have %zu\n", off, ws_size); return; }
    if (hipMemsetAsync(p.bar, 0, 16384, stream) != hipSuccess) { fprintf(stderr, "kernel_launch: memset failed\n"); return; }
#define L_(k, l) hipLaunchKernelGGL(k, dim3(grid), dim3(512), LDS_BYTES, stream, p, l)
    { const int l = 0; (void)l; L_(k_setup, 0); DIAG_AT(8); } L_(k_convert, 0); L_(k_norm0, 0);
    for (int l = 0; l < 2; ++l) {
        if (l == 1) L_(k_convert, 1);
        L_(k_up0, l); L_(k_dn0, l); DIAG_AT(1);
#if defined(DIAGS)
        if (l == DIAG_L && l == 1) { hipMemcpyAsync(p.G, p.out, (size_t)T * D * 4, hipMemcpyDeviceToDevice, stream); L_(k_normA, l); DIAG_AT(16); } else
#endif
        { L_(k_normA, l); if (l == 0) DIAG_AT(7); }
#if defined(STOP_AFTER) && STOP_AFTER == 1
        return;
#endif
        L_(k_proj1, l); DIAG_AT(2); L_(k_prep, l); DIAG_AT(9);
#if !defined(SKIP_NSA)
#if !defined(NSA_NO_CMP)
        L_(k_compress, l); L_(k_nsa_cmp, l);
#endif
        L_(k_nsa_attn, l);
#endif
#if !defined(SKIP_MLA)
        L_(k_mla_up, l); DIAG_AT(6); L_(k_mla_rope, l); L_(k_mla_attn, l);
#endif
#if !defined(SKIP_SCANS)
        L_(k_scans, l); L_(k_post, l);
#endif
        DIAG2_HERE();
#if defined(DUMP_WHICH) && DUMP_WHICH < 4
        hipLaunchKernelGGL(k_dump, dim3(1024), dim3(256), 0, stream, p, DUMP_WHICH); return;
#endif
        L_(k_gate, l); DIAG_AT(3);
#if defined(DUMP_WHICH) && DUMP_WHICH == 4
        hipLaunchKernelGGL(k_dump, dim3(1024), dim3(256), 0, stream, p, DUMP_WHICH); return;
#endif
        L_(k_merge, l); DIAG_AT(4);
#if defined(DUMP_WHICH) && (DUMP_WHICH == 7 || DUMP_WHICH == 8 || DUMP_WHICH == 9)
        hipLaunchKernelGGL(k_dump, dim3(1024), dim3(256), 0, stream, p, DUMP_WHICH); return;
#endif
        L_(k_mergesum, l); DIAG_AT(12);
#if defined(DUMP_WHICH) && DUMP_WHICH == 10
        L_(k_gate, l); L_(k_merge, l); L_(k_mergesum2, l); hipLaunchKernelGGL(k_dump, dim3(1024), dim3(256), 0, stream, p, DUMP_WHICH); return;
#endif
#if defined(DUMP_WHICH) && DUMP_WHICH == 5
        hipLaunchKernelGGL(k_dump, dim3(1024), dim3(256), 0, stream, p, DUMP_WHICH); return;
#endif
        L_(k_out, l); DIAG_AT(5);
#if defined(DUMP_WHICH) && DUMP_WHICH == 6
        hipLaunchKernelGGL(k_dump, dim3(1024), dim3(256), 0, stream, p, DUMP_WHICH); return;
#endif
#if defined(DIAGS)
        if (l == DIAG_L) { hipMemcpyAsync(p.G, p.out, (size_t)T * D * 4, hipMemcpyDeviceToDevice, stream); L_(k_normB, l); DIAG_AT(13); } else
#endif
        L_(k_normB, l);
#if defined(STOP_AFTER) && STOP_AFTER == 2
        return;
#endif
        L_(k_up1, l); L_(k_dn1, l); DIAG_AT(11);
#if defined(DIAGS)
        if (l == DIAG_L) { hipMemcpyAsync(p.G, p.out, (size_t)T * D * 4, hipMemcpyDeviceToDevice, stream); if (l == 0) { L_(k_normC, l); DIAG_AT(14); } else { L_(k_normEnd, l); DIAG_AT(15); } } else
#endif
        { if (l == 0) L_(k_normC, l); else L_(k_normEnd, l); }
    }
#if defined(DIAGS)
    hipLaunchKernelGGL(k_diag_final, dim3(1024), dim3(256), 0, stream, p, 0);
#endif
#if defined(DIAG_IDENT_LO)
    hipLaunchKernelGGL(k_diag_ident, dim3(1024), dim3(256), 0, stream, p, 0);
#endif
}
```

```cpp
#define ONE_LAUNCH 1
#include <hip/hip_runtime.h>
#include <stdint.h>
#include <stdio.h>

#define LAS __attribute__((address_space(3)))
#define DI __device__ __forceinline__
typedef unsigned short bf16_t;
typedef short bf16x8 __attribute__((ext_vector_type(8)));
typedef float f32x4 __attribute__((ext_vector_type(4)));
typedef float f32x2 __attribute__((ext_vector_type(2)));
typedef unsigned u32x4 __attribute__((ext_vector_type(4)));
typedef unsigned u32x2 __attribute__((ext_vector_type(2)));

constexpr int NB = 4, SEQ = 4096, T = NB * SEQ, D = 2048, DFF = 5632;
constexpr int NP1 = 5192, NP1P = 5376, NGATE = 8192, PROJ_IN = 13384;
constexpr int C_NSA_Q = 0, C_NSA_KC = 512, C_NSA_VC = 640, C_NSA_KS = 768, C_NSA_VS = 896, C_NSA_KW = 1024, C_NSA_VW = 1152, C_NSA_GL = 1280;
constexpr int C_RW = 1304, C_RW_R = 1304, C_RW_WLO = 1816, C_RW_K = 1880, C_RW_V = 2392, C_RW_ALO = 2904, C_RW_GLO = 2968;
constexpr int C_GLA_Q = 3096, C_GLA_K = 3352, C_GLA_V = 3608, C_GLA_ALO = 4120, C_GLA_R = 4136;
constexpr int C_MLA_CQ = 4648, C_MLA_CKV = 5032, C_MLA_KR = 5160;
constexpr float NORM_EPS = 1e-6f;

DI float bf2f(bf16_t v) { return __uint_as_float(((unsigned)v) << 16); }
DI bf16_t f2bf(float f) { unsigned u = __float_as_uint(f); u += 0x7FFFu + ((u >> 16) & 1u); return (bf16_t)(u >> 16); }
typedef __bf16 bf16x2_t_ __attribute__((ext_vector_type(2)));
DI unsigned pk2(float lo, float hi) { const f32x2 v = {lo, hi}; return __builtin_bit_cast(unsigned, __builtin_convertvector(v, bf16x2_t_)); }
DI float sigmoidf_(float x) { return 1.0f / (1.0f + __expf(-x)); }
DI float wsum(float v) {
#pragma unroll
    for (int o = 32; o >= 1; o >>= 1) v += __shfl_xor(v, o);
    return v;
}
DI float wmax(float v) {
#pragma unroll
    for (int o = 32; o >= 1; o >>= 1) v = fmaxf(v, __shfl_xor(v, o));
    return v;
}

DI int TIDX() { int t = (int)threadIdx.x; asm volatile("" : "+v"(t)); return t; }
DI int BIDX() { int t = __builtin_amdgcn_readfirstlane((int)blockIdx.x); asm volatile("" : "+s"(t)); return t; }
DI int NBLK() { int t = __builtin_amdgcn_readfirstlane((int)gridDim.x); asm volatile("" : "+s"(t)); return t; }

struct Params {
    const float *x, *c, *ada_w, *ada_b, *pre_g, *post_g, *ffn_wg, *ffn_wu, *ffn_wd, *mix_w_in, *mix_w_branch, *mix_w_out;
    const float *cmp_pos, *cmp_w1, *cmp_w2;
    const float *rw_mu, *rw_w0, *rw_w_w2, *rw_a0, *rw_a_w2, *rw_g_w2, *rw_k_k, *rw_k_a, *rw_r_k, *rw_ln_w, *rw_ln_b;
    const float *gla_w2, *gla_b, *gla_g;
    const float *mla_qn, *mla_wuq, *mla_kvn, *mla_wukv;
    float* out;
    unsigned* bar;
    float *mod, *cos64, *sin64, *cos32, *sin32;
    bf16_t *Wup0, *Wup1, *Wdn0, *Wdn1, *Win1, *Wg, *Wbr, *Wout, *Wuq, *Wukv;
    bf16_t *u, *P1, *G;
    float* y;
    bf16_t *nsa_q, *nsa_kc_in, *nsa_vc_in, *nsa_ks, *nsa_vs, *nsa_kw, *nsa_vw;
    float *nsa_gate, *nsa_kc, *nsa_vc, *nsa_ocmp;
    unsigned long long* nsa_sel;
    bf16_t *rw_r, *rw_k, *rw_v, *rw_g;
    float *rw_w, *rw_kk, *rw_b, *rw_y;
    float *gla_la, *gla_o;
    bf16_t *mla_cqn, *mla_ckvn, *mla_kpe, *mla_q, *mla_kv;
    bf16_t* ys;
    bf16_t* mg;
    bf16_t *cW1t, *cW2t, *chid;
    float* cbias;
    bf16_t* rwWlT;
};
typedef const __attribute__((address_space(4))) Params* KParamsPtr;
#define XB_TMO      128
#define XB_XCNT(j)  (256  + 64 * (j))
#define XB_XSUB(j)  (1280 + 64 * (j))
#define XB_XGEN(j)  (2304 + 64 * (j))
#define XB_TOP      3328
#define XB_TOPGEN   3392
#define XCD_BAR_WORDS 3456
#define XB_SPIN_CAP (1u << 18)

__device__ __forceinline__ unsigned xb_ld(unsigned* p)              { return __hip_atomic_load(p, __ATOMIC_RELAXED, __HIP_MEMORY_SCOPE_AGENT); }
__device__ __forceinline__ unsigned xb_add(unsigned* p, unsigned v) { return __hip_atomic_fetch_add(p, v, __ATOMIC_RELAXED, __HIP_MEMORY_SCOPE_AGENT); }
__device__ __forceinline__ unsigned xb_xcc_id() { return (unsigned)__builtin_amdgcn_s_getreg((3 << 11) | 20) & 0xFu; }
#define XB_SPIN(cond, bar) do { unsigned _sp = 0; while (cond) { __builtin_amdgcn_s_sleep(1); \
    if ((++_sp & 255u) == 0u) { if (xb_ld(&(bar)[XB_TMO])) break; if (_sp > XB_SPIN_CAP) { atomicAdd(&(bar)[XB_TMO], 1u); break; } } } } while (0)

struct XcdBarrier {
    unsigned* bar; unsigned x;
    volatile LAS unsigned* st;
};

__device__ __forceinline__ XcdBarrier xcd_barrier_post(unsigned* bar, volatile LAS unsigned* st) {
    XcdBarrier b; b.bar = bar; b.x = xb_xcc_id(); b.st = st;
    if (threadIdx.x == 0) (void)xb_add(&bar[XB_XCNT(b.x)], 1u);
    return b;
}
__device__ __forceinline__ void xcd_barrier_complete(unsigned* bar, unsigned x, unsigned& nloc, unsigned& nx) {
    const unsigned G = gridDim.x * gridDim.y * gridDim.z;
    unsigned sum, cnt, mine, sp = 0u;
    for (;;) {
        sum = 0u; cnt = 0u; mine = 0u;
#pragma unroll
        for (unsigned j = 0; j < 16; ++j) { const unsigned c = xb_ld(&bar[XB_XCNT(j)]); sum += c; cnt += (c > 0u) ? 1u : 0u; mine = (j == x) ? c : mine; }
        if (sum == G) break;
        __builtin_amdgcn_s_sleep(1);
        if ((++sp & 255u) == 0u) { if (xb_ld(&bar[XB_TMO])) break; if (sp > XB_SPIN_CAP) { atomicAdd(&bar[XB_TMO], 1u); break; } }
    }
    nloc = mine > 0u ? mine : 1u; nx = cnt > 0u ? cnt : 1u;
}

__device__ __forceinline__ void xcd_barrier(const XcdBarrier& b) {
    asm volatile("s_waitcnt vmcnt(0)" ::: "memory");
    __syncthreads();
    if (threadIdx.x == 0) {
        unsigned* bar = b.bar;
        __builtin_amdgcn_s_waitcnt(0);
        unsigned nloc = b.st[0], nx = b.st[1];
        if (nloc == 0u) { xcd_barrier_complete(bar, b.x, nloc, nx); b.st[0] = nloc; b.st[1] = nx; }
        const unsigned old = xb_add(&bar[XB_XSUB(b.x)], 1u);
        const unsigned gen = old / nloc;
        if (old + 1u == (gen + 1u) * nloc) {
            __builtin_amdgcn_fence(__ATOMIC_RELEASE, "agent");
            asm volatile("s_waitcnt vmcnt(0)" ::: "memory");
            const unsigned og = xb_add(&bar[XB_TOP], 1u);
            const unsigned tg = og / nx;
            if (og + 1u == (tg + 1u) * nx) xb_add(&bar[XB_TOPGEN], 1u);
            else XB_SPIN(xb_ld(&bar[XB_TOPGEN]) == tg, bar);
            __builtin_amdgcn_fence(__ATOMIC_ACQUIRE, "agent");
            xb_add(&bar[XB_XGEN(b.x)], 1u);
            asm volatile("s_waitcnt vmcnt(0)" ::: "memory");
        } else {
            XB_SPIN(xb_ld(&bar[XB_XGEN(b.x)]) == gen, bar);
            __builtin_amdgcn_fence(__ATOMIC_ACQUIRE, "agent");
            asm volatile("s_waitcnt vmcnt(0)" ::: "memory");
        }
    }
    __syncthreads();
}

namespace pg8 {
#define PG8_LAS __attribute__((address_space(3)))
constexpr int BM = 256, BK = 64, HALF = 128, HTB = HALF * BK * 2  , STAGE_BYTES = 8 * HTB, NXCD = 8, WGM = 8;

__host__ __device__ __forceinline__ int lds_byte(int r, int c) { const int st = (r >> 4) * 2 + (c >> 5), rr = r & 15, cc = c & 31, ob = rr * 64 + cc * 2; return st * 1024 + (ob ^ (((ob >> 9) & 1) << 5)); }
__host__ __device__ __forceinline__ void stage_rc(int b, int& R, int& C) { const int st = b / 1024, sb = b % 1024, swz = sb ^ (((sb >> 9) & 1) << 5); R = (st >> 1) * 16 + swz / 64; C = (st & 1) * 32 + (swz % 64) / 2; }
__host__ __device__ __forceinline__ int perm32(int rho) { const int n = rho >> 4, i = rho & 15; return 8 * (i >> 2) + 4 * n + (i & 3); }

struct Unit { int pm, pn; };
struct Gemm { const bf16_t* A; const bf16_t* Bt; int M, N, K, lda, ldb; };

struct StaticOrder {
    int nM, nN, nwg, G, c;
    __host__ __device__ void init(int M, int N, int G_, int c_) { nM = M / BM; nN = N / BM; nwg = nM * nN; G = G_; c = c_; }
    __host__ __device__ bool next(int i, Unit& u) const {
        const long L = (long)i * G + c; if (L >= nwg) return false;
        int wgid = (int)L; { const int q = nwg / NXCD, r = nwg % NXCD, xcd = wgid % NXCD, off = wgid / NXCD; wgid = (xcd < r ? xcd * (q + 1) : r * (q + 1) + (xcd - r) * q) + off; }
        const int nig = WGM * nN, gid = wgid / nig, fm = gid * WGM, gsz = (nM - fm) < WGM ? (nM - fm) : WGM;
        u.pm = fm + ((wgid % nig) % gsz); u.pn = (wgid % nig) / gsz; return true;
    }
    __device__ __forceinline__ void a_ready(const Unit&) const {}
    __device__ __forceinline__ void done(const Unit&) const {}
};
struct CountedOrder : StaticOrder {
    const unsigned* ready; unsigned need; unsigned* tmo;
    __device__ __forceinline__ void a_ready(const Unit& u) const {
        if (TIDX() < 64) {
            const unsigned long long t0 = __builtin_amdgcn_s_memrealtime(); unsigned polls = 0;
            while ((unsigned)__builtin_amdgcn_readfirstlane(__hip_atomic_load(ready + 64 * u.pm, __ATOMIC_RELAXED, __HIP_MEMORY_SCOPE_AGENT)) < need) {
                if ((++polls & 255u) == 0u && __builtin_amdgcn_readfirstlane(__hip_atomic_load(tmo, __ATOMIC_RELAXED, __HIP_MEMORY_SCOPE_AGENT)) != 0u) break;
                if (__builtin_amdgcn_s_memrealtime() - t0 > 2000000ull) {
                    if (TIDX() == 0) { unsigned expect = 0u; __hip_atomic_compare_exchange_strong(tmo + 1, &expect, 0x600u | (unsigned)(u.pm & 0xff), __ATOMIC_RELAXED, __ATOMIC_RELAXED, __HIP_MEMORY_SCOPE_AGENT); __hip_atomic_store(tmo, 1u, __ATOMIC_RELAXED, __HIP_MEMORY_SCOPE_AGENT); }
                    break; }
                __builtin_amdgcn_s_sleep(2); }
            __builtin_amdgcn_fence(__ATOMIC_ACQUIRE, "agent");
            asm volatile("s_waitcnt vmcnt(0)" ::: "memory");
        }
#if !defined(BROKEN_HOOK_NO_BARRIER)
        asm volatile("" ::: "memory"); __builtin_amdgcn_s_barrier(); asm volatile("" ::: "memory");
#endif
    }
};


template <class Epi, class Sched, bool STAMP = false>
__device__ __forceinline__ void gemm_phase(PG8_LAS unsigned char* lds, const Gemm g, const Sched& S, const Epi& E, unsigned long long* stamps) {
    const int tid = TIDX(), wid = __builtin_amdgcn_readfirstlane(tid >> 6), lane = tid & 63, wr = wid >> 2, wc = wid & 3, fr = lane & 15, fq = lane >> 4;
    const int K = g.K, nt = K / BK;
    int ts_lo = 0, ts_hi = 0, nts = 0; const unsigned long long rt_entry = STAMP ? (unsigned long long)wall_clock64() : 0ull;
#define PG8_STAMP() do { if (STAMP && wid == 0 && nts < 64) { const unsigned long long _c = (unsigned long long)clock64(); \
        ts_lo = (lane == nts) ? (int)(unsigned)_c : ts_lo; ts_hi = (lane == nts) ? (int)(unsigned)(_c >> 32) : ts_hi; ++nts; } } while (0)
    PG8_STAMP();
    unsigned voffA[2], voffB[2];
#pragma unroll
    for (int i = 0; i < 2; ++i) { int R, C; stage_rc(tid * 16 + i * 8192, R, C); const int Rb = Epi::PERM ? ((R & ~31) + perm32(R & 31)) : R;
        voffA[i] = (unsigned)(R * g.lda + C) * 2u; voffB[i] = (unsigned)(Rb * g.ldb + C) * 2u; }
    const size_t kstep = (size_t)(BK * 2);
    const size_t hstepA = (size_t)HALF * g.lda * 2, hstepB = (size_t)HALF * g.ldb * 2;
    const size_t tstepA = 2 * hstepA, tstepB = 2 * hstepB;
    const unsigned ldsw = (unsigned)wid * 1024u;
    const int aoff = lds_byte(wr * 64 + fr, fq * 8), boff = lds_byte(wc * 32 + fr, fq * 8);
#define PG8_SA(b, h) (((b) * 2 + (h)) * HTB)
#define PG8_SB(b, h) ((4 + (b) * 2 + (h)) * HTB)
#define PG8_STAGE(bufoff, gbase, voff) do { _Pragma("unroll") for (int _i = 0; _i < 2; ++_i) \
        __builtin_amdgcn_global_load_lds((const unsigned*)((const char*)(gbase) + (voff)[_i]), (PG8_LAS unsigned*)(lds + (bufoff) + ldsw + _i * 8192), 16, 0, 0); } while (0)
#define PG8_LDA(dst, b, h) do { _Pragma("unroll") for (int m = 0; m < 4; ++m) _Pragma("unroll") for (int k = 0; k < 2; ++k) dst[m][k] = *(const PG8_LAS bf16x8*)(lds + PG8_SA(b, h) + aoff + m * 2048 + k * 1024); } while (0)
#define PG8_LDB(dst, b, h) do { _Pragma("unroll") for (int n = 0; n < 2; ++n) _Pragma("unroll") for (int k = 0; k < 2; ++k) dst[n][k] = *(const PG8_LAS bf16x8*)(lds + PG8_SB(b, h) + boff + n * 2048 + k * 1024); } while (0)
#define PG8_MMA(ai, bj, At, Bt) do { __builtin_amdgcn_s_setprio(1); _Pragma("unroll") for (int m = 0; m < 4; ++m) _Pragma("unroll") for (int n = 0; n < 2; ++n) _Pragma("unroll") for (int k = 0; k < 2; ++k) \
        acc[ai][bj][m][n] = __builtin_amdgcn_mfma_f32_16x16x32_bf16(Bt[n][k], At[m][k], acc[ai][bj][m][n], 0, 0, 0); __builtin_amdgcn_s_setprio(0); } while (0)
#define PG8_WAIT_V(n) asm volatile("s_waitcnt vmcnt(" #n ")" ::: "memory")
#define PG8_WAIT_L(n) asm volatile("s_waitcnt lgkmcnt(" #n ")" ::: "memory")
#define PG8_BAR __builtin_amdgcn_s_barrier()
#define PG8_SCHED __builtin_amdgcn_sched_barrier(0)
    Unit cur, nxt; int ui = 0;
    if (!S.next(0, cur)) return;
    f32x4 acc[2][2][4][2];
#pragma unroll
    for (int a = 0; a < 2; ++a)
#pragma unroll
        for (int b = 0; b < 2; ++b)
#pragma unroll
            for (int m = 0; m < 4; ++m)
#pragma unroll
                for (int n = 0; n < 2; ++n) acc[a][b][m][n] = (f32x4){0.f, 0.f, 0.f, 0.f};
    bf16x8 At[4][2], B0[2][2], B1[2][2];
    const char* cA = (const char*)g.A + (size_t)cur.pm * tstepA; const char* cB = (const char*)g.Bt + (size_t)cur.pn * tstepB;
    S.a_ready(cur);
    PG8_STAGE(PG8_SB(0, 0), cB, voffB); PG8_STAGE(PG8_SA(0, 0), cA, voffA); PG8_STAGE(PG8_SB(0, 1), cB + hstepB, voffB); PG8_STAGE(PG8_SA(0, 1), cA + hstepA, voffA);
    if (wr == 1) PG8_BAR;
    PG8_WAIT_V(4); PG8_BAR;
    PG8_STAGE(PG8_SB(1, 0), cB + kstep, voffB); PG8_STAGE(PG8_SA(1, 0), cA + kstep, voffA); PG8_STAGE(PG8_SB(1, 1), cB + hstepB + kstep, voffB);
    PG8_WAIT_V(6); PG8_BAR;
    PG8_STAMP();
    for (;;) {
        const bool has_next = S.next(ui + 1, nxt);
        const char* nA = has_next ? (const char*)g.A + (size_t)nxt.pm * tstepA : cA; const char* nB = has_next ? (const char*)g.Bt + (size_t)nxt.pn * tstepB : cB;
        for (int t = 0; t < nt; t += 2) {
            const bool last = (t == nt - 2);
            const char* a1 = cA + (size_t)(t + 1) * kstep;
            const char* a2 = last ? nA : cA + (size_t)(t + 2) * kstep; const char* b2 = last ? nB : cB + (size_t)(t + 2) * kstep;
            const char* a3 = a2 + kstep; const char* b3 = b2 + kstep;
            if (last && has_next) S.a_ready(nxt);
            PG8_LDB(B0, 0, 0); PG8_SCHED; PG8_LDA(At, 0, 0); PG8_STAGE(PG8_SA(1, 1), a1 + hstepA, voffA);
            PG8_WAIT_L(8); PG8_BAR; PG8_WAIT_L(0); PG8_MMA(0, 0, At, B0); PG8_BAR; PG8_SCHED;
            PG8_LDB(B1, 0, 1); PG8_STAGE(PG8_SB(0, 0), b2, voffB);
            PG8_BAR; PG8_WAIT_L(0); PG8_MMA(0, 1, At, B1); PG8_BAR;
            PG8_LDA(At, 0, 1); PG8_STAGE(PG8_SA(0, 0), a2, voffA);
            PG8_BAR; PG8_WAIT_L(0); PG8_MMA(1, 0, At, B0); PG8_BAR; PG8_SCHED;
            PG8_STAGE(PG8_SB(0, 1), b2 + hstepB, voffB);
            PG8_WAIT_V(6); PG8_BAR; PG8_MMA(1, 1, At, B1); PG8_BAR;
            PG8_LDB(B0, 1, 0); PG8_SCHED; PG8_LDA(At, 1, 0); PG8_STAGE(PG8_SA(0, 1), a2 + hstepA, voffA);
            PG8_WAIT_L(8); PG8_BAR; PG8_WAIT_L(0); PG8_MMA(0, 0, At, B0); PG8_BAR; PG8_SCHED;
            PG8_LDB(B1, 1, 1); PG8_STAGE(PG8_SB(1, 0), b3, voffB);
            PG8_BAR; PG8_WAIT_L(0); PG8_MMA(0, 1, At, B1); PG8_BAR;
            PG8_LDA(At, 1, 1); PG8_STAGE(PG8_SA(1, 0), a3, voffA);
            PG8_BAR; PG8_WAIT_L(0); PG8_MMA(1, 0, At, B0); PG8_BAR; PG8_SCHED;
            PG8_STAGE(PG8_SB(1, 1), b3 + hstepB, voffB);
            PG8_WAIT_V(6); PG8_BAR; PG8_MMA(1, 1, At, B1); PG8_BAR;
        }
        PG8_STAMP();
        if constexpr (!Epi::AFTER_DRAIN) { E(acc, cur, wr, wc, fr, fq); S.done(cur); }
        PG8_STAMP();
        if (!has_next) break;
#pragma unroll
        for (int a = 0; a < 2; ++a)
#pragma unroll
            for (int b = 0; b < 2; ++b)
#pragma unroll
                for (int m = 0; m < 4; ++m)
#pragma unroll
                    for (int n = 0; n < 2; ++n) acc[a][b][m][n] = (f32x4){0.f, 0.f, 0.f, 0.f};
        cur = nxt; cA = nA; cB = nB; ++ui;
    }
    PG8_WAIT_V(0);
    if (wr == 0) PG8_BAR;
    PG8_BAR;
    if constexpr (Epi::AFTER_DRAIN) { E.fused(acc, cur, wr, wc, fr, fq, lds, wid, lane); S.done(cur); }
    PG8_STAMP();
    if (STAMP && wid == 0) { stamps[lane] = lane < nts ? (((unsigned long long)(unsigned)ts_hi << 32) | (unsigned)ts_lo) : 0ull;
        if (lane == 62) stamps[62] = rt_entry; if (lane == 63) stamps[63] = (unsigned long long)wall_clock64(); }
#undef PG8_STAMP
#undef PG8_SA
#undef PG8_SB
#undef PG8_STAGE
#undef PG8_LDA
#undef PG8_LDB
#undef PG8_MMA
#undef PG8_WAIT_V
#undef PG8_WAIT_L
#undef PG8_BAR
#undef PG8_SCHED
}
}
typedef __bf16 bf16x2_n __attribute__((ext_vector_type(2)));
DI unsigned cvt_pk_bf16(float lo, float hi) { const f32x2 v = {lo, hi}; return __builtin_bit_cast(unsigned, __builtin_convertvector(v, bf16x2_n)); }
DI float fast_sigmoid(float x) { return __builtin_amdgcn_rcpf(1.0f + __expf(-x)); }

struct EpiF32 {
    static constexpr bool PERM = false, AFTER_DRAIN = false;
    float* C; int ldc;
    DI void operator()(const f32x4 (&acc)[2][2][4][2], const pg8::Unit& u, int wr, int wc, int fr, int fq) const {
        const int row0 = u.pm * 256 + wr * 64 + fr, col0 = u.pn * 256 + wc * 32 + 4 * fq;
#pragma unroll
        for (int ai = 0; ai < 2; ++ai)
#pragma unroll
            for (int m = 0; m < 4; ++m) { float* rowp = C + (size_t)(row0 + ai * 128 + m * 16) * ldc + col0;
#pragma unroll
                for (int bj = 0; bj < 2; ++bj)
#pragma unroll
                    for (int n = 0; n < 2; ++n) *(f32x4*)(rowp + bj * 128 + n * 16) = acc[ai][bj][m][n]; }
    }
};
struct EpiF32Lo {
    static constexpr bool PERM = false, AFTER_DRAIN = false;
    float* C; int ldc;
    DI void operator()(const f32x4 (&acc)[2][2][4][2], const pg8::Unit& u, int wr, int wc, int fr, int fq) const {
        const int row0 = u.pm * 256 + wr * 64 + fr, col0 = u.pn * 256 + wc * 32 + 4 * fq;
#pragma unroll
        for (int ai = 0; ai < 2; ++ai)
#pragma unroll
            for (int m = 0; m < 4; ++m) { float* rowp = C + (size_t)(row0 + ai * 128 + m * 16) * ldc + col0;
#pragma unroll
                for (int n = 0; n < 2; ++n) *(f32x4*)(rowp + n * 16) = acc[ai][0][m][n]; }
    }
};
template <int ACT  > struct EpiBf16 {
    static constexpr bool PERM = true, AFTER_DRAIN = false;
    bf16_t* O; int ldc;
    DI void operator()(const f32x4 (&acc)[2][2][4][2], const pg8::Unit& u, int wr, int wc, int fr, int fq) const {
        const int row0 = u.pm * 256 + wr * 64 + fr, col0 = u.pn * 256 + wc * 32 + 8 * fq;
#pragma unroll
        for (int ai = 0; ai < 2; ++ai)
#pragma unroll
            for (int m = 0; m < 4; ++m) { bf16_t* rowp = O + (size_t)(row0 + ai * 128 + m * 16) * ldc + col0;
#pragma unroll
                for (int bj = 0; bj < 2; ++bj) { f32x4 v0 = acc[ai][bj][m][0], v1 = acc[ai][bj][m][1];
#if defined(NOISE_P1)
                    if (ACT == 0) { unsigned hsh = (unsigned)(row0 + ai * 128 + m * 16) * 2654435761u ^ (unsigned)(col0 + bj * 128) * 40503u;
#pragma unroll
                        for (int j = 0; j < 4; ++j) { hsh = hsh * 1664525u + 1013904223u; v0[j] *= 1.0f + NOISE_P1 * ((float)(hsh >> 8) * (1.0f / 8388608.0f) - 1.0f); hsh = hsh * 1664525u + 1013904223u; v1[j] *= 1.0f + NOISE_P1 * ((float)(hsh >> 8) * (1.0f / 8388608.0f) - 1.0f); } }
#endif
                    if (ACT == 1) {
#pragma unroll
                        for (int j = 0; j < 4; ++j) { v0[j] = fast_sigmoid(v0[j]); v1[j] = fast_sigmoid(v1[j]); } }
                    u32x4 w; w.x = cvt_pk_bf16(v0[0], v0[1]); w.y = cvt_pk_bf16(v0[2], v0[3]); w.z = cvt_pk_bf16(v1[0], v1[1]); w.w = cvt_pk_bf16(v1[2], v1[3]);
                    *(u32x4*)(rowp + bj * 128) = w; } }
    }
};
struct EpiSwiglu {
    static constexpr bool PERM = true, AFTER_DRAIN = false;
    bf16_t* H; int ldc;
    DI void operator()(const f32x4 (&acc)[2][2][4][2], const pg8::Unit& u, int wr, int wc, int fr, int fq) const {
        const int row0 = u.pm * 256 + wr * 64 + fr, col0 = u.pn * 128 + wc * 32 + 8 * fq;
#pragma unroll
        for (int ai = 0; ai < 2; ++ai)
#pragma unroll
            for (int m = 0; m < 4; ++m) { bf16_t* rowp = H + (size_t)(row0 + ai * 128 + m * 16) * ldc + col0;
                float h[8];
#pragma unroll
                for (int n = 0; n < 2; ++n)
#pragma unroll
                    for (int j = 0; j < 4; ++j) { const float g = acc[ai][0][m][n][j], up = acc[ai][1][m][n][j]; h[n * 4 + j] = g * fast_sigmoid(g) * up; }
                u32x4 w; w.x = cvt_pk_bf16(h[0], h[1]); w.y = cvt_pk_bf16(h[2], h[3]); w.z = cvt_pk_bf16(h[4], h[5]); w.w = cvt_pk_bf16(h[6], h[7]);
                *(u32x4*)rowp = w; }
    }
};
struct EpiPart {
    static constexpr bool PERM = true, AFTER_DRAIN = false;
    bf16_t* part01; bf16_t* part23;
    DI void operator()(const f32x4 (&acc)[2][2][4][2], const pg8::Unit& u, int wr, int wc, int fr, int fq) const {
        const int br = u.pm >> 6, pm = u.pm & 63, pn = u.pn & 7;
        bf16_t* O = (br < 2 ? part01 : part23) + (size_t)(br & 1) * T * 2048;
        const int row0 = pm * 256 + wr * 64 + fr, col0 = pn * 256 + wc * 32 + 8 * fq;
#pragma unroll
        for (int ai = 0; ai < 2; ++ai)
#pragma unroll
            for (int m = 0; m < 4; ++m) { bf16_t* rowp = O + (size_t)(row0 + ai * 128 + m * 16) * 2048 + col0;
#pragma unroll
                for (int bj = 0; bj < 2; ++bj) { const f32x4 v0 = acc[ai][bj][m][0], v1 = acc[ai][bj][m][1];
                    u32x4 w; w.x = cvt_pk_bf16(v0[0], v0[1]); w.y = cvt_pk_bf16(v0[2], v0[3]); w.z = cvt_pk_bf16(v1[0], v1[1]); w.w = cvt_pk_bf16(v1[2], v1[3]);
                    *(u32x4*)(rowp + bj * 128) = w; } }
    }
};
struct EpiMergeAcc {
    static constexpr bool PERM = true, AFTER_DRAIN = false;
    const bf16_t* G; bf16_t* O;
    DI void operator()(const f32x4 (&acc)[2][2][4][2], const pg8::Unit& u, int wr, int wc, int fr, int fq) const {
        const int br = u.pm >> 6, pm = u.pm & 63, pn = u.pn & 7;
        const int row0 = pm * 256 + wr * 64 + fr, col0 = pn * 256 + wc * 32 + 8 * fq;
#pragma unroll
        for (int ai = 0; ai < 2; ++ai) {
            u32x4 gw[4][2], ow[4][2];
#pragma unroll
            for (int m = 0; m < 4; ++m) { const size_t row = (size_t)(row0 + ai * 128 + m * 16);
#pragma unroll
                for (int bj = 0; bj < 2; ++bj) { gw[m][bj] = *(const u32x4*)(G + row * NGATE + br * 2048 + col0 + bj * 128);
                    ow[m][bj] = br > 0 ? *(const u32x4*)(O + row * 2048 + col0 + bj * 128) : (u32x4){0u, 0u, 0u, 0u}; } }
#pragma unroll
            for (int m = 0; m < 4; ++m) { bf16_t* op = O + (size_t)(row0 + ai * 128 + m * 16) * 2048 + col0;
#pragma unroll
                for (int bj = 0; bj < 2; ++bj) { const f32x4 v0 = acc[ai][bj][m][0], v1 = acc[ai][bj][m][1]; const u32x4 g = gw[m][bj], o = ow[m][bj];
                    float r[8];
                    r[0] = __uint_as_float(g.x << 16) * v0[0] + __uint_as_float(o.x << 16); r[1] = __uint_as_float(g.x & 0xffff0000u) * v0[1] + __uint_as_float(o.x & 0xffff0000u);
                    r[2] = __uint_as_float(g.y << 16) * v0[2] + __uint_as_float(o.y << 16); r[3] = __uint_as_float(g.y & 0xffff0000u) * v0[3] + __uint_as_float(o.y & 0xffff0000u);
                    r[4] = __uint_as_float(g.z << 16) * v1[0] + __uint_as_float(o.z << 16); r[5] = __uint_as_float(g.z & 0xffff0000u) * v1[1] + __uint_as_float(o.z & 0xffff0000u);
                    r[6] = __uint_as_float(g.w << 16) * v1[2] + __uint_as_float(o.w << 16); r[7] = __uint_as_float(g.w & 0xffff0000u) * v1[3] + __uint_as_float(o.w & 0xffff0000u);
                    u32x4 w; w.x = cvt_pk_bf16(r[0], r[1]); w.y = cvt_pk_bf16(r[2], r[3]); w.z = cvt_pk_bf16(r[4], r[5]); w.w = cvt_pk_bf16(r[6], r[7]);
                    *(u32x4*)(op + bj * 128) = w; } }
        }
    }
};
struct MergeOrder {
    int G, c;
    DI bool next(int i, pg8::Unit& u) const {
        const int ti = i >> 2, br = i & 3; const int tile = ti * G + c; if (tile >= 512) return false;
        int tm = tile >> 3, tn = tile & 7;
        if (G == 256) { const int x = c & 7, r = c >> 3; tm = ti * 32 + x * 4 + (r >> 3); tn = r & 7; }
        u.pm = br * 64 + tm; u.pn = br * 8 + tn; return true;
    }
    DI void a_ready(const pg8::Unit&) const {}
    DI void done(const pg8::Unit&) const {}
};

struct EpiGeluBias {
    static constexpr bool PERM = true, AFTER_DRAIN = false;
    bf16_t* O; int ldc; const float* bias;
    DI void operator()(const f32x4 (&acc)[2][2][4][2], const pg8::Unit& u, int wr, int wc, int fr, int fq) const {
        const int row0 = u.pm * 256 + wr * 64 + fr, col0 = u.pn * 256 + wc * 32 + 8 * fq;
#pragma unroll
        for (int ai = 0; ai < 2; ++ai)
#pragma unroll
            for (int m = 0; m < 4; ++m) { bf16_t* rowp = O + (size_t)(row0 + ai * 128 + m * 16) * ldc + col0;
#pragma unroll
                for (int bj = 0; bj < 2; ++bj) { float h[8];
#pragma unroll
                    for (int n = 0; n < 2; ++n)
#pragma unroll
                        for (int j = 0; j < 4; ++j) { const float x = acc[ai][bj][m][n][j] + bias[col0 + bj * 128 + n * 4 + j];
                            const float z = 0.7978845608028654f * (x + 0.044715f * x * x * x), th = 1.0f - 2.0f * __builtin_amdgcn_rcpf(1.0f + __expf(2.0f * z));
                            h[n * 4 + j] = 0.5f * x * (1.0f + th); }
                    u32x4 w; w.x = cvt_pk_bf16(h[0], h[1]); w.y = cvt_pk_bf16(h[2], h[3]); w.z = cvt_pk_bf16(h[4], h[5]); w.w = cvt_pk_bf16(h[6], h[7]);
                    *(u32x4*)(rowp + bj * 128) = w; } }
    }
};
struct EpiCmpOut {
    static constexpr bool PERM = false, AFTER_DRAIN = false;
    float* C;
    DI void operator()(const f32x4 (&acc)[2][2][4][2], const pg8::Unit& u, int wr, int wc, int fr, int fq) const {
        if (wc >= 2) return;
        const int row0 = u.pm * 256 + wr * 64 + fr, col0 = wc * 32 + 4 * fq;
#pragma unroll
        for (int ai = 0; ai < 2; ++ai)
#pragma unroll
            for (int m = 0; m < 4; ++m) { float* rowp = C + (size_t)(row0 + ai * 128 + m * 16) * 64 + col0;
#pragma unroll
                for (int n = 0; n < 2; ++n) *(f32x4*)(rowp + n * 16) = acc[ai][0][m][n]; }
    }
};
struct SplitOrder {
    int first, count, nN;
    DI bool next(int i, pg8::Unit& u) const { if (i >= count) return false; const int idx = first + i; u.pm = idx / nN; u.pn = idx % nN; return true; }
    DI void a_ready(const pg8::Unit&) const {}
    DI void done(const pg8::Unit&) const {}
};
struct RowWalkOrder {
    int pm, pn0, step, count;
    DI bool next(int i, pg8::Unit& u) const { if (i >= count) return false; u.pm = pm; u.pn = pn0 + i * step; return true; }
    DI void a_ready(const pg8::Unit&) const {}
    DI void done(const pg8::Unit&) const {}
};
template <class Epi>
DI void run_gemm(LAS unsigned char* lds, const bf16_t* A, int lda, const bf16_t* Bt, int ldb, int M, int N, int K, const Epi& E) {
    pg8::Gemm g; g.A = A; g.Bt = Bt; g.M = M; g.N = N; g.K = K; g.lda = lda; g.ldb = ldb;
    pg8::StaticOrder S; S.init(M, N, NBLK(), BIDX());
    pg8::gemm_phase<Epi, pg8::StaticOrder, false>((PG8_LAS unsigned char*)lds, g, S, E, nullptr);
}
#ifndef PREP_R1
#define PREP_R1 1
#endif
#ifndef PREP_R2
#define PREP_R2 1
#endif
#ifndef PREP_R3
#define PREP_R3 1
#endif
#ifndef PREP_R4
#define PREP_R4 1
#endif
#ifndef ZRWKV
#define ZRWKV 1.0f
#endif
#ifndef ZGLA
#define ZGLA 1.0f
#endif
DI void phase_setup(KParamsPtr p, LAS unsigned char* lds) {
    const int tid = TIDX(), bid = BIDX(), nb = NBLK();
    for (int i = bid * 512 + tid; i < SEQ * 48; i += nb * 512) {
        const int pos = i / 48, j = i % 48;
        const bool big = j < 32; const int jj = big ? j : j - 32;
        const double inv = exp2(-(double)jj * (13.287712379549449 / (big ? 32.0 : 16.0)));
        const double a = (double)pos * inv;
        const double r = a - 6.283185307179586 * floor(a / 6.283185307179586);
        const float cs = (float)cos(r), sn = (float)sin(r);
        if (big) { p->cos64[pos * 32 + jj] = cs; p->sin64[pos * 32 + jj] = sn; } else { p->cos32[pos * 16 + jj] = cs; p->sin32[pos * 16 + jj] = sn; }
    }
    LAS float* sc = (LAS float*)lds;
    LAS float* red = (LAS float*)(lds + 32768);
    for (int i = tid; i < NB * D; i += 512) { const float c = p->c[i]; sc[i] = c / (1.0f + __expf(-c)); }
    __syncthreads();
    const int cg = tid & 15, ks = tid >> 4;
    for (int chunk = bid; chunk < 576; chunk += nb) {
        const int ls = chunk / 96, col0 = (chunk % 96) * 64;
        const float* W = p->ada_w + (size_t)ls * D * 6144 + col0 + cg * 4;
        float acc[4][4];
#pragma unroll
        for (int b = 0; b < 4; ++b)
#pragma unroll
            for (int j = 0; j < 4; ++j) acc[b][j] = 0.f;
#pragma unroll 16
        for (int kk = 0; kk < 64; ++kk) {
            const int k = ks * 64 + kk;
            const f32x4 w = *(const f32x4*)(W + (size_t)k * 6144);
#pragma unroll
            for (int b = 0; b < 4; ++b) { const float s = sc[b * D + k];
#pragma unroll
                for (int j = 0; j < 4; ++j) acc[b][j] += s * w[j]; }
        }
#pragma unroll
        for (int b = 0; b < 4; ++b)
#pragma unroll
            for (int j = 0; j < 4; ++j) red[(ks * 4 + b) * 64 + cg * 4 + j] = acc[b][j];
        __syncthreads();
        if (tid < 256) { const int b = tid >> 6, col = tid & 63; float s = 0.f;
            for (int q = 0; q < 32; ++q) s += red[(q * 4 + b) * 64 + col];
            p->mod[(size_t)(ls * 4 + b) * 6144 + col0 + col] = s + p->ada_b[ls * 6144 + col0 + col]; }
        __syncthreads();
    }
}

template <class Map>
DI void conv_job(const float* src, int Ks, int Ns, const float* kscale, bf16_t* dst, int ldd, Map map, LAS float* tl) {
    const int tid = TIDX(), bid = BIDX(), nb = NBLK();
    const int ntk = Ks / 64, ntn = (Ns + 63) / 64, nt = ntk * ntn;
    for (int tile = bid; tile < nt; tile += nb) {
        const int k0 = (tile % ntk) * 64, n0 = (tile / ntk) * 64;
#pragma unroll
        for (int it = 0; it < 2; ++it) {
            const int kr = (tid >> 4) + 32 * it, n = n0 + 4 * (tid & 15);
            f32x4 v = (f32x4){0.f, 0.f, 0.f, 0.f};
            if (n < Ns) v = *(const f32x4*)(src + (size_t)(k0 + kr) * Ns + n);
            if (kscale) v *= kscale[k0 + kr];
#pragma unroll
            for (int j = 0; j < 4; ++j) tl[kr * 65 + 4 * (tid & 15) + j] = v[j];
        }
        __syncthreads();
        { const int nn = tid >> 3, k8 = tid & 7, n = n0 + nn;
            if (n < Ns) { float f[8];
#pragma unroll
                for (int i = 0; i < 8; ++i) f[i] = tl[(k8 * 8 + i) * 65 + nn];
                u32x4 w; w.x = pk2(f[0], f[1]); w.y = pk2(f[2], f[3]); w.z = pk2(f[4], f[5]); w.w = pk2(f[6], f[7]);
                *(u32x4*)(dst + (size_t)map(n) * ldd + k0 + k8 * 8) = w; } }
        __syncthreads();
    }
}
DI void phase_convert(KParamsPtr p, int l, LAS unsigned char* lds) {
    LAS float* tl = (LAS float*)lds;
    const int tid = TIDX(), bid = BIDX(), nb = NBLK();
    const size_t fsz = (size_t)D * DFF;
    for (int f = 0; f < 2; ++f) {
        bf16_t* Wup = f ? p->Wup1 : p->Wup0; bf16_t* Wdn = f ? p->Wdn1 : p->Wdn0;
        conv_job(p->ffn_wg + (size_t)(l * 2 + f) * fsz, D, DFF, nullptr, Wup, D, [](int n) { return 256 * (n >> 7) + (n & 127); }, tl);
        conv_job(p->ffn_wu + (size_t)(l * 2 + f) * fsz, D, DFF, nullptr, Wup, D, [](int n) { return 256 * (n >> 7) + 128 + (n & 127); }, tl);
        conv_job(p->ffn_wd + (size_t)(l * 2 + f) * fsz, DFF, D, nullptr, Wdn, DFF, [](int n) { return n; }, tl);
    }
    conv_job(p->mix_w_in + (size_t)l * D * PROJ_IN, D, PROJ_IN, nullptr, p->Win1, D, [](int n) { return n < NP1 ? n : n - NP1 + NP1P; }, tl);
    for (int i = 0; i < 4; ++i)
        conv_job(p->mix_w_branch + (size_t)(l * 4 + i) * 512 * D, 512, D, nullptr, p->Wbr + (size_t)i * D * 512, 512, [](int n) { return n; }, tl);
    conv_job(p->mix_w_out + (size_t)l * D * D, D, D, nullptr, p->Wout, D, [](int n) { return n; }, tl);
    conv_job(p->mla_wuq + (size_t)l * 384 * 768, 384, 768, p->mla_qn + l * 384, p->Wuq, 384, [](int n) { return n; }, tl);
    conv_job(p->mla_wukv + (size_t)l * 128 * 1024, 128, 1024, p->mla_kvn + l * 128, p->Wukv, 256, [](int n) { return n; }, tl);
    for (int wh = 0; wh < 2; ++wh) {
        conv_job(p->cmp_w1 + (size_t)(l * 2 + wh) * 2048 * 256, 2048, 256, nullptr, p->cW1t + (size_t)wh * 256 * 2048, 2048, [](int n) { return n; }, tl);
        conv_job(p->cmp_w2 + (size_t)(l * 2 + wh) * 256 * 64, 256, 64, nullptr, p->cW2t + (size_t)wh * 256 * 256, 256, [](int n) { return n; }, tl);
    }
    for (int i = bid * 512 + tid; i < 2 * 192 * 256 / 8; i += nb * 512) { const int wh = i / (192 * 32), r = (i % (192 * 32)) >> 5, c8 = i & 31; *(u32x4*)(p->cW2t + (size_t)wh * 256 * 256 + (size_t)(64 + r) * 256 + c8 * 8) = (u32x4){0u, 0u, 0u, 0u}; }
    __syncthreads();
    for (int job = nb - 1 - bid; job < 32; job += nb) { const int wh = job >> 4, n0 = (job & 15) * 16, c = tid & 15, ks = tid >> 4;
        const float* ps = p->cmp_pos + (l * 2 + wh) * 2048 + ks * 64; const float* w1 = p->cmp_w1 + (size_t)(l * 2 + wh) * 2048 * 256 + (size_t)ks * 64 * 256 + n0 + c;
        float a = 0.f;
#pragma unroll 16
        for (int k = 0; k < 64; ++k) a += ps[k] * w1[(size_t)k * 256];
        tl[ks * 16 + c] = a;
        __syncthreads();
        if (tid < 16) { float sm = 0.f;
            for (int q = 0; q < 32; ++q) sm += tl[q * 16 + tid];
            p->cbias[wh * 256 + n0 + tid] = sm; }
        __syncthreads(); }
    conv_job(p->rw_w_w2 + (size_t)l * 64 * 512, 64, 512, nullptr, p->rwWlT, 256, [](int n) { return n; }, tl);
    conv_job(p->rw_a_w2 + (size_t)l * 64 * 512, 64, 512, nullptr, p->rwWlT + 64, 256, [](int n) { return n; }, tl);
    conv_job(p->rw_g_w2 + (size_t)l * 128 * 512, 128, 512, nullptr, p->rwWlT + 128, 256, [](int n) { return n; }, tl);
    for (int i = bid * 512 + tid; i < (NP1P - NP1) * D / 8; i += nb * 512) ((u32x4*)(p->Win1 + (size_t)NP1 * D))[i] = (u32x4){0u, 0u, 0u, 0u};
    for (int i = bid * 512 + tid; i < 1024 * 16; i += nb * 512) { const int r = i >> 4, c8 = i & 15; *(u32x4*)(p->Wukv + (size_t)r * 256 + 128 + c8 * 8) = (u32x4){0u, 0u, 0u, 0u}; }
}

DI void ld8bf(const bf16_t* q, float (&f)[8]) { const u32x4 w = *(const u32x4*)q;
    f[0] = __uint_as_float(w.x << 16); f[1] = __uint_as_float(w.x & 0xffff0000u); f[2] = __uint_as_float(w.y << 16); f[3] = __uint_as_float(w.y & 0xffff0000u);
    f[4] = __uint_as_float(w.z << 16); f[5] = __uint_as_float(w.z & 0xffff0000u); f[6] = __uint_as_float(w.w << 16); f[7] = __uint_as_float(w.w & 0xffff0000u); }
DI u32x4 pack8bf(const float (&f)[8]) { u32x4 w; w.x = pk2(f[0], f[1]); w.y = pk2(f[2], f[3]); w.z = pk2(f[4], f[5]); w.w = pk2(f[6], f[7]); return w; }
DI void ld8f(const float* q, float (&f)[8]) { const f32x4 a = *(const f32x4*)q, b = *(const f32x4*)(q + 4); f[0] = a[0]; f[1] = a[1]; f[2] = a[2]; f[3] = a[3]; f[4] = b[0]; f[5] = b[1]; f[6] = b[2]; f[7] = b[3]; }
template <bool HAS_Y, bool HAS_U, bool XIN_BF = false, bool XOUT_BF = false>
DI void phase_norm(const void* xin_, const bf16_t* y, void* xout_, bf16_t* u, const float* g_post, const float* modPrev, float rw, const float* g_pre, const float* modNext) {
    const float* xin = (const float*)xin_; const bf16_t* xinb = (const bf16_t*)xin_; float* xout = (float*)xout_; bf16_t* xoutb = (bf16_t*)xout_;
    const int tid = TIDX(), lane = tid & 63, wave = tid >> 6;
    for (int row0 = (BIDX() * 8 + wave) * 2; row0 < T; row0 += NBLK() * 16) {
        const int b = row0 >> 12;
        float xv[2][4][8]; u32x4 yw[2][4];
#pragma unroll
        for (int r = 0; r < 2; ++r)
#pragma unroll
            for (int i = 0; i < 4; ++i) { const size_t o = (size_t)(row0 + r) * D + i * 512 + lane * 8;
                if (XIN_BF) ld8bf(xinb + o, xv[r][i]); else ld8f(xin + o, xv[r][i]);
                if (HAS_Y) yw[r][i] = *(const u32x4*)(y + o); }
        if (HAS_Y) {
            float gc[4][8];
#pragma unroll
            for (int i = 0; i < 4; ++i) { const int col = i * 512 + lane * 8; float gp[8], gt[8]; ld8f(g_post + col, gp); ld8f(modPrev + (size_t)b * 6144 + 4096 + col, gt);
#pragma unroll
                for (int e = 0; e < 8; ++e) gc[i][e] = gp[e] * gt[e]; }
#pragma unroll
            for (int r = 0; r < 2; ++r) { float yv[4][8]; float ss = 0.f;
#pragma unroll
                for (int i = 0; i < 4; ++i) { const u32x4 w = yw[r][i];
                    yv[i][0] = __uint_as_float(w.x << 16); yv[i][1] = __uint_as_float(w.x & 0xffff0000u); yv[i][2] = __uint_as_float(w.y << 16); yv[i][3] = __uint_as_float(w.y & 0xffff0000u);
                    yv[i][4] = __uint_as_float(w.z << 16); yv[i][5] = __uint_as_float(w.z & 0xffff0000u); yv[i][6] = __uint_as_float(w.w << 16); yv[i][7] = __uint_as_float(w.w & 0xffff0000u);
#pragma unroll
                    for (int e = 0; e < 8; ++e) ss += yv[i][e] * yv[i][e]; }
                ss = wsum(ss);
                const float rs = rsqrtf(ss * (1.0f / D) + NORM_EPS) * rw;
#pragma unroll
                for (int i = 0; i < 4; ++i)
#pragma unroll
                    for (int e = 0; e < 8; ++e) xv[r][i][e] += gc[i][e] * (yv[i][e] * rs); }
        }
        float cu[4][8], sh[4][8];
        if (HAS_U) {
#pragma unroll
            for (int i = 0; i < 4; ++i) { const int col = i * 512 + lane * 8; float gp[8], scl[8]; ld8f(g_pre + col, gp); ld8f(modNext + (size_t)b * 6144 + 2048 + col, scl); ld8f(modNext + (size_t)b * 6144 + col, sh[i]);
#pragma unroll
                for (int e = 0; e < 8; ++e) cu[i][e] = gp[e] * (scl[e] + 1.0f); }
        }
        if (HAS_Y) {
#pragma unroll
            for (int r = 0; r < 2; ++r)
#pragma unroll
                for (int i = 0; i < 4; ++i) { const size_t o = (size_t)(row0 + r) * D + i * 512 + lane * 8;
                    if (XOUT_BF) *(u32x4*)(xoutb + o) = pack8bf(xv[r][i]);
                    else { *(f32x4*)(xout + o) = (f32x4){xv[r][i][0], xv[r][i][1], xv[r][i][2], xv[r][i][3]}; *(f32x4*)(xout + o + 4) = (f32x4){xv[r][i][4], xv[r][i][5], xv[r][i][6], xv[r][i][7]}; } }
        }
        if (HAS_U) {
#pragma unroll
            for (int r = 0; r < 2; ++r) { float ss = 0.f;
#pragma unroll
                for (int i = 0; i < 4; ++i)
#pragma unroll
                    for (int e = 0; e < 8; ++e) ss += xv[r][i][e] * xv[r][i][e];
                ss = wsum(ss);
                const float rs = rsqrtf(ss * (1.0f / D) + NORM_EPS);
#pragma unroll
                for (int i = 0; i < 4; ++i) { float uu[8];
#pragma unroll
                    for (int e = 0; e < 8; ++e) uu[e] = (xv[r][i][e] * rs) * cu[i][e] + sh[i][e];
                    *(u32x4*)(u + (size_t)(row0 + r) * D + i * 512 + lane * 8) = pack8bf(uu); } }
        }
    }
}

DI float ldP(const bf16_t* P1, int t, int col) { return bf2f(P1[(size_t)t * NP1P + col]); }
DI void phase_prep(KParamsPtr p, int l, LAS unsigned char* lds) {
    constexpr int TT = 8;
    const int tid = TIDX(), lane = tid & 63, wave = tid >> 6;
    LAS float* wl = (LAS float*)lds;
    LAS float* al = wl + TT * 64;
    LAS float* gl = al + TT * 64;
    LAS float* ga = gl + TT * 128;
    LAS float* rsq = ga + TT * 16;
    LAS float* gw2 = rsq + TT * 2;
    for (int i = tid; i < 16 * 256; i += 512) gw2[i] = p->gla_w2[l * 16 * 256 + i];
    __syncthreads();
    const bf16_t* P1 = p->P1;
    const float* mu = p->rw_mu + l * 1792;
    const float* w_w2 = p->rw_w_w2 + l * 64 * 512; const float* a_w2 = p->rw_a_w2 + l * 64 * 512; const float* g_w2 = p->rw_g_w2 + l * 128 * 512;
    for (int tile = BIDX(); tile < T / TT; tile += NBLK()) {
        const int t0 = tile * TT;
        for (int rp1_ = 0; rp1_ < PREP_R1; ++rp1_) {
        for (int i = tid; i < TT * 256; i += 512) {
            const int tt = i >> 8, c = i & 255, t = t0 + tt, s = t & (SEQ - 1);
            const int col = c < 64 ? C_RW_WLO + c : (c < 128 ? C_RW_ALO + (c - 64) : C_RW_GLO + (c - 128));
            const float pv = ldP(P1, t, col), pp = s > 0 ? ldP(P1, t - 1, col) : 0.f;
            const float xs = pv + (pp - pv) * mu[col - C_RW];
            if (c < 64) wl[tt * 64 + c] = tanhf(xs); else if (c < 128) al[tt * 64 + c - 64] = xs; else gl[tt * 128 + c - 128] = sigmoidf_(xs);
        }
        if (tid < TT * 16) ga[tid] = ldP(P1, t0 + (tid >> 4), C_GLA_ALO + (tid & 15));
        for (int tk = wave; tk < TT; tk += 8) { const int t = t0 + tk; float sq = 0.f, skv = 0.f;
#pragma unroll
            for (int i = 0; i < 6; ++i) { const float v = ldP(P1, t, C_MLA_CQ + i * 64 + lane); sq += v * v; }
#pragma unroll
            for (int i = 0; i < 2; ++i) { const float v = ldP(P1, t, C_MLA_CKV + i * 64 + lane); skv += v * v; }
            sq = wsum(sq); skv = wsum(skv);
            if (lane == 0) { rsq[tk * 2] = rsqrtf(sq * (1.0f / 384.0f) + NORM_EPS); rsq[tk * 2 + 1] = rsqrtf(skv * (1.0f / 128.0f) + NORM_EPS); } }
        __syncthreads(); }
        for (int rp2_ = 0; rp2_ < PREP_R2; ++rp2_) { const int j = tid;
            float aw[TT], aa[TT], ag[TT];
            const float w0 = p->rw_w0[l * 512 + j], a0 = p->rw_a0[l * 512 + j];
#pragma unroll
            for (int tt = 0; tt < TT; ++tt) { aw[tt] = w0; aa[tt] = a0; ag[tt] = 0.f; }
#pragma unroll 4
            for (int i = 0; i < 64; i += 4) {
                const float ww0 = w_w2[i * 512 + j], ww1 = w_w2[(i + 1) * 512 + j], ww2 = w_w2[(i + 2) * 512 + j], ww3 = w_w2[(i + 3) * 512 + j];
                const float wa0 = a_w2[i * 512 + j], wa1 = a_w2[(i + 1) * 512 + j], wa2 = a_w2[(i + 2) * 512 + j], wa3 = a_w2[(i + 3) * 512 + j];
#pragma unroll
                for (int tt = 0; tt < TT; ++tt) { const f32x4 x = *(const LAS f32x4*)(wl + tt * 64 + i), z = *(const LAS f32x4*)(al + tt * 64 + i);
                    aw[tt] += (x[0] * ww0 + x[1] * ww1) + (x[2] * ww2 + x[3] * ww3); aa[tt] += (z[0] * wa0 + z[1] * wa1) + (z[2] * wa2 + z[3] * wa3); } }
#pragma unroll 4
            for (int i = 0; i < 128; i += 4) {
                const float wg0 = g_w2[i * 512 + j], wg1 = g_w2[(i + 1) * 512 + j], wg2 = g_w2[(i + 2) * 512 + j], wg3 = g_w2[(i + 3) * 512 + j];
#pragma unroll
                for (int tt = 0; tt < TT; ++tt) { const f32x4 x = *(const LAS f32x4*)(gl + tt * 128 + i); ag[tt] += (x[0] * wg0 + x[1] * wg1) + (x[2] * wg2 + x[3] * wg3); } }
            const float k_k = p->rw_k_k[l * 512 + j], k_a = p->rw_k_a[l * 512 + j];
            const float mur = mu[C_RW_R - C_RW + j], muk = mu[C_RW_K - C_RW + j], muv = mu[C_RW_V - C_RW + j];
#pragma unroll
            for (int tt = 0; tt < TT; ++tt) {
                const int t = t0 + tt, s = t & (SEQ - 1);
                float xr = ldP(P1, t, C_RW_R + j), xk = ldP(P1, t, C_RW_K + j), xv = ldP(P1, t, C_RW_V + j);
                const float pr = s > 0 ? ldP(P1, t - 1, C_RW_R + j) : 0.f, pk = s > 0 ? ldP(P1, t - 1, C_RW_K + j) : 0.f, pvv = s > 0 ? ldP(P1, t - 1, C_RW_V + j) : 0.f;
                xr += (pr - xr) * mur; xk += (pk - xk) * muk; xv += (pvv - xv) * muv;
                const float w = __expf(-0.6065306597126334f * sigmoidf_(aw[tt]));
                const float a = sigmoidf_(aa[tt]);
                const float kkr = xk * k_k;
                const float ss = wsum(kkr * kkr);
                const float kk = kkr / fmaxf(sqrtf(ss), 1e-12f);
                const float k2 = xk * (1.0f + (a - 1.0f) * k_a);
                const size_t o = (size_t)t * 512 + j;
                p->rw_r[o] = f2bf(xr); p->rw_w[o] = w; p->rw_k[o] = f2bf(k2); p->rw_v[o] = f2bf(xv); p->rw_kk[o] = kk; p->rw_b[o] = kk * a; p->rw_g[o] = f2bf(ag[tt]);
            } }
        for (int rp3_ = 0; rp3_ < PREP_R3; ++rp3_)
        for (int tt = 0; tt < TT; ++tt) {
            const int t = t0 + tt, s = t & (SEQ - 1), b = t >> 12;
            if (tid < 256) { const int h = tid >> 5, i = tid & 31;
                const float x1 = ldP(P1, t, C_NSA_Q + h * 64 + i), x2 = ldP(P1, t, C_NSA_Q + h * 64 + 32 + i), cs = p->cos64[s * 32 + i], sn = p->sin64[s * 32 + i];
                p->nsa_q[(size_t)t * 512 + h * 64 + i] = f2bf(x1 * cs - x2 * sn); p->nsa_q[(size_t)t * 512 + h * 64 + 32 + i] = f2bf(x1 * sn + x2 * cs);
            } else if (tid < 448) { const int r = tid - 256, which = r >> 6, hk = (r >> 5) & 1, i = r & 31;
                const int sc = (which == 0 ? C_NSA_KC : (which == 1 ? C_NSA_KS : C_NSA_KW)) + hk * 64;
                bf16_t* dst = which == 0 ? p->nsa_kc_in : (which == 1 ? p->nsa_ks : p->nsa_kw);
                const float x1 = ldP(P1, t, sc + i), x2 = ldP(P1, t, sc + 32 + i), cs = p->cos64[s * 32 + i], sn = p->sin64[s * 32 + i];
                const size_t o = ((size_t)(b * 2 + hk) * SEQ + s) * 64;
                dst[o + i] = f2bf(x1 * cs - x2 * sn); dst[o + 32 + i] = f2bf(x1 * sn + x2 * cs);
            } else if (tid < 472) { const int g = tid - 448; p->nsa_gate[(size_t)t * 24 + g] = sigmoidf_(ldP(P1, t, C_NSA_GL + g)); }
            if (tid < 384) { const int which = tid >> 7, hk = (tid >> 6) & 1, d = tid & 63;
                const int sc = (which == 0 ? C_NSA_VC : (which == 1 ? C_NSA_VS : C_NSA_VW)) + hk * 64;
                bf16_t* dst = which == 0 ? p->nsa_vc_in : (which == 1 ? p->nsa_vs : p->nsa_vw);
                dst[((size_t)(b * 2 + hk) * SEQ + s) * 64 + d] = P1[(size_t)t * NP1P + sc + d]; }
        }
        for (int rp4_ = 0; rp4_ < PREP_R4; ++rp4_) {
        for (int i = tid; i < TT * 256; i += 512) {
            const int tt = i >> 8, d = i & 255;
            float z = p->gla_b[l * 256 + d];
#pragma unroll
            for (int q = 0; q < 16; ++q) z += ga[tt * 16 + q] * gw2[q * 256 + d];
            const float ez = __expf(-fabsf(z)), ls = fminf(z, 0.f) - __logf(1.0f + ez);
            p->gla_la[(size_t)(t0 + tt) * 256 + d] = ls * (1.0f / 16.0f);
        }
        for (int i = tid; i < TT * 384; i += 512) { const int tt = i / 384, c = i % 384; p->mla_cqn[(size_t)(t0 + tt) * 384 + c] = f2bf(ldP(P1, t0 + tt, C_MLA_CQ + c) * rsq[tt * 2]); }
        for (int i = tid; i < TT * 256; i += 512) { const int tt = i >> 8, c = i & 255; p->mla_ckvn[(size_t)(t0 + tt) * 256 + c] = c < 128 ? f2bf(ldP(P1, t0 + tt, C_MLA_CKV + c) * rsq[tt * 2 + 1]) : (bf16_t)0; }
        if (tid < TT * 16) { const int tt = tid >> 4, i = tid & 15, t = t0 + tt, s = t & (SEQ - 1);
            const float x1 = ldP(P1, t, C_MLA_KR + i), x2 = ldP(P1, t, C_MLA_KR + 16 + i), cs = p->cos32[s * 16 + i], sn = p->sin32[s * 16 + i];
            p->mla_kpe[(size_t)t * 32 + i] = f2bf(x1 * cs - x2 * sn); p->mla_kpe[(size_t)t * 32 + 16 + i] = f2bf(x1 * sn + x2 * cs); }
        }
        __syncthreads();
    }
}

DI float prep_red16(float x) {
    x += __int_as_float(__builtin_amdgcn_update_dpp(0, __float_as_int(x), 0xB1, 0xF, 0xF, true)); x += __int_as_float(__builtin_amdgcn_update_dpp(0, __float_as_int(x), 0x4E, 0xF, 0xF, true));
    x += __int_as_float(__builtin_amdgcn_update_dpp(0, __float_as_int(x), 0x141, 0xF, 0xF, true)); x += __int_as_float(__builtin_amdgcn_update_dpp(0, __float_as_int(x), 0x140, 0xF, 0xF, true)); return x; }
DI void rope8(const bf16_t* src1, const bf16_t* src2, const float* cs, const float* sn, bf16_t* dst1, bf16_t* dst2) {
    float x1[8], x2[8], c[8], sgn[8], o1[8], o2[8]; ld8bf(src1, x1); ld8bf(src2, x2); ld8f(cs, c); ld8f(sn, sgn);
#pragma unroll
    for (int e = 0; e < 8; ++e) { o1[e] = x1[e] * c[e] - x2[e] * sgn[e]; o2[e] = x1[e] * sgn[e] + x2[e] * c[e]; }
    *(u32x4*)dst1 = pack8bf(o1); *(u32x4*)dst2 = pack8bf(o2); }
constexpr int P1TAIL = 5120;
DI float ldtail(const float* part, int t, int cc) { return (part[(size_t)t * 256 + cc] + part[((size_t)T + t) * 256 + cc]) + (part[((size_t)2 * T + t) * 256 + cc] + part[((size_t)3 * T + t) * 256 + cc]); }
DI void ldtail8(const float* part, int t, int cc, float (&f)[8]) { float a[8], b[8], c[8], d[8];
    ld8f(part + (size_t)t * 256 + cc, a); ld8f(part + ((size_t)T + t) * 256 + cc, b); ld8f(part + ((size_t)2 * T + t) * 256 + cc, c); ld8f(part + ((size_t)3 * T + t) * 256 + cc, d);
#pragma unroll
    for (int e = 0; e < 8; ++e) f[e] = (a[e] + b[e]) + (c[e] + d[e]); }
DI void phase_prep2(KParamsPtr p, int l, LAS unsigned char* lds) {
    constexpr int TT = 16, XS = 264;
    const int tid = TIDX(), lane = tid & 63, wave = tid >> 6, fr = lane & 15, q4 = lane >> 4;
    LAS bf16_t* xa = (LAS bf16_t*)lds;
    LAS float* ga = (LAS float*)(lds + TT * XS * 2);
    LAS float* rsq = ga + TT * 16;
    LAS float* gw2 = rsq + TT * 2;
    LAS float* tl = gw2 + 16 * 256;
    for (int i = tid; i < 16 * 256; i += 512) gw2[i] = p->gla_w2[l * 16 * 256 + i];
    __syncthreads();
    const bf16_t* P1 = p->P1; const float* ptail = (const float*)p->y;
    const float* mu = p->rw_mu + l * 1792;
    const bf16_t* WT = p->rwWlT;
    float c_w0[4], c_a0[4], c_kk[4], c_ka[4], c_mr[4], c_mk[4], c_mv[4];
#pragma unroll
    for (int nb = 0; nb < 4; ++nb) { const int ch = wave * 64 + nb * 16 + fr;
        c_w0[nb] = p->rw_w0[l * 512 + ch]; c_a0[nb] = p->rw_a0[l * 512 + ch]; c_kk[nb] = p->rw_k_k[l * 512 + ch]; c_ka[nb] = p->rw_k_a[l * 512 + ch];
        c_mr[nb] = mu[C_RW_R - C_RW + ch]; c_mk[nb] = mu[C_RW_K - C_RW + ch]; c_mv[nb] = mu[C_RW_V - C_RW + ch]; }
    const int ntile_ = T / TT, per_ = (ntile_ + NBLK() - 1) / NBLK();
    for (int tile = BIDX() * per_, tend_ = min(ntile_, (BIDX() + 1) * per_); tile < tend_; ++tile) {
        const int t0 = tile * TT;
        { const int tt = tid >> 5, c = (tid & 31) * 8, t = t0 + tt, s = t & (SEQ - 1);
            const int col = c < 64 ? C_RW_WLO + c : (c < 128 ? C_RW_ALO + (c - 64) : C_RW_GLO + (c - 128));
            float pv[8], pp[8], m8[8], o[8]; ld8bf(P1 + (size_t)t * NP1P + col, pv); ld8f(mu + col - C_RW, m8);
            if (s > 0) ld8bf(P1 + (size_t)(t - 1) * NP1P + col, pp); else {
#pragma unroll
                for (int e = 0; e < 8; ++e) pp[e] = 0.f; }
#pragma unroll
            for (int e = 0; e < 8; ++e) { const float xs = pv[e] + (pp[e] - pv[e]) * m8[e];
                o[e] = c < 64 ? 1.0f - 2.0f / (__expf(2.0f * xs) + 1.0f) : (c < 128 ? xs : sigmoidf_(xs)); }
            *(LAS u32x4*)(xa + tt * XS + c) = pack8bf(o); }
        if (tid >= 512 - TT * 9) { const int k_ = tid - (512 - TT * 9), tt = k_ / 9, ch = k_ % 9; float f8[8]; ldtail8(ptail, t0 + tt, ch * 8, f8);
            *(LAS f32x4*)(tl + tt * 80 + ch * 8) = (f32x4){f8[0], f8[1], f8[2], f8[3]}; *(LAS f32x4*)(tl + tt * 80 + ch * 8 + 4) = (f32x4){f8[4], f8[5], f8[6], f8[7]}; }
        if (tid < TT * 16) ga[tid] = ldP(P1, t0 + (tid >> 4), C_GLA_ALO + (tid & 15));
        __syncthreads();
        {
            f32x4 acc[3][4];
#pragma unroll
            for (int w3 = 0; w3 < 3; ++w3)
#pragma unroll
                for (int nb = 0; nb < 4; ++nb) acc[w3][nb] = (f32x4){0.f, 0.f, 0.f, 0.f};
#pragma unroll
            for (int ks = 0; ks < 8; ++ks) {
                const bf16x8 af = *(const LAS bf16x8*)(xa + fr * XS + ks * 32 + q4 * 8);
#pragma unroll
                for (int nb = 0; nb < 4; ++nb) { const bf16x8 bfr = *(const bf16x8*)(WT + (size_t)(wave * 64 + nb * 16 + fr) * 256 + ks * 32 + q4 * 8);
                    acc[ks < 2 ? 0 : (ks < 4 ? 1 : 2)][nb] = __builtin_amdgcn_mfma_f32_16x16x32_bf16(af, bfr, acc[ks < 2 ? 0 : (ks < 4 ? 1 : 2)][nb], 0, 0, 0); }
            }
#pragma unroll
            for (int jj = 0; jj < 4; ++jj) {
                const int t = t0 + q4 * 4 + jj, s = t & (SEQ - 1);
                float xr[4], xk[4], xv[4], kkr[4]; float ss = 0.f;
#pragma unroll
                for (int nb = 0; nb < 4; ++nb) { const int ch = wave * 64 + nb * 16 + fr;
                    xr[nb] = ldP(P1, t, C_RW_R + ch); xk[nb] = ldP(P1, t, C_RW_K + ch); xv[nb] = ldP(P1, t, C_RW_V + ch);
                    const float pr = s > 0 ? ldP(P1, t - 1, C_RW_R + ch) : 0.f, pk = s > 0 ? ldP(P1, t - 1, C_RW_K + ch) : 0.f, pvv = s > 0 ? ldP(P1, t - 1, C_RW_V + ch) : 0.f;
                    xr[nb] += (pr - xr[nb]) * c_mr[nb]; xk[nb] += (pk - xk[nb]) * c_mk[nb]; xv[nb] += (pvv - xv[nb]) * c_mv[nb];
                    kkr[nb] = xk[nb] * c_kk[nb]; ss += kkr[nb] * kkr[nb]; }
                ss = prep_red16(ss);
                const float rn = 1.0f / fmaxf(sqrtf(ss), 1e-12f);
#pragma unroll
                for (int nb = 0; nb < 4; ++nb) { const int ch = wave * 64 + nb * 16 + fr;
                    const float w = __expf(-0.6065306597126334f * sigmoidf_(c_w0[nb] + acc[0][nb][jj]));
                    const float a = sigmoidf_(c_a0[nb] + acc[1][nb][jj]);
                    const float kk = kkr[nb] * rn, k2 = xk[nb] * (1.0f + (a - 1.0f) * c_ka[nb]);
                    const size_t o = (size_t)t * 512 + ch;
                    p->rw_r[o] = f2bf(xr[nb]); p->rw_w[o] = w; p->rw_k[o] = f2bf(k2); p->rw_v[o] = f2bf(xv[nb]); p->rw_kk[o] = kk; p->rw_b[o] = kk * a; p->rw_g[o] = f2bf(acc[2][nb][jj]); }
            }
        }
        for (int tk = wave; tk < TT; tk += 8) { const int t = t0 + tk; float sq = 0.f, skv = 0.f;
#pragma unroll
            for (int i = 0; i < 6; ++i) { const float v = ldP(P1, t, C_MLA_CQ + i * 64 + lane); sq += v * v; }
#pragma unroll
            for (int i = 0; i < 2; ++i) { const int col = C_MLA_CKV + i * 64 + lane; const float v = col < P1TAIL ? ldP(P1, t, col) : tl[tk * 80 + col - P1TAIL]; skv += v * v; }
            sq = wsum(sq); skv = wsum(skv);
            if (lane == 0) { rsq[tk * 2] = rsqrtf(sq * (1.0f / 384.0f) + NORM_EPS); rsq[tk * 2 + 1] = rsqrtf(skv * (1.0f / 128.0f) + NORM_EPS); } }
        __syncthreads();
        { const int tt = tid >> 5, idx = tid & 31, t = t0 + tt, s = t & (SEQ - 1), b = t >> 12;
            const bf16_t* row = P1 + (size_t)t * NP1P;
            { const int h = idx >> 2, ic = idx & 3;
              rope8(row + C_NSA_Q + h * 64 + ic * 8, row + C_NSA_Q + h * 64 + 32 + ic * 8, p->cos64 + s * 32 + ic * 8, p->sin64 + s * 32 + ic * 8,
                    p->nsa_q + (size_t)t * 512 + h * 64 + ic * 8, p->nsa_q + (size_t)t * 512 + h * 64 + 32 + ic * 8); }
            asm volatile("" ::: "memory");
            if (idx < 24) { const int which = idx >> 3, hk = (idx >> 2) & 1, ic = idx & 3;
                const int sc = (which == 0 ? C_NSA_KC : (which == 1 ? C_NSA_KS : C_NSA_KW)) + hk * 64;
                bf16_t* dst = (which == 0 ? p->nsa_kc_in : (which == 1 ? p->nsa_ks : p->nsa_kw)) + ((size_t)(b * 2 + hk) * SEQ + s) * 64;
                rope8(row + sc + ic * 8, row + sc + 32 + ic * 8, p->cos64 + s * 32 + ic * 8, p->sin64 + s * 32 + ic * 8, dst + ic * 8, dst + 32 + ic * 8); }
#pragma unroll
            for (int ps = 0; ps < 2; ++ps) { const int k = idx + 32 * ps;
                if (k < 48) { const int which = k >> 4, hk = (k >> 3) & 1, ic = k & 7;
                    const int sc = (which == 0 ? C_NSA_VC : (which == 1 ? C_NSA_VS : C_NSA_VW)) + hk * 64;
                    bf16_t* dst = (which == 0 ? p->nsa_vc_in : (which == 1 ? p->nsa_vs : p->nsa_vw)) + ((size_t)(b * 2 + hk) * SEQ + s) * 64;
                    *(u32x4*)(dst + ic * 8) = *(const u32x4*)(row + sc + ic * 8); } }
            asm volatile("" ::: "memory");
            if (idx < 3) { float g8[8]; ld8bf(row + C_NSA_GL + idx * 8, g8);
                float* gd = p->nsa_gate + (size_t)t * 24 + idx * 8;
                *(f32x4*)gd = (f32x4){sigmoidf_(g8[0]), sigmoidf_(g8[1]), sigmoidf_(g8[2]), sigmoidf_(g8[3])}; *(f32x4*)(gd + 4) = (f32x4){sigmoidf_(g8[4]), sigmoidf_(g8[5]), sigmoidf_(g8[6]), sigmoidf_(g8[7])}; }
            asm volatile("" ::: "memory");
            { const int c = idx * 8; u32x4 w = (u32x4){0u, 0u, 0u, 0u};
              if (c < 128) { float v8[8]; if (C_MLA_CKV + c < P1TAIL) ld8bf(row + C_MLA_CKV + c, v8); else { const f32x4 a_ = *(const LAS f32x4*)(tl + tt * 80 + C_MLA_CKV + c - P1TAIL), b_ = *(const LAS f32x4*)(tl + tt * 80 + C_MLA_CKV + c - P1TAIL + 4); v8[0] = a_[0]; v8[1] = a_[1]; v8[2] = a_[2]; v8[3] = a_[3]; v8[4] = b_[0]; v8[5] = b_[1]; v8[6] = b_[2]; v8[7] = b_[3]; } const float r = rsq[tt * 2 + 1];
#pragma unroll
                  for (int e = 0; e < 8; ++e) v8[e] *= r;
                  w = pack8bf(v8); }
              *(u32x4*)(p->mla_ckvn + (size_t)t * 256 + c) = w; }
            if (idx < 2) { float x1[8], x2[8], cs[8], sn[8], o1[8], o2[8]; { const f32x4 a_ = *(const LAS f32x4*)(tl + tt * 80 + C_MLA_KR - P1TAIL + idx * 8), b_ = *(const LAS f32x4*)(tl + tt * 80 + C_MLA_KR - P1TAIL + idx * 8 + 4), c_ = *(const LAS f32x4*)(tl + tt * 80 + C_MLA_KR - P1TAIL + 16 + idx * 8), d_ = *(const LAS f32x4*)(tl + tt * 80 + C_MLA_KR - P1TAIL + 16 + idx * 8 + 4);
#pragma unroll
                  for (int e = 0; e < 4; ++e) { x1[e] = a_[e]; x1[4 + e] = b_[e]; x2[e] = c_[e]; x2[4 + e] = d_[e]; } }
                ld8f(p->cos32 + s * 16 + idx * 8, cs); ld8f(p->sin32 + s * 16 + idx * 8, sn);
#pragma unroll
                for (int e = 0; e < 8; ++e) { o1[e] = x1[e] * cs[e] - x2[e] * sn[e]; o2[e] = x1[e] * sn[e] + x2[e] * cs[e]; }
                *(u32x4*)(p->mla_kpe + (size_t)t * 32 + idx * 8) = pack8bf(o1); *(u32x4*)(p->mla_kpe + (size_t)t * 32 + 16 + idx * 8) = pack8bf(o2); }
        }
            asm volatile("" ::: "memory");
        for (int i = tid; i < TT * 48; i += 512) { const int tt = i / 48, c = (i % 48) * 8; float v8[8]; ld8bf(P1 + (size_t)(t0 + tt) * NP1P + C_MLA_CQ + c, v8); const float r = rsq[tt * 2];
#pragma unroll
            for (int e = 0; e < 8; ++e) v8[e] *= r;
            *(u32x4*)(p->mla_cqn + (size_t)(t0 + tt) * 384 + c) = pack8bf(v8); }
            asm volatile("" ::: "memory");
        { const int d = tid & 255; float wq[16];
#pragma unroll
            for (int q = 0; q < 16; ++q) wq[q] = gw2[q * 256 + d];
            const float bz = p->gla_b[l * 256 + d];
#pragma unroll
            for (int k = 0; k < TT / 2; ++k) { const int tt = (tid >> 8) + 2 * k; float z = bz;
#pragma unroll
                for (int q4_ = 0; q4_ < 4; ++q4_) { const f32x4 g = *(const LAS f32x4*)(ga + tt * 16 + q4_ * 4); z += (g[0] * wq[q4_ * 4] + g[1] * wq[q4_ * 4 + 1]) + (g[2] * wq[q4_ * 4 + 2] + g[3] * wq[q4_ * 4 + 3]); }
                const float ez = __expf(-fabsf(z)), ls = fminf(z, 0.f) - __logf(1.0f + ez);
                p->gla_la[(size_t)(t0 + tt) * 256 + d] = ls * (1.0f / 16.0f); } }
        __syncthreads();
    }
}


DI float gelu_tanh(float x) { return 0.5f * x * (1.0f + tanhf(0.7978845608028654f * (x + 0.044715f * x * x * x))); }
DI void phase_compress(KParamsPtr p, int l, LAS unsigned char* lds) {
    const int tid = TIDX();
    LAS float* A = (LAS float*)lds;
    LAS float* Hd = A + 8 * 2048;
    for (int task = BIDX(); task < 512; task += NBLK()) {
        const int which = task >> 8, bh = (task >> 5) & 7, n0 = (task & 31) * 8;
        const bf16_t* base = (which ? p->nsa_vc_in : p->nsa_kc_in) + (size_t)bh * SEQ * 64;
        const float* pos = p->cmp_pos + (l * 2 + which) * 2048;
        for (int i = tid; i < 8 * 2048; i += 512) { const int r = i >> 11, k = i & 2047, n = n0 + r;
            A[i] = n < 255 ? bf2f(base[(size_t)n * 1024 + k]) + pos[k] : 0.f; }
        __syncthreads();
        const float* w1 = p->cmp_w1 + (size_t)(l * 2 + which) * 2048 * 256;
        { const int j = tid & 255, half = tid >> 8;
            float acc[4] = {0.f, 0.f, 0.f, 0.f};
            for (int k = 0; k < 2048; ++k) { const float w = w1[(size_t)k * 256 + j];
#pragma unroll
                for (int r = 0; r < 4; ++r) acc[r] += A[(half * 4 + r) * 2048 + k] * w; }
#pragma unroll
            for (int r = 0; r < 4; ++r) Hd[(half * 4 + r) * 256 + j] = gelu_tanh(acc[r]); }
        __syncthreads();
        const float* w2 = p->cmp_w2 + (size_t)(l * 2 + which) * 256 * 64;
        { const int r = tid >> 6, d = tid & 63; float o = 0.f;
            for (int j = 0; j < 256; ++j) o += Hd[r * 256 + j] * w2[j * 64 + d];
            (which ? p->nsa_vc : p->nsa_kc)[((size_t)bh * 256 + n0 + r) * 64 + d] = o; }
        __syncthreads();
    }
}

DI void phase_nsa_cmp(KParamsPtr p, LAS unsigned char* lds) {
    const int tid = TIDX(), lane = tid & 63, wave = tid >> 6;
    LAS float* qs = (LAS float*)lds + wave * (256 + 1024);
    LAS float* pl = qs + 256;
    const float scale = 0.125f;
    for (int item_ = BIDX() * 8 + wave; item_ < NB * 2 * SEQ; item_ += NBLK() * 8) {
        const int item = __builtin_amdgcn_readfirstlane(item_);
        const int s = item & (SEQ - 1), hk = (item >> 12) & 1, b = item >> 13, t = b * SEQ + s, bh = b * 2 + hk;
        const int nvalid = s >= 31 ? min(255, (s - 31) / 16 + 1) : 0;
#pragma unroll
        for (int g = 0; g < 4; ++g) qs[g * 64 + lane] = bf2f(p->nsa_q[(size_t)t * 512 + (hk * 4 + g) * 64 + lane]);
        asm volatile("s_waitcnt lgkmcnt(0)" ::: "memory");
        float sc[4][4];
#pragma unroll
        for (int c = 0; c < 4; ++c) { const int n = lane + 64 * c;
#pragma unroll
            for (int g = 0; g < 4; ++g) sc[c][g] = -1e30f;
            if (n < nvalid) { const float* kr = p->nsa_kc + ((size_t)bh * 256 + n) * 64;
                float d0 = 0.f, d1 = 0.f, d2 = 0.f, d3 = 0.f;
#pragma unroll 4
                for (int k4 = 0; k4 < 16; ++k4) { const f32x4 kv = *(const f32x4*)(kr + k4 * 4);
                    const f32x4 q0 = *(const LAS f32x4*)(qs + k4 * 4), q1 = *(const LAS f32x4*)(qs + 64 + k4 * 4), q2 = *(const LAS f32x4*)(qs + 128 + k4 * 4), q3 = *(const LAS f32x4*)(qs + 192 + k4 * 4);
                    d0 += kv[0] * q0[0] + kv[1] * q0[1] + kv[2] * q0[2] + kv[3] * q0[3]; d1 += kv[0] * q1[0] + kv[1] * q1[1] + kv[2] * q1[2] + kv[3] * q1[3];
                    d2 += kv[0] * q2[0] + kv[1] * q2[1] + kv[2] * q2[2] + kv[3] * q2[3]; d3 += kv[0] * q3[0] + kv[1] * q3[1] + kv[2] * q3[2] + kv[3] * q3[3]; }
                sc[c][0] = d0 * scale; sc[c][1] = d1 * scale; sc[c][2] = d2 * scale; sc[c][3] = d3 * scale; } }
#pragma unroll
        for (int g = 0; g < 4; ++g) {
            float mx = fmaxf(fmaxf(sc[0][g], sc[1][g]), fmaxf(sc[2][g], sc[3][g])); mx = wmax(mx);
            float e[4], sm = 0.f;
#pragma unroll
            for (int c = 0; c < 4; ++c) { e[c] = (lane + 64 * c < nvalid) ? __expf(sc[c][g] - mx) : 0.f; sm += e[c]; }
            sm = wsum(sm);
            const float inv = sm > 0.f ? 1.0f / sm : 0.f;
#pragma unroll
            for (int c = 0; c < 4; ++c) pl[g * 256 + lane + 64 * c] = e[c] * inv;
        }
        asm volatile("s_waitcnt lgkmcnt(0)" ::: "memory");
        { float o[4] = {0.f, 0.f, 0.f, 0.f};
            const float* vr = p->nsa_vc + (size_t)bh * 256 * 64 + lane;
            for (int n = 0; n < nvalid; ++n) { const float v = vr[(size_t)n * 64];
#pragma unroll
                for (int g = 0; g < 4; ++g) o[g] += pl[g * 256 + n] * v; }
#pragma unroll
            for (int g = 0; g < 4; ++g) p->nsa_ocmp[(size_t)t * 512 + (hk * 4 + g) * 64 + lane] = o[g]; }
        float imp = 0.f;
#pragma unroll
        for (int dn = -1; dn <= 3; ++dn) { const int n = 4 * lane + dn;
            if (n >= 0 && n < 255) imp += pl[n] + pl[256 + n] + pl[512 + n] + pl[768 + n]; }
        const int cur = s >> 6;
        const bool valid = lane <= cur, forced = valid && (lane == 0 || lane >= cur - 1);
        const float val = forced ? 1e30f : (valid ? imp : -1e30f);
        int rank = 0;
        for (int jj = 0; jj < 64; ++jj) { const float o = __shfl(val, jj); rank += (o > val || (o == val && jj < lane)) ? 1 : 0; }
        const unsigned long long mask = __ballot(rank < 16);
        if (lane == 0) p->nsa_sel[(size_t)bh * SEQ + s] = mask;
        asm volatile("s_waitcnt lgkmcnt(0)" ::: "memory");
    }
}

DI void dot8(const u32x4 w, LAS const float* q0, int DQ, float (&s)[4]) {
    float kf[8];
    kf[0] = __uint_as_float(w.x << 16); kf[1] = __uint_as_float(w.x & 0xffff0000u); kf[2] = __uint_as_float(w.y << 16); kf[3] = __uint_as_float(w.y & 0xffff0000u);
    kf[4] = __uint_as_float(w.z << 16); kf[5] = __uint_as_float(w.z & 0xffff0000u); kf[6] = __uint_as_float(w.w << 16); kf[7] = __uint_as_float(w.w & 0xffff0000u);
#pragma unroll
    for (int g = 0; g < 4; ++g) { const f32x4 qa = *(const LAS f32x4*)(q0 + g * DQ), qb = *(const LAS f32x4*)(q0 + g * DQ + 4);
        s[g] += kf[0] * qa[0] + kf[1] * qa[1] + kf[2] * qa[2] + kf[3] * qa[3] + kf[4] * qb[0] + kf[5] * qb[1] + kf[6] * qb[2] + kf[7] * qb[3]; }
}
template <int DQ, class KPtr, class VLoad, class Mask>
DI void naive_attn_block(int lane, LAS float* qs  , LAS float* ps  , float scale, KPtr kptr, VLoad vload, Mask mask, float (&m)[4], float (&l)[4], float (&o)[4]) {
    float s[4] = {0.f, 0.f, 0.f, 0.f};
#pragma unroll 4
    for (int c8 = 0; c8 < DQ / 8; ++c8) { const u32x4 w = *(const u32x4*)kptr(c8); dot8(w, qs + c8 * 8, DQ, s); if ((c8 & 3) == 3) asm volatile("" ::: "memory"); }
    float pr[4];
#pragma unroll
    for (int g = 0; g < 4; ++g) {
        const bool ok = mask(g, lane);
        const float sv = ok ? s[g] * scale : -1e30f;
        const float bm = wmax(sv), mn = fmaxf(m[g], bm), corr = __expf(m[g] - mn);
        pr[g] = ok ? __expf(sv - mn) : 0.f;
        l[g] = l[g] * corr + pr[g]; o[g] *= corr; m[g] = mn;
    }
    *(LAS f32x4*)(ps + lane * 4) = (f32x4){pr[0], pr[1], pr[2], pr[3]};
    asm volatile("s_waitcnt lgkmcnt(0)" ::: "memory");
#pragma unroll 4
    for (int key = 0; key < 64; ++key) { const f32x4 pv = *(const LAS f32x4*)(ps + key * 4); const float v = vload(key, lane);
        o[0] += pv[0] * v; o[1] += pv[1] * v; o[2] += pv[2] * v; o[3] += pv[3] * v; if ((key & 3) == 3) asm volatile("" ::: "memory"); }
    asm volatile("s_waitcnt lgkmcnt(0)" ::: "memory");
}

DI void phase_nsa_attn(KParamsPtr p, LAS unsigned char* lds) {
    const int tid = TIDX(), lane = tid & 63, wave = tid >> 6;
    LAS float* qs = (LAS float*)lds + wave * 512;
    LAS float* ps = qs + 256;
    for (int item_ = BIDX() * 8 + wave; item_ < NB * 2 * SEQ; item_ += NBLK() * 8) {
        const int item = __builtin_amdgcn_readfirstlane(item_);
        const int s = item & (SEQ - 1), hk = (item >> 12) & 1, b = item >> 13, t = b * SEQ + s, bh = b * 2 + hk, cur = s >> 6;
#pragma unroll
        for (int g = 0; g < 4; ++g) qs[g * 64 + lane] = bf2f(p->nsa_q[(size_t)t * 512 + (hk * 4 + g) * 64 + lane]);
        asm volatile("s_waitcnt lgkmcnt(0)" ::: "memory");
        float res[4];
        { float m[4] = {-1e30f, -1e30f, -1e30f, -1e30f}, l[4] = {0.f, 0.f, 0.f, 0.f}, o[4] = {0.f, 0.f, 0.f, 0.f};
#if defined(NSA_NO_CMP)
            unsigned long long sel = NSA_SEL0;
#else
            unsigned long long sel = p->nsa_sel[(size_t)bh * SEQ + s];
#endif
            sel &= (cur >= 63) ? ~0ull : ((1ull << (cur + 1)) - 1ull);
            sel = ((unsigned long long)(unsigned)__builtin_amdgcn_readfirstlane((int)(sel >> 32)) << 32) | (unsigned)__builtin_amdgcn_readfirstlane((int)sel);
            const bf16_t* K = p->nsa_ks + (size_t)bh * SEQ * 64; const bf16_t* V = p->nsa_vs + (size_t)bh * SEQ * 64;
#if defined(NSA_NO_SLC)
            sel &= 1ull;
#endif
            while (sel) { const int j = __builtin_ctzll(sel); sel &= sel - 1;
                const int k0 = j * 64;
                naive_attn_block<64>(lane, qs, ps, 0.125f,
                    [&](int c8) { return K + (size_t)(k0 + lane) * 64 + c8 * 8; },
                    [&](int key, int d) { return bf2f(V[(size_t)(k0 + key) * 64 + d]); },
                    [&](int, int key) { return k0 + key <= s; }, m, l, o); }
#pragma unroll
            for (int g = 0; g < 4; ++g) { const float lt = wsum(l[g]); res[g] = p->nsa_gate[(size_t)t * 24 + (hk * 4 + g) * 3 + 1] * (o[g] / lt); } }
        { float m[4] = {-1e30f, -1e30f, -1e30f, -1e30f}, l[4] = {0.f, 0.f, 0.f, 0.f}, o[4] = {0.f, 0.f, 0.f, 0.f};
#if defined(NSA_WIN_USE_S)
            const bf16_t* K = p->nsa_ks + (size_t)bh * SEQ * 64; const bf16_t* V = p->nsa_vs + (size_t)bh * SEQ * 64;
#else
            const bf16_t* K = p->nsa_kw + (size_t)bh * SEQ * 64; const bf16_t* V = p->nsa_vw + (size_t)bh * SEQ * 64;
#endif
            const int lo = s - 511 > 0 ? s - 511 : 0;
#if defined(NSA_NO_WIN)
            for (int j = cur; j <= cur; ++j) { const int k0 = j * 64;
#else
            for (int j = lo >> 6; j <= cur; ++j) { const int k0 = j * 64;
#endif
                naive_attn_block<64>(lane, qs, ps, 0.125f,
                    [&](int c8) { return K + (size_t)(k0 + lane) * 64 + c8 * 8; },
                    [&](int key, int d) { return bf2f(V[(size_t)(k0 + key) * 64 + d]); },
                    [&](int, int key) { return k0 + key <= s && k0 + key >= lo; }, m, l, o); }
#pragma unroll
            for (int g = 0; g < 4; ++g) { const float lt = wsum(l[g]); res[g] += p->nsa_gate[(size_t)t * 24 + (hk * 4 + g) * 3 + 2] * (o[g] / lt); } }
#pragma unroll
        for (int g = 0; g < 4; ++g) { const size_t oi = (size_t)t * 512 + (hk * 4 + g) * 64 + lane;
#if !defined(NSA_NO_CMP)
            res[g] += p->nsa_gate[(size_t)t * 24 + (hk * 4 + g) * 3] * p->nsa_ocmp[oi];
#endif
            p->ys[oi] = f2bf(res[g]); }
    }
}

DI void phase_mla_rope(KParamsPtr p) {
    for (int i = BIDX() * 512 + TIDX(); i < T * 128; i += NBLK() * 512) {
        const int t = i >> 7, h = (i >> 4) & 7, j = i & 15, s = t & (SEQ - 1);
        bf16_t* q = p->mla_q + (size_t)t * 768 + h * 96 + 64;
        const float x1 = bf2f(q[j]), x2 = bf2f(q[16 + j]), cs = p->cos32[s * 16 + j], sn = p->sin32[s * 16 + j];
        q[j] = f2bf(x1 * cs - x2 * sn); q[16 + j] = f2bf(x1 * sn + x2 * cs);
    }
}
DI void phase_mla_attn(KParamsPtr p, LAS unsigned char* lds) {
    const int tid = TIDX(), lane = tid & 63, wave = tid >> 6;
    LAS float* qs = (LAS float*)lds + wave * 640;
    LAS float* ps = qs + 384;
    const float scale = 0.10206207261596577f;
    for (int item_ = BIDX() * 8 + wave; item_ < NB * 8 * (SEQ / 4); item_ += NBLK() * 8) {
        const int item = __builtin_amdgcn_readfirstlane(item_);
        const int s0 = (item & 1023) * 4, h = (item >> 10) & 7, b = item >> 13, t0 = b * SEQ + s0;
        for (int i = lane; i < 384; i += 64) { const int g = i / 96, c = i % 96; qs[i] = bf2f(p->mla_q[(size_t)(t0 + g) * 768 + h * 96 + c]); }
        asm volatile("s_waitcnt lgkmcnt(0)" ::: "memory");
        float m[4] = {-1e30f, -1e30f, -1e30f, -1e30f}, l[4] = {0.f, 0.f, 0.f, 0.f}, o[4] = {0.f, 0.f, 0.f, 0.f};
        const bf16_t* KV = p->mla_kv + (size_t)b * SEQ * 1024 + h * 128; const bf16_t* PE = p->mla_kpe + (size_t)b * SEQ * 32;
        for (int j = 0; j <= (s0 + 3) >> 6; ++j) { const int k0 = j * 64;
            naive_attn_block<96>(lane, qs, ps, scale,
                [&](int c8) { return c8 < 8 ? KV + (size_t)(k0 + lane) * 1024 + c8 * 8 : PE + (size_t)(k0 + lane) * 32 + (c8 - 8) * 8; },
                [&](int key, int d) { return bf2f(KV[(size_t)(k0 + key) * 1024 + 64 + d]); },
                [&](int g, int key) { return k0 + key <= s0 + g; }, m, l, o); }
#pragma unroll
        for (int g = 0; g < 4; ++g) { const float lt = wsum(l[g]); p->ys[(size_t)3 * T * 512 + (size_t)(t0 + g) * 512 + h * 64 + lane] = f2bf(o[g] / lt); }
    }
}

DI void phase_scan_rwkv(KParamsPtr p, LAS unsigned char* lds) {
    const int tid = TIDX(), bid = BIDX();
    if (bid < 32) {
        if (tid >= 64) return;
        const int b = bid >> 3, h = bid & 7, lane = tid;
        LAS float* L = (LAS float*)lds;
        float st[64];
#pragma unroll
        for (int j = 0; j < 64; ++j) st[j] = 0.f;
        size_t o = (size_t)b * SEQ * 512 + h * 64 + lane;
        float nkk = p->rw_kk[o], nw = p->rw_w[o], nk = bf2f(p->rw_k[o]), nb = p->rw_b[o], nr = bf2f(p->rw_r[o]), nv = bf2f(p->rw_v[o]);
        for (int s = 0; s < SEQ; ++s) {
            L[lane] = nkk; L[64 + lane] = nw; L[128 + lane] = nk; L[192 + lane] = nb; L[256 + lane] = nr;
            const float v = nv; const size_t oc = o;
            if (s + 1 < SEQ) { o += 512; nkk = p->rw_kk[o]; nw = p->rw_w[o]; nk = bf2f(p->rw_k[o]); nb = p->rw_b[o]; nr = bf2f(p->rw_r[o]); nv = bf2f(p->rw_v[o]); }
            asm volatile("s_waitcnt lgkmcnt(0)" ::: "memory");
            float skk = 0.f;
#pragma unroll
            for (int j4 = 0; j4 < 16; ++j4) { const f32x4 kk = *(const LAS f32x4*)(L + j4 * 4);
                skk += st[j4 * 4] * kk[0] + st[j4 * 4 + 1] * kk[1] + st[j4 * 4 + 2] * kk[2] + st[j4 * 4 + 3] * kk[3]; }
            float y = 0.f;
#pragma unroll
            for (int j4 = 0; j4 < 16; ++j4) { const f32x4 w = *(const LAS f32x4*)(L + 64 + j4 * 4), k = *(const LAS f32x4*)(L + 128 + j4 * 4), bb = *(const LAS f32x4*)(L + 192 + j4 * 4), r = *(const LAS f32x4*)(L + 256 + j4 * 4);
#pragma unroll
                for (int q = 0; q < 4; ++q) { const float ns = st[j4 * 4 + q] * w[q] - skk * bb[q] + v * k[q]; st[j4 * 4 + q] = ns; y += ns * r[q]; }
                if ((j4 & 3) == 3) asm volatile("" ::: "memory"); }
            p->rw_y[oc] = y;
            asm volatile("s_waitcnt lgkmcnt(0)" ::: "memory");
        }
    }
}
DI void phase_scan_gla(KParamsPtr p, LAS unsigned char* lds) {
    const int tid = TIDX(), bid = BIDX();
    if (bid >= 32 && bid < 48) {
        if (tid >= 128) return;
        const int bh = bid - 32, b = bh >> 2, h = bh & 3, e = tid, lane = tid & 63, wave = tid >> 6;
        LAS float* L = (LAS float*)lds + wave * 192;
        float st[64];
#pragma unroll
        for (int j = 0; j < 64; ++j) st[j] = 0.f;
        const bf16_t* P1 = p->P1;
        for (int s = 0; s < SEQ; ++s) {
            const int t = b * SEQ + s;
            L[lane] = __expf(p->gla_la[(size_t)t * 256 + h * 64 + lane]); L[64 + lane] = ldP(P1, t, C_GLA_K + h * 64 + lane); L[128 + lane] = ldP(P1, t, C_GLA_Q + h * 64 + lane) * 0.125f;
            const float v = ldP(P1, t, C_GLA_V + h * 128 + e);
            asm volatile("s_waitcnt lgkmcnt(0)" ::: "memory");
            float y = 0.f;
#pragma unroll
            for (int j4 = 0; j4 < 16; ++j4) { const f32x4 dc = *(const LAS f32x4*)(L + j4 * 4), k = *(const LAS f32x4*)(L + 64 + j4 * 4), q = *(const LAS f32x4*)(L + 128 + j4 * 4);
#pragma unroll
                for (int qq = 0; qq < 4; ++qq) { const float ns = st[j4 * 4 + qq] * dc[qq] + k[qq] * v; st[j4 * 4 + qq] = ns; y += ns * q[qq]; }
                if ((j4 & 3) == 3) asm volatile("" ::: "memory"); }
            p->gla_o[(size_t)t * 512 + h * 128 + e] = y;
            asm volatile("s_waitcnt lgkmcnt(0)" ::: "memory");
        }
    }
}

DI void phase_scans(KParamsPtr p, LAS unsigned char* lds) { phase_scan_rwkv(p, lds); phase_scan_gla(p, lds); }

DI void phase_post(KParamsPtr p, int l, LAS unsigned char* lds, int wg_skip) {
    const int tid = TIDX(), lane = tid & 63, wave = tid >> 6;
    if (BIDX() < wg_skip) return;
    const int nw = (NBLK() - wg_skip) * 8;
    float ln_w[8], ln_b[8], r_k[8], gg[8];
    ld8f(p->rw_ln_w + l * 512 + lane * 8, ln_w); ld8f(p->rw_ln_b + l * 512 + lane * 8, ln_b); ld8f(p->rw_r_k + l * 512 + lane * 8, r_k); ld8f(p->gla_g + l * 512 + lane * 8, gg);
    for (int tb = (BIDX() - wg_skip) * 8 + wave; tb < T; tb += 2 * nw) {
        float y[2][8], rr[2][8], kk[2][8], vv[2][8], g4[2][8], ov[2][8], gr[2][8]; bool ok[2];
#pragma unroll
        for (int q = 0; q < 2; ++q) { const int t = tb + q * nw; ok[q] = t < T; const size_t o = (size_t)(ok[q] ? t : 0) * 512 + lane * 8;
            ld8f(p->rw_y + o, y[q]); ld8bf(p->rw_r + o, rr[q]); ld8bf(p->rw_k + o, kk[q]); ld8bf(p->rw_v + o, vv[q]); ld8bf(p->rw_g + o, g4[q]); ld8f(p->gla_o + o, ov[q]);
            ld8bf(p->P1 + (size_t)(ok[q] ? t : 0) * NP1P + C_GLA_R + lane * 8, gr[q]); }
#pragma unroll
        for (int q = 0; q < 2; ++q) { const size_t o = (size_t)(tb + q * nw) * 512 + lane * 8;
            float sm = 0.f, sb = 0.f, so = 0.f;
#pragma unroll
            for (int e = 0; e < 8; ++e) { sm += y[q][e]; sb += rr[q][e] * kk[q][e] * r_k[e]; so += ov[q][e] * ov[q][e]; }
#pragma unroll
            for (int m = 1; m <= 4; m <<= 1) { sm += __shfl_xor(sm, m); sb += __shfl_xor(sb, m); so += __shfl_xor(so, m); }
            so += __shfl_xor(so, 8);
            const float mean = sm * (1.0f / 64.0f);
            float sv = 0.f;
#pragma unroll
            for (int e = 0; e < 8; ++e) { y[q][e] -= mean; sv += y[q][e] * y[q][e]; }
#pragma unroll
            for (int m = 1; m <= 4; m <<= 1) sv += __shfl_xor(sv, m);
            const float rstd = rsqrtf(sv * (1.0f / 64.0f) + 64e-5f), rs = rsqrtf(so * (1.0f / 128.0f) + NORM_EPS);
            float o1[8], o2[8];
#pragma unroll
            for (int e = 0; e < 8; ++e) { o1[e] = ((y[q][e] * rstd * ln_w[e] + ln_b[e]) + sb * vv[q][e]) * g4[q][e] * ZRWKV;
                o2[e] = ov[q][e] * rs * gg[e] * (gr[q][e] * sigmoidf_(gr[q][e])) * ZGLA; }
            if (ok[q]) { *(u32x4*)(p->ys + (size_t)1 * T * 512 + o) = pack8bf(o1); *(u32x4*)(p->ys + (size_t)2 * T * 512 + o) = pack8bf(o2); } }
    }
}

DI void unpack8(const u32x4 w, float (&f)[8]) {
    f[0] = __uint_as_float(w.x << 16); f[1] = __uint_as_float(w.x & 0xffff0000u); f[2] = __uint_as_float(w.y << 16); f[3] = __uint_as_float(w.y & 0xffff0000u);
    f[4] = __uint_as_float(w.z << 16); f[5] = __uint_as_float(w.z & 0xffff0000u); f[6] = __uint_as_float(w.w << 16); f[7] = __uint_as_float(w.w & 0xffff0000u);
}
DI void phase_mergesum(const bf16_t* G, const bf16_t* part01, const bf16_t* part23, bf16_t* merged) {
    const size_t n8 = (size_t)T * 2048 / 8;
    for (size_t i = (size_t)BIDX() * 512 + TIDX(); i < n8; i += (size_t)NBLK() * 512) {
        const size_t t = i >> 8, c = (i & 255) * 8;
        float acc[8] = {0.f, 0.f, 0.f, 0.f, 0.f, 0.f, 0.f, 0.f};
#pragma unroll
        for (int br = 0; br < 4; ++br) {
            const u32x4 gw = *(const u32x4*)(G + t * NGATE + br * 2048 + c);
            const u32x4 pw = *(const u32x4*)((br < 2 ? part01 : part23) + (size_t)(br & 1) * T * 2048 + t * 2048 + c);
            float g[8], q[8]; unpack8(gw, g); unpack8(pw, q);
#pragma unroll
            for (int j = 0; j < 8; ++j) acc[j] += g[j] * q[j];
        }
        u32x4 w; w.x = pk2(acc[0], acc[1]); w.y = pk2(acc[2], acc[3]); w.z = pk2(acc[4], acc[5]); w.w = pk2(acc[6], acc[7]);
        *(u32x4*)(merged + t * 2048 + c) = w;
    }
}
#ifndef ZSLC
#define ZSLC 1.0f
#endif
#ifndef ZWIN
#define ZWIN 1.0f
#endif
#ifndef ZCMP
#define ZCMP 1.0f
#endif
#ifndef ZMLA
#define ZMLA 1.0f
#endif
typedef short v4i16_t_ __attribute__((ext_vector_type(4)));
template <int DQ, int NDV = 4> struct FlashGeo {
    static constexpr int KS = DQ * 2 + 32;
    static constexpr int VS = 160;
    static constexpr int KBYTES = 64 * KS, VBYTES = 64 * VS, BUF = KBYTES + VBYTES;
};
template <int NDV> struct FlashAccT { f32x4 O[2][NDV]; float m[2], l[2]; };
typedef FlashAccT<4> FlashAcc;
template <int NDV> DI void flash_reset(FlashAccT<NDV>& a) {
#pragma unroll
    for (int rg = 0; rg < 2; ++rg) { a.m[rg] = -1e30f; a.l[rg] = 0.f;
#pragma unroll
        for (int d = 0; d < NDV; ++d) a.O[rg][d] = (f32x4){0.f, 0.f, 0.f, 0.f}; }
}
template <int DQ> struct FlashStage { u32x4 k, k2, v; };
template <int DQ, class KRow, class PRow, class VRow>
DI void flash_stage_load(FlashStage<DQ>& st, int tid, KRow krow, PRow prow, VRow vrow) {
    int r = tid >> 3, c = tid & 7;
    asm volatile("" : "+v"(r), "+v"(c));
    st.k = *(const u32x4*)(krow(r) + c * 8);
    if (DQ == 96) { if (c < 4) st.k2 = *(const u32x4*)(prow(r) + c * 8); }
    st.v = *(const u32x4*)(vrow(r) + c * 8);
}
template <int DQ>
DI void flash_stage_write(const FlashStage<DQ>& st, int tid, LAS unsigned char* buf) {
    typedef FlashGeo<DQ> G;
    const int r = tid >> 3, c = tid & 7;
    *(LAS u32x4*)(buf + r * G::KS + c * 16) = st.k;
    if (DQ == 96) { if (c < 4) *(LAS u32x4*)(buf + r * G::KS + 128 + c * 16) = st.k2; }
    *(LAS u32x4*)(buf + G::KBYTES + r * G::VS + c * 16) = st.v;
}
#ifndef FLASH_FENCE
#define FLASH_FENCE 1
#endif
template <int DQ, int NDV, int MODE, class Mask>
DI void flash_tile_n(LAS const unsigned char* buf, const bf16x8 (&Q)[2][DQ / 32], FlashAccT<NDV>& a, float sc2, int lane, Mask mask) {
    typedef FlashGeo<DQ, NDV> G;
    const int fr = lane & 15, q4 = lane >> 4;
    f32x4 S[2][4];
#pragma unroll
    for (int rg = 0; rg < 2; ++rg)
#pragma unroll
        for (int kb = 0; kb < 4; ++kb) S[rg][kb] = (f32x4){0.f, 0.f, 0.f, 0.f};
#pragma unroll
    for (int kb = 0; kb < 4; ++kb)
#pragma unroll
        for (int ks = 0; ks < DQ / 32; ++ks) {
            const bf16x8 kf = *(const LAS bf16x8*)(buf + (kb * 16 + fr) * G::KS + (ks * 32 + q4 * 8) * 2);
#pragma unroll
            for (int rg = 0; rg < 2; ++rg) S[rg][kb] = __builtin_amdgcn_mfma_f32_16x16x32_bf16(kf, Q[rg][ks], S[rg][kb], 0, 0, 0);
            if (FLASH_FENCE && DQ == 64 && ks == DQ / 32 - 1 && (kb & 1)) asm volatile("" ::: "memory");
        }
    bf16x8 P[2][2];
#pragma unroll
    for (int rg = 0; rg < 2; ++rg) {
        constexpr bool FULL = (MODE == 1);
        float mx = -1e30f; unsigned okm = 0u; const bool rowok = (MODE == 2) ? mask(rg, 0) : true;
        if (FULL || MODE == 2) {
#pragma unroll
            for (int kb = 0; kb < 4; ++kb) mx = fmaxf(mx, fmaxf(fmaxf(S[rg][kb][0], S[rg][kb][1]), fmaxf(S[rg][kb][2], S[rg][kb][3])));
            if (MODE == 2) mx = rowok ? mx : -1e30f;
        } else {
#pragma unroll
        for (int kb = 0; kb < 4; ++kb)
#pragma unroll
            for (int j = 0; j < 4; ++j) { const bool ok = mask(rg, kb * 16 + q4 * 4 + j); okm |= ok ? (1u << (kb * 4 + j)) : 0u;
                const float sv = ok ? S[rg][kb][j] : -1e30f; S[rg][kb][j] = sv; mx = fmaxf(mx, sv); }
        }
        { auto r16 = __builtin_amdgcn_permlane16_swap(__float_as_uint(mx), __float_as_uint(mx), false, false); mx = fmaxf(__uint_as_float(r16[0]), __uint_as_float(r16[1]));
          auto r32 = __builtin_amdgcn_permlane32_swap(__float_as_uint(mx), __float_as_uint(mx), false, false); mx = fmaxf(__uint_as_float(r32[0]), __uint_as_float(r32[1])); }
        mx = fmaxf(mx * sc2, -1e30f);
        const float mo = a.m[rg]; const bool mv = mx > mo + 8.0f; const float mn = mv ? mx : mo;
        a.m[rg] = mn;
        if (__builtin_amdgcn_ballot_w64(mv) != 0ull) { const float corr = __builtin_amdgcn_exp2f(mo - mn);
            a.l[rg] *= corr;
#pragma unroll
            for (int d = 0; d < NDV; ++d) a.O[rg][d] *= corr; }
        float ps = 0.f;
#pragma unroll
        for (int kb = 0; kb < 4; ++kb)
#pragma unroll
            for (int j = 0; j < 4; ++j) { const float pv = (FULL || (MODE == 2 ? rowok : (bool)((okm >> (kb * 4 + j)) & 1u))) ? __builtin_amdgcn_exp2f(__builtin_fmaf(S[rg][kb][j], sc2, -mn)) : 0.f; S[rg][kb][j] = pv; ps += pv; }
        a.l[rg] += ps;
#pragma unroll
        for (int pb = 0; pb < 2; ++pb) { u32x4 w;
            w.x = cvt_pk_bf16(S[rg][2 * pb][0], S[rg][2 * pb][1]); w.y = cvt_pk_bf16(S[rg][2 * pb][2], S[rg][2 * pb][3]);
            w.z = cvt_pk_bf16(S[rg][2 * pb + 1][0], S[rg][2 * pb + 1][1]); w.w = cvt_pk_bf16(S[rg][2 * pb + 1][2], S[rg][2 * pb + 1][3]);
            P[rg][pb] = __builtin_bit_cast(bf16x8, w); }
    }
    LAS const unsigned char* vt = buf + G::KBYTES;
#pragma unroll
    for (int pb = 0; pb < 2; ++pb)
#pragma unroll
        for (int dvb = 0; dvb < NDV; ++dvb) {
            LAS const unsigned char* vl = vt + (4 * q4 + (fr >> 2)) * G::VS + (fr & 3) * 8;
            const u32x2 lo = __builtin_bit_cast(u32x2, __builtin_amdgcn_ds_read_tr16_b64_v4i16((LAS v4i16_t_*)(vl + (32 * pb) * G::VS + dvb * 32)));
            const u32x2 hi = __builtin_bit_cast(u32x2, __builtin_amdgcn_ds_read_tr16_b64_v4i16((LAS v4i16_t_*)(vl + (32 * pb + 16) * G::VS + dvb * 32)));
            const u32x4 w = (u32x4){lo.x, lo.y, hi.x, hi.y};
            const bf16x8 vf = __builtin_bit_cast(bf16x8, w);
#pragma unroll
            for (int rg = 0; rg < 2; ++rg) a.O[rg][dvb] = __builtin_amdgcn_mfma_f32_16x16x32_bf16(vf, P[rg][pb], a.O[rg][dvb], 0, 0, 0);
        }
}
template <int DQ, class Mask>
DI void flash_tile(LAS const unsigned char* buf, const bf16x8 (&Q)[2][DQ / 32], FlashAcc& a, float sc2, int lane, Mask mask) { flash_tile_n<DQ, 4, 0>(buf, Q, a, sc2, lane, mask); }
template <int DQ>
DI void flash_tile_full(LAS const unsigned char* buf, const bf16x8 (&Q)[2][DQ / 32], FlashAcc& a, float sc2, int lane) { flash_tile_n<DQ, 4, 1>(buf, Q, a, sc2, lane, [](int, int) { return true; }); }
template <int DQ, class Mask>
DI void flash_tile_row(LAS const unsigned char* buf, const bf16x8 (&Q)[2][DQ / 32], FlashAcc& a, float sc2, int lane, Mask mask) { flash_tile_n<DQ, 4, 2>(buf, Q, a, sc2, lane, mask); }
DI float flash_lsum(float l) { l += __shfl_xor(l, 16); l += __shfl_xor(l, 32); return l; }

DI void bf8_to_f(const u32x4 w, f32x4& a, f32x4& b);
DI void phase_mla_flash(KParamsPtr p, LAS unsigned char* lds) {
    typedef FlashGeo<96> G;
    const int tid = TIDX(), lane = tid & 63, wave = __builtin_amdgcn_readfirstlane(tid >> 6), fr = lane & 15, q4 = lane >> 4;
    const float sc2 = 0.10206207261596577f * 1.4426950408889634f;
    const bf16_t* mq = p->mla_q; const bf16_t* mkv = p->mla_kv; const bf16_t* mpe = p->mla_kpe; bf16_t* yo = p->ys + (size_t)3 * T * 512;
    for (int c0 = BIDX(); c0 < 256; c0 += NBLK()) {
        const int c = NBLK() == 256 ? ((c0 & 7) * 32 + (c0 >> 3)) : c0;
        const int bh = c >> 3, b = bh >> 3, h = bh & 7;
#pragma unroll 1
        for (int half = 0; half < 2; ++half) {
            const int qt = half ? 15 - (c & 7) : (c & 7), q0 = qt * 256;
            const int tok0 = q0 + wave * 32 + fr;
            bf16x8 Q[2][3];
#pragma unroll
            for (int rg = 0; rg < 2; ++rg)
#pragma unroll
                for (int ks = 0; ks < 3; ++ks) Q[rg][ks] = *(const bf16x8*)(mq + (size_t)(b * SEQ + tok0 + rg * 16) * 768 + h * 96 + ks * 32 + q4 * 8);
#pragma unroll
            for (int rg = 0; rg < 2; ++rg) {
                const u32x4 mine = __builtin_bit_cast(u32x4, Q[rg][2]);
                u32x4 oth; oth.x = (unsigned)__shfl_xor((int)mine.x, 32); oth.y = (unsigned)__shfl_xor((int)mine.y, 32); oth.z = (unsigned)__shfl_xor((int)mine.z, 32); oth.w = (unsigned)__shfl_xor((int)mine.w, 32);
                f32x4 ma, mb, oa, ob; bf8_to_f(mine, ma, mb); bf8_to_f(oth, oa, ob);
                const size_t ti = (size_t)(tok0 + rg * 16) * 16 + (q4 & 1) * 8;
                const f32x4 ca = *(const f32x4*)(p->cos32 + ti), cb = *(const f32x4*)(p->cos32 + ti + 4), sa = *(const f32x4*)(p->sin32 + ti), sb = *(const f32x4*)(p->sin32 + ti + 4);
                const float sg = q4 < 2 ? -1.0f : 1.0f;
                const f32x4 ra = ma * ca + oa * sa * sg, rb = mb * cb + ob * sb * sg;
                u32x4 w; w.x = cvt_pk_bf16(ra[0], ra[1]); w.y = cvt_pk_bf16(ra[2], ra[3]); w.z = cvt_pk_bf16(rb[0], rb[1]); w.w = cvt_pk_bf16(rb[2], rb[3]);
                Q[rg][2] = __builtin_bit_cast(bf16x8, w); }
            FlashAcc a; flash_reset(a);
            const int nt = (q0 + 256) / 64;
            const bf16_t* kvb = mkv + (size_t)b * SEQ * 1024 + h * 128; const bf16_t* peb = mpe + (size_t)b * SEQ * 32;
            FlashStage<96> st;
            flash_stage_load<96>(st, tid, [&](int r) { return kvb + (size_t)r * 1024; }, [&](int r) { return peb + (size_t)r * 32; }, [&](int r) { return kvb + (size_t)r * 1024 + 64; });
            __syncthreads();
            flash_stage_write<96>(st, tid, lds);
            __syncthreads();
            for (int i = 0; i < nt; ++i) {
                const int k0 = i * 64;
                if (i + 1 < nt) flash_stage_load<96>(st, tid, [&](int r) { return kvb + (size_t)(k0 + 64 + r) * 1024; }, [&](int r) { return peb + (size_t)(k0 + 64 + r) * 32; }, [&](int r) { return kvb + (size_t)(k0 + 64 + r) * 1024 + 64; });
                if (k0 <= q0 + wave * 32 + 31) {
                    int d0 = tok0 - k0, d1 = tok0 - k0 + 16;
                    asm volatile("" : "+v"(d0), "+v"(d1));
                    if (k0 + 63 <= q0 + wave * 32) flash_tile_full<96>(lds + (i & 1) * G::BUF, Q, a, sc2, lane);
                    else flash_tile<96>(lds + (i & 1) * G::BUF, Q, a, sc2, lane, [&](int rg, int kidx) { return kidx <= (rg ? d1 : d0); });
                }
                if (i + 1 < nt) flash_stage_write<96>(st, tid, lds + ((i + 1) & 1) * G::BUF);
                __syncthreads();
            }
#pragma unroll
            for (int rg = 0; rg < 2; ++rg) { const float inv = 1.0f / flash_lsum(a.l[rg]);
                bf16_t* op = yo + (size_t)(b * SEQ + tok0 + rg * 16) * 512 + h * 64 + q4 * 4;
#pragma unroll
                for (int d = 0; d < 4; ++d) { u32x2 w; w.x = cvt_pk_bf16(a.O[rg][d][0] * inv * ZMLA, a.O[rg][d][1] * inv * ZMLA); w.y = cvt_pk_bf16(a.O[rg][d][2] * inv * ZMLA, a.O[rg][d][3] * inv * ZMLA);
                    *(u32x2*)(op + d * 16) = w; } }
        }
    }
}

DI void phase_nsa_flash(KParamsPtr p, LAS unsigned char* lds) {
    typedef FlashGeo<64> G;
    const int tid = TIDX(), lane = tid & 63, wave = __builtin_amdgcn_readfirstlane(tid >> 6), fr = lane & 15, q4 = lane >> 4;
    const float sc2 = 0.125f * 1.4426950408889634f;
    LAS unsigned* um = (LAS unsigned*)(lds + 2 * G::BUF);
    const bf16_t* nq = p->nsa_q; const unsigned long long* selp = p->nsa_sel; const float* gat = p->nsa_gate; const float* ocmp = p->nsa_ocmp; bf16_t* yo = p->ys;
    for (int c = BIDX(); c < 256; c += NBLK()) {
        const int bh = c >> 5, b = bh >> 1, hk = bh & 1;
        const bf16_t* Ks = p->nsa_ks + (size_t)bh * SEQ * 64; const bf16_t* Vs = p->nsa_vs + (size_t)bh * SEQ * 64;
        const bf16_t* Kw = p->nsa_kw + (size_t)bh * SEQ * 64; const bf16_t* Vw = p->nsa_vw + (size_t)bh * SEQ * 64;
#pragma unroll 1
        for (int half = 0; half < 2; ++half) {
            const int cur = half ? 63 - (c & 31) : (c & 31), s0 = cur * 64, g = wave >> 1, head = hk * 4 + g;
            const int qi0 = (wave & 1) * 32 + fr;
            const size_t t0 = (size_t)b * SEQ + s0 + qi0;
            bf16x8 Q[2][2];
#pragma unroll
            for (int rg = 0; rg < 2; ++rg)
#pragma unroll
                for (int ks = 0; ks < 2; ++ks) Q[rg][ks] = *(const bf16x8*)(nq + (t0 + rg * 16) * 512 + head * 64 + ks * 32 + q4 * 8);
            unsigned long long sel[2];
#pragma unroll
            for (int rg = 0; rg < 2; ++rg) sel[rg] = selp[(size_t)bh * SEQ + s0 + qi0 + rg * 16];
            if (wave == 0) {
                unsigned long long u = selp[(size_t)bh * SEQ + s0 + lane];
                unsigned lo = (unsigned)u, hi = (unsigned)(u >> 32);
#pragma unroll
                for (int o = 32; o >= 1; o >>= 1) { lo |= (unsigned)__shfl_xor((int)lo, o); hi |= (unsigned)__shfl_xor((int)hi, o); }
                if (lane == 0) { um[0] = lo; um[1] = hi; }
            }
            __syncthreads();
            unsigned long long uni = ((unsigned long long)um[1] << 32) | um[0];
            uni &= (cur >= 63) ? ~0ull : ((1ull << (cur + 1)) - 1ull);
            uni = ((unsigned long long)(unsigned)__builtin_amdgcn_readfirstlane((int)(uni >> 32)) << 32) | (unsigned)__builtin_amdgcn_readfirstlane((int)uni);
            float res[2][4][4];
            {
                FlashAcc a; flash_reset(a);
                FlashStage<64> st;
                unsigned long long rem = uni;
                int j = __builtin_ctzll(rem); rem &= rem - 1;
                flash_stage_load<64>(st, tid, [&](int r) { return Ks + (size_t)(j * 64 + r) * 64; }, [&](int r) { return Ks; }, [&](int r) { return Vs + (size_t)(j * 64 + r) * 64; });
                flash_stage_write<64>(st, tid, lds);
                __syncthreads();
                int i = 0;
                for (;;) {
                    const bool more = rem != 0ull;
                    int jn = 0;
                    if (more) { jn = __builtin_ctzll(rem); rem &= rem - 1;
                        flash_stage_load<64>(st, tid, [&](int r) { return Ks + (size_t)(jn * 64 + r) * 64; }, [&](int r) { return Ks; }, [&](int r) { return Vs + (size_t)(jn * 64 + r) * 64; }); }
                    { const bool diag = (j == cur);
                      const bool in0 = (sel[0] >> j) & 1ull, in1 = (sel[1] >> j) & 1ull;
                      int l0 = in0 ? (diag ? qi0 : 64) : -1, l1 = in1 ? (diag ? qi0 + 16 : 64) : -1;
                      asm volatile("" : "+v"(l0), "+v"(l1));
                      if (diag) flash_tile<64>(lds + (i & 1) * G::BUF, Q, a, sc2, lane, [&](int rg, int kidx) { return kidx <= (rg ? l1 : l0); });
                      else flash_tile_row<64>(lds + (i & 1) * G::BUF, Q, a, sc2, lane, [&](int rg, int) { return (rg ? l1 : l0) >= 0; }); }
                    if (more) flash_stage_write<64>(st, tid, lds + ((i + 1) & 1) * G::BUF);
                    __syncthreads();
                    if (!more) break;
                    j = jn; ++i;
                }
#pragma unroll
                for (int rg = 0; rg < 2; ++rg) { const float gt = gat[(t0 + rg * 16) * 24 + head * 3 + 1] / flash_lsum(a.l[rg]);
#pragma unroll
                    for (int d = 0; d < 4; ++d)
#pragma unroll
                        for (int e = 0; e < 4; ++e) res[rg][d][e] = a.O[rg][d][e] * gt * ZSLC; }
            }
            {
                FlashAcc a; flash_reset(a);
                FlashStage<64> st;
                const int jlo = cur >= 8 ? cur - 8 : 0;
                flash_stage_load<64>(st, tid, [&](int r) { return Kw + (size_t)(jlo * 64 + r) * 64; }, [&](int r) { return Kw; }, [&](int r) { return Vw + (size_t)(jlo * 64 + r) * 64; });
                flash_stage_write<64>(st, tid, lds);
                __syncthreads();
                for (int j = jlo, i = 0; j <= cur; ++j, ++i) {
                    if (j < cur) flash_stage_load<64>(st, tid, [&](int r) { return Kw + (size_t)((j + 1) * 64 + r) * 64; }, [&](int r) { return Kw; }, [&](int r) { return Vw + (size_t)((j + 1) * 64 + r) * 64; });
                    { const bool diag = (j == cur), tail = (j == cur - 8);
                      int h0 = diag ? qi0 : 64, h1 = diag ? qi0 + 16 : 64, t0_ = tail ? qi0 : -1, t1_ = tail ? qi0 + 16 : -1;
                      asm volatile("" : "+v"(h0), "+v"(h1), "+v"(t0_), "+v"(t1_));
                      flash_tile<64>(lds + (i & 1) * G::BUF, Q, a, sc2, lane, [&](int rg, int kidx) { return kidx <= (rg ? h1 : h0) && kidx > (rg ? t1_ : t0_); }); }
                    if (j < cur) flash_stage_write<64>(st, tid, lds + ((i + 1) & 1) * G::BUF);
                    __syncthreads();
                }
#pragma unroll
                for (int rg = 0; rg < 2; ++rg) { const float gt = gat[(t0 + rg * 16) * 24 + head * 3 + 2] / flash_lsum(a.l[rg]);
#pragma unroll
                    for (int d = 0; d < 4; ++d)
#pragma unroll
                        for (int e = 0; e < 4; ++e) res[rg][d][e] += a.O[rg][d][e] * gt * ZWIN; }
            }
#pragma unroll
            for (int rg = 0; rg < 2; ++rg) { const float g0 = gat[(t0 + rg * 16) * 24 + head * 3] * ZCMP;
                const size_t ob = (t0 + rg * 16) * 512 + head * 64 + q4 * 4;
#pragma unroll
                for (int d = 0; d < 4; ++d) { const f32x4 oc = *(const f32x4*)(ocmp + ob + d * 16);
                    u32x2 w; w.x = cvt_pk_bf16(res[rg][d][0] + g0 * oc[0], res[rg][d][1] + g0 * oc[1]); w.y = cvt_pk_bf16(res[rg][d][2] + g0 * oc[2], res[rg][d][3] + g0 * oc[3]);
                    *(u32x2*)(yo + ob + d * 16) = w; } }
            __syncthreads();
        }
    }
}

DI void phase_nsa_full(KParamsPtr p, LAS unsigned char* lds) {
    typedef FlashGeo<64> G;
    const int tid = TIDX(), lane = tid & 63, wave = __builtin_amdgcn_readfirstlane(tid >> 6), fr = lane & 15, q4 = lane >> 4;
    const float sc2 = 0.125f * 1.4426950408889634f;
    LAS float* impbuf = (LAS float*)(lds + 2 * G::BUF);
    LAS unsigned long long* selbuf = (LAS unsigned long long*)(lds + 2 * G::BUF + 65536);
    LAS unsigned* um = (LAS unsigned*)(lds + 2 * G::BUF + 65536 + 512);
    const float* kcp = p->nsa_kc; const float* vcp = p->nsa_vc;
    LAS float* rs = impbuf + tid;
    const bf16_t* nq = p->nsa_q; const float* gat = p->nsa_gate; bf16_t* yo = p->ys;
    for (int c0 = BIDX(); c0 < 256; c0 += NBLK()) {
        const int c = NBLK() == 256 ? ((c0 & 7) * 32 + (c0 >> 3)) : c0;
        const int bh = c >> 5, b = bh >> 1, hk = bh & 1;
        const bf16_t* Ks = p->nsa_ks + (size_t)bh * SEQ * 64; const bf16_t* Vs = p->nsa_vs + (size_t)bh * SEQ * 64;
        const bf16_t* Kw = p->nsa_kw + (size_t)bh * SEQ * 64; const bf16_t* Vw = p->nsa_vw + (size_t)bh * SEQ * 64;
#pragma unroll 1
        for (int half = 0; half < 2; ++half) {
            const int cur = half ? 63 - (c & 31) : (c & 31), s0 = cur * 64, g = wave >> 1, head = hk * 4 + g;
            const int qi0 = (wave & 1) * 32 + fr;
            const size_t t0 = (size_t)b * SEQ + s0 + qi0;
            int q4l = q4; asm volatile("" : "+v"(q4l));
            bf16x8 Q[2][2];
#pragma unroll
            for (int rg = 0; rg < 2; ++rg)
#pragma unroll
                for (int ks = 0; ks < 2; ++ks) Q[rg][ks] = *(const bf16x8*)(nq + (t0 + rg * 16) * 512 + head * 64 + ks * 32 + q4l * 8);
            unsigned long long sel[2];
            {
                const int nvmax = min(255, (s0 + 32) / 16 + 1), ntc = (nvmax + 63) >> 6;
                int nv[2];
#pragma unroll
                for (int rg = 0; rg < 2; ++rg) { const int tk = s0 + qi0 + rg * 16; nv[rg] = tk >= 31 ? min(255, (tk - 31) / 16 + 1) : 0; }
#pragma unroll 1
                for (int it = 0; it < 2; ++it) { const int pz = 1 - it;
                    FlashAcc a0; flash_reset(a0);
                    u32x4 sk, sv;
                    auto ld0 = [&](int tl) { int r = tid >> 3, c8 = tid & 7; asm volatile("" : "+v"(r), "+v"(c8)); const size_t o = ((size_t)bh * 256 + tl * 64 + r) * 64 + c8 * 8;
                        const f32x4 k0 = *(const f32x4*)(kcp + o), k1 = *(const f32x4*)(kcp + o + 4);
                        sk = (u32x4){cvt_pk_bf16(k0[0], k0[1]), cvt_pk_bf16(k0[2], k0[3]), cvt_pk_bf16(k1[0], k1[1]), cvt_pk_bf16(k1[2], k1[3])};
                        if (pz == 0) { const f32x4 v0 = *(const f32x4*)(vcp + o), v1 = *(const f32x4*)(vcp + o + 4);
                            sv = (u32x4){cvt_pk_bf16(v0[0], v0[1]), cvt_pk_bf16(v0[2], v0[3]), cvt_pk_bf16(v1[0], v1[1]), cvt_pk_bf16(v1[2], v1[3])}; }
                        else { int n = tl * 64 + r; asm volatile("" : "+v"(n)); unsigned w[4];
#pragma unroll
                            for (int e2 = 0; e2 < 4; ++e2) { const int J0 = c8 * 8 + 2 * e2, J1 = J0 + 1;
                                const unsigned lo = (n >= 4 * J0 - 1 && n <= 4 * J0 + 3 && n < 255) ? 0x3F80u : 0u, hi = (n >= 4 * J1 - 1 && n <= 4 * J1 + 3 && n < 255) ? 0x3F80u : 0u; w[e2] = lo | (hi << 16); }
                            sv = (u32x4){w[0], w[1], w[2], w[3]}; } };
                    FlashStage<64> st0;
                    ld0(0); st0.k = sk; st0.v = sv;
                    flash_stage_write<64>(st0, tid, lds);
                    __syncthreads();
                    for (int tl = 0; tl < ntc; ++tl) {
                        if (tl + 1 < ntc) { ld0(tl + 1); st0.k = sk; st0.v = sv; }
                        { int n0 = nv[0] - tl * 64, n1 = nv[1] - tl * 64;
                          asm volatile("" : "+v"(n0), "+v"(n1));
                          flash_tile<64>(lds + (tl & 1) * G::BUF, Q, a0, sc2, lane, [&](int rg, int kidx) { return kidx < (rg ? n1 : n0); }); }
                        if (tl + 1 < ntc) flash_stage_write<64>(st0, tid, lds + ((tl + 1) & 1) * G::BUF);
                        __syncthreads();
                    }
#pragma unroll
                    for (int rg = 0; rg < 2; ++rg) { const float lt = flash_lsum(a0.l[rg]), inv = lt > 0.f ? 1.0f / lt : 0.f;
                        if (pz == 0) { const float g0 = gat[(t0 + rg * 16) * 24 + head * 3] * inv * ZCMP;
#pragma unroll
                            for (int d = 0; d < 4; ++d)
#pragma unroll
                                for (int e = 0; e < 4; ++e) rs[((rg * 4 + d) * 4 + e) * 512] = a0.O[rg][d][e] * g0; }
                        else {
#pragma unroll
                            for (int d = 0; d < 4; ++d) *(LAS f32x4*)(impbuf + ((size_t)(g * 64 + qi0 + rg * 16)) * 64 + d * 16 + q4 * 4) = a0.O[rg][d] * inv; } }
                    if (it == 0) {
            __syncthreads();
            for (int k = 0; k < 8; ++k) { const int tokl = wave * 8 + k;
                const float im = (impbuf[(0 * 64 + tokl) * 64 + lane] + impbuf[(1 * 64 + tokl) * 64 + lane]) + (impbuf[(2 * 64 + tokl) * 64 + lane] + impbuf[(3 * 64 + tokl) * 64 + lane]);
                const bool valid = lane <= cur, forced = valid && (lane == 0 || lane >= cur - 1);
                const float val = forced ? 1e30f : (valid ? im : -1e30f);
                int rank = 0;
                for (int jj = 0; jj < 64; ++jj) { const float o = __shfl(val, jj); rank += (o > val || (o == val && jj < lane)) ? 1 : 0; }
                const unsigned long long mk = __ballot(rank < 16);
                if (lane == 0) selbuf[tokl] = mk; }
            __syncthreads();
#pragma unroll
            for (int rg = 0; rg < 2; ++rg) sel[rg] = selbuf[qi0 + rg * 16];
            if (wave == 0) {
                unsigned long long u = selbuf[lane];
                unsigned lo = (unsigned)u, hi = (unsigned)(u >> 32);
#pragma unroll
                for (int o = 32; o >= 1; o >>= 1) { lo |= (unsigned)__shfl_xor((int)lo, o); hi |= (unsigned)__shfl_xor((int)hi, o); }
                if (lane == 0) { um[0] = lo; um[1] = hi; }
            }
            __syncthreads();
                    }
                }
            }
            __syncthreads();
            unsigned long long uni = ((unsigned long long)um[1] << 32) | um[0];
            uni &= (cur >= 63) ? ~0ull : ((1ull << (cur + 1)) - 1ull);
            uni = ((unsigned long long)(unsigned)__builtin_amdgcn_readfirstlane((int)(uni >> 32)) << 32) | (unsigned)__builtin_amdgcn_readfirstlane((int)uni);
            FlashAcc a; flash_reset(a);
            {
                FlashStage<64> st;
                unsigned long long rem = uni & ~(1ull << cur);
                if (rem != 0ull) {
                    int j = __builtin_ctzll(rem); rem &= rem - 1;
                    flash_stage_load<64>(st, tid, [&](int r) { return Ks + (size_t)(j * 64 + r) * 64; }, [&](int r) { return Ks; }, [&](int r) { return Vs + (size_t)(j * 64 + r) * 64; });
                    flash_stage_write<64>(st, tid, lds);
                    __syncthreads();
                    int i = 0;
                    for (;;) {
                        const bool more = rem != 0ull;
                        int jn = 0;
                        if (more) { jn = __builtin_ctzll(rem); rem &= rem - 1;
                            flash_stage_load<64>(st, tid, [&](int r) { return Ks + (size_t)(jn * 64 + r) * 64; }, [&](int r) { return Ks; }, [&](int r) { return Vs + (size_t)(jn * 64 + r) * 64; }); }
                        { int l0 = (int)((sel[0] >> j) & 1ull), l1 = (int)((sel[1] >> j) & 1ull);
                          asm volatile("" : "+v"(l0), "+v"(l1));
                          flash_tile_row<64>(lds + (i & 1) * G::BUF, Q, a, sc2, lane, [&](int rg, int) { return (rg ? l1 : l0) != 0; }); }
                        if (more) flash_stage_write<64>(st, tid, lds + ((i + 1) & 1) * G::BUF);
                        __syncthreads();
                        if (!more) break;
                        j = jn; ++i;
                    }
                }
            }
            {
                FlashStage<64> st;
                const int jlo = cur >= 8 ? cur - 8 : 0, ntw = cur - jlo + 1;
                flash_stage_load<64>(st, tid, [&](int r) { return Ks + (size_t)(cur * 64 + r) * 64; }, [&](int r) { return Ks; }, [&](int r) { return Vs + (size_t)(cur * 64 + r) * 64; });
                flash_stage_write<64>(st, tid, lds);
                __syncthreads();
                for (int i2 = 0; i2 <= ntw; ++i2) {
                    if (i2 < ntw) { const int jn = jlo + i2;
                        flash_stage_load<64>(st, tid, [&](int r) { return Kw + (size_t)(jn * 64 + r) * 64; }, [&](int r) { return Kw; }, [&](int r) { return Vw + (size_t)(jn * 64 + r) * 64; }); }
                    { const int j = i2 == 0 ? cur : jlo + i2 - 1; const bool diag = (j == cur), tail = (i2 > 0 && j == cur - 8);
                      int h0 = diag ? qi0 : 64, h1 = diag ? qi0 + 16 : 64, t0_ = tail ? qi0 : -1, t1_ = tail ? qi0 + 16 : -1;
                      asm volatile("" : "+v"(h0), "+v"(h1), "+v"(t0_), "+v"(t1_));
                      if (diag || tail) flash_tile<64>(lds + (i2 & 1) * G::BUF, Q, a, sc2, lane, [&](int rg, int kidx) { return kidx <= (rg ? h1 : h0) && kidx > (rg ? t1_ : t0_); });
                      else flash_tile_row<64>(lds + (i2 & 1) * G::BUF, Q, a, sc2, lane, [&](int rg, int) { return (rg ? h1 : h0) > 0; }); }
                    if (i2 < ntw) flash_stage_write<64>(st, tid, lds + ((i2 + 1) & 1) * G::BUF);
                    __syncthreads();
                    if (i2 == 0) {
#pragma unroll
                        for (int rg = 0; rg < 2; ++rg) { const float gt = gat[(t0 + rg * 16) * 24 + head * 3 + 1] / flash_lsum(a.l[rg]);
#pragma unroll
                            for (int d = 0; d < 4; ++d)
#pragma unroll
                                for (int e = 0; e < 4; ++e) rs[((rg * 4 + d) * 4 + e) * 512] += a.O[rg][d][e] * gt * ZSLC; }
                        flash_reset(a); }
                }
#pragma unroll
                for (int rg = 0; rg < 2; ++rg) { const float gt = gat[(t0 + rg * 16) * 24 + head * 3 + 2] / flash_lsum(a.l[rg]);
#pragma unroll
                    for (int d = 0; d < 4; ++d)
#pragma unroll
                        for (int e = 0; e < 4; ++e) rs[((rg * 4 + d) * 4 + e) * 512] += a.O[rg][d][e] * gt * ZWIN; }
            }
#pragma unroll
            for (int rg = 0; rg < 2; ++rg) { const size_t ob = (t0 + rg * 16) * 512 + head * 64 + q4l * 4;
#pragma unroll
                for (int d = 0; d < 4; ++d) { u32x2 w; w.x = cvt_pk_bf16(rs[((rg * 4 + d) * 4 + 0) * 512], rs[((rg * 4 + d) * 4 + 1) * 512]); w.y = cvt_pk_bf16(rs[((rg * 4 + d) * 4 + 2) * 512], rs[((rg * 4 + d) * 4 + 3) * 512]);
                    *(u32x2*)(yo + ob + d * 16) = w; } }
            __syncthreads();
        }
    }
}
#define DPPF(x, ctrl) __int_as_float(__builtin_amdgcn_update_dpp(0, __float_as_int(x), ctrl, 0xF, 0xF, true))
DI float red16(float x) { x += DPPF(x, 0xB1); x += DPPF(x, 0x4E); x += DPPF(x, 0x141); x += DPPF(x, 0x140); return x; }
DI float dot4(const f32x4 a, const f32x4 b) { f32x2 t = (f32x2){a[0], a[1]} * (f32x2){b[0], b[1]}; t = (f32x2){a[2], a[3]} * (f32x2){b[2], b[3]} + t; return t[0] + t[1]; }
DI void bf8_to_f(const u32x4 w, f32x4& a, f32x4& b) {
    a = (f32x4){__uint_as_float(w.x << 16), __uint_as_float(w.x & 0xffff0000u), __uint_as_float(w.y << 16), __uint_as_float(w.y & 0xffff0000u)};
    b = (f32x4){__uint_as_float(w.z << 16), __uint_as_float(w.z & 0xffff0000u), __uint_as_float(w.w << 16), __uint_as_float(w.w & 0xffff0000u)};
}
template <int MODE>
DI void rowscan_unit(KParamsPtr p, LAS unsigned char* lds, int unit) {
    constexpr int TC = 32, NV = MODE == 0 ? 5 : 3;
    constexpr int NR = 32;
    constexpr int BUFF = NV * TC * 64 + TC * NR + TC * NR;
    const int tid = TIDX(), lane = tid & 63, wave = __builtin_amdgcn_readfirstlane(tid >> 6);
    LAS float* L = (LAS float*)lds;
    int b, h, sub;
    if (MODE == 0) { const int bh = unit >> 1; b = bh >> 3; h = bh & 7; sub = unit & 1; } else { const int bh = unit >> 2; b = bh >> 2; h = bh & 3; sub = unit & 3; }
    const size_t tb = (size_t)b * SEQ;
    f32x4 f0, f1, f2; u32x4 h0, hv;
    auto stage_load = [&](int t0) {
        const int s = tid >> 4, c4 = tid & 15, s2 = (tid & 255) >> 3, c8 = tid & 7;
        if (MODE == 0) {
            const size_t o = (tb + t0 + s) * 512 + h * 64 + c4 * 4;
            f0 = *(const f32x4*)(p->rw_kk + o); f1 = *(const f32x4*)(p->rw_w + o); f2 = *(const f32x4*)(p->rw_b + o);
            const size_t o2 = (tb + t0 + s2) * 512 + h * 64 + c8 * 8;
            h0 = *(const u32x4*)((tid < 256 ? p->rw_k : p->rw_r) + o2);
            if (tid < 128) hv = *(const u32x4*)(p->rw_v + (tb + t0 + (tid >> 2)) * 512 + h * 64 + sub * NR + (tid & 3) * 8);
        } else {
            f0 = *(const f32x4*)(p->gla_la + (tb + t0 + s) * 256 + h * 64 + c4 * 4);
            const bf16_t* row = p->P1 + (tb + t0 + s2) * NP1P;
            h0 = *(const u32x4*)(row + (tid < 256 ? C_GLA_K : C_GLA_Q) + h * 64 + c8 * 8);
            if (tid < 128) hv = *(const u32x4*)(p->P1 + (tb + t0 + (tid >> 2)) * NP1P + C_GLA_V + h * 128 + sub * NR + (tid & 3) * 8);
        }
    };
    auto stage_write = [&](int buf) {
        LAS float* B = L + buf * BUFF;
        const int s = tid >> 4, c4 = tid & 15, s2 = (tid & 255) >> 3, c8 = tid & 7;
        f32x4 a, c; bf8_to_f(h0, a, c);
        if (MODE == 0) {
            *(LAS f32x4*)(B + (0 * TC + s) * 64 + c4 * 4) = f0; *(LAS f32x4*)(B + (1 * TC + s) * 64 + c4 * 4) = f1; *(LAS f32x4*)(B + (3 * TC + s) * 64 + c4 * 4) = f2;
            LAS float* d = B + ((tid < 256 ? 2 : 4) * TC + s2) * 64 + c8 * 8;
            *(LAS f32x4*)d = a; *(LAS f32x4*)(d + 4) = c;
        } else {
            *(LAS f32x4*)(B + (0 * TC + s) * 64 + c4 * 4) = (f32x4){__expf(f0[0]), __expf(f0[1]), __expf(f0[2]), __expf(f0[3])};
            if (tid >= 256) { a *= 0.125f; c *= 0.125f; }
            LAS float* d = B + ((tid < 256 ? 1 : 2) * TC + s2) * 64 + c8 * 8;
            *(LAS f32x4*)d = a; *(LAS f32x4*)(d + 4) = c;
        }
        if (tid < 128) { f32x4 va, vc; bf8_to_f(hv, va, vc); LAS float* d = B + NV * TC * 64 + (tid >> 2) * NR + (tid & 3) * 8; *(LAS f32x4*)d = va; *(LAS f32x4*)(d + 4) = vc; }
    };
    auto flush_y = [&](int buf, int t0) {
        if (tid < TC * 8) { const int s = tid >> 3, q = tid & 7;
            const f32x4 v = *(const LAS f32x4*)(L + buf * BUFF + NV * TC * 64 + TC * NR + s * NR + q * 4);
            float* dst = (MODE == 0 ? p->rw_y + (tb + t0 + s) * 512 + h * 64 : p->gla_o + (tb + t0 + s) * 512 + h * 128) + sub * NR + q * 4;
            *(f32x4*)dst = v; }
    };
    const int row = wave * 4 + (lane >> 4), j = lane & 15;
    f32x4 st = (f32x4){0.f, 0.f, 0.f, 0.f};
    stage_load(0);
    __syncthreads();
    stage_write(0);
    __syncthreads();
    constexpr int NCH = SEQ / TC;
    for (int c = 0; c < NCH; ++c) {
        if (c + 1 < NCH) stage_load((c + 1) * TC);
        if (c > 0) flush_y((c - 1) & 1, (c - 1) * TC);
        {
            LAS const float* B = L + (c & 1) * BUFF;
            LAS float* Y = L + (c & 1) * BUFF + NV * TC * 64 + TC * NR;
#pragma unroll 1
            for (int s0 = 0; s0 < TC; s0 += 4) {
                float v[4]; f32x4 x0[4], x1[4], x2[4], x3[4], x4[4];
#pragma unroll
                for (int u = 0; u < 4; ++u) { const int s = s0 + u;
                    v[u] = B[NV * TC * 64 + s * NR + row];
                    x0[u] = *(const LAS f32x4*)(B + (0 * TC + s) * 64 + j * 4); x1[u] = *(const LAS f32x4*)(B + (1 * TC + s) * 64 + j * 4); x2[u] = *(const LAS f32x4*)(B + (2 * TC + s) * 64 + j * 4);
                    if (MODE == 0) { x3[u] = *(const LAS f32x4*)(B + (3 * TC + s) * 64 + j * 4); x4[u] = *(const LAS f32x4*)(B + (4 * TC + s) * 64 + j * 4); } }
#pragma unroll
                for (int u = 0; u < 4; ++u) { const int s = s0 + u;
                    if (MODE == 0) {
                        const float skk = red16(dot4(st, x0[u]));
                        st = st * x1[u] + (x2[u] * v[u] - x3[u] * skk);
                        const float y = red16(dot4(st, x4[u]));
                        Y[s * NR + row] = y;
                    } else {
                        st = st * x0[u] + x1[u] * v[u];
                        const float y = red16(dot4(st, x2[u]));
                        Y[s * NR + row] = y;
                    } }
            }
        }
        if (c + 1 < NCH) stage_write((c + 1) & 1);
        __syncthreads();
    }
    flush_y((NCH - 1) & 1, (NCH - 1) * TC);
    __syncthreads();
}
DI void phase_rowscans(KParamsPtr p, LAS unsigned char* lds) {
    for (int u = BIDX(); u < 128; u += NBLK()) { if (u < 64) rowscan_unit<0>(p, lds, u); else rowscan_unit<1>(p, lds, u - 64); }
}

template <int MODE>
DI void rowscan_half(KParamsPtr p, LAS float* L, int unit, int tl, int wl, int lane) {
    constexpr int TC = 16, NV = MODE == 0 ? 5 : 3, NR = 16;
    constexpr int BUFF = NV * TC * 64 + TC * NR + TC * NR;
    int b, h, sub;
    if (MODE == 0) { const int bh = unit >> 2; b = bh >> 3; h = bh & 7; sub = unit & 3; } else { const int bh = unit >> 3; b = bh >> 2; h = bh & 3; sub = unit & 7; }
    const size_t tb = (size_t)b * SEQ;
    f32x4 f0, f1, f2; u32x4 h0, hv;
    auto stage_load = [&](int t0) {
        const int s = tl >> 4, c4 = tl & 15, s2 = (tl & 127) >> 3, c8 = tl & 7;
        if (MODE == 0) {
            const size_t o = (tb + t0 + s) * 512 + h * 64 + c4 * 4;
            f0 = *(const f32x4*)(p->rw_kk + o); f1 = *(const f32x4*)(p->rw_w + o); f2 = *(const f32x4*)(p->rw_b + o);
            h0 = *(const u32x4*)((tl < 128 ? p->rw_k : p->rw_r) + (tb + t0 + s2) * 512 + h * 64 + c8 * 8);
            if (tl < 32) hv = *(const u32x4*)(p->rw_v + (tb + t0 + (tl >> 1)) * 512 + h * 64 + sub * NR + (tl & 1) * 8);
        } else {
            f0 = *(const f32x4*)(p->gla_la + (tb + t0 + s) * 256 + h * 64 + c4 * 4);
            h0 = *(const u32x4*)(p->P1 + (tb + t0 + s2) * NP1P + (tl < 128 ? C_GLA_K : C_GLA_Q) + h * 64 + c8 * 8);
            if (tl < 32) hv = *(const u32x4*)(p->P1 + (tb + t0 + (tl >> 1)) * NP1P + C_GLA_V + h * 128 + sub * NR + (tl & 1) * 8);
        }
    };
    auto stage_write = [&](int buf) {
        LAS float* B = L + buf * BUFF;
        const int s = tl >> 4, c4 = tl & 15, s2 = (tl & 127) >> 3, c8 = tl & 7;
        f32x4 a, c; bf8_to_f(h0, a, c);
        if (MODE == 0) {
            *(LAS f32x4*)(B + (0 * TC + s) * 64 + c4 * 4) = f0; *(LAS f32x4*)(B + (1 * TC + s) * 64 + c4 * 4) = f1; *(LAS f32x4*)(B + (3 * TC + s) * 64 + c4 * 4) = f2;
            LAS float* d = B + ((tl < 128 ? 2 : 4) * TC + s2) * 64 + c8 * 8; *(LAS f32x4*)d = a; *(LAS f32x4*)(d + 4) = c;
        } else {
            *(LAS f32x4*)(B + (0 * TC + s) * 64 + c4 * 4) = (f32x4){__expf(f0[0]), __expf(f0[1]), __expf(f0[2]), __expf(f0[3])};
            if (tl >= 128) { a *= 0.125f; c *= 0.125f; }
            LAS float* d = B + ((tl < 128 ? 1 : 2) * TC + s2) * 64 + c8 * 8; *(LAS f32x4*)d = a; *(LAS f32x4*)(d + 4) = c;
        }
        if (tl < 32) { f32x4 va, vc; bf8_to_f(hv, va, vc); LAS float* d = B + NV * TC * 64 + (tl >> 1) * NR + (tl & 1) * 8; *(LAS f32x4*)d = va; *(LAS f32x4*)(d + 4) = vc; }
    };
    auto flush_y = [&](int buf, int t0) {
        if (tl < TC * 4) { const int s = tl >> 2, q = tl & 3;
            const f32x4 v = *(const LAS f32x4*)(L + buf * BUFF + NV * TC * 64 + TC * NR + s * NR + q * 4);
            float* dst = (MODE == 0 ? p->rw_y + (tb + t0 + s) * 512 + h * 64 : p->gla_o + (tb + t0 + s) * 512 + h * 128) + sub * NR + q * 4;
            *(f32x4*)dst = v; }
    };
    const int row = wl * 4 + (lane >> 4), j = lane & 15;
    f32x4 st = (f32x4){0.f, 0.f, 0.f, 0.f};
    stage_load(0);
    __syncthreads();
    stage_write(0);
    __syncthreads();
    constexpr int NCH = SEQ / TC;
    for (int c = 0; c < NCH; ++c) {
        if (c + 1 < NCH) stage_load((c + 1) * TC);
        if (c > 0) flush_y((c - 1) & 1, (c - 1) * TC);
        LAS const float* B = L + (c & 1) * BUFF;
        LAS float* Y = L + (c & 1) * BUFF + NV * TC * 64 + TC * NR;
#pragma unroll 1
        for (int s0 = 0; s0 < TC; s0 += 4) {
            float v[4]; f32x4 x0[4], x1[4], x2[4], x3[4], x4[4];
#pragma unroll
            for (int u = 0; u < 4; ++u) { const int s = s0 + u;
                v[u] = B[NV * TC * 64 + s * NR + row];
                x0[u] = *(const LAS f32x4*)(B + (0 * TC + s) * 64 + j * 4); x1[u] = *(const LAS f32x4*)(B + (1 * TC + s) * 64 + j * 4); x2[u] = *(const LAS f32x4*)(B + (2 * TC + s) * 64 + j * 4);
                if (MODE == 0) { x3[u] = *(const LAS f32x4*)(B + (3 * TC + s) * 64 + j * 4); x4[u] = *(const LAS f32x4*)(B + (4 * TC + s) * 64 + j * 4); } }
#pragma unroll
            for (int u = 0; u < 4; ++u) { const int s = s0 + u;
                if (MODE == 0) { const float skk = red16(dot4(st, x0[u])); st = st * x1[u] + (x2[u] * v[u] - x3[u] * skk); Y[s * NR + row] = red16(dot4(st, x4[u])); }
                else { st = st * x0[u] + x1[u] * v[u]; Y[s * NR + row] = red16(dot4(st, x2[u])); } }
        }
        if (c + 1 < NCH) stage_write((c + 1) & 1);
        __syncthreads();
    }
    flush_y((NCH - 1) & 1, (NCH - 1) * TC);
    __syncthreads();
}
DI void phase_rowscans_paired(KParamsPtr p, LAS unsigned char* lds) {
    const int tid = TIDX(), lane = tid & 63, wave = __builtin_amdgcn_readfirstlane(tid >> 6);
    for (int u0 = BIDX(); u0 < 128; u0 += NBLK()) {
        const int u = NBLK() == 256 ? ((u0 & 7) * 16 + (u0 >> 3)) : u0;
        if (wave < 4) rowscan_half<0>(p, (LAS float*)lds, u, tid, wave, lane);
        else rowscan_half<1>(p, (LAS float*)(lds + 49152), u, tid - 256, wave - 4, lane);
    }
}
constexpr int LDS_BYTES = 147456;
constexpr int LDS_XB_OFF = 131072;

#ifndef REP_SETUP
#define REP_SETUP 1
#endif
#ifndef REP_CONV
#define REP_CONV 1
#endif
#ifndef REP_PREP
#define REP_PREP 1
#endif
#ifndef REP_CMPR
#define REP_CMPR 1
#endif
#ifndef REP_MLAUP
#define REP_MLAUP 1
#endif
#ifndef REP_NSACMP
#define REP_NSACMP 1
#endif
#ifndef REP_NSAF
#define REP_NSAF 1
#endif
#ifndef REP_MLAF
#define REP_MLAF 1
#endif
#ifndef REP_SCAN
#define REP_SCAN 1
#endif
#ifndef REP_POST
#define REP_POST 1
#endif
#ifndef REP_MSUM
#define REP_MSUM 1
#endif
#ifndef REP_NORM0
#define REP_NORM0 1
#endif
#ifndef REP_GATE
#define REP_GATE 1
#endif
#ifndef REP_MERGE
#define REP_MERGE 1
#endif
#ifndef REP_UP
#define REP_UP 1
#endif
#ifndef REP_DN
#define REP_DN 1
#endif
#ifndef REP_PROJ
#define REP_PROJ 1
#endif
#ifndef SCAN_GATE_UNITS
#define SCAN_GATE_UNITS 3
#endif
#define REPEAT(n) for (int r_ = 0; r_ < (n); ++r_)
__global__ void __launch_bounds__(512, 2) mega(Params p_arg, int ph_lo, int ph_hi) {
    extern __shared__ __attribute__((aligned(16))) unsigned char lds_raw[];
    LAS unsigned char* lds = (LAS unsigned char*)lds_raw;
    volatile LAS unsigned* xbw = (volatile LAS unsigned*)(lds + LDS_XB_OFF);
    if (threadIdx.x == 0) { xbw[0] = 0u; xbw[1] = 0u; xbw[2] = 0u; xbw[3] = 0u; }
    __syncthreads();
    XcdBarrier bar; bar.bar = p_arg.bar; bar.x = 0; bar.st = xbw;
    if (ph_hi - ph_lo > 1) bar = xcd_barrier_post(p_arg.bar, xbw);
    int ph = 0;
#define PHASE_BEGIN if (ph >= ph_lo && ph < ph_hi) { KParamsPtr p = (KParamsPtr)__builtin_amdgcn_kernarg_segment_ptr(); asm volatile("" : "+s"(p));
#define PHASE_END   __syncthreads(); if (ph + 1 < ph_hi) xcd_barrier(bar); } ++ph;

    PHASE_BEGIN REPEAT(REP_SETUP) { phase_setup(p, lds); __syncthreads(); } REPEAT(REP_CONV) { phase_convert(p, 0, lds); __syncthreads(); } PHASE_END
    PHASE_BEGIN REPEAT(REP_NORM0) phase_norm<false, true>(p->x, nullptr, nullptr, p->u, nullptr, nullptr, 0.f, p->pre_g, p->mod); PHASE_END

    { constexpr int l = 0;

#define modA (p->mod + (size_t)(l * 3 + 0) * 4 * 6144)
#define modB (p->mod + (size_t)(l * 3 + 1) * 4 * 6144)
#define modC (p->mod + (size_t)(l * 3 + 2) * 4 * 6144)
        PHASE_BEGIN REPEAT(REP_UP) { EpiSwiglu E; E.H = p->P1; E.ldc = DFF; run_gemm(lds, p->u, D, p->Wup0, D, T, 2 * DFF, D, E); __syncthreads(); } PHASE_END
        PHASE_BEGIN REPEAT(REP_DN) { EpiBf16<0> E; E.O = (bf16_t*)p->y; E.ldc = D; run_gemm(lds, p->P1, DFF, p->Wdn0, DFF, T, D, DFF, E); __syncthreads(); } PHASE_END
        PHASE_BEGIN phase_norm<true, true, (l != 0), true>(l == 0 ? (const void*)p->x : (const void*)p->out, (const bf16_t*)p->y, p->out, p->u, p->post_g + (l * 3 + 0) * D, modA, 0.5f, p->pre_g + (l * 3 + 1) * D, modB); PHASE_END
        PHASE_BEGIN REPEAT(REP_PROJ) {
            { EpiBf16<0> E; E.O = p->P1; E.ldc = NP1P; run_gemm(lds, p->u, D, p->Win1, D, T, P1TAIL, D, E); } __syncthreads();
            for (int i_ = BIDX(); i_ < 256; i_ += NBLK()) { const int pm_ = i_ >> 2, kp_ = i_ & 3;
                EpiF32Lo E; E.C = p->y + (size_t)kp_ * T * 256; E.ldc = 256;
                pg8::Gemm g; g.A = p->u + kp_ * 512; g.Bt = p->Win1 + (size_t)P1TAIL * D + kp_ * 512; g.M = T; g.N = 256; g.K = 512; g.lda = D; g.ldb = D;
                SplitOrder S; S.first = pm_; S.count = 1; S.nN = 1;
                pg8::gemm_phase<EpiF32Lo, SplitOrder, false>((PG8_LAS unsigned char*)lds, g, S, E, nullptr); __syncthreads(); }
            __syncthreads(); } PHASE_END
        PHASE_BEGIN REPEAT(REP_PREP) { phase_prep2(p, l, lds); __syncthreads(); } PHASE_END
        PHASE_BEGIN {
            REPEAT(REP_SCAN) { phase_rowscans_paired(p, lds); __syncthreads(); }
            EpiBf16<1> E; E.O = p->G; E.ldc = NGATE;
            pg8::Gemm g; g.A = p->u; g.Bt = p->Wg; g.M = T; g.N = NGATE; g.K = D; g.lda = D; g.ldb = D;
            const int nb_ = NBLK(), bid_ = BIDX();
            if (nb_ == 256 && SCAN_GATE_UNITS == 3) {
                const int x_ = bid_ & 7; RowWalkOrder S;
                if (bid_ < 128) { const int r_ = bid_ >> 3; S.pm = 8 * x_ + (r_ & 7); S.pn0 = (r_ >> 3) * 3; S.step = 1; S.count = 3; }
                else { const int r_ = (bid_ - 128) >> 3; S.pm = 8 * x_ + (r_ & 7); S.pn0 = 6 + (r_ >> 3); S.step = 2; S.count = 13; }
                pg8::gemm_phase<EpiBf16<1>, RowWalkOrder, false>((PG8_LAS unsigned char*)lds, g, S, E, nullptr); }
            else if (nb_ == 256) { SplitOrder S; S.nN = 32; if (bid_ < 128) { S.first = bid_ * SCAN_GATE_UNITS; S.count = SCAN_GATE_UNITS; } else { S.first = 128 * SCAN_GATE_UNITS + (bid_ - 128) * (16 - SCAN_GATE_UNITS); S.count = 16 - SCAN_GATE_UNITS; }
                pg8::gemm_phase<EpiBf16<1>, SplitOrder, false>((PG8_LAS unsigned char*)lds, g, S, E, nullptr); }
            else { pg8::StaticOrder S; S.init(T, NGATE, nb_, bid_); pg8::gemm_phase<EpiBf16<1>, pg8::StaticOrder, false>((PG8_LAS unsigned char*)lds, g, S, E, nullptr); }
        } PHASE_END
        PHASE_BEGIN REPEAT(REP_CMPR) {
            const int c_ = BIDX();
            if (c_ < 16) { const int wh = c_ >> 3, pan = c_ & 7;
                { EpiGeluBias E; E.O = p->chid + (size_t)wh * 2048 * 256; E.ldc = 256; E.bias = p->cbias + wh * 256;
                  pg8::Gemm g; g.A = wh ? p->nsa_vc_in : p->nsa_kc_in; g.Bt = p->cW1t + (size_t)wh * 256 * 2048; g.M = 2048; g.N = 256; g.K = 2048; g.lda = 1024; g.ldb = 2048;
                  SplitOrder S; S.first = pan; S.count = 1; S.nN = 1;
                  pg8::gemm_phase<EpiGeluBias, SplitOrder, false>((PG8_LAS unsigned char*)lds, g, S, E, nullptr); }
                asm volatile("s_waitcnt vmcnt(0)" ::: "memory"); __syncthreads();
                { EpiCmpOut E; E.C = wh ? p->nsa_vc : p->nsa_kc;
                  pg8::Gemm g; g.A = p->chid + (size_t)wh * 2048 * 256; g.Bt = p->cW2t + (size_t)wh * 256 * 256; g.M = 2048; g.N = 256; g.K = 256; g.lda = 256; g.ldb = 256;
                  SplitOrder S; S.first = pan; S.count = 1; S.nN = 1;
                  pg8::gemm_phase<EpiCmpOut, SplitOrder, false>((PG8_LAS unsigned char*)lds, g, S, E, nullptr); }
            }
            __syncthreads(); } REPEAT(REP_MLAUP) {
            const int skip_ = NBLK() == 256 ? 16 : 0, G_ = NBLK() - skip_, c2_ = BIDX() - skip_;
            if (c2_ >= 0) {
                { EpiBf16<0> E; E.O = p->mla_q; E.ldc = 768; pg8::Gemm g; g.A = p->mla_cqn; g.Bt = p->Wuq; g.M = T; g.N = 768; g.K = 384; g.lda = 384; g.ldb = 384;
                  pg8::StaticOrder S; S.init(T, 768, G_, c2_); pg8::gemm_phase<EpiBf16<0>, pg8::StaticOrder, false>((PG8_LAS unsigned char*)lds, g, S, E, nullptr); } __syncthreads();
                { EpiBf16<0> E; E.O = p->mla_kv; E.ldc = 1024; pg8::Gemm g; g.A = p->mla_ckvn; g.Bt = p->Wukv; g.M = T; g.N = 1024; g.K = 256; g.lda = 256; g.ldb = 256;
                  pg8::StaticOrder S; S.init(T, 1024, G_, (c2_ + 48) % G_); pg8::gemm_phase<EpiBf16<0>, pg8::StaticOrder, false>((PG8_LAS unsigned char*)lds, g, S, E, nullptr); } __syncthreads(); } } __syncthreads(); REPEAT(REP_POST) { phase_post(p, l, lds, NBLK() == 256 ? 16 : 0); __syncthreads(); } PHASE_END
        PHASE_BEGIN REPEAT(REP_NSAF) { phase_nsa_full(p, lds); __syncthreads(); } REPEAT(REP_MLAF) { phase_mla_flash(p, lds); __syncthreads(); } PHASE_END
        PHASE_BEGIN { EpiMergeAcc E; E.G = p->G; E.O = p->mg;
            pg8::Gemm g; g.A = p->ys; g.Bt = p->Wbr; g.M = 4 * T; g.N = 4 * D; g.K = 512; g.lda = 512; g.ldb = 512;
            MergeOrder S; S.G = NBLK(); S.c = BIDX();
            REPEAT(REP_MERGE) { pg8::gemm_phase<EpiMergeAcc, MergeOrder, false>((PG8_LAS unsigned char*)lds, g, S, E, nullptr); __syncthreads(); } } PHASE_END
        PHASE_BEGIN { EpiBf16<0> E; E.O = (bf16_t*)p->y; E.ldc = D; run_gemm(lds, p->mg, D, p->Wout, D, T, D, D, E); } PHASE_END
        PHASE_BEGIN phase_norm<true, true, true, true>(p->out, (const bf16_t*)p->y, p->G, p->u, p->post_g + (l * 3 + 1) * D, modB, 1.0f, p->pre_g + (l * 3 + 2) * D, modC); PHASE_END
        PHASE_BEGIN { EpiSwiglu E; E.H = p->P1; E.ldc = DFF; run_gemm(lds, p->u, D, p->Wup1, D, T, 2 * DFF, D, E); } PHASE_END
        PHASE_BEGIN { EpiBf16<0> E; E.O = (bf16_t*)p->y; E.ldc = D; run_gemm(lds, p->P1, DFF, p->Wdn1, DFF, T, D, DFF, E); } PHASE_END
        if (l == 0) { PHASE_BEGIN phase_norm<true, true, true, true>(p->G, (const bf16_t*)p->y, p->out, p->u, p->post_g + (l * 3 + 2) * D, modC, 0.5f, p->pre_g + ((l + 1) * 3) * D, p->mod + (size_t)((l + 1) * 3) * 4 * 6144);
            __syncthreads(); REPEAT(REP_CONV) { phase_convert(p, 1, lds); __syncthreads(); } PHASE_END }
        else        { PHASE_BEGIN phase_norm<true, false, true, false>(p->G, (const bf16_t*)p->y, p->out, nullptr, p->post_g + (l * 3 + 2) * D, modC, 0.5f, nullptr, nullptr); PHASE_END }
    }
    { constexpr int l = 1;

#define modA (p->mod + (size_t)(l * 3 + 0) * 4 * 6144)
#define modB (p->mod + (size_t)(l * 3 + 1) * 4 * 6144)
#define modC (p->mod + (size_t)(l * 3 + 2) * 4 * 6144)
        PHASE_BEGIN REPEAT(REP_UP) { EpiSwiglu E; E.H = p->P1; E.ldc = DFF; run_gemm(lds, p->u, D, p->Wup0, D, T, 2 * DFF, D, E); __syncthreads(); } PHASE_END
        PHASE_BEGIN REPEAT(REP_DN) { EpiBf16<0> E; E.O = (bf16_t*)p->y; E.ldc = D; run_gemm(lds, p->P1, DFF, p->Wdn0, DFF, T, D, DFF, E); __syncthreads(); } PHASE_END
        PHASE_BEGIN phase_norm<true, true, (l != 0), true>(l == 0 ? (const void*)p->x : (const void*)p->out, (const bf16_t*)p->y, p->out, p->u, p->post_g + (l * 3 + 0) * D, modA, 0.5f, p->pre_g + (l * 3 + 1) * D, modB); PHASE_END
        PHASE_BEGIN REPEAT(REP_PROJ) {
            { EpiBf16<0> E; E.O = p->P1; E.ldc = NP1P; run_gemm(lds, p->u, D, p->Win1, D, T, P1TAIL, D, E); } __syncthreads();
            for (int i_ = BIDX(); i_ < 256; i_ += NBLK()) { const int pm_ = i_ >> 2, kp_ = i_ & 3;
                EpiF32Lo E; E.C = p->y + (size_t)kp_ * T * 256; E.ldc = 256;
                pg8::Gemm g; g.A = p->u + kp_ * 512; g.Bt = p->Win1 + (size_t)P1TAIL * D + kp_ * 512; g.M = T; g.N = 256; g.K = 512; g.lda = D; g.ldb = D;
                SplitOrder S; S.first = pm_; S.count = 1; S.nN = 1;
                pg8::gemm_phase<EpiF32Lo, SplitOrder, false>((PG8_LAS unsigned char*)lds, g, S, E, nullptr); __syncthreads(); }
            __syncthreads(); } PHASE_END
        PHASE_BEGIN REPEAT(REP_PREP) { phase_prep2(p, l, lds); __syncthreads(); } PHASE_END
        PHASE_BEGIN {
            REPEAT(REP_SCAN) { phase_rowscans_paired(p, lds); __syncthreads(); }
            EpiBf16<1> E; E.O = p->G; E.ldc = NGATE;
            pg8::Gemm g; g.A = p->u; g.Bt = p->Wg; g.M = T; g.N = NGATE; g.K = D; g.lda = D; g.ldb = D;
            const int nb_ = NBLK(), bid_ = BIDX();
            if (nb_ == 256 && SCAN_GATE_UNITS == 3) {
                const int x_ = bid_ & 7; RowWalkOrder S;
                if (bid_ < 128) { const int r_ = bid_ >> 3; S.pm = 8 * x_ + (r_ & 7); S.pn0 = (r_ >> 3) * 3; S.step = 1; S.count = 3; }
                else { const int r_ = (bid_ - 128) >> 3; S.pm = 8 * x_ + (r_ & 7); S.pn0 = 6 + (r_ >> 3); S.step = 2; S.count = 13; }
                pg8::gemm_phase<EpiBf16<1>, RowWalkOrder, false>((PG8_LAS unsigned char*)lds, g, S, E, nullptr); }
            else if (nb_ == 256) { SplitOrder S; S.nN = 32; if (bid_ < 128) { S.first = bid_ * SCAN_GATE_UNITS; S.count = SCAN_GATE_UNITS; } else { S.first = 128 * SCAN_GATE_UNITS + (bid_ - 128) * (16 - SCAN_GATE_UNITS); S.count = 16 - SCAN_GATE_UNITS; }
                pg8::gemm_phase<EpiBf16<1>, SplitOrder, false>((PG8_LAS unsigned char*)lds, g, S, E, nullptr); }
            else { pg8::StaticOrder S; S.init(T, NGATE, nb_, bid_); pg8::gemm_phase<EpiBf16<1>, pg8::StaticOrder, false>((PG8_LAS unsigned char*)lds, g, S, E, nullptr); }
        } PHASE_END
        PHASE_BEGIN REPEAT(REP_CMPR) {
            const int c_ = BIDX();
            if (c_ < 16) { const int wh = c_ >> 3, pan = c_ & 7;
                { EpiGeluBias E; E.O = p->chid + (size_t)wh * 2048 * 256; E.ldc = 256; E.bias = p->cbias + wh * 256;
                  pg8::Gemm g; g.A = wh ? p->nsa_vc_in : p->nsa_kc_in; g.Bt = p->cW1t + (size_t)wh * 256 * 2048; g.M = 2048; g.N = 256; g.K = 2048; g.lda = 1024; g.ldb = 2048;
                  SplitOrder S; S.first = pan; S.count = 1; S.nN = 1;
                  pg8::gemm_phase<EpiGeluBias, SplitOrder, false>((PG8_LAS unsigned char*)lds, g, S, E, nullptr); }
                asm volatile("s_waitcnt vmcnt(0)" ::: "memory"); __syncthreads();
                { EpiCmpOut E; E.C = wh ? p->nsa_vc : p->nsa_kc;
                  pg8::Gemm g; g.A = p->chid + (size_t)wh * 2048 * 256; g.Bt = p->cW2t + (size_t)wh * 256 * 256; g.M = 2048; g.N = 256; g.K = 256; g.lda = 256; g.ldb = 256;
                  SplitOrder S; S.first = pan; S.count = 1; S.nN = 1;
                  pg8::gemm_phase<EpiCmpOut, SplitOrder, false>((PG8_LAS unsigned char*)lds, g, S, E, nullptr); }
            }
            __syncthreads(); } REPEAT(REP_MLAUP) {
            const int skip_ = NBLK() == 256 ? 16 : 0, G_ = NBLK() - skip_, c2_ = BIDX() - skip_;
            if (c2_ >= 0) {
                { EpiBf16<0> E; E.O = p->mla_q; E.ldc = 768; pg8::Gemm g; g.A = p->mla_cqn; g.Bt = p->Wuq; g.M = T; g.N = 768; g.K = 384; g.lda = 384; g.ldb = 384;
                  pg8::StaticOrder S; S.init(T, 768, G_, c2_); pg8::gemm_phase<EpiBf16<0>, pg8::StaticOrder, false>((PG8_LAS unsigned char*)lds, g, S, E, nullptr); } __syncthreads();
                { EpiBf16<0> E; E.O = p->mla_kv; E.ldc = 1024; pg8::Gemm g; g.A = p->mla_ckvn; g.Bt = p->Wukv; g.M = T; g.N = 1024; g.K = 256; g.lda = 256; g.ldb = 256;
                  pg8::StaticOrder S; S.init(T, 1024, G_, (c2_ + 48) % G_); pg8::gemm_phase<EpiBf16<0>, pg8::StaticOrder, false>((PG8_LAS unsigned char*)lds, g, S, E, nullptr); } __syncthreads(); } } __syncthreads(); REPEAT(REP_POST) { phase_post(p, l, lds, NBLK() == 256 ? 16 : 0); __syncthreads(); } PHASE_END
        PHASE_BEGIN REPEAT(REP_NSAF) { phase_nsa_full(p, lds); __syncthreads(); } REPEAT(REP_MLAF) { phase_mla_flash(p, lds); __syncthreads(); } PHASE_END
        PHASE_BEGIN { EpiMergeAcc E; E.G = p->G; E.O = p->mg;
            pg8::Gemm g; g.A = p->ys; g.Bt = p->Wbr; g.M = 4 * T; g.N = 4 * D; g.K = 512; g.lda = 512; g.ldb = 512;
            MergeOrder S; S.G = NBLK(); S.c = BIDX();
            REPEAT(REP_MERGE) { pg8::gemm_phase<EpiMergeAcc, MergeOrder, false>((PG8_LAS unsigned char*)lds, g, S, E, nullptr); __syncthreads(); } } PHASE_END
        PHASE_BEGIN { EpiBf16<0> E; E.O = (bf16_t*)p->y; E.ldc = D; run_gemm(lds, p->mg, D, p->Wout, D, T, D, D, E); } PHASE_END
        PHASE_BEGIN phase_norm<true, true, true, true>(p->out, (const bf16_t*)p->y, p->G, p->u, p->post_g + (l * 3 + 1) * D, modB, 1.0f, p->pre_g + (l * 3 + 2) * D, modC); PHASE_END
        PHASE_BEGIN { EpiSwiglu E; E.H = p->P1; E.ldc = DFF; run_gemm(lds, p->u, D, p->Wup1, D, T, 2 * DFF, D, E); } PHASE_END
        PHASE_BEGIN { EpiBf16<0> E; E.O = (bf16_t*)p->y; E.ldc = D; run_gemm(lds, p->P1, DFF, p->Wdn1, DFF, T, D, DFF, E); } PHASE_END
        if (l == 0) { PHASE_BEGIN phase_norm<true, true, true, true>(p->G, (const bf16_t*)p->y, p->out, p->u, p->post_g + (l * 3 + 2) * D, modC, 0.5f, p->pre_g + ((l + 1) * 3) * D, p->mod + (size_t)((l + 1) * 3) * 4 * 6144);
            __syncthreads(); REPEAT(REP_CONV) { phase_convert(p, 1, lds); __syncthreads(); } PHASE_END }
        else        { PHASE_BEGIN phase_norm<true, false, true, false>(p->G, (const bf16_t*)p->y, p->out, nullptr, p->post_g + (l * 3 + 2) * D, modC, 0.5f, nullptr, nullptr); PHASE_END }
    }

}
constexpr int N_PHASES = 2 + 2 * 14;

extern "C" void kernel_launch(void* const* d_in, const int* in_sizes, int n_in, void* d_out, int out_size, void* d_ws, size_t ws_size, hipStream_t stream) {
    static int grid = 0;
    if (grid == 0) {
        int dev = 0, cus = 0;
        if (hipGetDevice(&dev) != hipSuccess || hipDeviceGetAttribute(&cus, hipDeviceAttributeMultiprocessorCount, dev) != hipSuccess) { fprintf(stderr, "kernel_launch: device query failed\n"); grid = -1; return; }
        if (hipFuncSetAttribute((const void*)mega, hipFuncAttributeMaxDynamicSharedMemorySize, LDS_BYTES) != hipSuccess) { fprintf(stderr, "kernel_launch: hipFuncSetAttribute failed\n"); grid = -1; return; }
        int per_cu = 0;
        if (hipOccupancyMaxActiveBlocksPerMultiprocessor(&per_cu, (const void*)mega, 512, LDS_BYTES) != hipSuccess || per_cu < 1) fprintf(stderr, "kernel_launch: occupancy query says %d\n", per_cu);
        (void)hipGetLastError();
        grid = cus;
    }
    if (grid < 0) return;
    Params p{};
    const float* const* in = (const float* const*)d_in;
    p.x = in[0]; p.c = in[1]; p.ada_w = in[2]; p.ada_b = in[3]; p.pre_g = in[4]; p.post_g = in[5]; p.ffn_wg = in[6]; p.ffn_wu = in[7]; p.ffn_wd = in[8];
    p.mix_w_in = in[9]; p.mix_w_branch = in[10]; p.mix_w_out = in[11]; p.cmp_pos = in[12]; p.cmp_w1 = in[13]; p.cmp_w2 = in[14];
    p.rw_mu = in[15]; p.rw_w0 = in[16]; p.rw_w_w2 = in[17]; p.rw_a0 = in[18]; p.rw_a_w2 = in[19]; p.rw_g_w2 = in[20]; p.rw_k_k = in[21]; p.rw_k_a = in[22];
    p.rw_r_k = in[23]; p.rw_ln_w = in[24]; p.rw_ln_b = in[25]; p.gla_w2 = in[26]; p.gla_b = in[27]; p.gla_g = in[28];
    p.mla_qn = in[29]; p.mla_wuq = in[30]; p.mla_kvn = in[31]; p.mla_wukv = in[32];
    p.out = (float*)d_out;
    unsigned char* ws = (unsigned char*)d_ws; size_t off = 0;
    auto take = [&](size_t bytes) { unsigned char* r = ws + off; off += (bytes + 255) & ~(size_t)255; return r; };
    p.bar = (unsigned*)take(16384);
    p.mod = (float*)take((size_t)6 * 4 * 6144 * 4);
    p.cos64 = (float*)take((size_t)SEQ * 32 * 4); p.sin64 = (float*)take((size_t)SEQ * 32 * 4); p.cos32 = (float*)take((size_t)SEQ * 16 * 4); p.sin32 = (float*)take((size_t)SEQ * 16 * 4);
    p.Wup0 = (bf16_t*)take((size_t)2 * DFF * D * 2); p.Wup1 = (bf16_t*)take((size_t)2 * DFF * D * 2);
    p.Wdn0 = (bf16_t*)take((size_t)D * DFF * 2); p.Wdn1 = (bf16_t*)take((size_t)D * DFF * 2);
    p.Win1 = (bf16_t*)take((size_t)(NP1P + NGATE) * D * 2); p.Wg = p.Win1 + (size_t)NP1P * D;
    p.Wbr = (bf16_t*)take((size_t)4 * D * 512 * 2); p.Wout = (bf16_t*)take((size_t)D * D * 2);
    p.Wuq = (bf16_t*)take((size_t)768 * 384 * 2); p.Wukv = (bf16_t*)take((size_t)1024 * 256 * 2);
    p.u = (bf16_t*)take((size_t)T * D * 2);
    p.P1 = (bf16_t*)take((size_t)T * DFF * 2);
    p.y = (float*)take((size_t)T * D * 4);
    p.G = (bf16_t*)take((size_t)T * NGATE * 2);
    { unsigned char* yb = (unsigned char*)p.y; size_t yo = 0;
      auto ytake = [&](size_t bytes) { unsigned char* r = yb + yo; yo += (bytes + 255) & ~(size_t)255; return r; };
      p.mla_q = (bf16_t*)ytake((size_t)T * 768 * 2); p.mla_kv = (bf16_t*)ytake((size_t)T * 1024 * 2); p.gla_o = (float*)ytake((size_t)T * 512 * 4); p.nsa_ocmp = (float*)ytake((size_t)T * 512 * 4);
      if (yo > (size_t)T * D * 4) { fprintf(stderr, "kernel_launch: y aliases overflow\n"); return; } }
    p.nsa_q = (bf16_t*)take((size_t)T * 512 * 2);
    p.nsa_kc_in = (bf16_t*)take((size_t)T * 128 * 2 + 4096); p.nsa_vc_in = (bf16_t*)take((size_t)T * 128 * 2 + 4096);
    p.nsa_ks = (bf16_t*)take((size_t)T * 128 * 2); p.nsa_vs = (bf16_t*)take((size_t)T * 128 * 2); p.nsa_kw = (bf16_t*)take((size_t)T * 128 * 2); p.nsa_vw = (bf16_t*)take((size_t)T * 128 * 2);
    p.nsa_gate = (float*)take((size_t)T * 24 * 4); p.nsa_kc = (float*)take((size_t)8 * 256 * 64 * 4); p.nsa_vc = (float*)take((size_t)8 * 256 * 64 * 4);
    p.nsa_sel = (unsigned long long*)take((size_t)8 * SEQ * 8);
    p.rw_r = (bf16_t*)take((size_t)T * 512 * 2); p.rw_k = (bf16_t*)take((size_t)T * 512 * 2); p.rw_v = (bf16_t*)take((size_t)T * 512 * 2); p.rw_g = (bf16_t*)take((size_t)T * 512 * 2);
    p.rw_w = (float*)take((size_t)T * 512 * 4); p.rw_kk = (float*)take((size_t)T * 512 * 4); p.rw_b = (float*)take((size_t)T * 512 * 4); p.rw_y = (float*)take((size_t)T * 512 * 4);
    p.gla_la = (float*)take((size_t)T * 256 * 4);
    p.mla_cqn = (bf16_t*)take((size_t)T * 384 * 2); p.mla_ckvn = (bf16_t*)take((size_t)T * 256 * 2); p.mla_kpe = (bf16_t*)take((size_t)T * 32 * 2);
    p.ys = (bf16_t*)take((size_t)4 * T * 512 * 2);
    p.mg = p.u;
    p.cW1t = (bf16_t*)take((size_t)2 * 256 * 2048 * 2); p.cW2t = (bf16_t*)take((size_t)2 * 256 * 256 * 2); p.chid = (bf16_t*)take((size_t)2 * 2048 * 256 * 2); p.cbias = (float*)take(2 * 256 * 4); p.rwWlT = (bf16_t*)take((size_t)512 * 256 * 2);
    if (off > ws_size) { fprintf(stderr, "kernel_launch: workspace too small: need %zu, have %zu\n", off, ws_size); return; }
    if (hipMemsetAsync(p.bar, 0, 16384, stream) != hipSuccess) { fprintf(stderr, "kernel_launch: memset failed\n"); return; }
#if defined(ONE_LAUNCH)
    hipLaunchKernelGGL(mega, dim3(grid), dim3(512), LDS_BYTES, stream, p, 0, N_PHASES);
#else
    for (int ph = 0; ph < N_PHASES; ++ph) hipLaunchKernelGGL(mega, dim3(grid), dim3(512), LDS_BYTES, stream, p, ph, ph + 1);
#endif
}
```

```cpp
#define ONE_LAUNCH 1
#include <hip/hip_runtime.h>
#include <stdint.h>
#include <stdio.h>

#define LAS __attribute__((address_space(3)))
#define DI __device__ __forceinline__
typedef unsigned short bf16_t;
typedef short bf16x8 __attribute__((ext_vector_type(8)));
typedef float f32x4 __attribute__((ext_vector_type(4)));
typedef float f32x2 __attribute__((ext_vector_type(2)));
typedef unsigned u32x4 __attribute__((ext_vector_type(4)));
typedef unsigned u32x2 __attribute__((ext_vector_type(2)));

constexpr int NB = 4, SEQ = 4096, T = NB * SEQ, D = 2048, DFF = 5632;
constexpr int NP1 = 5192, NP1P = 5376, NGATE = 8192, PROJ_IN = 13384;
constexpr int C_NSA_Q = 0, C_NSA_KC = 512, C_NSA_VC = 640, C_NSA_KS = 768, C_NSA_VS = 896, C_NSA_KW = 1024, C_NSA_VW = 1152, C_NSA_GL = 1280;
constexpr int C_RW = 1304, C_RW_R = 1304, C_RW_WLO = 1816, C_RW_K = 1880, C_RW_V = 2392, C_RW_ALO = 2904, C_RW_GLO = 2968;
constexpr int C_GLA_Q = 3096, C_GLA_K = 3352, C_GLA_V = 3608, C_GLA_ALO = 4120, C_GLA_R = 4136;
constexpr int C_MLA_CQ = 4648, C_MLA_CKV = 5032, C_MLA_KR = 5160;
constexpr float NORM_EPS = 1e-6f;

DI float bf2f(bf16_t v) { return __uint_as_float(((unsigned)v) << 16); }
DI bf16_t f2bf(float f) { unsigned u = __float_as_uint(f); u += 0x7FFFu + ((u >> 16) & 1u); return (bf16_t)(u >> 16); }
typedef __bf16 bf16x2_t_ __attribute__((ext_vector_type(2)));
DI unsigned pk2(float lo, float hi) { const f32x2 v = {lo, hi}; return __builtin_bit_cast(unsigned, __builtin_convertvector(v, bf16x2_t_)); }
DI float sigmoidf_(float x) { return 1.0f / (1.0f + __expf(-x)); }
DI float wsum(float v) {
#pragma unroll
    for (int o = 32; o >= 1; o >>= 1) v += __shfl_xor(v, o);
    return v;
}
DI float wmax(float v) {
#pragma unroll
    for (int o = 32; o >= 1; o >>= 1) v = fmaxf(v, __shfl_xor(v, o));
    return v;
}

DI int TIDX() { int t = (int)threadIdx.x; asm volatile("" : "+v"(t)); return t; }
DI int BIDX() { int t = __builtin_amdgcn_readfirstlane((int)blockIdx.x); asm volatile("" : "+s"(t)); return t; }
DI int NBLK() { int t = __builtin_amdgcn_readfirstlane((int)gridDim.x); asm volatile("" : "+s"(t)); return t; }

struct Params {
    const float *x, *c, *ada_w, *ada_b, *pre_g, *post_g, *ffn_wg, *ffn_wu, *ffn_wd, *mix_w_in, *mix_w_branch, *mix_w_out;
    const float *cmp_pos, *cmp_w1, *cmp_w2;
    const float *rw_mu, *rw_w0, *rw_w_w2, *rw_a0, *rw_a_w2, *rw_g_w2, *rw_k_k, *rw_k_a, *rw_r_k, *rw_ln_w, *rw_ln_b;
    const float *gla_w2, *gla_b, *gla_g;
    const float *mla_qn, *mla_wuq, *mla_kvn, *mla_wukv;
    float* out;
    unsigned* bar;
    float *mod, *cos64, *sin64, *cos32, *sin32;
    bf16_t *Wup0, *Wup1, *Wdn0, *Wdn1, *Win1, *Wg, *Wbr, *Wout, *Wuq, *Wukv;
    bf16_t *u, *P1, *G;
    float* y;
    bf16_t *nsa_q, *nsa_kc_in, *nsa_vc_in, *nsa_ks, *nsa_vs, *nsa_kw, *nsa_vw;
    float *nsa_gate, *nsa_kc, *nsa_vc, *nsa_ocmp;
    unsigned long long* nsa_sel;
    bf16_t *rw_r, *rw_k, *rw_v, *rw_g;
    float *rw_w, *rw_kk, *rw_b, *rw_y;
    float *gla_la, *gla_o;
    bf16_t *mla_cqn, *mla_ckvn, *mla_kpe, *mla_q, *mla_kv;
    bf16_t* ys;
    bf16_t* mg;
    bf16_t *cW1t, *cW2t, *chid;
    float* cbias;
    bf16_t* rwWlT;
};
typedef const __attribute__((address_space(4))) Params* KParamsPtr;
#define XB_TMO      128
#define XB_XCNT(j)  (256  + 64 * (j))
#define XB_XSUB(j)  (1280 + 64 * (j))
#define XB_XGEN(j)  (2304 + 64 * (j))
#define XB_TOP      3328
#define XB_TOPGEN   3392
#define XCD_BAR_WORDS 3456
#define XB_SPIN_CAP (1u << 18)

__device__ __forceinline__ unsigned xb_ld(unsigned* p)              { return __hip_atomic_load(p, __ATOMIC_RELAXED, __HIP_MEMORY_SCOPE_AGENT); }
__device__ __forceinline__ unsigned xb_add(unsigned* p, unsigned v) { return __hip_atomic_fetch_add(p, v, __ATOMIC_RELAXED, __HIP_MEMORY_SCOPE_AGENT); }
__device__ __forceinline__ unsigned xb_xcc_id() { return (unsigned)__builtin_amdgcn_s_getreg((3 << 11) | 20) & 0xFu; }
#define XB_SPIN(cond, bar) do { unsigned _sp = 0; while (cond) { __builtin_amdgcn_s_sleep(1); \
    if ((++_sp & 255u) == 0u) { if (xb_ld(&(bar)[XB_TMO])) break; if (_sp > XB_SPIN_CAP) { atomicAdd(&(bar)[XB_TMO], 1u); break; } } } } while (0)

struct XcdBarrier {
    unsigned* bar; unsigned x;
    volatile LAS unsigned* st;
};

__device__ __forceinline__ XcdBarrier xcd_barrier_post(unsigned* bar, volatile LAS unsigned* st) {
    XcdBarrier b; b.bar = bar; b.x = xb_xcc_id(); b.st = st;
    if (threadIdx.x == 0) (void)xb_add(&bar[XB_XCNT(b.x)], 1u);
    return b;
}
__device__ __forceinline__ void xcd_barrier_complete(unsigned* bar, unsigned x, unsigned& nloc, unsigned& nx) {
    const unsigned G = gridDim.x * gridDim.y * gridDim.z;
    unsigned sum, cnt, mine, sp = 0u;
    for (;;) {
        sum = 0u; cnt = 0u; mine = 0u;
#pragma unroll
        for (unsigned j = 0; j < 16; ++j) { const unsigned c = xb_ld(&bar[XB_XCNT(j)]); sum += c; cnt += (c > 0u) ? 1u : 0u; mine = (j == x) ? c : mine; }
        if (sum == G) break;
        __builtin_amdgcn_s_sleep(1);
        if ((++sp & 255u) == 0u) { if (xb_ld(&bar[XB_TMO])) break; if (sp > XB_SPIN_CAP) { atomicAdd(&bar[XB_TMO], 1u); break; } }
    }
    nloc = mine > 0u ? mine : 1u; nx = cnt > 0u ? cnt : 1u;
}

__device__ __forceinline__ void xcd_barrier(const XcdBarrier& b) {
    asm volatile("s_waitcnt vmcnt(0)" ::: "memory");
    __syncthreads();
    if (threadIdx.x == 0) {
        unsigned* bar = b.bar;
        __builtin_amdgcn_s_waitcnt(0);
        unsigned nloc = b.st[0], nx = b.st[1];
        if (nloc == 0u) { xcd_barrier_complete(bar, b.x, nloc, nx); b.st[0] = nloc; b.st[1] = nx; }
        const unsigned old = xb_add(&bar[XB_XSUB(b.x)], 1u);
        const unsigned gen = old / nloc;
        if (old + 1u == (gen + 1u) * nloc) {
            __builtin_amdgcn_fence(__ATOMIC_RELEASE, "agent");
            asm volatile("s_waitcnt vmcnt(0)" ::: "memory");
            const unsigned og = xb_add(&bar[XB_TOP], 1u);
            const unsigned tg = og / nx;
            if (og + 1u == (tg + 1u) * nx) xb_add(&bar[XB_TOPGEN], 1u);
            else XB_SPIN(xb_ld(&bar[XB_TOPGEN]) == tg, bar);
            __builtin_amdgcn_fence(__ATOMIC_ACQUIRE, "agent");
            xb_add(&bar[XB_XGEN(b.x)], 1u);
            asm volatile("s_waitcnt vmcnt(0)" ::: "memory");
        } else {
            XB_SPIN(xb_ld(&bar[XB_XGEN(b.x)]) == gen, bar);
            __builtin_amdgcn_fence(__ATOMIC_ACQUIRE, "agent");
            asm volatile("s_waitcnt vmcnt(0)" ::: "memory");
        }
    }
    __syncthreads();
}

namespace pg8 {
#define PG8_LAS __attribute__((address_space(3)))
constexpr int BM = 256, BK = 64, HALF = 128, HTB = HALF * BK * 2  , STAGE_BYTES = 8 * HTB, NXCD = 8, WGM = 8;

__host__ __device__ __forceinline__ int lds_byte(int r, int c) { const int st = (r >> 4) * 2 + (c >> 5), rr = r & 15, cc = c & 31, ob = rr * 64 + cc * 2; return st * 1024 + (ob ^ (((ob >> 9) & 1) << 5)); }
__host__ __device__ __forceinline__ void stage_rc(int b, int& R, int& C) { const int st = b / 1024, sb = b % 1024, swz = sb ^ (((sb >> 9) & 1) << 5); R = (st >> 1) * 16 + swz / 64; C = (st & 1) * 32 + (swz % 64) / 2; }
__host__ __device__ __forceinline__ int perm32(int rho) { const int n = rho >> 4, i = rho & 15; return 8 * (i >> 2) + 4 * n + (i & 3); }

struct Unit { int pm, pn; };
struct Gemm { const bf16_t* A; const bf16_t* Bt; int M, N, K, lda, ldb; };

struct StaticOrder {
    int nM, nN, nwg, G, c;
    __host__ __device__ void init(int M, int N, int G_, int c_) { nM = M / BM; nN = N / BM; nwg = nM * nN; G = G_; c = c_; }
    __host__ __device__ bool next(int i, Unit& u) const {
        const long L = (long)i * G + c; if (L >= nwg) return false;
        int wgid = (int)L; { const int q = nwg / NXCD, r = nwg % NXCD, xcd = wgid % NXCD, off = wgid / NXCD; wgid = (xcd < r ? xcd * (q + 1) : r * (q + 1) + (xcd - r) * q) + off; }
        const int nig = WGM * nN, gid = wgid / nig, fm = gid * WGM, gsz = (nM - fm) < WGM ? (nM - fm) : WGM;
        u.pm = fm + ((wgid % nig) % gsz); u.pn = (wgid % nig) / gsz; return true;
    }
    __device__ __forceinline__ void a_ready(const Unit&) const {}
    __device__ __forceinline__ void done(const Unit&) const {}
};
struct CountedOrder : StaticOrder {
    const unsigned* ready; unsigned need; unsigned* tmo;
    __device__ __forceinline__ void a_ready(const Unit& u) const {
        if (TIDX() < 64) {
            const unsigned long long t0 = __builtin_amdgcn_s_memrealtime(); unsigned polls = 0;
            while ((unsigned)__builtin_amdgcn_readfirstlane(__hip_atomic_load(ready + 64 * u.pm, __ATOMIC_RELAXED, __HIP_MEMORY_SCOPE_AGENT)) < need) {
                if ((++polls & 255u) == 0u && __builtin_amdgcn_readfirstlane(__hip_atomic_load(tmo, __ATOMIC_RELAXED, __HIP_MEMORY_SCOPE_AGENT)) != 0u) break;
                if (__builtin_amdgcn_s_memrealtime() - t0 > 2000000ull) {
                    if (TIDX() == 0) { unsigned expect = 0u; __hip_atomic_compare_exchange_strong(tmo + 1, &expect, 0x600u | (unsigned)(u.pm & 0xff), __ATOMIC_RELAXED, __ATOMIC_RELAXED, __HIP_MEMORY_SCOPE_AGENT); __hip_atomic_store(tmo, 1u, __ATOMIC_RELAXED, __HIP_MEMORY_SCOPE_AGENT); }
                    break; }
                __builtin_amdgcn_s_sleep(2); }
            __builtin_amdgcn_fence(__ATOMIC_ACQUIRE, "agent");
            asm volatile("s_waitcnt vmcnt(0)" ::: "memory");
        }
#if !defined(BROKEN_HOOK_NO_BARRIER)
        asm volatile("" ::: "memory"); __builtin_amdgcn_s_barrier(); asm volatile("" ::: "memory");
#endif
    }
};


template <class Epi, class Sched, bool STAMP = false>
__device__ __forceinline__ void gemm_phase(PG8_LAS unsigned char* lds, const Gemm g, const Sched& S, const Epi& E, unsigned long long* stamps) {
    const int tid = TIDX(), wid = __builtin_amdgcn_readfirstlane(tid >> 6), lane = tid & 63, wr = wid >> 2, wc = wid & 3, fr = lane & 15, fq = lane >> 4;
    const int K = g.K, nt = K / BK;
    int ts_lo = 0, ts_hi = 0, nts = 0; const unsigned long long rt_entry = STAMP ? (unsigned long long)wall_clock64() : 0ull;
#define PG8_STAMP() do { if (STAMP && wid == 0 && nts < 64) { const unsigned long long _c = (unsigned long long)clock64(); \
        ts_lo = (lane == nts) ? (int)(unsigned)_c : ts_lo; ts_hi = (lane == nts) ? (int)(unsigned)(_c >> 32) : ts_hi; ++nts; } } while (0)
    PG8_STAMP();
    unsigned voffA[2], voffB[2];
#pragma unroll
    for (int i = 0; i < 2; ++i) { int R, C; stage_rc(tid * 16 + i * 8192, R, C); const int Rb = Epi::PERM ? ((R & ~31) + perm32(R & 31)) : R;
        voffA[i] = (unsigned)(R * g.lda + C) * 2u; voffB[i] = (unsigned)(Rb * g.ldb + C) * 2u; }
    const size_t kstep = (size_t)(BK * 2);
    const size_t hstepA = (size_t)HALF * g.lda * 2, hstepB = (size_t)HALF * g.ldb * 2;
    const size_t tstepA = 2 * hstepA, tstepB = 2 * hstepB;
    const unsigned ldsw = (unsigned)wid * 1024u;
    const int aoff = lds_byte(wr * 64 + fr, fq * 8), boff = lds_byte(wc * 32 + fr, fq * 8);
#define PG8_SA(b, h) (((b) * 2 + (h)) * HTB)
#define PG8_SB(b, h) ((4 + (b) * 2 + (h)) * HTB)
#define PG8_STAGE(bufoff, gbase, voff) do { _Pragma("unroll") for (int _i = 0; _i < 2; ++_i) \
        __builtin_amdgcn_global_load_lds((const unsigned*)((const char*)(gbase) + (voff)[_i]), (PG8_LAS unsigned*)(lds + (bufoff) + ldsw + _i * 8192), 16, 0, 0); } while (0)
#define PG8_LDA(dst, b, h) do { _Pragma("unroll") for (int m = 0; m < 4; ++m) _Pragma("unroll") for (int k = 0; k < 2; ++k) dst[m][k] = *(const PG8_LAS bf16x8*)(lds + PG8_SA(b, h) + aoff + m * 2048 + k * 1024); } while (0)
#define PG8_LDB(dst, b, h) do { _Pragma("unroll") for (int n = 0; n < 2; ++n) _Pragma("unroll") for (int k = 0; k < 2; ++k) dst[n][k] = *(const PG8_LAS bf16x8*)(lds + PG8_SB(b, h) + boff + n * 2048 + k * 1024); } while (0)
#define PG8_MMA(ai, bj, At, Bt) do { __builtin_amdgcn_s_setprio(1); _Pragma("unroll") for (int m = 0; m < 4; ++m) _Pragma("unroll") for (int n = 0; n < 2; ++n) _Pragma("unroll") for (int k = 0; k < 2; ++k) \
        acc[ai][bj][m][n] = __builtin_amdgcn_mfma_f32_16x16x32_bf16(Bt[n][k], At[m][k], acc[ai][bj][m][n], 0, 0, 0); __builtin_amdgcn_s_setprio(0); } while (0)
#define PG8_WAIT_V(n) asm volatile("s_waitcnt vmcnt(" #n ")" ::: "memory")
#define PG8_WAIT_L(n) asm volatile("s_waitcnt lgkmcnt(" #n ")" ::: "memory")
#define PG8_BAR __builtin_amdgcn_s_barrier()
#define PG8_SCHED __builtin_amdgcn_sched_barrier(0)
    Unit cur, nxt; int ui = 0;
    if (!S.next(0, cur)) return;
    f32x4 acc[2][2][4][2];
#pragma unroll
    for (int a = 0; a < 2; ++a)
#pragma unroll
        for (int b = 0; b < 2; ++b)
#pragma unroll
            for (int m = 0; m < 4; ++m)
#pragma unroll
                for (int n = 0; n < 2; ++n) acc[a][b][m][n] = (f32x4){0.f, 0.f, 0.f, 0.f};
    bf16x8 At[4][2], B0[2][2], B1[2][2];
    const char* cA = (const char*)g.A + (size_t)cur.pm * tstepA; const char* cB = (const char*)g.Bt + (size_t)cur.pn * tstepB;
    S.a_ready(cur);
    PG8_STAGE(PG8_SB(0, 0), cB, voffB); PG8_STAGE(PG8_SA(0, 0), cA, voffA); PG8_STAGE(PG8_SB(0, 1), cB + hstepB, voffB); PG8_STAGE(PG8_SA(0, 1), cA + hstepA, voffA);
    if (wr == 1) PG8_BAR;
    PG8_WAIT_V(4); PG8_BAR;
    PG8_STAGE(PG8_SB(1, 0), cB + kstep, voffB); PG8_STAGE(PG8_SA(1, 0), cA + kstep, voffA); PG8_STAGE(PG8_SB(1, 1), cB + hstepB + kstep, voffB);
    PG8_WAIT_V(6); PG8_BAR;
    PG8_STAMP();
    for (;;) {
        const bool has_next = S.next(ui + 1, nxt);
        const char* nA = has_next ? (const char*)g.A + (size_t)nxt.pm * tstepA : cA; const char* nB = has_next ? (const char*)g.Bt + (size_t)nxt.pn * tstepB : cB;
        for (int t = 0; t < nt; t += 2) {
            const bool last = (t == nt - 2);
            const char* a1 = cA + (size_t)(t + 1) * kstep;
            const char* a2 = last ? nA : cA + (size_t)(t + 2) * kstep; const char* b2 = last ? nB : cB + (size_t)(t + 2) * kstep;
            const char* a3 = a2 + kstep; const char* b3 = b2 + kstep;
            if (last && has_next) S.a_ready(nxt);
            PG8_LDB(B0, 0, 0); PG8_SCHED; PG8_LDA(At, 0, 0); PG8_STAGE(PG8_SA(1, 1), a1 + hstepA, voffA);
            PG8_WAIT_L(8); PG8_BAR; PG8_WAIT_L(0); PG8_MMA(0, 0, At, B0); PG8_BAR; PG8_SCHED;
            PG8_LDB(B1, 0, 1); PG8_STAGE(PG8_SB(0, 0), b2, voffB);
            PG8_BAR; PG8_WAIT_L(0); PG8_MMA(0, 1, At, B1); PG8_BAR;
            PG8_LDA(At, 0, 1); PG8_STAGE(PG8_SA(0, 0), a2, voffA);
            PG8_BAR; PG8_WAIT_L(0); PG8_MMA(1, 0, At, B0); PG8_BAR; PG8_SCHED;
            PG8_STAGE(PG8_SB(0, 1), b2 + hstepB, voffB);
            PG8_WAIT_V(6); PG8_BAR; PG8_MMA(1, 1, At, B1); PG8_BAR;
            PG8_LDB(B0, 1, 0); PG8_SCHED; PG8_LDA(At, 1, 0); PG8_STAGE(PG8_SA(0, 1), a2 + hstepA, voffA);
            PG8_WAIT_L(8); PG8_BAR; PG8_WAIT_L(0); PG8_MMA(0, 0, At, B0); PG8_BAR; PG8_SCHED;
            PG8_LDB(B1, 1, 1); PG8_STAGE(PG8_SB(1, 0), b3, voffB);
            PG8_BAR; PG8_WAIT_L(0); PG8_MMA(0, 1, At, B1); PG8_BAR;
            PG8_LDA(At, 1, 1); PG8_STAGE(PG8_SA(1, 0), a3, voffA);
            PG8_BAR; PG8_WAIT_L(0); PG8_MMA(1, 0, At, B0); PG8_BAR; PG8_SCHED;
            PG8_STAGE(PG8_SB(1, 1), b3 + hstepB, voffB);
            PG8_WAIT_V(6); PG8_BAR; PG8_MMA(1, 1, At, B1); PG8_BAR;
        }
        PG8_STAMP();
        if constexpr (!Epi::AFTER_DRAIN) { E(acc, cur, wr, wc, fr, fq); S.done(cur); }
        PG8_STAMP();
        if (!has_next) break;
#pragma unroll
        for (int a = 0; a < 2; ++a)
#pragma unroll
            for (int b = 0; b < 2; ++b)
#pragma unroll
                for (int m = 0; m < 4; ++m)
#pragma unroll
                    for (int n = 0; n < 2; ++n) acc[a][b][m][n] = (f32x4){0.f, 0.f, 0.f, 0.f};
        cur = nxt; cA = nA; cB = nB; ++ui;
    }
    PG8_WAIT_V(0);
    if (wr == 0) PG8_BAR;
    PG8_BAR;
    if constexpr (Epi::AFTER_DRAIN) { E.fused(acc, cur, wr, wc, fr, fq, lds, wid, lane); S.done(cur); }
    PG8_STAMP();
    if (STAMP && wid == 0) { stamps[lane] = lane < nts ? (((unsigned long long)(unsigned)ts_hi << 32) | (unsigned)ts_lo) : 0ull;
        if (lane == 62) stamps[62] = rt_entry; if (lane == 63) stamps[63] = (unsigned long long)wall_clock64(); }
#undef PG8_STAMP
#undef PG8_SA
#undef PG8_SB
#undef PG8_STAGE
#undef PG8_LDA
#undef PG8_LDB
#undef PG8_MMA
#undef PG8_WAIT_V
#undef PG8_WAIT_L
#undef PG8_BAR
#undef PG8_SCHED
}
}
typedef __bf16 bf16x2_n __attribute__((ext_vector_type(2)));
DI unsigned cvt_pk_bf16(float lo, float hi) { const f32x2 v = {lo, hi}; return __builtin_bit_cast(unsigned, __builtin_convertvector(v, bf16x2_n)); }
DI float fast_sigmoid(float x) { return __builtin_amdgcn_rcpf(1.0f + __expf(-x)); }

struct EpiF32 {
    static constexpr bool PERM = false, AFTER_DRAIN = false;
    float* C; int ldc;
    DI void operator()(const f32x4 (&acc)[2][2][4][2], const pg8::Unit& u, int wr, int wc, int fr, int fq) const {
        const int row0 = u.pm * 256 + wr * 64 + fr, col0 = u.pn * 256 + wc * 32 + 4 * fq;
#pragma unroll
        for (int ai = 0; ai < 2; ++ai)
#pragma unroll
            for (int m = 0; m < 4; ++m) { float* rowp = C + (size_t)(row0 + ai * 128 + m * 16) * ldc + col0;
#pragma unroll
                for (int bj = 0; bj < 2; ++bj)
#pragma unroll
                    for (int n = 0; n < 2; ++n) *(f32x4*)(rowp + bj * 128 + n * 16) = acc[ai][bj][m][n]; }
    }
};
struct EpiF32Lo {
    static constexpr bool PERM = false, AFTER_DRAIN = false;
    float* C; int ldc;
    DI void operator()(const f32x4 (&acc)[2][2][4][2], const pg8::Unit& u, int wr, int wc, int fr, int fq) const {
        const int row0 = u.pm * 256 + wr * 64 + fr, col0 = u.pn * 256 + wc * 32 + 4 * fq;
#pragma unroll
        for (int ai = 0; ai < 2; ++ai)
#pragma unroll
            for (int m = 0; m < 4; ++m) { float* rowp = C + (size_t)(row0 + ai * 128 + m * 16) * ldc + col0;
#pragma unroll
                for (int n = 0; n < 2; ++n) *(f32x4*)(rowp + n * 16) = acc[ai][0][m][n]; }
    }
};
template <int ACT  > struct EpiBf16 {
    static constexpr bool PERM = true, AFTER_DRAIN = false;
    bf16_t* O; int ldc;
    DI void operator()(const f32x4 (&acc)[2][2][4][2], const pg8::Unit& u, int wr, int wc, int fr, int fq) const {
        const int row0 = u.pm * 256 + wr * 64 + fr, col0 = u.pn * 256 + wc * 32 + 8 * fq;
#pragma unroll
        for (int ai = 0; ai < 2; ++ai)
#pragma unroll
            for (int m = 0; m < 4; ++m) { bf16_t* rowp = O + (size_t)(row0 + ai * 128 + m * 16) * ldc + col0;
#pragma unroll
                for (int bj = 0; bj < 2; ++bj) { f32x4 v0 = acc[ai][bj][m][0], v1 = acc[ai][bj][m][1];
#if defined(NOISE_P1)
                    if (ACT == 0) { unsigned hsh = (unsigned)(row0 + ai * 128 + m * 16) * 2654435761u ^ (unsigned)(col0 + bj * 128) * 40503u;
#pragma unroll
                        for (int j = 0; j < 4; ++j) { hsh = hsh * 1664525u + 1013904223u; v0[j] *= 1.0f + NOISE_P1 * ((float)(hsh >> 8) * (1.0f / 8388608.0f) - 1.0f); hsh = hsh * 1664525u + 1013904223u; v1[j] *= 1.0f + NOISE_P1 * ((float)(hsh >> 8) * (1.0f / 8388608.0f) - 1.0f); } }
#endif
                    if (ACT == 1) {
#pragma unroll
                        for (int j = 0; j < 4; ++j) { v0[j] = fast_sigmoid(v0[j]); v1[j] = fast_sigmoid(v1[j]); } }
                    u32x4 w; w.x = cvt_pk_bf16(v0[0], v0[1]); w.y = cvt_pk_bf16(v0[2], v0[3]); w.z = cvt_pk_bf16(v1[0], v1[1]); w.w = cvt_pk_bf16(v1[2], v1[3]);
                    __builtin_nontemporal_store(w, (u32x4*)(rowp + bj * 128)); } }
    }
};
struct EpiSwiglu {
    static constexpr bool PERM = true, AFTER_DRAIN = false;
    bf16_t* H; int ldc;
    DI void operator()(const f32x4 (&acc)[2][2][4][2], const pg8::Unit& u, int wr, int wc, int fr, int fq) const {
        const int row0 = u.pm * 256 + wr * 64 + fr, col0 = u.pn * 128 + wc * 32 + 8 * fq;
#pragma unroll
        for (int ai = 0; ai < 2; ++ai)
#pragma unroll
            for (int m = 0; m < 4; ++m) { bf16_t* rowp = H + (size_t)(row0 + ai * 128 + m * 16) * ldc + col0;
                float h[8];
#pragma unroll
                for (int n = 0; n < 2; ++n)
#pragma unroll
                    for (int j = 0; j < 4; ++j) { const float g = acc[ai][0][m][n][j], up = acc[ai][1][m][n][j]; h[n * 4 + j] = g * fast_sigmoid(g) * up; }
                u32x4 w; w.x = cvt_pk_bf16(h[0], h[1]); w.y = cvt_pk_bf16(h[2], h[3]); w.z = cvt_pk_bf16(h[4], h[5]); w.w = cvt_pk_bf16(h[6], h[7]);
                __builtin_nontemporal_store(w, (u32x4*)rowp); }
    }
};
struct EpiPart {
    static constexpr bool PERM = true, AFTER_DRAIN = false;
    bf16_t* part01; bf16_t* part23;
    DI void operator()(const f32x4 (&acc)[2][2][4][2], const pg8::Unit& u, int wr, int wc, int fr, int fq) const {
        const int br = u.pm >> 6, pm = u.pm & 63, pn = u.pn & 7;
        bf16_t* O = (br < 2 ? part01 : part23) + (size_t)(br & 1) * T * 2048;
        const int row0 = pm * 256 + wr * 64 + fr, col0 = pn * 256 + wc * 32 + 8 * fq;
#pragma unroll
        for (int ai = 0; ai < 2; ++ai)
#pragma unroll
            for (int m = 0; m < 4; ++m) { bf16_t* rowp = O + (size_t)(row0 + ai * 128 + m * 16) * 2048 + col0;
#pragma unroll
                for (int bj = 0; bj < 2; ++bj) { const f32x4 v0 = acc[ai][bj][m][0], v1 = acc[ai][bj][m][1];
                    u32x4 w; w.x = cvt_pk_bf16(v0[0], v0[1]); w.y = cvt_pk_bf16(v0[2], v0[3]); w.z = cvt_pk_bf16(v1[0], v1[1]); w.w = cvt_pk_bf16(v1[2], v1[3]);
                    *(u32x4*)(rowp + bj * 128) = w; } }
    }
};
struct EpiMergeAcc {
    static constexpr bool PERM = true, AFTER_DRAIN = false;
    const bf16_t* G; bf16_t* O;
    DI void operator()(const f32x4 (&acc)[2][2][4][2], const pg8::Unit& u, int wr, int wc, int fr, int fq) const {
        const int br = u.pm >> 6, pm = u.pm & 63, pn = u.pn & 7;
        const int row0 = pm * 256 + wr * 64 + fr, col0 = pn * 256 + wc * 32 + 8 * fq;
#pragma unroll
        for (int ai = 0; ai < 2; ++ai) {
            u32x4 gw[4][2], ow[4][2];
#pragma unroll
            for (int m = 0; m < 4; ++m) { const size_t row = (size_t)(row0 + ai * 128 + m * 16);
#pragma unroll
                for (int bj = 0; bj < 2; ++bj) { gw[m][bj] = *(const u32x4*)(G + row * NGATE + br * 2048 + col0 + bj * 128);
                    ow[m][bj] = br > 0 ? *(const u32x4*)(O + row * 2048 + col0 + bj * 128) : (u32x4){0u, 0u, 0u, 0u}; } }
#pragma unroll
            for (int m = 0; m < 4; ++m) { bf16_t* op = O + (size_t)(row0 + ai * 128 + m * 16) * 2048 + col0;
#pragma unroll
                for (int bj = 0; bj < 2; ++bj) { const f32x4 v0 = acc[ai][bj][m][0], v1 = acc[ai][bj][m][1]; const u32x4 g = gw[m][bj], o = ow[m][bj];
                    float r[8];
                    r[0] = __uint_as_float(g.x << 16) * v0[0] + __uint_as_float(o.x << 16); r[1] = __uint_as_float(g.x & 0xffff0000u) * v0[1] + __uint_as_float(o.x & 0xffff0000u);
                    r[2] = __uint_as_float(g.y << 16) * v0[2] + __uint_as_float(o.y << 16); r[3] = __uint_as_float(g.y & 0xffff0000u) * v0[3] + __uint_as_float(o.y & 0xffff0000u);
                    r[4] = __uint_as_float(g.z << 16) * v1[0] + __uint_as_float(o.z << 16); r[5] = __uint_as_float(g.z & 0xffff0000u) * v1[1] + __uint_as_float(o.z & 0xffff0000u);
                    r[6] = __uint_as_float(g.w << 16) * v1[2] + __uint_as_float(o.w << 16); r[7] = __uint_as_float(g.w & 0xffff0000u) * v1[3] + __uint_as_float(o.w & 0xffff0000u);
                    u32x4 w; w.x = cvt_pk_bf16(r[0], r[1]); w.y = cvt_pk_bf16(r[2], r[3]); w.z = cvt_pk_bf16(r[4], r[5]); w.w = cvt_pk_bf16(r[6], r[7]);
                    *(u32x4*)(op + bj * 128) = w; } }
        }
    }
};
struct MergeOrder {
    int G, c;
    DI bool next(int i, pg8::Unit& u) const {
        const int ti = i >> 2, br = i & 3; const int tile = ti * G + c; if (tile >= 512) return false;
        int tm = tile >> 3, tn = tile & 7;
        if (G == 256) { const int x = c & 7, r = c >> 3; tm = ti * 32 + x * 4 + (r >> 3); tn = r & 7; }
        u.pm = br * 64 + tm; u.pn = br * 8 + tn; return true;
    }
    DI void a_ready(const pg8::Unit&) const {}
    DI void done(const pg8::Unit&) const {}
};

struct EpiGeluBias {
    static constexpr bool PERM = true, AFTER_DRAIN = false;
    bf16_t* O; int ldc; const float* bias;
    DI void operator()(const f32x4 (&acc)[2][2][4][2], const pg8::Unit& u, int wr, int wc, int fr, int fq) const {
        const int row0 = u.pm * 256 + wr * 64 + fr, col0 = u.pn * 256 + wc * 32 + 8 * fq;
#pragma unroll
        for (int ai = 0; ai < 2; ++ai)
#pragma unroll
            for (int m = 0; m < 4; ++m) { bf16_t* rowp = O + (size_t)(row0 + ai * 128 + m * 16) * ldc + col0;
#pragma unroll
                for (int bj = 0; bj < 2; ++bj) { float h[8];
#pragma unroll
                    for (int n = 0; n < 2; ++n)
#pragma unroll
                        for (int j = 0; j < 4; ++j) { const float x = acc[ai][bj][m][n][j] + bias[col0 + bj * 128 + n * 4 + j];
                            const float z = 0.7978845608028654f * (x + 0.044715f * x * x * x), th = 1.0f - 2.0f * __builtin_amdgcn_rcpf(1.0f + __expf(2.0f * z));
                            h[n * 4 + j] = 0.5f * x * (1.0f + th); }
                    u32x4 w; w.x = cvt_pk_bf16(h[0], h[1]); w.y = cvt_pk_bf16(h[2], h[3]); w.z = cvt_pk_bf16(h[4], h[5]); w.w = cvt_pk_bf16(h[6], h[7]);
                    *(u32x4*)(rowp + bj * 128) = w; } }
    }
};
struct EpiCmpOut {
    static constexpr bool PERM = false, AFTER_DRAIN = false;
    float* C;
    DI void operator()(const f32x4 (&acc)[2][2][4][2], const pg8::Unit& u, int wr, int wc, int fr, int fq) const {
        if (wc >= 2) return;
        const int row0 = u.pm * 256 + wr * 64 + fr, col0 = wc * 32 + 4 * fq;
#pragma unroll
        for (int ai = 0; ai < 2; ++ai)
#pragma unroll
            for (int m = 0; m < 4; ++m) { float* rowp = C + (size_t)(row0 + ai * 128 + m * 16) * 64 + col0;
#pragma unroll
                for (int n = 0; n < 2; ++n) *(f32x4*)(rowp + n * 16) = acc[ai][0][m][n]; }
    }
};
struct SplitOrder {
    int first, count, nN;
    DI bool next(int i, pg8::Unit& u) const { if (i >= count) return false; const int idx = first + i; u.pm = idx / nN; u.pn = idx % nN; return true; }
    DI void a_ready(const pg8::Unit&) const {}
    DI void done(const pg8::Unit&) const {}
};
struct RowWalkOrder {
    int pm, pn0, step, count;
    DI bool next(int i, pg8::Unit& u) const { if (i >= count) return false; u.pm = pm; u.pn = pn0 + i * step; return true; }
    DI void a_ready(const pg8::Unit&) const {}
    DI void done(const pg8::Unit&) const {}
};
template <class Epi>
DI void run_gemm(LAS unsigned char* lds, const bf16_t* A, int lda, const bf16_t* Bt, int ldb, int M, int N, int K, const Epi& E) {
    pg8::Gemm g; g.A = A; g.Bt = Bt; g.M = M; g.N = N; g.K = K; g.lda = lda; g.ldb = ldb;
    pg8::StaticOrder S; S.init(M, N, NBLK(), BIDX());
    pg8::gemm_phase<Epi, pg8::StaticOrder, false>((PG8_LAS unsigned char*)lds, g, S, E, nullptr);
}
#ifndef PREP_R1
#define PREP_R1 1
#endif
#ifndef PREP_R2
#define PREP_R2 1
#endif
#ifndef PREP_R3
#define PREP_R3 1
#endif
#ifndef PREP_R4
#define PREP_R4 1
#endif
#ifndef ZRWKV
#define ZRWKV 1.0f
#endif
#ifndef ZGLA
#define ZGLA 1.0f
#endif
DI void phase_setup(KParamsPtr p, LAS unsigned char* lds) {
    const int tid = TIDX(), bid = BIDX(), nb = NBLK();
    for (int i = bid * 512 + tid; i < SEQ * 48; i += nb * 512) {
        const int pos = i / 48, j = i % 48;
        const bool big = j < 32; const int jj = big ? j : j - 32;
        const double inv = exp2(-(double)jj * (13.287712379549449 / (big ? 32.0 : 16.0)));
        const double a = (double)pos * inv;
        const double r = a - 6.283185307179586 * floor(a / 6.283185307179586);
        const float cs = (float)cos(r), sn = (float)sin(r);
        if (big) { p->cos64[pos * 32 + jj] = cs; p->sin64[pos * 32 + jj] = sn; } else { p->cos32[pos * 16 + jj] = cs; p->sin32[pos * 16 + jj] = sn; }
    }
    LAS float* sc = (LAS float*)lds;
    LAS float* red = (LAS float*)(lds + 32768);
    for (int i = tid; i < NB * D; i += 512) { const float c = p->c[i]; sc[i] = c / (1.0f + __expf(-c)); }
    __syncthreads();
    const int cg = tid & 15, ks = tid >> 4;
    for (int chunk = bid; chunk < 576; chunk += nb) {
        const int ls = chunk / 96, col0 = (chunk % 96) * 64;
        const float* W = p->ada_w + (size_t)ls * D * 6144 + col0 + cg * 4;
        float acc[4][4];
#pragma unroll
        for (int b = 0; b < 4; ++b)
#pragma unroll
            for (int j = 0; j < 4; ++j) acc[b][j] = 0.f;
#pragma unroll 16
        for (int kk = 0; kk < 64; ++kk) {
            const int k = ks * 64 + kk;
            const f32x4 w = *(const f32x4*)(W + (size_t)k * 6144);
#pragma unroll
            for (int b = 0; b < 4; ++b) { const float s = sc[b * D + k];
#pragma unroll
                for (int j = 0; j < 4; ++j) acc[b][j] += s * w[j]; }
        }
#pragma unroll
        for (int b = 0; b < 4; ++b)
#pragma unroll
            for (int j = 0; j < 4; ++j) red[(ks * 4 + b) * 64 + cg * 4 + j] = acc[b][j];
        __syncthreads();
        if (tid < 256) { const int b = tid >> 6, col = tid & 63; float s = 0.f;
            for (int q = 0; q < 32; ++q) s += red[(q * 4 + b) * 64 + col];
            p->mod[(size_t)(ls * 4 + b) * 6144 + col0 + col] = s + p->ada_b[ls * 6144 + col0 + col]; }
        __syncthreads();
    }
}

template <class Map>
DI void conv_job(const float* src, int Ks, int Ns, const float* kscale, bf16_t* dst, int ldd, Map map, LAS float* tl) {
    const int tid = TIDX(), bid = BIDX(), nb = NBLK();
    const int ntk = Ks / 64, ntn = (Ns + 63) / 64, nt = ntk * ntn;
    for (int tile = bid; tile < nt; tile += nb) {
        const int k0 = (tile % ntk) * 64, n0 = (tile / ntk) * 64;
#pragma unroll
        for (int it = 0; it < 2; ++it) {
            const int kr = (tid >> 4) + 32 * it, n = n0 + 4 * (tid & 15);
            f32x4 v = (f32x4){0.f, 0.f, 0.f, 0.f};
            if (n < Ns) v = *(const f32x4*)(src + (size_t)(k0 + kr) * Ns + n);
            if (kscale) v *= kscale[k0 + kr];
#pragma unroll
            for (int j = 0; j < 4; ++j) tl[kr * 65 + 4 * (tid & 15) + j] = v[j];
        }
        __syncthreads();
        { const int nn = tid >> 3, k8 = tid & 7, n = n0 + nn;
            if (n < Ns) { float f[8];
#pragma unroll
                for (int i = 0; i < 8; ++i) f[i] = tl[(k8 * 8 + i) * 65 + nn];
                u32x4 w; w.x = pk2(f[0], f[1]); w.y = pk2(f[2], f[3]); w.z = pk2(f[4], f[5]); w.w = pk2(f[6], f[7]);
                *(u32x4*)(dst + (size_t)map(n) * ldd + k0 + k8 * 8) = w; } }
        __syncthreads();
    }
}
DI void phase_convert(KParamsPtr p, int l, LAS unsigned char* lds) {
    LAS float* tl = (LAS float*)lds;
    const int tid = TIDX(), bid = BIDX(), nb = NBLK();
    const size_t fsz = (size_t)D * DFF;
    for (int f = 0; f < 2; ++f) {
        bf16_t* Wup = f ? p->Wup1 : p->Wup0; bf16_t* Wdn = f ? p->Wdn1 : p->Wdn0;
        conv_job(p->ffn_wg + (size_t)(l * 2 + f) * fsz, D, DFF, nullptr, Wup, D, [](int n) { return 256 * (n >> 7) + (n & 127); }, tl);
        conv_job(p->ffn_wu + (size_t)(l * 2 + f) * fsz, D, DFF, nullptr, Wup, D, [](int n) { return 256 * (n >> 7) + 128 + (n & 127); }, tl);
        conv_job(p->ffn_wd + (size_t)(l * 2 + f) * fsz, DFF, D, nullptr, Wdn, DFF, [](int n) { return n; }, tl);
    }
    conv_job(p->mix_w_in + (size_t)l * D * PROJ_IN, D, PROJ_IN, nullptr, p->Win1, D, [](int n) { return n < NP1 ? n : n - NP1 + NP1P; }, tl);
    for (int i = 0; i < 4; ++i)
        conv_job(p->mix_w_branch + (size_t)(l * 4 + i) * 512 * D, 512, D, nullptr, p->Wbr + (size_t)i * D * 512, 512, [](int n) { return n; }, tl);
    conv_job(p->mix_w_out + (size_t)l * D * D, D, D, nullptr, p->Wout, D, [](int n) { return n; }, tl);
    conv_job(p->mla_wuq + (size_t)l * 384 * 768, 384, 768, p->mla_qn + l * 384, p->Wuq, 384, [](int n) { return n; }, tl);
    conv_job(p->mla_wukv + (size_t)l * 128 * 1024, 128, 1024, p->mla_kvn + l * 128, p->Wukv, 256, [](int n) { return n; }, tl);
    for (int wh = 0; wh < 2; ++wh) {
        conv_job(p->cmp_w1 + (size_t)(l * 2 + wh) * 2048 * 256, 2048, 256, nullptr, p->cW1t + (size_t)wh * 256 * 2048, 2048, [](int n) { return n; }, tl);
        conv_job(p->cmp_w2 + (size_t)(l * 2 + wh) * 256 * 64, 256, 64, nullptr, p->cW2t + (size_t)wh * 256 * 256, 256, [](int n) { return n; }, tl);
    }
    for (int i = bid * 512 + tid; i < 2 * 192 * 256 / 8; i += nb * 512) { const int wh = i / (192 * 32), r = (i % (192 * 32)) >> 5, c8 = i & 31; *(u32x4*)(p->cW2t + (size_t)wh * 256 * 256 + (size_t)(64 + r) * 256 + c8 * 8) = (u32x4){0u, 0u, 0u, 0u}; }
    __syncthreads();
    for (int job = nb - 1 - bid; job < 32; job += nb) { const int wh = job >> 4, n0 = (job & 15) * 16, c = tid & 15, ks = tid >> 4;
        const float* ps = p->cmp_pos + (l * 2 + wh) * 2048 + ks * 64; const float* w1 = p->cmp_w1 + (size_t)(l * 2 + wh) * 2048 * 256 + (size_t)ks * 64 * 256 + n0 + c;
        float a = 0.f;
#pragma unroll 16
        for (int k = 0; k < 64; ++k) a += ps[k] * w1[(size_t)k * 256];
        tl[ks * 16 + c] = a;
        __syncthreads();
        if (tid < 16) { float sm = 0.f;
            for (int q = 0; q < 32; ++q) sm += tl[q * 16 + tid];
            p->cbias[wh * 256 + n0 + tid] = sm; }
        __syncthreads(); }
    conv_job(p->rw_w_w2 + (size_t)l * 64 * 512, 64, 512, nullptr, p->rwWlT, 256, [](int n) { return n; }, tl);
    conv_job(p->rw_a_w2 + (size_t)l * 64 * 512, 64, 512, nullptr, p->rwWlT + 64, 256, [](int n) { return n; }, tl);
    conv_job(p->rw_g_w2 + (size_t)l * 128 * 512, 128, 512, nullptr, p->rwWlT + 128, 256, [](int n) { return n; }, tl);
    for (int i = bid * 512 + tid; i < (NP1P - NP1) * D / 8; i += nb * 512) ((u32x4*)(p->Win1 + (size_t)NP1 * D))[i] = (u32x4){0u, 0u, 0u, 0u};
    for (int i = bid * 512 + tid; i < 1024 * 16; i += nb * 512) { const int r = i >> 4, c8 = i & 15; *(u32x4*)(p->Wukv + (size_t)r * 256 + 128 + c8 * 8) = (u32x4){0u, 0u, 0u, 0u}; }
}

DI void ld8bf(const bf16_t* q, float (&f)[8]) { const u32x4 w = *(const u32x4*)q;
    f[0] = __uint_as_float(w.x << 16); f[1] = __uint_as_float(w.x & 0xffff0000u); f[2] = __uint_as_float(w.y << 16); f[3] = __uint_as_float(w.y & 0xffff0000u);
    f[4] = __uint_as_float(w.z << 16); f[5] = __uint_as_float(w.z & 0xffff0000u); f[6] = __uint_as_float(w.w << 16); f[7] = __uint_as_float(w.w & 0xffff0000u); }
DI u32x4 pack8bf(const float (&f)[8]) { u32x4 w; w.x = pk2(f[0], f[1]); w.y = pk2(f[2], f[3]); w.z = pk2(f[4], f[5]); w.w = pk2(f[6], f[7]); return w; }
DI void ld8f(const float* q, float (&f)[8]) { const f32x4 a = *(const f32x4*)q, b = *(const f32x4*)(q + 4); f[0] = a[0]; f[1] = a[1]; f[2] = a[2]; f[3] = a[3]; f[4] = b[0]; f[5] = b[1]; f[6] = b[2]; f[7] = b[3]; }
template <bool HAS_Y, bool HAS_U, bool XIN_BF = false, bool XOUT_BF = false>
DI void phase_norm(const void* xin_, const bf16_t* y, void* xout_, bf16_t* u, const float* g_post, const float* modPrev, float rw, const float* g_pre, const float* modNext) {
    const float* xin = (const float*)xin_; const bf16_t* xinb = (const bf16_t*)xin_; float* xout = (float*)xout_; bf16_t* xoutb = (bf16_t*)xout_;
    const int tid = TIDX(), lane = tid & 63, wave = tid >> 6;
    for (int row0 = (BIDX() * 8 + wave) * 2; row0 < T; row0 += NBLK() * 16) {
        const int b = row0 >> 12;
        float xv[2][4][8]; u32x4 yw[2][4];
#pragma unroll
        for (int r = 0; r < 2; ++r)
#pragma unroll
            for (int i = 0; i < 4; ++i) { const size_t o = (size_t)(row0 + r) * D + i * 512 + lane * 8;
                if (XIN_BF) ld8bf(xinb + o, xv[r][i]); else ld8f(xin + o, xv[r][i]);
                if (HAS_Y) yw[r][i] = *(const u32x4*)(y + o); }
        if (HAS_Y) {
            float gc[4][8];
#pragma unroll
            for (int i = 0; i < 4; ++i) { const int col = i * 512 + lane * 8; float gp[8], gt[8]; ld8f(g_post + col, gp); ld8f(modPrev + (size_t)b * 6144 + 4096 + col, gt);
#pragma unroll
                for (int e = 0; e < 8; ++e) gc[i][e] = gp[e] * gt[e]; }
#pragma unroll
            for (int r = 0; r < 2; ++r) { float yv[4][8]; float ss = 0.f;
#pragma unroll
                for (int i = 0; i < 4; ++i) { const u32x4 w = yw[r][i];
                    yv[i][0] = __uint_as_float(w.x << 16); yv[i][1] = __uint_as_float(w.x & 0xffff0000u); yv[i][2] = __uint_as_float(w.y << 16); yv[i][3] = __uint_as_float(w.y & 0xffff0000u);
                    yv[i][4] = __uint_as_float(w.z << 16); yv[i][5] = __uint_as_float(w.z & 0xffff0000u); yv[i][6] = __uint_as_float(w.w << 16); yv[i][7] = __uint_as_float(w.w & 0xffff0000u);
#pragma unroll
                    for (int e = 0; e < 8; ++e) ss += yv[i][e] * yv[i][e]; }
                ss = wsum(ss);
                const float rs = rsqrtf(ss * (1.0f / D) + NORM_EPS) * rw;
#pragma unroll
                for (int i = 0; i < 4; ++i)
#pragma unroll
                    for (int e = 0; e < 8; ++e) xv[r][i][e] += gc[i][e] * (yv[i][e] * rs); }
        }
        float cu[4][8], sh[4][8];
        if (HAS_U) {
#pragma unroll
            for (int i = 0; i < 4; ++i) { const int col = i * 512 + lane * 8; float gp[8], scl[8]; ld8f(g_pre + col, gp); ld8f(modNext + (size_t)b * 6144 + 2048 + col, scl); ld8f(modNext + (size_t)b * 6144 + col, sh[i]);
#pragma unroll
                for (int e = 0; e < 8; ++e) cu[i][e] = gp[e] * (scl[e] + 1.0f); }
        }
        if (HAS_Y) {
#pragma unroll
            for (int r = 0; r < 2; ++r)
#pragma unroll
                for (int i = 0; i < 4; ++i) { const size_t o = (size_t)(row0 + r) * D + i * 512 + lane * 8;
                    if (XOUT_BF) *(u32x4*)(xoutb + o) = pack8bf(xv[r][i]);
                    else { *(f32x4*)(xout + o) = (f32x4){xv[r][i][0], xv[r][i][1], xv[r][i][2], xv[r][i][3]}; *(f32x4*)(xout + o + 4) = (f32x4){xv[r][i][4], xv[r][i][5], xv[r][i][6], xv[r][i][7]}; } }
        }
        if (HAS_U) {
#pragma unroll
            for (int r = 0; r < 2; ++r) { float ss = 0.f;
#pragma unroll
                for (int i = 0; i < 4; ++i)
#pragma unroll
                    for (int e = 0; e < 8; ++e) ss += xv[r][i][e] * xv[r][i][e];
                ss = wsum(ss);
                const float rs = rsqrtf(ss * (1.0f / D) + NORM_EPS);
#pragma unroll
                for (int i = 0; i < 4; ++i) { float uu[8];
#pragma unroll
                    for (int e = 0; e < 8; ++e) uu[e] = (xv[r][i][e] * rs) * cu[i][e] + sh[i][e];
                    *(u32x4*)(u + (size_t)(row0 + r) * D + i * 512 + lane * 8) = pack8bf(uu); } }
        }
    }
}

DI float ldP(const bf16_t* P1, int t, int col) { return bf2f(P1[(size_t)t * NP1P + col]); }
DI void phase_prep(KParamsPtr p, int l, LAS unsigned char* lds) {
    constexpr int TT = 8;
    const int tid = TIDX(), lane = tid & 63, wave = tid >> 6;
    LAS float* wl = (LAS float*)lds;
    LAS float* al = wl + TT * 64;
    LAS float* gl = al + TT * 64;
    LAS float* ga = gl + TT * 128;
    LAS float* rsq = ga + TT * 16;
    LAS float* gw2 = rsq + TT * 2;
    for (int i = tid; i < 16 * 256; i += 512) gw2[i] = p->gla_w2[l * 16 * 256 + i];
    __syncthreads();
    const bf16_t* P1 = p->P1;
    const float* mu = p->rw_mu + l * 1792;
    const float* w_w2 = p->rw_w_w2 + l * 64 * 512; const float* a_w2 = p->rw_a_w2 + l * 64 * 512; const float* g_w2 = p->rw_g_w2 + l * 128 * 512;
    for (int tile = BIDX(); tile < T / TT; tile += NBLK()) {
        const int t0 = tile * TT;
        for (int rp1_ = 0; rp1_ < PREP_R1; ++rp1_) {
        for (int i = tid; i < TT * 256; i += 512) {
            const int tt = i >> 8, c = i & 255, t = t0 + tt, s = t & (SEQ - 1);
            const int col = c < 64 ? C_RW_WLO + c : (c < 128 ? C_RW_ALO + (c - 64) : C_RW_GLO + (c - 128));
            const float pv = ldP(P1, t, col), pp = s > 0 ? ldP(P1, t - 1, col) : 0.f;
            const float xs = pv + (pp - pv) * mu[col - C_RW];
            if (c < 64) wl[tt * 64 + c] = tanhf(xs); else if (c < 128) al[tt * 64 + c - 64] = xs; else gl[tt * 128 + c - 128] = sigmoidf_(xs);
        }
        if (tid < TT * 16) ga[tid] = ldP(P1, t0 + (tid >> 4), C_GLA_ALO + (tid & 15));
        for (int tk = wave; tk < TT; tk += 8) { const int t = t0 + tk; float sq = 0.f, skv = 0.f;
#pragma unroll
            for (int i = 0; i < 6; ++i) { const float v = ldP(P1, t, C_MLA_CQ + i * 64 + lane); sq += v * v; }
#pragma unroll
            for (int i = 0; i < 2; ++i) { const float v = ldP(P1, t, C_MLA_CKV + i * 64 + lane); skv += v * v; }
            sq = wsum(sq); skv = wsum(skv);
            if (lane == 0) { rsq[tk * 2] = rsqrtf(sq * (1.0f / 384.0f) + NORM_EPS); rsq[tk * 2 + 1] = rsqrtf(skv * (1.0f / 128.0f) + NORM_EPS); } }
        __syncthreads(); }
        for (int rp2_ = 0; rp2_ < PREP_R2; ++rp2_) { const int j = tid;
            float aw[TT], aa[TT], ag[TT];
            const float w0 = p->rw_w0[l * 512 + j], a0 = p->rw_a0[l * 512 + j];
#pragma unroll
            for (int tt = 0; tt < TT; ++tt) { aw[tt] = w0; aa[tt] = a0; ag[tt] = 0.f; }
#pragma unroll 4
            for (int i = 0; i < 64; i += 4) {
                const float ww0 = w_w2[i * 512 + j], ww1 = w_w2[(i + 1) * 512 + j], ww2 = w_w2[(i + 2) * 512 + j], ww3 = w_w2[(i + 3) * 512 + j];
                const float wa0 = a_w2[i * 512 + j], wa1 = a_w2[(i + 1) * 512 + j], wa2 = a_w2[(i + 2) * 512 + j], wa3 = a_w2[(i + 3) * 512 + j];
#pragma unroll
                for (int tt = 0; tt < TT; ++tt) { const f32x4 x = *(const LAS f32x4*)(wl + tt * 64 + i), z = *(const LAS f32x4*)(al + tt * 64 + i);
                    aw[tt] += (x[0] * ww0 + x[1] * ww1) + (x[2] * ww2 + x[3] * ww3); aa[tt] += (z[0] * wa0 + z[1] * wa1) + (z[2] * wa2 + z[3] * wa3); } }
#pragma unroll 4
            for (int i = 0; i < 128; i += 4) {
                const float wg0 = g_w2[i * 512 + j], wg1 = g_w2[(i + 1) * 512 + j], wg2 = g_w2[(i + 2) * 512 + j], wg3 = g_w2[(i + 3) * 512 + j];
#pragma unroll
                for (int tt = 0; tt < TT; ++tt) { const f32x4 x = *(const LAS f32x4*)(gl + tt * 128 + i); ag[tt] += (x[0] * wg0 + x[1] * wg1) + (x[2] * wg2 + x[3] * wg3); } }
            const float k_k = p->rw_k_k[l * 512 + j], k_a = p->rw_k_a[l * 512 + j];
            const float mur = mu[C_RW_R - C_RW + j], muk = mu[C_RW_K - C_RW + j], muv = mu[C_RW_V - C_RW + j];
#pragma unroll
            for (int tt = 0; tt < TT; ++tt) {
                const int t = t0 + tt, s = t & (SEQ - 1);
                float xr = ldP(P1, t, C_RW_R + j), xk = ldP(P1, t, C_RW_K + j), xv = ldP(P1, t, C_RW_V + j);
                const float pr = s > 0 ? ldP(P1, t - 1, C_RW_R + j) : 0.f, pk = s > 0 ? ldP(P1, t - 1, C_RW_K + j) : 0.f, pvv = s > 0 ? ldP(P1, t - 1, C_RW_V + j) : 0.f;
                xr += (pr - xr) * mur; xk += (pk - xk) * muk; xv += (pvv - xv) * muv;
                const float w = __expf(-0.6065306597126334f * sigmoidf_(aw[tt]));
                const float a = sigmoidf_(aa[tt]);
                const float kkr = xk * k_k;
                const float ss = wsum(kkr * kkr);
                const float kk = kkr / fmaxf(sqrtf(ss), 1e-12f);
                const float k2 = xk * (1.0f + (a - 1.0f) * k_a);
                const size_t o = (size_t)t * 512 + j;
                p->rw_r[o] = f2bf(xr); p->rw_w[o] = w; p->rw_k[o] = f2bf(k2); p->rw_v[o] = f2bf(xv); p->rw_kk[o] = kk; p->rw_b[o] = kk * a; p->rw_g[o] = f2bf(ag[tt]);
            } }
        for (int rp3_ = 0; rp3_ < PREP_R3; ++rp3_)
        for (int tt = 0; tt < TT; ++tt) {
            const int t = t0 + tt, s = t & (SEQ - 1), b = t >> 12;
            if (tid < 256) { const int h = tid >> 5, i = tid & 31;
                const float x1 = ldP(P1, t, C_NSA_Q + h * 64 + i), x2 = ldP(P1, t, C_NSA_Q + h * 64 + 32 + i), cs = p->cos64[s * 32 + i], sn = p->sin64[s * 32 + i];
                p->nsa_q[(size_t)t * 512 + h * 64 + i] = f2bf(x1 * cs - x2 * sn); p->nsa_q[(size_t)t * 512 + h * 64 + 32 + i] = f2bf(x1 * sn + x2 * cs);
            } else if (tid < 448) { const int r = tid - 256, which = r >> 6, hk = (r >> 5) & 1, i = r & 31;
                const int sc = (which == 0 ? C_NSA_KC : (which == 1 ? C_NSA_KS : C_NSA_KW)) + hk * 64;
                bf16_t* dst = which == 0 ? p->nsa_kc_in : (which == 1 ? p->nsa_ks : p->nsa_kw);
                const float x1 = ldP(P1, t, sc + i), x2 = ldP(P1, t, sc + 32 + i), cs = p->cos64[s * 32 + i], sn = p->sin64[s * 32 + i];
                const size_t o = ((size_t)(b * 2 + hk) * SEQ + s) * 64;
                dst[o + i] = f2bf(x1 * cs - x2 * sn); dst[o + 32 + i] = f2bf(x1 * sn + x2 * cs);
            } else if (tid < 472) { const int g = tid - 448; p->nsa_gate[(size_t)t * 24 + g] = sigmoidf_(ldP(P1, t, C_NSA_GL + g)); }
            if (tid < 384) { const int which = tid >> 7, hk = (tid >> 6) & 1, d = tid & 63;
                const int sc = (which == 0 ? C_NSA_VC : (which == 1 ? C_NSA_VS : C_NSA_VW)) + hk * 64;
                bf16_t* dst = which == 0 ? p->nsa_vc_in : (which == 1 ? p->nsa_vs : p->nsa_vw);
                dst[((size_t)(b * 2 + hk) * SEQ + s) * 64 + d] = P1[(size_t)t * NP1P + sc + d]; }
        }
        for (int rp4_ = 0; rp4_ < PREP_R4; ++rp4_) {
        for (int i = tid; i < TT * 256; i += 512) {
            const int tt = i >> 8, d = i & 255;
            float z = p->gla_b[l * 256 + d];
#pragma unroll
            for (int q = 0; q < 16; ++q) z += ga[tt * 16 + q] * gw2[q * 256 + d];
            const float ez = __expf(-fabsf(z)), ls = fminf(z, 0.f) - __logf(1.0f + ez);
            p->gla_la[(size_t)(t0 + tt) * 256 + d] = ls * (1.0f / 16.0f);
        }
        for (int i = tid; i < TT * 384; i += 512) { const int tt = i / 384, c = i % 384; p->mla_cqn[(size_t)(t0 + tt) * 384 + c] = f2bf(ldP(P1, t0 + tt, C_MLA_CQ + c) * rsq[tt * 2]); }
        for (int i = tid; i < TT * 256; i += 512) { const int tt = i >> 8, c = i & 255; p->mla_ckvn[(size_t)(t0 + tt) * 256 + c] = c < 128 ? f2bf(ldP(P1, t0 + tt, C_MLA_CKV + c) * rsq[tt * 2 + 1]) : (bf16_t)0; }
        if (tid < TT * 16) { const int tt = tid >> 4, i = tid & 15, t = t0 + tt, s = t & (SEQ - 1);
            const float x1 = ldP(P1, t, C_MLA_KR + i), x2 = ldP(P1, t, C_MLA_KR + 16 + i), cs = p->cos32[s * 16 + i], sn = p->sin32[s * 16 + i];
            p->mla_kpe[(size_t)t * 32 + i] = f2bf(x1 * cs - x2 * sn); p->mla_kpe[(size_t)t * 32 + 16 + i] = f2bf(x1 * sn + x2 * cs); }
        }
        __syncthreads();
    }
}

DI float prep_red16(float x) {
    x += __int_as_float(__builtin_amdgcn_update_dpp(0, __float_as_int(x), 0xB1, 0xF, 0xF, true)); x += __int_as_float(__builtin_amdgcn_update_dpp(0, __float_as_int(x), 0x4E, 0xF, 0xF, true));
    x += __int_as_float(__builtin_amdgcn_update_dpp(0, __float_as_int(x), 0x141, 0xF, 0xF, true)); x += __int_as_float(__builtin_amdgcn_update_dpp(0, __float_as_int(x), 0x140, 0xF, 0xF, true)); return x; }
DI void rope8(const bf16_t* src1, const bf16_t* src2, const float* cs, const float* sn, bf16_t* dst1, bf16_t* dst2) {
    float x1[8], x2[8], c[8], sgn[8], o1[8], o2[8]; ld8bf(src1, x1); ld8bf(src2, x2); ld8f(cs, c); ld8f(sn, sgn);
#pragma unroll
    for (int e = 0; e < 8; ++e) { o1[e] = x1[e] * c[e] - x2[e] * sgn[e]; o2[e] = x1[e] * sgn[e] + x2[e] * c[e]; }
    *(u32x4*)dst1 = pack8bf(o1); *(u32x4*)dst2 = pack8bf(o2); }
constexpr int P1TAIL = 5120;
DI float ldtail(const float* part, int t, int cc) { return (part[(size_t)t * 256 + cc] + part[((size_t)T + t) * 256 + cc]) + (part[((size_t)2 * T + t) * 256 + cc] + part[((size_t)3 * T + t) * 256 + cc]); }
DI void ldtail8(const float* part, int t, int cc, float (&f)[8]) { float a[8], b[8], c[8], d[8];
    ld8f(part + (size_t)t * 256 + cc, a); ld8f(part + ((size_t)T + t) * 256 + cc, b); ld8f(part + ((size_t)2 * T + t) * 256 + cc, c); ld8f(part + ((size_t)3 * T + t) * 256 + cc, d);
#pragma unroll
    for (int e = 0; e < 8; ++e) f[e] = (a[e] + b[e]) + (c[e] + d[e]); }
DI void phase_prep2(KParamsPtr p, int l, LAS unsigned char* lds) {
    constexpr int TT = 16, XS = 264;
    const int tid = TIDX(), lane = tid & 63, wave = tid >> 6, fr = lane & 15, q4 = lane >> 4;
    LAS bf16_t* xa = (LAS bf16_t*)lds;
    LAS float* ga = (LAS float*)(lds + TT * XS * 2);
    LAS float* rsq = ga + TT * 16;
    LAS float* gw2 = rsq + TT * 2;
    LAS float* tl = gw2 + 16 * 256;
    for (int i = tid; i < 16 * 256; i += 512) gw2[i] = p->gla_w2[l * 16 * 256 + i];
    __syncthreads();
    const bf16_t* P1 = p->P1; const float* ptail = (const float*)p->y;
    const float* mu = p->rw_mu + l * 1792;
    const bf16_t* WT = p->rwWlT;
    float c_w0[4], c_a0[4], c_kk[4], c_ka[4], c_mr[4], c_mk[4], c_mv[4];
#pragma unroll
    for (int nb = 0; nb < 4; ++nb) { const int ch = wave * 64 + nb * 16 + fr;
        c_w0[nb] = p->rw_w0[l * 512 + ch]; c_a0[nb] = p->rw_a0[l * 512 + ch]; c_kk[nb] = p->rw_k_k[l * 512 + ch]; c_ka[nb] = p->rw_k_a[l * 512 + ch];
        c_mr[nb] = mu[C_RW_R - C_RW + ch]; c_mk[nb] = mu[C_RW_K - C_RW + ch]; c_mv[nb] = mu[C_RW_V - C_RW + ch]; }
    for (int tile = BIDX(); tile < T / TT; tile += NBLK()) {
        const int t0 = tile * TT;
        { const int tt = tid >> 5, c = (tid & 31) * 8, t = t0 + tt, s = t & (SEQ - 1);
            const int col = c < 64 ? C_RW_WLO + c : (c < 128 ? C_RW_ALO + (c - 64) : C_RW_GLO + (c - 128));
            float pv[8], pp[8], m8[8], o[8]; ld8bf(P1 + (size_t)t * NP1P + col, pv); ld8f(mu + col - C_RW, m8);
            if (s > 0) ld8bf(P1 + (size_t)(t - 1) * NP1P + col, pp); else {
#pragma unroll
                for (int e = 0; e < 8; ++e) pp[e] = 0.f; }
#pragma unroll
            for (int e = 0; e < 8; ++e) { const float xs = pv[e] + (pp[e] - pv[e]) * m8[e];
                o[e] = c < 64 ? 1.0f - 2.0f / (__expf(2.0f * xs) + 1.0f) : (c < 128 ? xs : sigmoidf_(xs)); }
            *(LAS u32x4*)(xa + tt * XS + c) = pack8bf(o); }
        if (tid >= 512 - TT * 9) { const int k_ = tid - (512 - TT * 9), tt = k_ / 9, ch = k_ % 9; float f8[8]; ldtail8(ptail, t0 + tt, ch * 8, f8);
            *(LAS f32x4*)(tl + tt * 80 + ch * 8) = (f32x4){f8[0], f8[1], f8[2], f8[3]}; *(LAS f32x4*)(tl + tt * 80 + ch * 8 + 4) = (f32x4){f8[4], f8[5], f8[6], f8[7]}; }
        if (tid < TT * 16) ga[tid] = ldP(P1, t0 + (tid >> 4), C_GLA_ALO + (tid & 15));
        __syncthreads();
        {
            f32x4 acc[3][4];
#pragma unroll
            for (int w3 = 0; w3 < 3; ++w3)
#pragma unroll
                for (int nb = 0; nb < 4; ++nb) acc[w3][nb] = (f32x4){0.f, 0.f, 0.f, 0.f};
#pragma unroll
            for (int ks = 0; ks < 8; ++ks) {
                const bf16x8 af = *(const LAS bf16x8*)(xa + fr * XS + ks * 32 + q4 * 8);
#pragma unroll
                for (int nb = 0; nb < 4; ++nb) { const bf16x8 bfr = *(const bf16x8*)(WT + (size_t)(wave * 64 + nb * 16 + fr) * 256 + ks * 32 + q4 * 8);
                    acc[ks < 2 ? 0 : (ks < 4 ? 1 : 2)][nb] = __builtin_amdgcn_mfma_f32_16x16x32_bf16(af, bfr, acc[ks < 2 ? 0 : (ks < 4 ? 1 : 2)][nb], 0, 0, 0); }
            }
#pragma unroll
            for (int jj = 0; jj < 4; ++jj) {
                const int t = t0 + q4 * 4 + jj, s = t & (SEQ - 1);
                float xr[4], xk[4], xv[4], kkr[4]; float ss = 0.f;
#pragma unroll
                for (int nb = 0; nb < 4; ++nb) { const int ch = wave * 64 + nb * 16 + fr;
                    xr[nb] = ldP(P1, t, C_RW_R + ch); xk[nb] = ldP(P1, t, C_RW_K + ch); xv[nb] = ldP(P1, t, C_RW_V + ch);
                    const float pr = s > 0 ? ldP(P1, t - 1, C_RW_R + ch) : 0.f, pk = s > 0 ? ldP(P1, t - 1, C_RW_K + ch) : 0.f, pvv = s > 0 ? ldP(P1, t - 1, C_RW_V + ch) : 0.f;
                    xr[nb] += (pr - xr[nb]) * c_mr[nb]; xk[nb] += (pk - xk[nb]) * c_mk[nb]; xv[nb] += (pvv - xv[nb]) * c_mv[nb];
                    kkr[nb] = xk[nb] * c_kk[nb]; ss += kkr[nb] * kkr[nb]; }
                ss = prep_red16(ss);
                const float rn = 1.0f / fmaxf(sqrtf(ss), 1e-12f);
#pragma unroll
                for (int nb = 0; nb < 4; ++nb) { const int ch = wave * 64 + nb * 16 + fr;
                    const float w = __expf(-0.6065306597126334f * sigmoidf_(c_w0[nb] + acc[0][nb][jj]));
                    const float a = sigmoidf_(c_a0[nb] + acc[1][nb][jj]);
                    const float kk = kkr[nb] * rn, k2 = xk[nb] * (1.0f + (a - 1.0f) * c_ka[nb]);
                    const size_t o = (size_t)t * 512 + ch;
                    p->rw_r[o] = f2bf(xr[nb]); p->rw_w[o] = w; p->rw_k[o] = f2bf(k2); p->rw_v[o] = f2bf(xv[nb]); p->rw_kk[o] = kk; p->rw_b[o] = kk * a; p->rw_g[o] = f2bf(acc[2][nb][jj]); }
            }
        }
        for (int tk = wave; tk < TT; tk += 8) { const int t = t0 + tk; float sq = 0.f, skv = 0.f;
#pragma unroll
            for (int i = 0; i < 6; ++i) { const float v = ldP(P1, t, C_MLA_CQ + i * 64 + lane); sq += v * v; }
#pragma unroll
            for (int i = 0; i < 2; ++i) { const int col = C_MLA_CKV + i * 64 + lane; const float v = col < P1TAIL ? ldP(P1, t, col) : tl[tk * 80 + col - P1TAIL]; skv += v * v; }
            sq = wsum(sq); skv = wsum(skv);
            if (lane == 0) { rsq[tk * 2] = rsqrtf(sq * (1.0f / 384.0f) + NORM_EPS); rsq[tk * 2 + 1] = rsqrtf(skv * (1.0f / 128.0f) + NORM_EPS); } }
        __syncthreads();
        { const int tt = tid >> 5, idx = tid & 31, t = t0 + tt, s = t & (SEQ - 1), b = t >> 12;
            const bf16_t* row = P1 + (size_t)t * NP1P;
            { const int h = idx >> 2, ic = idx & 3;
              rope8(row + C_NSA_Q + h * 64 + ic * 8, row + C_NSA_Q + h * 64 + 32 + ic * 8, p->cos64 + s * 32 + ic * 8, p->sin64 + s * 32 + ic * 8,
                    p->nsa_q + (size_t)t * 512 + h * 64 + ic * 8, p->nsa_q + (size_t)t * 512 + h * 64 + 32 + ic * 8); }
            asm volatile("" ::: "memory");
            if (idx < 24) { const int which = idx >> 3, hk = (idx >> 2) & 1, ic = idx & 3;
                const int sc = (which == 0 ? C_NSA_KC : (which == 1 ? C_NSA_KS : C_NSA_KW)) + hk * 64;
                bf16_t* dst = (which == 0 ? p->nsa_kc_in : (which == 1 ? p->nsa_ks : p->nsa_kw)) + ((size_t)(b * 2 + hk) * SEQ + s) * 64;
                rope8(row + sc + ic * 8, row + sc + 32 + ic * 8, p->cos64 + s * 32 + ic * 8, p->sin64 + s * 32 + ic * 8, dst + ic * 8, dst + 32 + ic * 8); }
#pragma unroll
            for (int ps = 0; ps < 2; ++ps) { const int k = idx + 32 * ps;
                if (k < 48) { const int which = k >> 4, hk = (k >> 3) & 1, ic = k & 7;
                    const int sc = (which == 0 ? C_NSA_VC : (which == 1 ? C_NSA_VS : C_NSA_VW)) + hk * 64;
                    bf16_t* dst = (which == 0 ? p->nsa_vc_in : (which == 1 ? p->nsa_vs : p->nsa_vw)) + ((size_t)(b * 2 + hk) * SEQ + s) * 64;
                    *(u32x4*)(dst + ic * 8) = *(const u32x4*)(row + sc + ic * 8); } }
            asm volatile("" ::: "memory");
            if (idx < 3) { float g8[8]; ld8bf(row + C_NSA_GL + idx * 8, g8);
                float* gd = p->nsa_gate + (size_t)t * 24 + idx * 8;
                *(f32x4*)gd = (f32x4){sigmoidf_(g8[0]), sigmoidf_(g8[1]), sigmoidf_(g8[2]), sigmoidf_(g8[3])}; *(f32x4*)(gd + 4) = (f32x4){sigmoidf_(g8[4]), sigmoidf_(g8[5]), sigmoidf_(g8[6]), sigmoidf_(g8[7])}; }
            asm volatile("" ::: "memory");
            { const int c = idx * 8; u32x4 w = (u32x4){0u, 0u, 0u, 0u};
              if (c < 128) { float v8[8]; if (C_MLA_CKV + c < P1TAIL) ld8bf(row + C_MLA_CKV + c, v8); else { const f32x4 a_ = *(const LAS f32x4*)(tl + tt * 80 + C_MLA_CKV + c - P1TAIL), b_ = *(const LAS f32x4*)(tl + tt * 80 + C_MLA_CKV + c - P1TAIL + 4); v8[0] = a_[0]; v8[1] = a_[1]; v8[2] = a_[2]; v8[3] = a_[3]; v8[4] = b_[0]; v8[5] = b_[1]; v8[6] = b_[2]; v8[7] = b_[3]; } const float r = rsq[tt * 2 + 1];
#pragma unroll
                  for (int e = 0; e < 8; ++e) v8[e] *= r;
                  w = pack8bf(v8); }
              *(u32x4*)(p->mla_ckvn + (size_t)t * 256 + c) = w; }
            if (idx < 2) { float x1[8], x2[8], cs[8], sn[8], o1[8], o2[8]; { const f32x4 a_ = *(const LAS f32x4*)(tl + tt * 80 + C_MLA_KR - P1TAIL + idx * 8), b_ = *(const LAS f32x4*)(tl + tt * 80 + C_MLA_KR - P1TAIL + idx * 8 + 4), c_ = *(const LAS f32x4*)(tl + tt * 80 + C_MLA_KR - P1TAIL + 16 + idx * 8), d_ = *(const LAS f32x4*)(tl + tt * 80 + C_MLA_KR - P1TAIL + 16 + idx * 8 + 4);
#pragma unroll
                  for (int e = 0; e < 4; ++e) { x1[e] = a_[e]; x1[4 + e] = b_[e]; x2[e] = c_[e]; x2[4 + e] = d_[e]; } }
                ld8f(p->cos32 + s * 16 + idx * 8, cs); ld8f(p->sin32 + s * 16 + idx * 8, sn);
#pragma unroll
                for (int e = 0; e < 8; ++e) { o1[e] = x1[e] * cs[e] - x2[e] * sn[e]; o2[e] = x1[e] * sn[e] + x2[e] * cs[e]; }
                *(u32x4*)(p->mla_kpe + (size_t)t * 32 + idx * 8) = pack8bf(o1); *(u32x4*)(p->mla_kpe + (size_t)t * 32 + 16 + idx * 8) = pack8bf(o2); }
        }
            asm volatile("" ::: "memory");
        for (int i = tid; i < TT * 48; i += 512) { const int tt = i / 48, c = (i % 48) * 8; float v8[8]; ld8bf(P1 + (size_t)(t0 + tt) * NP1P + C_MLA_CQ + c, v8); const float r = rsq[tt * 2];
#pragma unroll
            for (int e = 0; e < 8; ++e) v8[e] *= r;
            *(u32x4*)(p->mla_cqn + (size_t)(t0 + tt) * 384 + c) = pack8bf(v8); }
            asm volatile("" ::: "memory");
        { const int d = tid & 255; float wq[16];
#pragma unroll
            for (int q = 0; q < 16; ++q) wq[q] = gw2[q * 256 + d];
            const float bz = p->gla_b[l * 256 + d];
#pragma unroll
            for (int k = 0; k < TT / 2; ++k) { const int tt = (tid >> 8) + 2 * k; float z = bz;
#pragma unroll
                for (int q4_ = 0; q4_ < 4; ++q4_) { const f32x4 g = *(const LAS f32x4*)(ga + tt * 16 + q4_ * 4); z += (g[0] * wq[q4_ * 4] + g[1] * wq[q4_ * 4 + 1]) + (g[2] * wq[q4_ * 4 + 2] + g[3] * wq[q4_ * 4 + 3]); }
                const float ez = __expf(-fabsf(z)), ls = fminf(z, 0.f) - __logf(1.0f + ez);
                p->gla_la[(size_t)(t0 + tt) * 256 + d] = ls * (1.0f / 16.0f); } }
        __syncthreads();
    }
}


DI float gelu_tanh(float x) { return 0.5f * x * (1.0f + tanhf(0.7978845608028654f * (x + 0.044715f * x * x * x))); }
DI void phase_compress(KParamsPtr p, int l, LAS unsigned char* lds) {
    const int tid = TIDX();
    LAS float* A = (LAS float*)lds;
    LAS float* Hd = A + 8 * 2048;
    for (int task = BIDX(); task < 512; task += NBLK()) {
        const int which = task >> 8, bh = (task >> 5) & 7, n0 = (task & 31) * 8;
        const bf16_t* base = (which ? p->nsa_vc_in : p->nsa_kc_in) + (size_t)bh * SEQ * 64;
        const float* pos = p->cmp_pos + (l * 2 + which) * 2048;
        for (int i = tid; i < 8 * 2048; i += 512) { const int r = i >> 11, k = i & 2047, n = n0 + r;
            A[i] = n < 255 ? bf2f(base[(size_t)n * 1024 + k]) + pos[k] : 0.f; }
        __syncthreads();
        const float* w1 = p->cmp_w1 + (size_t)(l * 2 + which) * 2048 * 256;
        { const int j = tid & 255, half = tid >> 8;
            float acc[4] = {0.f, 0.f, 0.f, 0.f};
            for (int k = 0; k < 2048; ++k) { const float w = w1[(size_t)k * 256 + j];
#pragma unroll
                for (int r = 0; r < 4; ++r) acc[r] += A[(half * 4 + r) * 2048 + k] * w; }
#pragma unroll
            for (int r = 0; r < 4; ++r) Hd[(half * 4 + r) * 256 + j] = gelu_tanh(acc[r]); }
        __syncthreads();
        const float* w2 = p->cmp_w2 + (size_t)(l * 2 + which) * 256 * 64;
        { const int r = tid >> 6, d = tid & 63; float o = 0.f;
            for (int j = 0; j < 256; ++j) o += Hd[r * 256 + j] * w2[j * 64 + d];
            (which ? p->nsa_vc : p->nsa_kc)[((size_t)bh * 256 + n0 + r) * 64 + d] = o; }
        __syncthreads();
    }
}

DI void phase_nsa_cmp(KParamsPtr p, LAS unsigned char* lds) {
    const int tid = TIDX(), lane = tid & 63, wave = tid >> 6;
    LAS float* qs = (LAS float*)lds + wave * (256 + 1024);
    LAS float* pl = qs + 256;
    const float scale = 0.125f;
    for (int item_ = BIDX() * 8 + wave; item_ < NB * 2 * SEQ; item_ += NBLK() * 8) {
        const int item = __builtin_amdgcn_readfirstlane(item_);
        const int s = item & (SEQ - 1), hk = (item >> 12) & 1, b = item >> 13, t = b * SEQ + s, bh = b * 2 + hk;
        const int nvalid = s >= 31 ? min(255, (s - 31) / 16 + 1) : 0;
#pragma unroll
        for (int g = 0; g < 4; ++g) qs[g * 64 + lane] = bf2f(p->nsa_q[(size_t)t * 512 + (hk * 4 + g) * 64 + lane]);
        asm volatile("s_waitcnt lgkmcnt(0)" ::: "memory");
        float sc[4][4];
#pragma unroll
        for (int c = 0; c < 4; ++c) { const int n = lane + 64 * c;
#pragma unroll
            for (int g = 0; g < 4; ++g) sc[c][g] = -1e30f;
            if (n < nvalid) { const float* kr = p->nsa_kc + ((size_t)bh * 256 + n) * 64;
                float d0 = 0.f, d1 = 0.f, d2 = 0.f, d3 = 0.f;
#pragma unroll 4
                for (int k4 = 0; k4 < 16; ++k4) { const f32x4 kv = *(const f32x4*)(kr + k4 * 4);
                    const f32x4 q0 = *(const LAS f32x4*)(qs + k4 * 4), q1 = *(const LAS f32x4*)(qs + 64 + k4 * 4), q2 = *(const LAS f32x4*)(qs + 128 + k4 * 4), q3 = *(const LAS f32x4*)(qs + 192 + k4 * 4);
                    d0 += kv[0] * q0[0] + kv[1] * q0[1] + kv[2] * q0[2] + kv[3] * q0[3]; d1 += kv[0] * q1[0] + kv[1] * q1[1] + kv[2] * q1[2] + kv[3] * q1[3];
                    d2 += kv[0] * q2[0] + kv[1] * q2[1] + kv[2] * q2[2] + kv[3] * q2[3]; d3 += kv[0] * q3[0] + kv[1] * q3[1] + kv[2] * q3[2] + kv[3] * q3[3]; }
                sc[c][0] = d0 * scale; sc[c][1] = d1 * scale; sc[c][2] = d2 * scale; sc[c][3] = d3 * scale; } }
#pragma unroll
        for (int g = 0; g < 4; ++g) {
            float mx = fmaxf(fmaxf(sc[0][g], sc[1][g]), fmaxf(sc[2][g], sc[3][g])); mx = wmax(mx);
            float e[4], sm = 0.f;
#pragma unroll
            for (int c = 0; c < 4; ++c) { e[c] = (lane + 64 * c < nvalid) ? __expf(sc[c][g] - mx) : 0.f; sm += e[c]; }
            sm = wsum(sm);
            const float inv = sm > 0.f ? 1.0f / sm : 0.f;
#pragma unroll
            for (int c = 0; c < 4; ++c) pl[g * 256 + lane + 64 * c] = e[c] * inv;
        }
        asm volatile("s_waitcnt lgkmcnt(0)" ::: "memory");
        { float o[4] = {0.f, 0.f, 0.f, 0.f};
            const float* vr = p->nsa_vc + (size_t)bh * 256 * 64 + lane;
            for (int n = 0; n < nvalid; ++n) { const float v = vr[(size_t)n * 64];
#pragma unroll
                for (int g = 0; g < 4; ++g) o[g] += pl[g * 256 + n] * v; }
#pragma unroll
            for (int g = 0; g < 4; ++g) p->nsa_ocmp[(size_t)t * 512 + (hk * 4 + g) * 64 + lane] = o[g]; }
        float imp = 0.f;
#pragma unroll
        for (int dn = -1; dn <= 3; ++dn) { const int n = 4 * lane + dn;
            if (n >= 0 && n < 255) imp += pl[n] + pl[256 + n] + pl[512 + n] + pl[768 + n]; }
        const int cur = s >> 6;
        const bool valid = lane <= cur, forced = valid && (lane == 0 || lane >= cur - 1);
        const float val = forced ? 1e30f : (valid ? imp : -1e30f);
        int rank = 0;
        for (int jj = 0; jj < 64; ++jj) { const float o = __shfl(val, jj); rank += (o > val || (o == val && jj < lane)) ? 1 : 0; }
        const unsigned long long mask = __ballot(rank < 16);
        if (lane == 0) p->nsa_sel[(size_t)bh * SEQ + s] = mask;
        asm volatile("s_waitcnt lgkmcnt(0)" ::: "memory");
    }
}

DI void dot8(const u32x4 w, LAS const float* q0, int DQ, float (&s)[4]) {
    float kf[8];
    kf[0] = __uint_as_float(w.x << 16); kf[1] = __uint_as_float(w.x & 0xffff0000u); kf[2] = __uint_as_float(w.y << 16); kf[3] = __uint_as_float(w.y & 0xffff0000u);
    kf[4] = __uint_as_float(w.z << 16); kf[5] = __uint_as_float(w.z & 0xffff0000u); kf[6] = __uint_as_float(w.w << 16); kf[7] = __uint_as_float(w.w & 0xffff0000u);
#pragma unroll
    for (int g = 0; g < 4; ++g) { const f32x4 qa = *(const LAS f32x4*)(q0 + g * DQ), qb = *(const LAS f32x4*)(q0 + g * DQ + 4);
        s[g] += kf[0] * qa[0] + kf[1] * qa[1] + kf[2] * qa[2] + kf[3] * qa[3] + kf[4] * qb[0] + kf[5] * qb[1] + kf[6] * qb[2] + kf[7] * qb[3]; }
}
template <int DQ, class KPtr, class VLoad, class Mask>
DI void naive_attn_block(int lane, LAS float* qs  , LAS float* ps  , float scale, KPtr kptr, VLoad vload, Mask mask, float (&m)[4], float (&l)[4], float (&o)[4]) {
    float s[4] = {0.f, 0.f, 0.f, 0.f};
#pragma unroll 4
    for (int c8 = 0; c8 < DQ / 8; ++c8) { const u32x4 w = *(const u32x4*)kptr(c8); dot8(w, qs + c8 * 8, DQ, s); if ((c8 & 3) == 3) asm volatile("" ::: "memory"); }
    float pr[4];
#pragma unroll
    for (int g = 0; g < 4; ++g) {
        const bool ok = mask(g, lane);
        const float sv = ok ? s[g] * scale : -1e30f;
        const float bm = wmax(sv), mn = fmaxf(m[g], bm), corr = __expf(m[g] - mn);
        pr[g] = ok ? __expf(sv - mn) : 0.f;
        l[g] = l[g] * corr + pr[g]; o[g] *= corr; m[g] = mn;
    }
    *(LAS f32x4*)(ps + lane * 4) = (f32x4){pr[0], pr[1], pr[2], pr[3]};
    asm volatile("s_waitcnt lgkmcnt(0)" ::: "memory");
#pragma unroll 4
    for (int key = 0; key < 64; ++key) { const f32x4 pv = *(const LAS f32x4*)(ps + key * 4); const float v = vload(key, lane);
        o[0] += pv[0] * v; o[1] += pv[1] * v; o[2] += pv[2] * v; o[3] += pv[3] * v; if ((key & 3) == 3) asm volatile("" ::: "memory"); }
    asm volatile("s_waitcnt lgkmcnt(0)" ::: "memory");
}

DI void phase_nsa_attn(KParamsPtr p, LAS unsigned char* lds) {
    const int tid = TIDX(), lane = tid & 63, wave = tid >> 6;
    LAS float* qs = (LAS float*)lds + wave * 512;
    LAS float* ps = qs + 256;
    for (int item_ = BIDX() * 8 + wave; item_ < NB * 2 * SEQ; item_ += NBLK() * 8) {
        const int item = __builtin_amdgcn_readfirstlane(item_);
        const int s = item & (SEQ - 1), hk = (item >> 12) & 1, b = item >> 13, t = b * SEQ + s, bh = b * 2 + hk, cur = s >> 6;
#pragma unroll
        for (int g = 0; g < 4; ++g) qs[g * 64 + lane] = bf2f(p->nsa_q[(size_t)t * 512 + (hk * 4 + g) * 64 + lane]);
        asm volatile("s_waitcnt lgkmcnt(0)" ::: "memory");
        float res[4];
        { float m[4] = {-1e30f, -1e30f, -1e30f, -1e30f}, l[4] = {0.f, 0.f, 0.f, 0.f}, o[4] = {0.f, 0.f, 0.f, 0.f};
#if defined(NSA_NO_CMP)
            unsigned long long sel = NSA_SEL0;
#else
            unsigned long long sel = p->nsa_sel[(size_t)bh * SEQ + s];
#endif
            sel &= (cur >= 63) ? ~0ull : ((1ull << (cur + 1)) - 1ull);
            sel = ((unsigned long long)(unsigned)__builtin_amdgcn_readfirstlane((int)(sel >> 32)) << 32) | (unsigned)__builtin_amdgcn_readfirstlane((int)sel);
            const bf16_t* K = p->nsa_ks + (size_t)bh * SEQ * 64; const bf16_t* V = p->nsa_vs + (size_t)bh * SEQ * 64;
#if defined(NSA_NO_SLC)
            sel &= 1ull;
#endif
            while (sel) { const int j = __builtin_ctzll(sel); sel &= sel - 1;
                const int k0 = j * 64;
                naive_attn_block<64>(lane, qs, ps, 0.125f,
                    [&](int c8) { return K + (size_t)(k0 + lane) * 64 + c8 * 8; },
                    [&](int key, int d) { return bf2f(V[(size_t)(k0 + key) * 64 + d]); },
                    [&](int, int key) { return k0 + key <= s; }, m, l, o); }
#pragma unroll
            for (int g = 0; g < 4; ++g) { const float lt = wsum(l[g]); res[g] = p->nsa_gate[(size_t)t * 24 + (hk * 4 + g) * 3 + 1] * (o[g] / lt); } }
        { float m[4] = {-1e30f, -1e30f, -1e30f, -1e30f}, l[4] = {0.f, 0.f, 0.f, 0.f}, o[4] = {0.f, 0.f, 0.f, 0.f};
#if defined(NSA_WIN_USE_S)
            const bf16_t* K = p->nsa_ks + (size_t)bh * SEQ * 64; const bf16_t* V = p->nsa_vs + (size_t)bh * SEQ * 64;
#else
            const bf16_t* K = p->nsa_kw + (size_t)bh * SEQ * 64; const bf16_t* V = p->nsa_vw + (size_t)bh * SEQ * 64;
#endif
            const int lo = s - 511 > 0 ? s - 511 : 0;
#if defined(NSA_NO_WIN)
            for (int j = cur; j <= cur; ++j) { const int k0 = j * 64;
#else
            for (int j = lo >> 6; j <= cur; ++j) { const int k0 = j * 64;
#endif
                naive_attn_block<64>(lane, qs, ps, 0.125f,
                    [&](int c8) { return K + (size_t)(k0 + lane) * 64 + c8 * 8; },
                    [&](int key, int d) { return bf2f(V[(size_t)(k0 + key) * 64 + d]); },
                    [&](int, int key) { return k0 + key <= s && k0 + key >= lo; }, m, l, o); }
#pragma unroll
            for (int g = 0; g < 4; ++g) { const float lt = wsum(l[g]); res[g] += p->nsa_gate[(size_t)t * 24 + (hk * 4 + g) * 3 + 2] * (o[g] / lt); } }
#pragma unroll
        for (int g = 0; g < 4; ++g) { const size_t oi = (size_t)t * 512 + (hk * 4 + g) * 64 + lane;
#if !defined(NSA_NO_CMP)
            res[g] += p->nsa_gate[(size_t)t * 24 + (hk * 4 + g) * 3] * p->nsa_ocmp[oi];
#endif
            p->ys[oi] = f2bf(res[g]); }
    }
}

DI void phase_mla_rope(KParamsPtr p) {
    for (int i = BIDX() * 512 + TIDX(); i < T * 128; i += NBLK() * 512) {
        const int t = i >> 7, h = (i >> 4) & 7, j = i & 15, s = t & (SEQ - 1);
        bf16_t* q = p->mla_q + (size_t)t * 768 + h * 96 + 64;
        const float x1 = bf2f(q[j]), x2 = bf2f(q[16 + j]), cs = p->cos32[s * 16 + j], sn = p->sin32[s * 16 + j];
        q[j] = f2bf(x1 * cs - x2 * sn); q[16 + j] = f2bf(x1 * sn + x2 * cs);
    }
}
DI void phase_mla_attn(KParamsPtr p, LAS unsigned char* lds) {
    const int tid = TIDX(), lane = tid & 63, wave = tid >> 6;
    LAS float* qs = (LAS float*)lds + wave * 640;
    LAS float* ps = qs + 384;
    const float scale = 0.10206207261596577f;
    for (int item_ = BIDX() * 8 + wave; item_ < NB * 8 * (SEQ / 4); item_ += NBLK() * 8) {
        const int item = __builtin_amdgcn_readfirstlane(item_);
        const int s0 = (item & 1023) * 4, h = (item >> 10) & 7, b = item >> 13, t0 = b * SEQ + s0;
        for (int i = lane; i < 384; i += 64) { const int g = i / 96, c = i % 96; qs[i] = bf2f(p->mla_q[(size_t)(t0 + g) * 768 + h * 96 + c]); }
        asm volatile("s_waitcnt lgkmcnt(0)" ::: "memory");
        float m[4] = {-1e30f, -1e30f, -1e30f, -1e30f}, l[4] = {0.f, 0.f, 0.f, 0.f}, o[4] = {0.f, 0.f, 0.f, 0.f};
        const bf16_t* KV = p->mla_kv + (size_t)b * SEQ * 1024 + h * 128; const bf16_t* PE = p->mla_kpe + (size_t)b * SEQ * 32;
        for (int j = 0; j <= (s0 + 3) >> 6; ++j) { const int k0 = j * 64;
            naive_attn_block<96>(lane, qs, ps, scale,
                [&](int c8) { return c8 < 8 ? KV + (size_t)(k0 + lane) * 1024 + c8 * 8 : PE + (size_t)(k0 + lane) * 32 + (c8 - 8) * 8; },
                [&](int key, int d) { return bf2f(KV[(size_t)(k0 + key) * 1024 + 64 + d]); },
                [&](int g, int key) { return k0 + key <= s0 + g; }, m, l, o); }
#pragma unroll
        for (int g = 0; g < 4; ++g) { const float lt = wsum(l[g]); p->ys[(size_t)3 * T * 512 + (size_t)(t0 + g) * 512 + h * 64 + lane] = f2bf(o[g] / lt); }
    }
}

DI void phase_scan_rwkv(KParamsPtr p, LAS unsigned char* lds) {
    const int tid = TIDX(), bid = BIDX();
    if (bid < 32) {
        if (tid >= 64) return;
        const int b = bid >> 3, h = bid & 7, lane = tid;
        LAS float* L = (LAS float*)lds;
        float st[64];
#pragma unroll
        for (int j = 0; j < 64; ++j) st[j] = 0.f;
        size_t o = (size_t)b * SEQ * 512 + h * 64 + lane;
        float nkk = p->rw_kk[o], nw = p->rw_w[o], nk = bf2f(p->rw_k[o]), nb = p->rw_b[o], nr = bf2f(p->rw_r[o]), nv = bf2f(p->rw_v[o]);
        for (int s = 0; s < SEQ; ++s) {
            L[lane] = nkk; L[64 + lane] = nw; L[128 + lane] = nk; L[192 + lane] = nb; L[256 + lane] = nr;
            const float v = nv; const size_t oc = o;
            if (s + 1 < SEQ) { o += 512; nkk = p->rw_kk[o]; nw = p->rw_w[o]; nk = bf2f(p->rw_k[o]); nb = p->rw_b[o]; nr = bf2f(p->rw_r[o]); nv = bf2f(p->rw_v[o]); }
            asm volatile("s_waitcnt lgkmcnt(0)" ::: "memory");
            float skk = 0.f;
#pragma unroll
            for (int j4 = 0; j4 < 16; ++j4) { const f32x4 kk = *(const LAS f32x4*)(L + j4 * 4);
                skk += st[j4 * 4] * kk[0] + st[j4 * 4 + 1] * kk[1] + st[j4 * 4 + 2] * kk[2] + st[j4 * 4 + 3] * kk[3]; }
            float y = 0.f;
#pragma unroll
            for (int j4 = 0; j4 < 16; ++j4) { const f32x4 w = *(const LAS f32x4*)(L + 64 + j4 * 4), k = *(const LAS f32x4*)(L + 128 + j4 * 4), bb = *(const LAS f32x4*)(L + 192 + j4 * 4), r = *(const LAS f32x4*)(L + 256 + j4 * 4);
#pragma unroll
                for (int q = 0; q < 4; ++q) { const float ns = st[j4 * 4 + q] * w[q] - skk * bb[q] + v * k[q]; st[j4 * 4 + q] = ns; y += ns * r[q]; }
                if ((j4 & 3) == 3) asm volatile("" ::: "memory"); }
            p->rw_y[oc] = y;
            asm volatile("s_waitcnt lgkmcnt(0)" ::: "memory");
        }
    }
}
DI void phase_scan_gla(KParamsPtr p, LAS unsigned char* lds) {
    const int tid = TIDX(), bid = BIDX();
    if (bid >= 32 && bid < 48) {
        if (tid >= 128) return;
        const int bh = bid - 32, b = bh >> 2, h = bh & 3, e = tid, lane = tid & 63, wave = tid >> 6;
        LAS float* L = (LAS float*)lds + wave * 192;
        float st[64];
#pragma unroll
        for (int j = 0; j < 64; ++j) st[j] = 0.f;
        const bf16_t* P1 = p->P1;
        for (int s = 0; s < SEQ; ++s) {
            const int t = b * SEQ + s;
            L[lane] = __expf(p->gla_la[(size_t)t * 256 + h * 64 + lane]); L[64 + lane] = ldP(P1, t, C_GLA_K + h * 64 + lane); L[128 + lane] = ldP(P1, t, C_GLA_Q + h * 64 + lane) * 0.125f;
            const float v = ldP(P1, t, C_GLA_V + h * 128 + e);
            asm volatile("s_waitcnt lgkmcnt(0)" ::: "memory");
            float y = 0.f;
#pragma unroll
            for (int j4 = 0; j4 < 16; ++j4) { const f32x4 dc = *(const LAS f32x4*)(L + j4 * 4), k = *(const LAS f32x4*)(L + 64 + j4 * 4), q = *(const LAS f32x4*)(L + 128 + j4 * 4);
#pragma unroll
                for (int qq = 0; qq < 4; ++qq) { const float ns = st[j4 * 4 + qq] * dc[qq] + k[qq] * v; st[j4 * 4 + qq] = ns; y += ns * q[qq]; }
                if ((j4 & 3) == 3) asm volatile("" ::: "memory"); }
            p->gla_o[(size_t)t * 512 + h * 128 + e] = y;
            asm volatile("s_waitcnt lgkmcnt(0)" ::: "memory");
        }
    }
}

DI void phase_scans(KParamsPtr p, LAS unsigned char* lds) { phase_scan_rwkv(p, lds); phase_scan_gla(p, lds); }

DI void phase_post(KParamsPtr p, int l, LAS unsigned char* lds, int wg_skip) {
    const int tid = TIDX(), lane = tid & 63, wave = tid >> 6;
    if (BIDX() < wg_skip) return;
    const int nw = (NBLK() - wg_skip) * 8;
    float ln_w[8], ln_b[8], r_k[8], gg[8];
    ld8f(p->rw_ln_w + l * 512 + lane * 8, ln_w); ld8f(p->rw_ln_b + l * 512 + lane * 8, ln_b); ld8f(p->rw_r_k + l * 512 + lane * 8, r_k); ld8f(p->gla_g + l * 512 + lane * 8, gg);
    for (int tb = (BIDX() - wg_skip) * 8 + wave; tb < T; tb += 2 * nw) {
        float y[2][8], rr[2][8], kk[2][8], vv[2][8], g4[2][8], ov[2][8], gr[2][8]; bool ok[2];
#pragma unroll
        for (int q = 0; q < 2; ++q) { const int t = tb + q * nw; ok[q] = t < T; const size_t o = (size_t)(ok[q] ? t : 0) * 512 + lane * 8;
            ld8f(p->rw_y + o, y[q]); ld8bf(p->rw_r + o, rr[q]); ld8bf(p->rw_k + o, kk[q]); ld8bf(p->rw_v + o, vv[q]); ld8bf(p->rw_g + o, g4[q]); ld8f(p->gla_o + o, ov[q]);
            ld8bf(p->P1 + (size_t)(ok[q] ? t : 0) * NP1P + C_GLA_R + lane * 8, gr[q]); }
#pragma unroll
        for (int q = 0; q < 2; ++q) { const size_t o = (size_t)(tb + q * nw) * 512 + lane * 8;
            float sm = 0.f, sb = 0.f, so = 0.f;
#pragma unroll
            for (int e = 0; e < 8; ++e) { sm += y[q][e]; sb += rr[q][e] * kk[q][e] * r_k[e]; so += ov[q][e] * ov[q][e]; }
#pragma unroll
            for (int m = 1; m <= 4; m <<= 1) { sm += __shfl_xor(sm, m); sb += __shfl_xor(sb, m); so += __shfl_xor(so, m); }
            so += __shfl_xor(so, 8);
            const float mean = sm * (1.0f / 64.0f);
            float sv = 0.f;
#pragma unroll
            for (int e = 0; e < 8; ++e) { y[q][e] -= mean; sv += y[q][e] * y[q][e]; }
#pragma unroll
            for (int m = 1; m <= 4; m <<= 1) sv += __shfl_xor(sv, m);
            const float rstd = rsqrtf(sv * (1.0f / 64.0f) + 64e-5f), rs = rsqrtf(so * (1.0f / 128.0f) + NORM_EPS);
            float o1[8], o2[8];
#pragma unroll
            for (int e = 0; e < 8; ++e) { o1[e] = ((y[q][e] * rstd * ln_w[e] + ln_b[e]) + sb * vv[q][e]) * g4[q][e] * ZRWKV;
                o2[e] = ov[q][e] * rs * gg[e] * (gr[q][e] * sigmoidf_(gr[q][e])) * ZGLA; }
            if (ok[q]) { *(u32x4*)(p->ys + (size_t)1 * T * 512 + o) = pack8bf(o1); *(u32x4*)(p->ys + (size_t)2 * T * 512 + o) = pack8bf(o2); } }
    }
}

DI void unpack8(const u32x4 w, float (&f)[8]) {
    f[0] = __uint_as_float(w.x << 16); f[1] = __uint_as_float(w.x & 0xffff0000u); f[2] = __uint_as_float(w.y << 16); f[3] = __uint_as_float(w.y & 0xffff0000u);
    f[4] = __uint_as_float(w.z << 16); f[5] = __uint_as_float(w.z & 0xffff0000u); f[6] = __uint_as_float(w.w << 16); f[7] = __uint_as_float(w.w & 0xffff0000u);
}
DI void phase_mergesum(const bf16_t* G, const bf16_t* part01, const bf16_t* part23, bf16_t* merged) {
    const size_t n8 = (size_t)T * 2048 / 8;
    for (size_t i = (size_t)BIDX() * 512 + TIDX(); i < n8; i += (size_t)NBLK() * 512) {
        const size_t t = i >> 8, c = (i & 255) * 8;
        float acc[8] = {0.f, 0.f, 0.f, 0.f, 0.f, 0.f, 0.f, 0.f};
#pragma unroll
        for (int br = 0; br < 4; ++br) {
            const u32x4 gw = *(const u32x4*)(G + t * NGATE + br * 2048 + c);
            const u32x4 pw = *(const u32x4*)((br < 2 ? part01 : part23) + (size_t)(br & 1) * T * 2048 + t * 2048 + c);
            float g[8], q[8]; unpack8(gw, g); unpack8(pw, q);
#pragma unroll
            for (int j = 0; j < 8; ++j) acc[j] += g[j] * q[j];
        }
        u32x4 w; w.x = pk2(acc[0], acc[1]); w.y = pk2(acc[2], acc[3]); w.z = pk2(acc[4], acc[5]); w.w = pk2(acc[6], acc[7]);
        *(u32x4*)(merged + t * 2048 + c) = w;
    }
}
#ifndef ZSLC
#define ZSLC 1.0f
#endif
#ifndef ZWIN
#define ZWIN 1.0f
#endif
#ifndef ZCMP
#define ZCMP 1.0f
#endif
#ifndef ZMLA
#define ZMLA 1.0f
#endif
typedef short v4i16_t_ __attribute__((ext_vector_type(4)));
template <int DQ, int NDV = 4> struct FlashGeo {
    static constexpr int KS = DQ * 2 + 32;
    static constexpr int VS = 160;
    static constexpr int KBYTES = 64 * KS, VBYTES = 64 * VS, BUF = KBYTES + VBYTES;
};
template <int NDV> struct FlashAccT { f32x4 O[2][NDV]; float m[2], l[2]; };
typedef FlashAccT<4> FlashAcc;
template <int NDV> DI void flash_reset(FlashAccT<NDV>& a) {
#pragma unroll
    for (int rg = 0; rg < 2; ++rg) { a.m[rg] = -1e30f; a.l[rg] = 0.f;
#pragma unroll
        for (int d = 0; d < NDV; ++d) a.O[rg][d] = (f32x4){0.f, 0.f, 0.f, 0.f}; }
}
template <int DQ> struct FlashStage { u32x4 k, k2, v; };
template <int DQ, class KRow, class PRow, class VRow>
DI void flash_stage_load(FlashStage<DQ>& st, int tid, KRow krow, PRow prow, VRow vrow) {
    int r = tid >> 3, c = tid & 7;
    asm volatile("" : "+v"(r), "+v"(c));
    st.k = *(const u32x4*)(krow(r) + c * 8);
    if (DQ == 96) { if (c < 4) st.k2 = *(const u32x4*)(prow(r) + c * 8); }
    st.v = *(const u32x4*)(vrow(r) + c * 8);
}
template <int DQ>
DI void flash_stage_write(const FlashStage<DQ>& st, int tid, LAS unsigned char* buf) {
    typedef FlashGeo<DQ> G;
    const int r = tid >> 3, c = tid & 7;
    *(LAS u32x4*)(buf + r * G::KS + c * 16) = st.k;
    if (DQ == 96) { if (c < 4) *(LAS u32x4*)(buf + r * G::KS + 128 + c * 16) = st.k2; }
    *(LAS u32x4*)(buf + G::KBYTES + r * G::VS + c * 16) = st.v;
}
#ifndef FLASH_FENCE
#define FLASH_FENCE 1
#endif
template <int DQ, int NDV, int MODE, class Mask>
DI void flash_tile_n(LAS const unsigned char* buf, const bf16x8 (&Q)[2][DQ / 32], FlashAccT<NDV>& a, float sc2, int lane, Mask mask) {
    typedef FlashGeo<DQ, NDV> G;
    const int fr = lane & 15, q4 = lane >> 4;
    f32x4 S[2][4];
#pragma unroll
    for (int rg = 0; rg < 2; ++rg)
#pragma unroll
        for (int kb = 0; kb < 4; ++kb) S[rg][kb] = (f32x4){0.f, 0.f, 0.f, 0.f};
#pragma unroll
    for (int kb = 0; kb < 4; ++kb)
#pragma unroll
        for (int ks = 0; ks < DQ / 32; ++ks) {
            const bf16x8 kf = *(const LAS bf16x8*)(buf + (kb * 16 + fr) * G::KS + (ks * 32 + q4 * 8) * 2);
#pragma unroll
            for (int rg = 0; rg < 2; ++rg) S[rg][kb] = __builtin_amdgcn_mfma_f32_16x16x32_bf16(kf, Q[rg][ks], S[rg][kb], 0, 0, 0);
            if (FLASH_FENCE && DQ == 64 && ks == DQ / 32 - 1 && (kb & 1)) asm volatile("" ::: "memory");
        }
    bf16x8 P[2][2];
#pragma unroll
    for (int rg = 0; rg < 2; ++rg) {
        constexpr bool FULL = (MODE == 1);
        float mx = -1e30f; unsigned okm = 0u; const bool rowok = (MODE == 2) ? mask(rg, 0) : true;
        if (FULL || MODE == 2) {
#pragma unroll
            for (int kb = 0; kb < 4; ++kb) mx = fmaxf(mx, fmaxf(fmaxf(S[rg][kb][0], S[rg][kb][1]), fmaxf(S[rg][kb][2], S[rg][kb][3])));
            if (MODE == 2) mx = rowok ? mx : -1e30f;
        } else {
#pragma unroll
        for (int kb = 0; kb < 4; ++kb)
#pragma unroll
            for (int j = 0; j < 4; ++j) { const bool ok = mask(rg, kb * 16 + q4 * 4 + j); okm |= ok ? (1u << (kb * 4 + j)) : 0u;
                const float sv = ok ? S[rg][kb][j] : -1e30f; S[rg][kb][j] = sv; mx = fmaxf(mx, sv); }
        }
        { auto r16 = __builtin_amdgcn_permlane16_swap(__float_as_uint(mx), __float_as_uint(mx), false, false); mx = fmaxf(__uint_as_float(r16[0]), __uint_as_float(r16[1]));
          auto r32 = __builtin_amdgcn_permlane32_swap(__float_as_uint(mx), __float_as_uint(mx), false, false); mx = fmaxf(__uint_as_float(r32[0]), __uint_as_float(r32[1])); }
        mx = fmaxf(mx * sc2, -1e30f);
        const float mo = a.m[rg]; const bool mv = mx > mo + 8.0f; const float mn = mv ? mx : mo;
        a.m[rg] = mn;
        if (__builtin_amdgcn_ballot_w64(mv) != 0ull) { const float corr = __builtin_amdgcn_exp2f(mo - mn);
            a.l[rg] *= corr;
#pragma unroll
            for (int d = 0; d < NDV; ++d) a.O[rg][d] *= corr; }
        float ps = 0.f;
#pragma unroll
        for (int kb = 0; kb < 4; ++kb)
#pragma unroll
            for (int j = 0; j < 4; ++j) { const float pv = (FULL || (MODE == 2 ? rowok : (bool)((okm >> (kb * 4 + j)) & 1u))) ? __builtin_amdgcn_exp2f(__builtin_fmaf(S[rg][kb][j], sc2, -mn)) : 0.f; S[rg][kb][j] = pv; ps += pv; }
        a.l[rg] += ps;
#pragma unroll
        for (int pb = 0; pb < 2; ++pb) { u32x4 w;
            w.x = cvt_pk_bf16(S[rg][2 * pb][0], S[rg][2 * pb][1]); w.y = cvt_pk_bf16(S[rg][2 * pb][2], S[rg][2 * pb][3]);
            w.z = cvt_pk_bf16(S[rg][2 * pb + 1][0], S[rg][2 * pb + 1][1]); w.w = cvt_pk_bf16(S[rg][2 * pb + 1][2], S[rg][2 * pb + 1][3]);
            P[rg][pb] = __builtin_bit_cast(bf16x8, w); }
    }
    LAS const unsigned char* vt = buf + G::KBYTES;
#pragma unroll
    for (int pb = 0; pb < 2; ++pb)
#pragma unroll
        for (int dvb = 0; dvb < NDV; ++dvb) {
            LAS const unsigned char* vl = vt + (4 * q4 + (fr >> 2)) * G::VS + (fr & 3) * 8;
            const u32x2 lo = __builtin_bit_cast(u32x2, __builtin_amdgcn_ds_read_tr16_b64_v4i16((LAS v4i16_t_*)(vl + (32 * pb) * G::VS + dvb * 32)));
            const u32x2 hi = __builtin_bit_cast(u32x2, __builtin_amdgcn_ds_read_tr16_b64_v4i16((LAS v4i16_t_*)(vl + (32 * pb + 16) * G::VS + dvb * 32)));
            const u32x4 w = (u32x4){lo.x, lo.y, hi.x, hi.y};
            const bf16x8 vf = __builtin_bit_cast(bf16x8, w);
#pragma unroll
            for (int rg = 0; rg < 2; ++rg) a.O[rg][dvb] = __builtin_amdgcn_mfma_f32_16x16x32_bf16(vf, P[rg][pb], a.O[rg][dvb], 0, 0, 0);
        }
}
template <int DQ, class Mask>
DI void flash_tile(LAS const unsigned char* buf, const bf16x8 (&Q)[2][DQ / 32], FlashAcc& a, float sc2, int lane, Mask mask) { flash_tile_n<DQ, 4, 0>(buf, Q, a, sc2, lane, mask); }
template <int DQ>
DI void flash_tile_full(LAS const unsigned char* buf, const bf16x8 (&Q)[2][DQ / 32], FlashAcc& a, float sc2, int lane) { flash_tile_n<DQ, 4, 1>(buf, Q, a, sc2, lane, [](int, int) { return true; }); }
template <int DQ, class Mask>
DI void flash_tile_row(LAS const unsigned char* buf, const bf16x8 (&Q)[2][DQ / 32], FlashAcc& a, float sc2, int lane, Mask mask) { flash_tile_n<DQ, 4, 2>(buf, Q, a, sc2, lane, mask); }
DI float flash_lsum(float l) { l += __shfl_xor(l, 16); l += __shfl_xor(l, 32); return l; }

DI void bf8_to_f(const u32x4 w, f32x4& a, f32x4& b);
DI void phase_mla_flash(KParamsPtr p, LAS unsigned char* lds) {
    typedef FlashGeo<96> G;
    const int tid = TIDX(), lane = tid & 63, wave = __builtin_amdgcn_readfirstlane(tid >> 6), fr = lane & 15, q4 = lane >> 4;
    const float sc2 = 0.10206207261596577f * 1.4426950408889634f;
    const bf16_t* mq = p->mla_q; const bf16_t* mkv = p->mla_kv; const bf16_t* mpe = p->mla_kpe; bf16_t* yo = p->ys + (size_t)3 * T * 512;
    for (int c0 = BIDX(); c0 < 256; c0 += NBLK()) {
        const int c = NBLK() == 256 ? ((c0 & 7) * 32 + (c0 >> 3)) : c0;
        const int bh = c >> 3, b = bh >> 3, h = bh & 7;
#pragma unroll 1
        for (int half = 0; half < 2; ++half) {
            const int qt = half ? 15 - (c & 7) : (c & 7), q0 = qt * 256;
            const int tok0 = q0 + wave * 32 + fr;
            bf16x8 Q[2][3];
#pragma unroll
            for (int rg = 0; rg < 2; ++rg)
#pragma unroll
                for (int ks = 0; ks < 3; ++ks) Q[rg][ks] = *(const bf16x8*)(mq + (size_t)(b * SEQ + tok0 + rg * 16) * 768 + h * 96 + ks * 32 + q4 * 8);
#pragma unroll
            for (int rg = 0; rg < 2; ++rg) {
                const u32x4 mine = __builtin_bit_cast(u32x4, Q[rg][2]);
                u32x4 oth; oth.x = (unsigned)__shfl_xor((int)mine.x, 32); oth.y = (unsigned)__shfl_xor((int)mine.y, 32); oth.z = (unsigned)__shfl_xor((int)mine.z, 32); oth.w = (unsigned)__shfl_xor((int)mine.w, 32);
                f32x4 ma, mb, oa, ob; bf8_to_f(mine, ma, mb); bf8_to_f(oth, oa, ob);
                const size_t ti = (size_t)(tok0 + rg * 16) * 16 + (q4 & 1) * 8;
                const f32x4 ca = *(const f32x4*)(p->cos32 + ti), cb = *(const f32x4*)(p->cos32 + ti + 4), sa = *(const f32x4*)(p->sin32 + ti), sb = *(const f32x4*)(p->sin32 + ti + 4);
                const float sg = q4 < 2 ? -1.0f : 1.0f;
                const f32x4 ra = ma * ca + oa * sa * sg, rb = mb * cb + ob * sb * sg;
                u32x4 w; w.x = cvt_pk_bf16(ra[0], ra[1]); w.y = cvt_pk_bf16(ra[2], ra[3]); w.z = cvt_pk_bf16(rb[0], rb[1]); w.w = cvt_pk_bf16(rb[2], rb[3]);
                Q[rg][2] = __builtin_bit_cast(bf16x8, w); }
            FlashAcc a; flash_reset(a);
            const int nt = (q0 + 256) / 64;
            const bf16_t* kvb = mkv + (size_t)b * SEQ * 1024 + h * 128; const bf16_t* peb = mpe + (size_t)b * SEQ * 32;
            FlashStage<96> st;
            flash_stage_load<96>(st, tid, [&](int r) { return kvb + (size_t)r * 1024; }, [&](int r) { return peb + (size_t)r * 32; }, [&](int r) { return kvb + (size_t)r * 1024 + 64; });
            __syncthreads();
            flash_stage_write<96>(st, tid, lds);
            __syncthreads();
            for (int i = 0; i < nt; ++i) {
                const int k0 = i * 64;
                if (i + 1 < nt) flash_stage_load<96>(st, tid, [&](int r) { return kvb + (size_t)(k0 + 64 + r) * 1024; }, [&](int r) { return peb + (size_t)(k0 + 64 + r) * 32; }, [&](int r) { return kvb + (size_t)(k0 + 64 + r) * 1024 + 64; });
                if (k0 <= q0 + wave * 32 + 31) {
                    int d0 = tok0 - k0, d1 = tok0 - k0 + 16;
                    asm volatile("" : "+v"(d0), "+v"(d1));
                    if (k0 + 63 <= q0 + wave * 32) flash_tile_full<96>(lds + (i & 1) * G::BUF, Q, a, sc2, lane);
                    else flash_tile<96>(lds + (i & 1) * G::BUF, Q, a, sc2, lane, [&](int rg, int kidx) { return kidx <= (rg ? d1 : d0); });
                }
                if (i + 1 < nt) flash_stage_write<96>(st, tid, lds + ((i + 1) & 1) * G::BUF);
                __syncthreads();
            }
#pragma unroll
            for (int rg = 0; rg < 2; ++rg) { const float inv = 1.0f / flash_lsum(a.l[rg]);
                bf16_t* op = yo + (size_t)(b * SEQ + tok0 + rg * 16) * 512 + h * 64 + q4 * 4;
#pragma unroll
                for (int d = 0; d < 4; ++d) { u32x2 w; w.x = cvt_pk_bf16(a.O[rg][d][0] * inv * ZMLA, a.O[rg][d][1] * inv * ZMLA); w.y = cvt_pk_bf16(a.O[rg][d][2] * inv * ZMLA, a.O[rg][d][3] * inv * ZMLA);
                    *(u32x2*)(op + d * 16) = w; } }
        }
    }
}

DI void phase_nsa_flash(KParamsPtr p, LAS unsigned char* lds) {
    typedef FlashGeo<64> G;
    const int tid = TIDX(), lane = tid & 63, wave = __builtin_amdgcn_readfirstlane(tid >> 6), fr = lane & 15, q4 = lane >> 4;
    const float sc2 = 0.125f * 1.4426950408889634f;
    LAS unsigned* um = (LAS unsigned*)(lds + 2 * G::BUF);
    const bf16_t* nq = p->nsa_q; const unsigned long long* selp = p->nsa_sel; const float* gat = p->nsa_gate; const float* ocmp = p->nsa_ocmp; bf16_t* yo = p->ys;
    for (int c = BIDX(); c < 256; c += NBLK()) {
        const int bh = c >> 5, b = bh >> 1, hk = bh & 1;
        const bf16_t* Ks = p->nsa_ks + (size_t)bh * SEQ * 64; const bf16_t* Vs = p->nsa_vs + (size_t)bh * SEQ * 64;
        const bf16_t* Kw = p->nsa_kw + (size_t)bh * SEQ * 64; const bf16_t* Vw = p->nsa_vw + (size_t)bh * SEQ * 64;
#pragma unroll 1
        for (int half = 0; half < 2; ++half) {
            const int cur = half ? 63 - (c & 31) : (c & 31), s0 = cur * 64, g = wave >> 1, head = hk * 4 + g;
            const int qi0 = (wave & 1) * 32 + fr;
            const size_t t0 = (size_t)b * SEQ + s0 + qi0;
            bf16x8 Q[2][2];
#pragma unroll
            for (int rg = 0; rg < 2; ++rg)
#pragma unroll
                for (int ks = 0; ks < 2; ++ks) Q[rg][ks] = *(const bf16x8*)(nq + (t0 + rg * 16) * 512 + head * 64 + ks * 32 + q4 * 8);
            unsigned long long sel[2];
#pragma unroll
            for (int rg = 0; rg < 2; ++rg) sel[rg] = selp[(size_t)bh * SEQ + s0 + qi0 + rg * 16];
            if (wave == 0) {
                unsigned long long u = selp[(size_t)bh * SEQ + s0 + lane];
                unsigned lo = (unsigned)u, hi = (unsigned)(u >> 32);
#pragma unroll
                for (int o = 32; o >= 1; o >>= 1) { lo |= (unsigned)__shfl_xor((int)lo, o); hi |= (unsigned)__shfl_xor((int)hi, o); }
                if (lane == 0) { um[0] = lo; um[1] = hi; }
            }
            __syncthreads();
            unsigned long long uni = ((unsigned long long)um[1] << 32) | um[0];
            uni &= (cur >= 63) ? ~0ull : ((1ull << (cur + 1)) - 1ull);
            uni = ((unsigned long long)(unsigned)__builtin_amdgcn_readfirstlane((int)(uni >> 32)) << 32) | (unsigned)__builtin_amdgcn_readfirstlane((int)uni);
            float res[2][4][4];
            {
                FlashAcc a; flash_reset(a);
                FlashStage<64> st;
                unsigned long long rem = uni;
                int j = __builtin_ctzll(rem); rem &= rem - 1;
                flash_stage_load<64>(st, tid, [&](int r) { return Ks + (size_t)(j * 64 + r) * 64; }, [&](int r) { return Ks; }, [&](int r) { return Vs + (size_t)(j * 64 + r) * 64; });
                flash_stage_write<64>(st, tid, lds);
                __syncthreads();
                int i = 0;
                for (;;) {
                    const bool more = rem != 0ull;
                    int jn = 0;
                    if (more) { jn = __builtin_ctzll(rem); rem &= rem - 1;
                        flash_stage_load<64>(st, tid, [&](int r) { return Ks + (size_t)(jn * 64 + r) * 64; }, [&](int r) { return Ks; }, [&](int r) { return Vs + (size_t)(jn * 64 + r) * 64; }); }
                    { const bool diag = (j == cur);
                      const bool in0 = (sel[0] >> j) & 1ull, in1 = (sel[1] >> j) & 1ull;
                      int l0 = in0 ? (diag ? qi0 : 64) : -1, l1 = in1 ? (diag ? qi0 + 16 : 64) : -1;
                      asm volatile("" : "+v"(l0), "+v"(l1));
                      if (diag) flash_tile<64>(lds + (i & 1) * G::BUF, Q, a, sc2, lane, [&](int rg, int kidx) { return kidx <= (rg ? l1 : l0); });
                      else flash_tile_row<64>(lds + (i & 1) * G::BUF, Q, a, sc2, lane, [&](int rg, int) { return (rg ? l1 : l0) >= 0; }); }
                    if (more) flash_stage_write<64>(st, tid, lds + ((i + 1) & 1) * G::BUF);
                    __syncthreads();
                    if (!more) break;
                    j = jn; ++i;
                }
#pragma unroll
                for (int rg = 0; rg < 2; ++rg) { const float gt = gat[(t0 + rg * 16) * 24 + head * 3 + 1] / flash_lsum(a.l[rg]);
#pragma unroll
                    for (int d = 0; d < 4; ++d)
#pragma unroll
                        for (int e = 0; e < 4; ++e) res[rg][d][e] = a.O[rg][d][e] * gt * ZSLC; }
            }
            {
                FlashAcc a; flash_reset(a);
                FlashStage<64> st;
                const int jlo = cur >= 8 ? cur - 8 : 0;
                flash_stage_load<64>(st, tid, [&](int r) { return Kw + (size_t)(jlo * 64 + r) * 64; }, [&](int r) { return Kw; }, [&](int r) { return Vw + (size_t)(jlo * 64 + r) * 64; });
                flash_stage_write<64>(st, tid, lds);
                __syncthreads();
                for (int j = jlo, i = 0; j <= cur; ++j, ++i) {
                    if (j < cur) flash_stage_load<64>(st, tid, [&](int r) { return Kw + (size_t)((j + 1) * 64 + r) * 64; }, [&](int r) { return Kw; }, [&](int r) { return Vw + (size_t)((j + 1) * 64 + r) * 64; });
                    { const bool diag = (j == cur), tail = (j == cur - 8);
                      int h0 = diag ? qi0 : 64, h1 = diag ? qi0 + 16 : 64, t0_ = tail ? qi0 : -1, t1_ = tail ? qi0 + 16 : -1;
                      asm volatile("" : "+v"(h0), "+v"(h1), "+v"(t0_), "+v"(t1_));
                      flash_tile<64>(lds + (i & 1) * G::BUF, Q, a, sc2, lane, [&](int rg, int kidx) { return kidx <= (rg ? h1 : h0) && kidx > (rg ? t1_ : t0_); }); }
                    if (j < cur) flash_stage_write<64>(st, tid, lds + ((i + 1) & 1) * G::BUF);
                    __syncthreads();
                }
#pragma unroll
                for (int rg = 0; rg < 2; ++rg) { const float gt = gat[(t0 + rg * 16) * 24 + head * 3 + 2] / flash_lsum(a.l[rg]);
#pragma unroll
                    for (int d = 0; d < 4; ++d)
#pragma unroll
                        for (int e = 0; e < 4; ++e) res[rg][d][e] += a.O[rg][d][e] * gt * ZWIN; }
            }
#pragma unroll
            for (int rg = 0; rg < 2; ++rg) { const float g0 = gat[(t0 + rg * 16) * 24 + head * 3] * ZCMP;
                const size_t ob = (t0 + rg * 16) * 512 + head * 64 + q4 * 4;
#pragma unroll
                for (int d = 0; d < 4; ++d) { const f32x4 oc = *(const f32x4*)(ocmp + ob + d * 16);
                    u32x2 w; w.x = cvt_pk_bf16(res[rg][d][0] + g0 * oc[0], res[rg][d][1] + g0 * oc[1]); w.y = cvt_pk_bf16(res[rg][d][2] + g0 * oc[2], res[rg][d][3] + g0 * oc[3]);
                    *(u32x2*)(yo + ob + d * 16) = w; } }
            __syncthreads();
        }
    }
}

DI void phase_nsa_full(KParamsPtr p, LAS unsigned char* lds) {
    typedef FlashGeo<64> G;
    const int tid = TIDX(), lane = tid & 63, wave = __builtin_amdgcn_readfirstlane(tid >> 6), fr = lane & 15, q4 = lane >> 4;
    const float sc2 = 0.125f * 1.4426950408889634f;
    LAS float* impbuf = (LAS float*)(lds + 2 * G::BUF);
    LAS unsigned long long* selbuf = (LAS unsigned long long*)(lds + 2 * G::BUF + 65536);
    LAS unsigned* um = (LAS unsigned*)(lds + 2 * G::BUF + 65536 + 512);
    const float* kcp = p->nsa_kc; const float* vcp = p->nsa_vc;
    LAS float* rs = impbuf + tid;
    const bf16_t* nq = p->nsa_q; const float* gat = p->nsa_gate; bf16_t* yo = p->ys;
    for (int c0 = BIDX(); c0 < 256; c0 += NBLK()) {
        const int c = NBLK() == 256 ? ((c0 & 7) * 32 + (c0 >> 3)) : c0;
        const int bh = c >> 5, b = bh >> 1, hk = bh & 1;
        const bf16_t* Ks = p->nsa_ks + (size_t)bh * SEQ * 64; const bf16_t* Vs = p->nsa_vs + (size_t)bh * SEQ * 64;
        const bf16_t* Kw = p->nsa_kw + (size_t)bh * SEQ * 64; const bf16_t* Vw = p->nsa_vw + (size_t)bh * SEQ * 64;
#pragma unroll 1
        for (int half = 0; half < 2; ++half) {
            const int cur = half ? 63 - (c & 31) : (c & 31), s0 = cur * 64, g = wave >> 1, head = hk * 4 + g;
            const int qi0 = (wave & 1) * 32 + fr;
            const size_t t0 = (size_t)b * SEQ + s0 + qi0;
            int q4l = q4; asm volatile("" : "+v"(q4l));
            bf16x8 Q[2][2];
#pragma unroll
            for (int rg = 0; rg < 2; ++rg)
#pragma unroll
                for (int ks = 0; ks < 2; ++ks) Q[rg][ks] = *(const bf16x8*)(nq + (t0 + rg * 16) * 512 + head * 64 + ks * 32 + q4l * 8);
            unsigned long long sel[2];
            {
                const int nvmax = min(255, (s0 + 32) / 16 + 1), ntc = (nvmax + 63) >> 6;
                int nv[2];
#pragma unroll
                for (int rg = 0; rg < 2; ++rg) { const int tk = s0 + qi0 + rg * 16; nv[rg] = tk >= 31 ? min(255, (tk - 31) / 16 + 1) : 0; }
#pragma unroll 1
                for (int it = 0; it < 2; ++it) { const int pz = 1 - it;
                    FlashAcc a0; flash_reset(a0);
                    u32x4 sk, sv;
                    auto ld0 = [&](int tl) { int r = tid >> 3, c8 = tid & 7; asm volatile("" : "+v"(r), "+v"(c8)); const size_t o = ((size_t)bh * 256 + tl * 64 + r) * 64 + c8 * 8;
                        const f32x4 k0 = *(const f32x4*)(kcp + o), k1 = *(const f32x4*)(kcp + o + 4);
                        sk = (u32x4){cvt_pk_bf16(k0[0], k0[1]), cvt_pk_bf16(k0[2], k0[3]), cvt_pk_bf16(k1[0], k1[1]), cvt_pk_bf16(k1[2], k1[3])};
                        if (pz == 0) { const f32x4 v0 = *(const f32x4*)(vcp + o), v1 = *(const f32x4*)(vcp + o + 4);
                            sv = (u32x4){cvt_pk_bf16(v0[0], v0[1]), cvt_pk_bf16(v0[2], v0[3]), cvt_pk_bf16(v1[0], v1[1]), cvt_pk_bf16(v1[2], v1[3])}; }
                        else { int n = tl * 64 + r; asm volatile("" : "+v"(n)); unsigned w[4];
#pragma unroll
                            for (int e2 = 0; e2 < 4; ++e2) { const int J0 = c8 * 8 + 2 * e2, J1 = J0 + 1;
                                const unsigned lo = (n >= 4 * J0 - 1 && n <= 4 * J0 + 3 && n < 255) ? 0x3F80u : 0u, hi = (n >= 4 * J1 - 1 && n <= 4 * J1 + 3 && n < 255) ? 0x3F80u : 0u; w[e2] = lo | (hi << 16); }
                            sv = (u32x4){w[0], w[1], w[2], w[3]}; } };
                    FlashStage<64> st0;
                    ld0(0); st0.k = sk; st0.v = sv;
                    flash_stage_write<64>(st0, tid, lds);
                    __syncthreads();
                    for (int tl = 0; tl < ntc; ++tl) {
                        if (tl + 1 < ntc) { ld0(tl + 1); st0.k = sk; st0.v = sv; }
                        { int n0 = nv[0] - tl * 64, n1 = nv[1] - tl * 64;
                          asm volatile("" : "+v"(n0), "+v"(n1));
                          flash_tile<64>(lds + (tl & 1) * G::BUF, Q, a0, sc2, lane, [&](int rg, int kidx) { return kidx < (rg ? n1 : n0); }); }
                        if (tl + 1 < ntc) flash_stage_write<64>(st0, tid, lds + ((tl + 1) & 1) * G::BUF);
                        __syncthreads();
                    }
#pragma unroll
                    for (int rg = 0; rg < 2; ++rg) { const float lt = flash_lsum(a0.l[rg]), inv = lt > 0.f ? 1.0f / lt : 0.f;
                        if (pz == 0) { const float g0 = gat[(t0 + rg * 16) * 24 + head * 3] * inv * ZCMP;
#pragma unroll
                            for (int d = 0; d < 4; ++d)
#pragma unroll
                                for (int e = 0; e < 4; ++e) rs[((rg * 4 + d) * 4 + e) * 512] = a0.O[rg][d][e] * g0; }
                        else {
#pragma unroll
                            for (int d = 0; d < 4; ++d) *(LAS f32x4*)(impbuf + ((size_t)(g * 64 + qi0 + rg * 16)) * 64 + d * 16 + q4 * 4) = a0.O[rg][d] * inv; } }
                    if (it == 0) {
            __syncthreads();
            for (int k = 0; k < 8; ++k) { const int tokl = wave * 8 + k;
                const float im = (impbuf[(0 * 64 + tokl) * 64 + lane] + impbuf[(1 * 64 + tokl) * 64 + lane]) + (impbuf[(2 * 64 + tokl) * 64 + lane] + impbuf[(3 * 64 + tokl) * 64 + lane]);
                const bool valid = lane <= cur, forced = valid && (lane == 0 || lane >= cur - 1);
                const float val = forced ? 1e30f : (valid ? im : -1e30f);
                int rank = 0;
                for (int jj = 0; jj < 64; ++jj) { const float o = __shfl(val, jj); rank += (o > val || (o == val && jj < lane)) ? 1 : 0; }
                const unsigned long long mk = __ballot(rank < 16);
                if (lane == 0) selbuf[tokl] = mk; }
            __syncthreads();
#pragma unroll
            for (int rg = 0; rg < 2; ++rg) sel[rg] = selbuf[qi0 + rg * 16];
            if (wave == 0) {
                unsigned long long u = selbuf[lane];
                unsigned lo = (unsigned)u, hi = (unsigned)(u >> 32);
#pragma unroll
                for (int o = 32; o >= 1; o >>= 1) { lo |= (unsigned)__shfl_xor((int)lo, o); hi |= (unsigned)__shfl_xor((int)hi, o); }
                if (lane == 0) { um[0] = lo; um[1] = hi; }
            }
            __syncthreads();
                    }
                }
            }
            __syncthreads();
            unsigned long long uni = ((unsigned long long)um[1] << 32) | um[0];
            uni &= (cur >= 63) ? ~0ull : ((1ull << (cur + 1)) - 1ull);
            uni = ((unsigned long long)(unsigned)__builtin_amdgcn_readfirstlane((int)(uni >> 32)) << 32) | (unsigned)__builtin_amdgcn_readfirstlane((int)uni);
            FlashAcc a; flash_reset(a);
            {
                FlashStage<64> st;
                unsigned long long rem = uni & ~(1ull << cur);
                if (rem != 0ull) {
                    int j = __builtin_ctzll(rem); rem &= rem - 1;
                    flash_stage_load<64>(st, tid, [&](int r) { return Ks + (size_t)(j * 64 + r) * 64; }, [&](int r) { return Ks; }, [&](int r) { return Vs + (size_t)(j * 64 + r) * 64; });
                    flash_stage_write<64>(st, tid, lds);
                    __syncthreads();
                    int i = 0;
                    for (;;) {
                        const bool more = rem != 0ull;
                        int jn = 0;
                        if (more) { jn = __builtin_ctzll(rem); rem &= rem - 1;
                            flash_stage_load<64>(st, tid, [&](int r) { return Ks + (size_t)(jn * 64 + r) * 64; }, [&](int r) { return Ks; }, [&](int r) { return Vs + (size_t)(jn * 64 + r) * 64; }); }
                        { int l0 = (int)((sel[0] >> j) & 1ull), l1 = (int)((sel[1] >> j) & 1ull);
                          asm volatile("" : "+v"(l0), "+v"(l1));
                          flash_tile_row<64>(lds + (i & 1) * G::BUF, Q, a, sc2, lane, [&](int rg, int) { return (rg ? l1 : l0) != 0; }); }
                        if (more) flash_stage_write<64>(st, tid, lds + ((i + 1) & 1) * G::BUF);
                        __syncthreads();
                        if (!more) break;
                        j = jn; ++i;
                    }
                }
            }
            {
                FlashStage<64> st;
                const int jlo = cur >= 8 ? cur - 8 : 0, ntw = cur - jlo + 1;
                flash_stage_load<64>(st, tid, [&](int r) { return Ks + (size_t)(cur * 64 + r) * 64; }, [&](int r) { return Ks; }, [&](int r) { return Vs + (size_t)(cur * 64 + r) * 64; });
                flash_stage_write<64>(st, tid, lds);
                __syncthreads();
                for (int i2 = 0; i2 <= ntw; ++i2) {
                    if (i2 < ntw) { const int jn = jlo + i2;
                        flash_stage_load<64>(st, tid, [&](int r) { return Kw + (size_t)(jn * 64 + r) * 64; }, [&](int r) { return Kw; }, [&](int r) { return Vw + (size_t)(jn * 64 + r) * 64; }); }
                    { const int j = i2 == 0 ? cur : jlo + i2 - 1; const bool diag = (j == cur), tail = (i2 > 0 && j == cur - 8);
                      int h0 = diag ? qi0 : 64, h1 = diag ? qi0 + 16 : 64, t0_ = tail ? qi0 : -1, t1_ = tail ? qi0 + 16 : -1;
                      asm volatile("" : "+v"(h0), "+v"(h1), "+v"(t0_), "+v"(t1_));
                      if (diag || tail) flash_tile<64>(lds + (i2 & 1) * G::BUF, Q, a, sc2, lane, [&](int rg, int kidx) { return kidx <= (rg ? h1 : h0) && kidx > (rg ? t1_ : t0_); });
                      else flash_tile_row<64>(lds + (i2 & 1) * G::BUF, Q, a, sc2, lane, [&](int rg, int) { return (rg ? h1 : h0) > 0; }); }
                    if (i2 < ntw) flash_stage_write<64>(st, tid, lds + ((i2 + 1) & 1) * G::BUF);
                    __syncthreads();
                    if (i2 == 0) {
#pragma unroll
                        for (int rg = 0; rg < 2; ++rg) { const float gt = gat[(t0 + rg * 16) * 24 + head * 3 + 1] / flash_lsum(a.l[rg]);
#pragma unroll
                            for (int d = 0; d < 4; ++d)
#pragma unroll
                                for (int e = 0; e < 4; ++e) rs[((rg * 4 + d) * 4 + e) * 512] += a.O[rg][d][e] * gt * ZSLC; }
                        flash_reset(a); }
                }
#pragma unroll
                for (int rg = 0; rg < 2; ++rg) { const float gt = gat[(t0 + rg * 16) * 24 + head * 3 + 2] / flash_lsum(a.l[rg]);
#pragma unroll
                    for (int d = 0; d < 4; ++d)
#pragma unroll
                        for (int e = 0; e < 4; ++e) rs[((rg * 4 + d) * 4 + e) * 512] += a.O[rg][d][e] * gt * ZWIN; }
            }
#pragma unroll
            for (int rg = 0; rg < 2; ++rg) { const size_t ob = (t0 + rg * 16) * 512 + head * 64 + q4l * 4;
#pragma unroll
                for (int d = 0; d < 4; ++d) { u32x2 w; w.x = cvt_pk_bf16(rs[((rg * 4 + d) * 4 + 0) * 512], rs[((rg * 4 + d) * 4 + 1) * 512]); w.y = cvt_pk_bf16(rs[((rg * 4 + d) * 4 + 2) * 512], rs[((rg * 4 + d) * 4 + 3) * 512]);
                    *(u32x2*)(yo + ob + d * 16) = w; } }
            __syncthreads();
        }
    }
}
#define DPPF(x, ctrl) __int_as_float(__builtin_amdgcn_update_dpp(0, __float_as_int(x), ctrl, 0xF, 0xF, true))
DI float red16(float x) { x += DPPF(x, 0xB1); x += DPPF(x, 0x4E); x += DPPF(x, 0x141); x += DPPF(x, 0x140); return x; }
DI float dot4(const f32x4 a, const f32x4 b) { f32x2 t = (f32x2){a[0], a[1]} * (f32x2){b[0], b[1]}; t = (f32x2){a[2], a[3]} * (f32x2){b[2], b[3]} + t; return t[0] + t[1]; }
DI void bf8_to_f(const u32x4 w, f32x4& a, f32x4& b) {
    a = (f32x4){__uint_as_float(w.x << 16), __uint_as_float(w.x & 0xffff0000u), __uint_as_float(w.y << 16), __uint_as_float(w.y & 0xffff0000u)};
    b = (f32x4){__uint_as_float(w.z << 16), __uint_as_float(w.z & 0xffff0000u), __uint_as_float(w.w << 16), __uint_as_float(w.w & 0xffff0000u)};
}
template <int MODE>
DI void rowscan_unit(KParamsPtr p, LAS unsigned char* lds, int unit) {
    constexpr int TC = 32, NV = MODE == 0 ? 5 : 3;
    constexpr int NR = 32;
    constexpr int BUFF = NV * TC * 64 + TC * NR + TC * NR;
    const int tid = TIDX(), lane = tid & 63, wave = __builtin_amdgcn_readfirstlane(tid >> 6);
    LAS float* L = (LAS float*)lds;
    int b, h, sub;
    if (MODE == 0) { const int bh = unit >> 1; b = bh >> 3; h = bh & 7; sub = unit & 1; } else { const int bh = unit >> 2; b = bh >> 2; h = bh & 3; sub = unit & 3; }
    const size_t tb = (size_t)b * SEQ;
    f32x4 f0, f1, f2; u32x4 h0, hv;
    auto stage_load = [&](int t0) {
        const int s = tid >> 4, c4 = tid & 15, s2 = (tid & 255) >> 3, c8 = tid & 7;
        if (MODE == 0) {
            const size_t o = (tb + t0 + s) * 512 + h * 64 + c4 * 4;
            f0 = *(const f32x4*)(p->rw_kk + o); f1 = *(const f32x4*)(p->rw_w + o); f2 = *(const f32x4*)(p->rw_b + o);
            const size_t o2 = (tb + t0 + s2) * 512 + h * 64 + c8 * 8;
            h0 = *(const u32x4*)((tid < 256 ? p->rw_k : p->rw_r) + o2);
            if (tid < 128) hv = *(const u32x4*)(p->rw_v + (tb + t0 + (tid >> 2)) * 512 + h * 64 + sub * NR + (tid & 3) * 8);
        } else {
            f0 = *(const f32x4*)(p->gla_la + (tb + t0 + s) * 256 + h * 64 + c4 * 4);
            const bf16_t* row = p->P1 + (tb + t0 + s2) * NP1P;
            h0 = *(const u32x4*)(row + (tid < 256 ? C_GLA_K : C_GLA_Q) + h * 64 + c8 * 8);
            if (tid < 128) hv = *(const u32x4*)(p->P1 + (tb + t0 + (tid >> 2)) * NP1P + C_GLA_V + h * 128 + sub * NR + (tid & 3) * 8);
        }
    };
    auto stage_write = [&](int buf) {
        LAS float* B = L + buf * BUFF;
        const int s = tid >> 4, c4 = tid & 15, s2 = (tid & 255) >> 3, c8 = tid & 7;
        f32x4 a, c; bf8_to_f(h0, a, c);
        if (MODE == 0) {
            *(LAS f32x4*)(B + (0 * TC + s) * 64 + c4 * 4) = f0; *(LAS f32x4*)(B + (1 * TC + s) * 64 + c4 * 4) = f1; *(LAS f32x4*)(B + (3 * TC + s) * 64 + c4 * 4) = f2;
            LAS float* d = B + ((tid < 256 ? 2 : 4) * TC + s2) * 64 + c8 * 8;
            *(LAS f32x4*)d = a; *(LAS f32x4*)(d + 4) = c;
        } else {
            *(LAS f32x4*)(B + (0 * TC + s) * 64 + c4 * 4) = (f32x4){__expf(f0[0]), __expf(f0[1]), __expf(f0[2]), __expf(f0[3])};
            if (tid >= 256) { a *= 0.125f; c *= 0.125f; }
            LAS float* d = B + ((tid < 256 ? 1 : 2) * TC + s2) * 64 + c8 * 8;
            *(LAS f32x4*)d = a; *(LAS f32x4*)(d + 4) = c;
        }
        if (tid < 128) { f32x4 va, vc; bf8_to_f(hv, va, vc); LAS float* d = B + NV * TC * 64 + (tid >> 2) * NR + (tid & 3) * 8; *(LAS f32x4*)d = va; *(LAS f32x4*)(d + 4) = vc; }
    };
    auto flush_y = [&](int buf, int t0) {
        if (tid < TC * 8) { const int s = tid >> 3, q = tid & 7;
            const f32x4 v = *(const LAS f32x4*)(L + buf * BUFF + NV * TC * 64 + TC * NR + s * NR + q * 4);
            float* dst = (MODE == 0 ? p->rw_y + (tb + t0 + s) * 512 + h * 64 : p->gla_o + (tb + t0 + s) * 512 + h * 128) + sub * NR + q * 4;
            *(f32x4*)dst = v; }
    };
    const int row = wave * 4 + (lane >> 4), j = lane & 15;
    f32x4 st = (f32x4){0.f, 0.f, 0.f, 0.f};
    stage_load(0);
    __syncthreads();
    stage_write(0);
    __syncthreads();
    constexpr int NCH = SEQ / TC;
    for (int c = 0; c < NCH; ++c) {
        if (c + 1 < NCH) stage_load((c + 1) * TC);
        if (c > 0) flush_y((c - 1) & 1, (c - 1) * TC);
        {
            LAS const float* B = L + (c & 1) * BUFF;
            LAS float* Y = L + (c & 1) * BUFF + NV * TC * 64 + TC * NR;
#pragma unroll 1
            for (int s0 = 0; s0 < TC; s0 += 4) {
                float v[4]; f32x4 x0[4], x1[4], x2[4], x3[4], x4[4];
#pragma unroll
                for (int u = 0; u < 4; ++u) { const int s = s0 + u;
                    v[u] = B[NV * TC * 64 + s * NR + row];
                    x0[u] = *(const LAS f32x4*)(B + (0 * TC + s) * 64 + j * 4); x1[u] = *(const LAS f32x4*)(B + (1 * TC + s) * 64 + j * 4); x2[u] = *(const LAS f32x4*)(B + (2 * TC + s) * 64 + j * 4);
                    if (MODE == 0) { x3[u] = *(const LAS f32x4*)(B + (3 * TC + s) * 64 + j * 4); x4[u] = *(const LAS f32x4*)(B + (4 * TC + s) * 64 + j * 4); } }
#pragma unroll
                for (int u = 0; u < 4; ++u) { const int s = s0 + u;
                    if (MODE == 0) {
                        const float skk = red16(dot4(st, x0[u]));
                        st = st * x1[u] + (x2[u] * v[u] - x3[u] * skk);
                        const float y = red16(dot4(st, x4[u]));
                        Y[s * NR + row] = y;
                    } else {
                        st = st * x0[u] + x1[u] * v[u];
                        const float y = red16(dot4(st, x2[u]));
                        Y[s * NR + row] = y;
                    } }
            }
        }
        if (c + 1 < NCH) stage_write((c + 1) & 1);
        __syncthreads();
    }
    flush_y((NCH - 1) & 1, (NCH - 1) * TC);
    __syncthreads();
}
DI void phase_rowscans(KParamsPtr p, LAS unsigned char* lds) {
    for (int u = BIDX(); u < 128; u += NBLK()) { if (u < 64) rowscan_unit<0>(p, lds, u); else rowscan_unit<1>(p, lds, u - 64); }
}

template <int MODE>
DI void rowscan_half(KParamsPtr p, LAS float* L, int unit, int tl, int wl, int lane) {
    constexpr int TC = 16, NV = MODE == 0 ? 5 : 3, NR = 16;
    constexpr int BUFF = NV * TC * 64 + TC * NR + TC * NR;
    int b, h, sub;
    if (MODE == 0) { const int bh = unit >> 2; b = bh >> 3; h = bh & 7; sub = unit & 3; } else { const int bh = unit >> 3; b = bh >> 2; h = bh & 3; sub = unit & 7; }
    const size_t tb = (size_t)b * SEQ;
    f32x4 f0, f1, f2; u32x4 h0, hv;
    auto stage_load = [&](int t0) {
        const int s = tl >> 4, c4 = tl & 15, s2 = (tl & 127) >> 3, c8 = tl & 7;
        if (MODE == 0) {
            const size_t o = (tb + t0 + s) * 512 + h * 64 + c4 * 4;
            f0 = *(const f32x4*)(p->rw_kk + o); f1 = *(const f32x4*)(p->rw_w + o); f2 = *(const f32x4*)(p->rw_b + o);
            h0 = *(const u32x4*)((tl < 128 ? p->rw_k : p->rw_r) + (tb + t0 + s2) * 512 + h * 64 + c8 * 8);
            if (tl < 32) hv = *(const u32x4*)(p->rw_v + (tb + t0 + (tl >> 1)) * 512 + h * 64 + sub * NR + (tl & 1) * 8);
        } else {
            f0 = *(const f32x4*)(p->gla_la + (tb + t0 + s) * 256 + h * 64 + c4 * 4);
            h0 = *(const u32x4*)(p->P1 + (tb + t0 + s2) * NP1P + (tl < 128 ? C_GLA_K : C_GLA_Q) + h * 64 + c8 * 8);
            if (tl < 32) hv = *(const u32x4*)(p->P1 + (tb + t0 + (tl >> 1)) * NP1P + C_GLA_V + h * 128 + sub * NR + (tl & 1) * 8);
        }
    };
    auto stage_write = [&](int buf) {
        LAS float* B = L + buf * BUFF;
        const int s = tl >> 4, c4 = tl & 15, s2 = (tl & 127) >> 3, c8 = tl & 7;
        f32x4 a, c; bf8_to_f(h0, a, c);
        if (MODE == 0) {
            *(LAS f32x4*)(B + (0 * TC + s) * 64 + c4 * 4) = f0; *(LAS f32x4*)(B + (1 * TC + s) * 64 + c4 * 4) = f1; *(LAS f32x4*)(B + (3 * TC + s) * 64 + c4 * 4) = f2;
            LAS float* d = B + ((tl < 128 ? 2 : 4) * TC + s2) * 64 + c8 * 8; *(LAS f32x4*)d = a; *(LAS f32x4*)(d + 4) = c;
        } else {
            *(LAS f32x4*)(B + (0 * TC + s) * 64 + c4 * 4) = (f32x4){__expf(f0[0]), __expf(f0[1]), __expf(f0[2]), __expf(f0[3])};
            if (tl >= 128) { a *= 0.125f; c *= 0.125f; }
            LAS float* d = B + ((tl < 128 ? 1 : 2) * TC + s2) * 64 + c8 * 8; *(LAS f32x4*)d = a; *(LAS f32x4*)(d + 4) = c;
        }
        if (tl < 32) { f32x4 va, vc; bf8_to_f(hv, va, vc); LAS float* d = B + NV * TC * 64 + (tl >> 1) * NR + (tl & 1) * 8; *(LAS f32x4*)d = va; *(LAS f32x4*)(d + 4) = vc; }
    };
    auto flush_y = [&](int buf, int t0) {
        if (tl < TC * 4) { const int s = tl >> 2, q = tl & 3;
            const f32x4 v = *(const LAS f32x4*)(L + buf * BUFF + NV * TC * 64 + TC * NR + s * NR + q * 4);
            float* dst = (MODE == 0 ? p->rw_y + (tb + t0 + s) * 512 + h * 64 : p->gla_o + (tb + t0 + s) * 512 + h * 128) + sub * NR + q * 4;
            *(f32x4*)dst = v; }
    };
    const int row = wl * 4 + (lane >> 4), j = lane & 15;
    f32x4 st = (f32x4){0.f, 0.f, 0.f, 0.f};
    stage_load(0);
    __syncthreads();
    stage_write(0);
    __syncthreads();
    constexpr int NCH = SEQ / TC;
    for (int c = 0; c < NCH; ++c) {
        if (c + 1 < NCH) stage_load((c + 1) * TC);
        if (c > 0) flush_y((c - 1) & 1, (c - 1) * TC);
        LAS const float* B = L + (c & 1) * BUFF;
        LAS float* Y = L + (c & 1) * BUFF + NV * TC * 64 + TC * NR;
#pragma unroll 1
        for (int s0 = 0; s0 < TC; s0 += 4) {
            float v[4]; f32x4 x0[4], x1[4], x2[4], x3[4], x4[4];
#pragma unroll
            for (int u = 0; u < 4; ++u) { const int s = s0 + u;
                v[u] = B[NV * TC * 64 + s * NR + row];
                x0[u] = *(const LAS f32x4*)(B + (0 * TC + s) * 64 + j * 4); x1[u] = *(const LAS f32x4*)(B + (1 * TC + s) * 64 + j * 4); x2[u] = *(const LAS f32x4*)(B + (2 * TC + s) * 64 + j * 4);
                if (MODE == 0) { x3[u] = *(const LAS f32x4*)(B + (3 * TC + s) * 64 + j * 4); x4[u] = *(const LAS f32x4*)(B + (4 * TC + s) * 64 + j * 4); } }
#pragma unroll
            for (int u = 0; u < 4; ++u) { const int s = s0 + u;
                if (MODE == 0) { const float skk = red16(dot4(st, x0[u])); st = st * x1[u] + (x2[u] * v[u] - x3[u] * skk); Y[s * NR + row] = red16(dot4(st, x4[u])); }
                else { st = st * x0[u] + x1[u] * v[u]; Y[s * NR + row] = red16(dot4(st, x2[u])); } }
        }
        if (c + 1 < NCH) stage_write((c + 1) & 1);
        __syncthreads();
    }
    flush_y((NCH - 1) & 1, (NCH - 1) * TC);
    __syncthreads();
}
DI void phase_rowscans_paired(KParamsPtr p, LAS unsigned char* lds) {
    const int tid = TIDX(), lane = tid & 63, wave = __builtin_amdgcn_readfirstlane(tid >> 6);
    for (int u0 = BIDX(); u0 < 128; u0 += NBLK()) {
        const int u = NBLK() == 256 ? ((u0 & 7) * 16 + (u0 >> 3)) : u0;
        if (wave < 4) rowscan_half<0>(p, (LAS float*)lds, u, tid, wave, lane);
        else rowscan_half<1>(p, (LAS float*)(lds + 49152), u, tid - 256, wave - 4, lane);
    }
}
constexpr int LDS_BYTES = 147456;
constexpr int LDS_XB_OFF = 131072;

#ifndef REP_SETUP
#define REP_SETUP 1
#endif
#ifndef REP_CONV
#define REP_CONV 1
#endif
#ifndef REP_PREP
#define REP_PREP 1
#endif
#ifndef REP_CMPR
#define REP_CMPR 1
#endif
#ifndef REP_MLAUP
#define REP_MLAUP 1
#endif
#ifndef REP_NSACMP
#define REP_NSACMP 1
#endif
#ifndef REP_NSAF
#define REP_NSAF 1
#endif
#ifndef REP_MLAF
#define REP_MLAF 1
#endif
#ifndef REP_SCAN
#define REP_SCAN 1
#endif
#ifndef REP_POST
#define REP_POST 1
#endif
#ifndef REP_MSUM
#define REP_MSUM 1
#endif
#ifndef REP_NORM0
#define REP_NORM0 1
#endif
#ifndef REP_GATE
#define REP_GATE 1
#endif
#ifndef REP_MERGE
#define REP_MERGE 1
#endif
#ifndef REP_UP
#define REP_UP 1
#endif
#ifndef REP_DN
#define REP_DN 1
#endif
#ifndef REP_PROJ
#define REP_PROJ 1
#endif
#ifndef SCAN_GATE_UNITS
#define SCAN_GATE_UNITS 3
#endif
#define REPEAT(n) for (int r_ = 0; r_ < (n); ++r_)
__global__ void __launch_bounds__(512, 2) mega(Params p_arg, int ph_lo, int ph_hi) {
    extern __shared__ __attribute__((aligned(16))) unsigned char lds_raw[];
    LAS unsigned char* lds = (LAS unsigned char*)lds_raw;
    volatile LAS unsigned* xbw = (volatile LAS unsigned*)(lds + LDS_XB_OFF);
    if (threadIdx.x == 0) { xbw[0] = 0u; xbw[1] = 0u; xbw[2] = 0u; xbw[3] = 0u; }
    __syncthreads();
    XcdBarrier bar; bar.bar = p_arg.bar; bar.x = 0; bar.st = xbw;
    if (ph_hi - ph_lo > 1) bar = xcd_barrier_post(p_arg.bar, xbw);
    int ph = 0;
#define PHASE_BEGIN if (ph >= ph_lo && ph < ph_hi) { KParamsPtr p = (KParamsPtr)__builtin_amdgcn_kernarg_segment_ptr(); asm volatile("" : "+s"(p));
#define PHASE_END   __syncthreads(); if (ph + 1 < ph_hi) xcd_barrier(bar); } ++ph;

    PHASE_BEGIN REPEAT(REP_SETUP) { phase_setup(p, lds); __syncthreads(); } REPEAT(REP_CONV) { phase_convert(p, 0, lds); __syncthreads(); } PHASE_END
    PHASE_BEGIN REPEAT(REP_NORM0) phase_norm<false, true>(p->x, nullptr, nullptr, p->u, nullptr, nullptr, 0.f, p->pre_g, p->mod); PHASE_END

    { constexpr int l = 0;

#define modA (p->mod + (size_t)(l * 3 + 0) * 4 * 6144)
#define modB (p->mod + (size_t)(l * 3 + 1) * 4 * 6144)
#define modC (p->mod + (size_t)(l * 3 + 2) * 4 * 6144)
        PHASE_BEGIN REPEAT(REP_UP) { EpiSwiglu E; E.H = p->P1; E.ldc = DFF; run_gemm(lds, p->u, D, p->Wup0, D, T, 2 * DFF, D, E); __syncthreads(); } PHASE_END
        PHASE_BEGIN REPEAT(REP_DN) { EpiBf16<0> E; E.O = (bf16_t*)p->y; E.ldc = D; run_gemm(lds, p->P1, DFF, p->Wdn0, DFF, T, D, DFF, E); __syncthreads(); } PHASE_END
        PHASE_BEGIN phase_norm<true, true, (l != 0), true>(l == 0 ? (const void*)p->x : (const void*)p->out, (const bf16_t*)p->y, p->out, p->u, p->post_g + (l * 3 + 0) * D, modA, 0.5f, p->pre_g + (l * 3 + 1) * D, modB); PHASE_END
        PHASE_BEGIN REPEAT(REP_PROJ) {
            { EpiBf16<0> E; E.O = p->P1; E.ldc = NP1P; run_gemm(lds, p->u, D, p->Win1, D, T, P1TAIL, D, E); } __syncthreads();
            for (int i_ = BIDX(); i_ < 256; i_ += NBLK()) { const int pm_ = i_ >> 2, kp_ = i_ & 3;
                EpiF32Lo E; E.C = p->y + (size_t)kp_ * T * 256; E.ldc = 256;
                pg8::Gemm g; g.A = p->u + kp_ * 512; g.Bt = p->Win1 + (size_t)P1TAIL * D + kp_ * 512; g.M = T; g.N = 256; g.K = 512; g.lda = D; g.ldb = D;
                SplitOrder S; S.first = pm_; S.count = 1; S.nN = 1;
                pg8::gemm_phase<EpiF32Lo, SplitOrder, false>((PG8_LAS unsigned char*)lds, g, S, E, nullptr); __syncthreads(); }
            __syncthreads(); } PHASE_END
        PHASE_BEGIN REPEAT(REP_PREP) { phase_prep2(p, l, lds); __syncthreads(); } PHASE_END
        PHASE_BEGIN {
            REPEAT(REP_SCAN) { phase_rowscans_paired(p, lds); __syncthreads(); }
            EpiBf16<1> E; E.O = p->G; E.ldc = NGATE;
            pg8::Gemm g; g.A = p->u; g.Bt = p->Wg; g.M = T; g.N = NGATE; g.K = D; g.lda = D; g.ldb = D;
            const int nb_ = NBLK(), bid_ = BIDX();
            if (nb_ == 256 && SCAN_GATE_UNITS == 3) {
                const int x_ = bid_ & 7; RowWalkOrder S;
                if (bid_ < 128) { const int r_ = bid_ >> 3; S.pm = 8 * x_ + (r_ & 7); S.pn0 = (r_ >> 3) * 3; S.step = 1; S.count = 3; }
                else { const int r_ = (bid_ - 128) >> 3; S.pm = 8 * x_ + (r_ & 7); S.pn0 = 6 + (r_ >> 3); S.step = 2; S.count = 13; }
                pg8::gemm_phase<EpiBf16<1>, RowWalkOrder, false>((PG8_LAS unsigned char*)lds, g, S, E, nullptr); }
            else if (nb_ == 256) { SplitOrder S; S.nN = 32; if (bid_ < 128) { S.first = bid_ * SCAN_GATE_UNITS; S.count = SCAN_GATE_UNITS; } else { S.first = 128 * SCAN_GATE_UNITS + (bid_ - 128) * (16 - SCAN_GATE_UNITS); S.count = 16 - SCAN_GATE_UNITS; }
                pg8::gemm_phase<EpiBf16<1>, SplitOrder, false>((PG8_LAS unsigned char*)lds, g, S, E, nullptr); }
            else { pg8::StaticOrder S; S.init(T, NGATE, nb_, bid_); pg8::gemm_phase<EpiBf16<1>, pg8::StaticOrder, false>((PG8_LAS unsigned char*)lds, g, S, E, nullptr); }
        } PHASE_END
        PHASE_BEGIN REPEAT(REP_CMPR) {
            const int c_ = BIDX();
            if (c_ < 16) { const int wh = c_ >> 3, pan = c_ & 7;
                { EpiGeluBias E; E.O = p->chid + (size_t)wh * 2048 * 256; E.ldc = 256; E.bias = p->cbias + wh * 256;
                  pg8::Gemm g; g.A = wh ? p->nsa_vc_in : p->nsa_kc_in; g.Bt = p->cW1t + (size_t)wh * 256 * 2048; g.M = 2048; g.N = 256; g.K = 2048; g.lda = 1024; g.ldb = 2048;
                  SplitOrder S; S.first = pan; S.count = 1; S.nN = 1;
                  pg8::gemm_phase<EpiGeluBias, SplitOrder, false>((PG8_LAS unsigned char*)lds, g, S, E, nullptr); }
                asm volatile("s_waitcnt vmcnt(0)" ::: "memory"); __syncthreads();
                { EpiCmpOut E; E.C = wh ? p->nsa_vc : p->nsa_kc;
                  pg8::Gemm g; g.A = p->chid + (size_t)wh * 2048 * 256; g.Bt = p->cW2t + (size_t)wh * 256 * 256; g.M = 2048; g.N = 256; g.K = 256; g.lda = 256; g.ldb = 256;
                  SplitOrder S; S.first = pan; S.count = 1; S.nN = 1;
                  pg8::gemm_phase<EpiCmpOut, SplitOrder, false>((PG8_LAS unsigned char*)lds, g, S, E, nullptr); }
            }
            __syncthreads(); } REPEAT(REP_MLAUP) {
            const int skip_ = NBLK() == 256 ? 16 : 0, G_ = NBLK() - skip_, c2_ = BIDX() - skip_;
            if (c2_ >= 0) {
                { EpiBf16<0> E; E.O = p->mla_q; E.ldc = 768; pg8::Gemm g; g.A = p->mla_cqn; g.Bt = p->Wuq; g.M = T; g.N = 768; g.K = 384; g.lda = 384; g.ldb = 384;
                  pg8::StaticOrder S; S.init(T, 768, G_, c2_); pg8::gemm_phase<EpiBf16<0>, pg8::StaticOrder, false>((PG8_LAS unsigned char*)lds, g, S, E, nullptr); } __syncthreads();
                { EpiBf16<0> E; E.O = p->mla_kv; E.ldc = 1024; pg8::Gemm g; g.A = p->mla_ckvn; g.Bt = p->Wukv; g.M = T; g.N = 1024; g.K = 256; g.lda = 256; g.ldb = 256;
                  pg8::StaticOrder S; S.init(T, 1024, G_, (c2_ + 48) % G_); pg8::gemm_phase<EpiBf16<0>, pg8::StaticOrder, false>((PG8_LAS unsigned char*)lds, g, S, E, nullptr); } __syncthreads(); } } __syncthreads(); REPEAT(REP_POST) { phase_post(p, l, lds, NBLK() == 256 ? 16 : 0); __syncthreads(); } PHASE_END
        PHASE_BEGIN REPEAT(REP_NSAF) { phase_nsa_full(p, lds); __syncthreads(); } REPEAT(REP_MLAF) { phase_mla_flash(p, lds); __syncthreads(); } PHASE_END
        PHASE_BEGIN { EpiMergeAcc E; E.G = p->G; E.O = p->mg;
            pg8::Gemm g; g.A = p->ys; g.Bt = p->Wbr; g.M = 4 * T; g.N = 4 * D; g.K = 512; g.lda = 512; g.ldb = 512;
            MergeOrder S; S.G = NBLK(); S.c = BIDX();
            REPEAT(REP_MERGE) { pg8::gemm_phase<EpiMergeAcc, MergeOrder, false>((PG8_LAS unsigned char*)lds, g, S, E, nullptr); __syncthreads(); } } PHASE_END
        PHASE_BEGIN { EpiBf16<0> E; E.O = (bf16_t*)p->y; E.ldc = D; run_gemm(lds, p->mg, D, p->Wout, D, T, D, D, E); } PHASE_END
        PHASE_BEGIN phase_norm<true, true, true, true>(p->out, (const bf16_t*)p->y, p->G, p->u, p->post_g + (l * 3 + 1) * D, modB, 1.0f, p->pre_g + (l * 3 + 2) * D, modC); PHASE_END
        PHASE_BEGIN { EpiSwiglu E; E.H = p->P1; E.ldc = DFF; run_gemm(lds, p->u, D, p->Wup1, D, T, 2 * DFF, D, E); } PHASE_END
        PHASE_BEGIN { EpiBf16<0> E; E.O = (bf16_t*)p->y; E.ldc = D; run_gemm(lds, p->P1, DFF, p->Wdn1, DFF, T, D, DFF, E); } PHASE_END
        if (l == 0) { PHASE_BEGIN phase_norm<true, true, true, true>(p->G, (const bf16_t*)p->y, p->out, p->u, p->post_g + (l * 3 + 2) * D, modC, 0.5f, p->pre_g + ((l + 1) * 3) * D, p->mod + (size_t)((l + 1) * 3) * 4 * 6144);
            __syncthreads(); REPEAT(REP_CONV) { phase_convert(p, 1, lds); __syncthreads(); } PHASE_END }
        else        { PHASE_BEGIN phase_norm<true, false, true, false>(p->G, (const bf16_t*)p->y, p->out, nullptr, p->post_g + (l * 3 + 2) * D, modC, 0.5f, nullptr, nullptr); PHASE_END }
    }
    { constexpr int l = 1;

#define modA (p->mod + (size_t)(l * 3 + 0) * 4 * 6144)
#define modB (p->mod + (size_t)(l * 3 + 1) * 4 * 6144)
#define modC (p->mod + (size_t)(l * 3 + 2) * 4 * 6144)
        PHASE_BEGIN REPEAT(REP_UP) { EpiSwiglu E; E.H = p->P1; E.ldc = DFF; run_gemm(lds, p->u, D, p->Wup0, D, T, 2 * DFF, D, E); __syncthreads(); } PHASE_END
        PHASE_BEGIN REPEAT(REP_DN) { EpiBf16<0> E; E.O = (bf16_t*)p->y; E.ldc = D; run_gemm(lds, p->P1, DFF, p->Wdn0, DFF, T, D, DFF, E); __syncthreads(); } PHASE_END
        PHASE_BEGIN phase_norm<true, true, (l != 0), true>(l == 0 ? (const void*)p->x : (const void*)p->out, (const bf16_t*)p->y, p->out, p->u, p->post_g + (l * 3 + 0) * D, modA, 0.5f, p->pre_g + (l * 3 + 1) * D, modB); PHASE_END
        PHASE_BEGIN REPEAT(REP_PROJ) {
            { EpiBf16<0> E; E.O = p->P1; E.ldc = NP1P; run_gemm(lds, p->u, D, p->Win1, D, T, P1TAIL, D, E); } __syncthreads();
            for (int i_ = BIDX(); i_ < 256; i_ += NBLK()) { const int pm_ = i_ >> 2, kp_ = i_ & 3;
                EpiF32Lo E; E.C = p->y + (size_t)kp_ * T * 256; E.ldc = 256;
                pg8::Gemm g; g.A = p->u + kp_ * 512; g.Bt = p->Win1 + (size_t)P1TAIL * D + kp_ * 512; g.M = T; g.N = 256; g.K = 512; g.lda = D; g.ldb = D;
                SplitOrder S; S.first = pm_; S.count = 1; S.nN = 1;
                pg8::gemm_phase<EpiF32Lo, SplitOrder, false>((PG8_LAS unsigned char*)lds, g, S, E, nullptr); __syncthreads(); }
            __syncthreads(); } PHASE_END
        PHASE_BEGIN REPEAT(REP_PREP) { phase_prep2(p, l, lds); __syncthreads(); } PHASE_END
        PHASE_BEGIN {
            REPEAT(REP_SCAN) { phase_rowscans_paired(p, lds); __syncthreads(); }
            EpiBf16<1> E; E.O = p->G; E.ldc = NGATE;
            pg8::Gemm g; g.A = p->u; g.Bt = p->Wg; g.M = T; g.N = NGATE; g.K = D; g.lda = D; g.ldb = D;
            const int nb_ = NBLK(), bid_ = BIDX();
            if (nb_ == 256 && SCAN_GATE_UNITS == 3) {
                const int x_ = bid_ & 7; RowWalkOrder S;
                if (bid_ < 128) { const int r_ = bid_ >> 3; S.pm = 8 * x_ + (r_ & 7); S.pn0 = (r_ >> 3) * 3; S.step = 1; S.count = 3; }
                else { const int r_ = (bid_ - 128) >> 3; S.pm = 8 * x_ + (r_ & 7); S.pn0 = 6 + (r_ >> 3); S.step = 2; S.count = 13; }
                pg8::gemm_phase<EpiBf16<1>, RowWalkOrder, false>((PG8_LAS unsigned char*)lds, g, S, E, nullptr); }
            else if (nb_ == 256) { SplitOrder S; S.nN = 32; if (bid_ < 128) { S.first = bid_ * SCAN_GATE_UNITS; S.count = SCAN_GATE_UNITS; } else { S.first = 128 * SCAN_GATE_UNITS + (bid_ - 128) * (16 - SCAN_GATE_UNITS); S.count = 16 - SCAN_GATE_UNITS; }
                pg8::gemm_phase<EpiBf16<1>, SplitOrder, false>((PG8_LAS unsigned char*)lds, g, S, E, nullptr); }
            else { pg8::StaticOrder S; S.init(T, NGATE, nb_, bid_); pg8::gemm_phase<EpiBf16<1>, pg8::StaticOrder, false>((PG8_LAS unsigned char*)lds, g, S, E, nullptr); }
        } PHASE_END
        PHASE_BEGIN REPEAT(REP_CMPR) {
            const int c_ = BIDX();
            if (c_ < 16) { const int wh = c_ >> 3, pan = c_ & 7;
                { EpiGeluBias E; E.O = p->chid + (size_t)wh * 2048 * 256; E.ldc = 256; E.bias = p->cbias + wh * 256;
                  pg8::Gemm g; g.A = wh ? p->nsa_vc_in : p->nsa_kc_in; g.Bt = p->cW1t + (size_t)wh * 256 * 2048; g.M = 2048; g.N = 256; g.K = 2048; g.lda = 1024; g.ldb = 2048;
                  SplitOrder S; S.first = pan; S.count = 1; S.nN = 1;
                  pg8::gemm_phase<EpiGeluBias, SplitOrder, false>((PG8_LAS unsigned char*)lds, g, S, E, nullptr); }
                asm volatile("s_waitcnt vmcnt(0)" ::: "memory"); __syncthreads();
                { EpiCmpOut E; E.C = wh ? p->nsa_vc : p->nsa_kc;
                  pg8::Gemm g; g.A = p->chid + (size_t)wh * 2048 * 256; g.Bt = p->cW2t + (size_t)wh * 256 * 256; g.M = 2048; g.N = 256; g.K = 256; g.lda = 256; g.ldb = 256;
                  SplitOrder S; S.first = pan; S.count = 1; S.nN = 1;
                  pg8::gemm_phase<EpiCmpOut, SplitOrder, false>((PG8_LAS unsigned char*)lds, g, S, E, nullptr); }
            }
            __syncthreads(); } REPEAT(REP_MLAUP) {
            const int skip_ = NBLK() == 256 ? 16 : 0, G_ = NBLK() - skip_, c2_ = BIDX() - skip_;
            if (c2_ >= 0) {
                { EpiBf16<0> E; E.O = p->mla_q; E.ldc = 768; pg8::Gemm g; g.A = p->mla_cqn; g.Bt = p->Wuq; g.M = T; g.N = 768; g.K = 384; g.lda = 384; g.ldb = 384;
                  pg8::StaticOrder S; S.init(T, 768, G_, c2_); pg8::gemm_phase<EpiBf16<0>, pg8::StaticOrder, false>((PG8_LAS unsigned char*)lds, g, S, E, nullptr); } __syncthreads();
                { EpiBf16<0> E; E.O = p->mla_kv; E.ldc = 1024; pg8::Gemm g; g.A = p->mla_ckvn; g.Bt = p->Wukv; g.M = T; g.N = 1024; g.K = 256; g.lda = 256; g.ldb = 256;
                  pg8::StaticOrder S; S.init(T, 1024, G_, (c2_ + 48) % G_); pg8::gemm_phase<EpiBf16<0>, pg8::StaticOrder, false>((PG8_LAS unsigned char*)lds, g, S, E, nullptr); } __syncthreads(); } } __syncthreads(); REPEAT(REP_POST) { phase_post(p, l, lds, NBLK() == 256 ? 16 : 0); __syncthreads(); } PHASE_END
        PHASE_BEGIN REPEAT(REP_NSAF) { phase_nsa_full(p, lds); __syncthreads(); } REPEAT(REP_MLAF) { phase_mla_flash(p, lds); __syncthreads(); } PHASE_END
        PHASE_BEGIN { EpiMergeAcc E; E.G = p->G; E.O = p->mg;
            pg8::Gemm g; g.A = p->ys; g.Bt = p->Wbr; g.M = 4 * T; g.N = 4 * D; g.K = 512; g.lda = 512; g.ldb = 512;
            MergeOrder S; S.G = NBLK(); S.c = BIDX();
            REPEAT(REP_MERGE) { pg8::gemm_phase<EpiMergeAcc, MergeOrder, false>((PG8_LAS unsigned char*)lds, g, S, E, nullptr); __syncthreads(); } } PHASE_END
        PHASE_BEGIN { EpiBf16<0> E; E.O = (bf16_t*)p->y; E.ldc = D; run_gemm(lds, p->mg, D, p->Wout, D, T, D, D, E); } PHASE_END
        PHASE_BEGIN phase_norm<true, true, true, true>(p->out, (const bf16_t*)p->y, p->G, p->u, p->post_g + (l * 3 + 1) * D, modB, 1.0f, p->pre_g + (l * 3 + 2) * D, modC); PHASE_END
        PHASE_BEGIN { EpiSwiglu E; E.H = p->P1; E.ldc = DFF; run_gemm(lds, p->u, D, p->Wup1, D, T, 2 * DFF, D, E); } PHASE_END
        PHASE_BEGIN { EpiBf16<0> E; E.O = (bf16_t*)p->y; E.ldc = D; run_gemm(lds, p->P1, DFF, p->Wdn1, DFF, T, D, DFF, E); } PHASE_END
        if (l == 0) { PHASE_BEGIN phase_norm<true, true, true, true>(p->G, (const bf16_t*)p->y, p->out, p->u, p->post_g + (l * 3 + 2) * D, modC, 0.5f, p->pre_g + ((l + 1) * 3) * D, p->mod + (size_t)((l + 1) * 3) * 4 * 6144);
            __syncthreads(); REPEAT(REP_CONV) { phase_convert(p, 1, lds); __syncthreads(); } PHASE_END }
        else        { PHASE_BEGIN phase_norm<true, false, true, false>(p->G, (const bf16_t*)p->y, p->out, nullptr, p->post_g + (l * 3 + 2) * D, modC, 0.5f, nullptr, nullptr); PHASE_END }
    }

}
constexpr int N_PHASES = 2 + 2 * 14;

extern "C" void kernel_launch(void* const* d_in, const int* in_sizes, int n_in, void* d_out, int out_size, void* d_ws, size_t ws_size, hipStream_t stream) {
    static int grid = 0;
    if (grid == 0) {
        int dev = 0, cus = 0;
        if (hipGetDevice(&dev) != hipSuccess || hipDeviceGetAttribute(&cus, hipDeviceAttributeMultiprocessorCount, dev) != hipSuccess) { fprintf(stderr, "kernel_launch: device query failed\n"); grid = -1; return; }
        if (hipFuncSetAttribute((const void*)mega, hipFuncAttributeMaxDynamicSharedMemorySize, LDS_BYTES) != hipSuccess) { fprintf(stderr, "kernel_launch: hipFuncSetAttribute failed\n"); grid = -1; return; }
        int per_cu = 0;
        if (hipOccupancyMaxActiveBlocksPerMultiprocessor(&per_cu, (const void*)mega, 512, LDS_BYTES) != hipSuccess || per_cu < 1) fprintf(stderr, "kernel_launch: occupancy query says %d\n", per_cu);
        (void)hipGetLastError();
        grid = cus;
    }
    if (grid < 0) return;
    Params p{};
    const float* const* in = (const float* const*)d_in;
    p.x = in[0]; p.c = in[1]; p.ada_w = in[2]; p.ada_b = in[3]; p.pre_g = in[4]; p.post_g = in[5]; p.ffn_wg = in[6]; p.ffn_wu = in[7]; p.ffn_wd = in[8];
    p.mix_w_in = in[9]; p.mix_w_branch = in[10]; p.mix_w_out = in[11]; p.cmp_pos = in[12]; p.cmp_w1 = in[13]; p.cmp_w2 = in[14];
    p.rw_mu = in[15]; p.rw_w0 = in[16]; p.rw_w_w2 = in[17]; p.rw_a0 = in[18]; p.rw_a_w2 = in[19]; p.rw_g_w2 = in[20]; p.rw_k_k = in[21]; p.rw_k_a = in[22];
    p.rw_r_k = in[23]; p.rw_ln_w = in[24]; p.rw_ln_b = in[25]; p.gla_w2 = in[26]; p.gla_b = in[27]; p.gla_g = in[28];
    p.mla_qn = in[29]; p.mla_wuq = in[30]; p.mla_kvn = in[31]; p.mla_wukv = in[32];
    p.out = (float*)d_out;
    unsigned char* ws = (unsigned char*)d_ws; size_t off = 0;
    auto take = [&](size_t bytes) { unsigned char* r = ws + off; off += (bytes + 255) & ~(size_t)255; return r; };
    p.bar = (unsigned*)take(16384);
    p.mod = (float*)take((size_t)6 * 4 * 6144 * 4);
    p.cos64 = (float*)take((size_t)SEQ * 32 * 4); p.sin64 = (float*)take((size_t)SEQ * 32 * 4); p.cos32 = (float*)take((size_t)SEQ * 16 * 4); p.sin32 = (float*)take((size_t)SEQ * 16 * 4);
    p.Wup0 = (bf16_t*)take((size_t)2 * DFF * D * 2); p.Wup1 = (bf16_t*)take((size_t)2 * DFF * D * 2);
    p.Wdn0 = (bf16_t*)take((size_t)D * DFF * 2); p.Wdn1 = (bf16_t*)take((size_t)D * DFF * 2);
    p.Win1 = (bf16_t*)take((size_t)(NP1P + NGATE) * D * 2); p.Wg = p.Win1 + (size_t)NP1P * D;
    p.Wbr = (bf16_t*)take((size_t)4 * D * 512 * 2); p.Wout = (bf16_t*)take((size_t)D * D * 2);
    p.Wuq = (bf16_t*)take((size_t)768 * 384 * 2); p.Wukv = (bf16_t*)take((size_t)1024 * 256 * 2);
    p.u = (bf16_t*)take((size_t)T * D * 2);
    p.P1 = (bf16_t*)take((size_t)T * DFF * 2);
    p.y = (float*)take((size_t)T * D * 4);
    p.G = (bf16_t*)take((size_t)T * NGATE * 2);
    { unsigned char* yb = (unsigned char*)p.y; size_t yo = 0;
      auto ytake = [&](size_t bytes) { unsigned char* r = yb + yo; yo += (bytes + 255) & ~(size_t)255; return r; };
      p.mla_q = (bf16_t*)ytake((size_t)T * 768 * 2); p.mla_kv = (bf16_t*)ytake((size_t)T * 1024 * 2); p.gla_o = (float*)ytake((size_t)T * 512 * 4); p.nsa_ocmp = (float*)ytake((size_t)T * 512 * 4);
      if (yo > (size_t)T * D * 4) { fprintf(stderr, "kernel_launch: y aliases overflow\n"); return; } }
    p.nsa_q = (bf16_t*)take((size_t)T * 512 * 2);
    p.nsa_kc_in = (bf16_t*)take((size_t)T * 128 * 2 + 4096); p.nsa_vc_in = (bf16_t*)take((size_t)T * 128 * 2 + 4096);
    p.nsa_ks = (bf16_t*)take((size_t)T * 128 * 2); p.nsa_vs = (bf16_t*)take((size_t)T * 128 * 2); p.nsa_kw = (bf16_t*)take((size_t)T * 128 * 2); p.nsa_vw = (bf16_t*)take((size_t)T * 128 * 2);
    p.nsa_gate = (float*)take((size_t)T * 24 * 4); p.nsa_kc = (float*)take((size_t)8 * 256 * 64 * 4); p.nsa_vc = (float*)take((size_t)8 * 256 * 64 * 4);
    p.nsa_sel = (unsigned long long*)take((size_t)8 * SEQ * 8);
    p.rw_r = (bf16_t*)take((size_t)T * 512 * 2); p.rw_k = (bf16_t*)take((size_t)T * 512 * 2); p.rw_v = (bf16_t*)take((size_t)T * 512 * 2); p.rw_g = (bf16_t*)take((size_t)T * 512 * 2);
    p.rw_w = (float*)take((size_t)T * 512 * 4); p.rw_kk = (float*)take((size_t)T * 512 * 4); p.rw_b = (float*)take((size_t)T * 512 * 4); p.rw_y = (float*)take((size_t)T * 512 * 4);
    p.gla_la = (float*)take((size_t)T * 256 * 4);
    p.mla_cqn = (bf16_t*)take((size_t)T * 384 * 2); p.mla_ckvn = (bf16_t*)take((size_t)T * 256 * 2); p.mla_kpe = (bf16_t*)take((size_t)T * 32 * 2);
    p.ys = (bf16_t*)take((size_t)4 * T * 512 * 2);
    p.mg = p.u;
    p.cW1t = (bf16_t*)take((size_t)2 * 256 * 2048 * 2); p.cW2t = (bf16_t*)take((size_t)2 * 256 * 256 * 2); p.chid = (bf16_t*)take((size_t)2 * 2048 * 256 * 2); p.cbias = (float*)take(2 * 256 * 4); p.rwWlT = (bf16_t*)take((size_t)512 * 256 * 2);
    if (off > ws_size) { fprintf(stderr, "kernel_launch: workspace too small: need %zu, have %zu\n", off, ws_size); return; }
    if (hipMemsetAsync(p.bar, 0, 16384, stream) != hipSuccess) { fprintf(stderr, "kernel_launch: memset failed\n"); return; }
#if defined(ONE_LAUNCH)
    hipLaunchKernelGGL(mega, dim3(grid), dim3(512), LDS_BYTES, stream, p, 0, N_PHASES);
#else
    for (int ph = 0; ph < N_PHASES; ++ph) hipLaunchKernelGGL(mega, dim3(grid), dim3(512), LDS_BYTES, stream, p, ph, ph + 1);
#endif
}
```

```cpp
#define ONE_LAUNCH 1
#include <hip/hip_runtime.h>
#include <stdint.h>
#include <stdio.h>

#define LAS __attribute__((address_space(3)))
#define DI __device__ __forceinline__
typedef unsigned short bf16_t;
typedef short bf16x8 __attribute__((ext_vector_type(8)));
typedef float f32x4 __attribute__((ext_vector_type(4)));
typedef float f32x2 __attribute__((ext_vector_type(2)));
typedef unsigned u32x4 __attribute__((ext_vector_type(4)));
typedef unsigned u32x2 __attribute__((ext_vector_type(2)));

constexpr int NB = 4, SEQ = 4096, T = NB * SEQ, D = 2048, DFF = 5632;
constexpr int NP1 = 5192, NP1P = 5376, NGATE = 8192, PROJ_IN = 13384;
constexpr int C_NSA_Q = 0, C_NSA_KC = 512, C_NSA_VC = 640, C_NSA_KS = 768, C_NSA_VS = 896, C_NSA_KW = 1024, C_NSA_VW = 1152, C_NSA_GL = 1280;
constexpr int C_RW = 1304, C_RW_R = 1304, C_RW_WLO = 1816, C_RW_K = 1880, C_RW_V = 2392, C_RW_ALO = 2904, C_RW_GLO = 2968;
constexpr int C_GLA_Q = 3096, C_GLA_K = 3352, C_GLA_V = 3608, C_GLA_ALO = 4120, C_GLA_R = 4136;
constexpr int C_MLA_CQ = 4648, C_MLA_CKV = 5032, C_MLA_KR = 5160;
constexpr float NORM_EPS = 1e-6f;

DI float bf2f(bf16_t v) { return __uint_as_float(((unsigned)v) << 16); }
DI bf16_t f2bf(float f) { unsigned u = __float_as_uint(f); u += 0x7FFFu + ((u >> 16) & 1u); return (bf16_t)(u >> 16); }
typedef __bf16 bf16x2_t_ __attribute__((ext_vector_type(2)));
DI unsigned pk2(float lo, float hi) { const f32x2 v = {lo, hi}; return __builtin_bit_cast(unsigned, __builtin_convertvector(v, bf16x2_t_)); }
DI float sigmoidf_(float x) { return 1.0f / (1.0f + __expf(-x)); }
DI float wsum(float v) {
#pragma unroll
    for (int o = 32; o >= 1; o >>= 1) v += __shfl_xor(v, o);
    return v;
}
DI float wmax(float v) {
#pragma unroll
    for (int o = 32; o >= 1; o >>= 1) v = fmaxf(v, __shfl_xor(v, o));
    return v;
}

DI int TIDX() { int t = (int)threadIdx.x; asm volatile("" : "+v"(t)); return t; }
DI int BIDX() { int t = __builtin_amdgcn_readfirstlane((int)blockIdx.x); asm volatile("" : "+s"(t)); return t; }
DI int NBLK() { int t = __builtin_amdgcn_readfirstlane((int)gridDim.x); asm volatile("" : "+s"(t)); return t; }

struct Params {
    const float *x, *c, *ada_w, *ada_b, *pre_g, *post_g, *ffn_wg, *ffn_wu, *ffn_wd, *mix_w_in, *mix_w_branch, *mix_w_out;
    const float *cmp_pos, *cmp_w1, *cmp_w2;
    const float *rw_mu, *rw_w0, *rw_w_w2, *rw_a0, *rw_a_w2, *rw_g_w2, *rw_k_k, *rw_k_a, *rw_r_k, *rw_ln_w, *rw_ln_b;
    const float *gla_w2, *gla_b, *gla_g;
    const float *mla_qn, *mla_wuq, *mla_kvn, *mla_wukv;
    float* out;
    unsigned* bar;
    float *mod, *cos64, *sin64, *cos32, *sin32;
    bf16_t *Wup0, *Wup1, *Wdn0, *Wdn1, *Win1, *Wg, *Wbr, *Wout, *Wuq, *Wukv;
    bf16_t *u, *P1, *G;
    float* y;
    bf16_t *nsa_q, *nsa_kc_in, *nsa_vc_in, *nsa_ks, *nsa_vs, *nsa_kw, *nsa_vw;
    float *nsa_gate, *nsa_kc, *nsa_vc, *nsa_ocmp;
    unsigned long long* nsa_sel;
    bf16_t *rw_r, *rw_k, *rw_v, *rw_g;
    float *rw_w, *rw_kk, *rw_b, *rw_y;
    float *gla_la, *gla_o;
    bf16_t *mla_cqn, *mla_ckvn, *mla_kpe, *mla_q, *mla_kv;
    bf16_t* ys;
    bf16_t* mg;
    bf16_t *cW1t, *cW2t, *chid;
    float* cbias;
    bf16_t* rwWlT;
};
typedef const __attribute__((address_space(4))) Params* KParamsPtr;
#define XB_TMO      128
#define XB_XCNT(j)  (256  + 64 * (j))
#define XB_XSUB(j)  (1280 + 64 * (j))
#define XB_XGEN(j)  (2304 + 64 * (j))
#define XB_TOP      3328
#define XB_TOPGEN   3392
#define XCD_BAR_WORDS 3456
#define XB_SPIN_CAP (1u << 18)

__device__ __forceinline__ unsigned xb_ld(unsigned* p)              { return __hip_atomic_load(p, __ATOMIC_RELAXED, __HIP_MEMORY_SCOPE_AGENT); }
__device__ __forceinline__ unsigned xb_add(unsigned* p, unsigned v) { return __hip_atomic_fetch_add(p, v, __ATOMIC_RELAXED, __HIP_MEMORY_SCOPE_AGENT); }
__device__ __forceinline__ unsigned xb_xcc_id() { return (unsigned)__builtin_amdgcn_s_getreg((3 << 11) | 20) & 0xFu; }
#define XB_SPIN(cond, bar) do { unsigned _sp = 0; while (cond) { __builtin_amdgcn_s_sleep(1); \
    if ((++_sp & 255u) == 0u) { if (xb_ld(&(bar)[XB_TMO])) break; if (_sp > XB_SPIN_CAP) { atomicAdd(&(bar)[XB_TMO], 1u); break; } } } } while (0)

struct XcdBarrier {
    unsigned* bar; unsigned x;
    volatile LAS unsigned* st;
};

__device__ __forceinline__ XcdBarrier xcd_barrier_post(unsigned* bar, volatile LAS unsigned* st) {
    XcdBarrier b; b.bar = bar; b.x = xb_xcc_id(); b.st = st;
    if (threadIdx.x == 0) (void)xb_add(&bar[XB_XCNT(b.x)], 1u);
    return b;
}
__device__ __forceinline__ void xcd_barrier_complete(unsigned* bar, unsigned x, unsigned& nloc, unsigned& nx) {
    const unsigned G = gridDim.x * gridDim.y * gridDim.z;
    unsigned sum, cnt, mine, sp = 0u;
    for (;;) {
        sum = 0u; cnt = 0u; mine = 0u;
#pragma unroll
        for (unsigned j = 0; j < 16; ++j) { const unsigned c = xb_ld(&bar[XB_XCNT(j)]); sum += c; cnt += (c > 0u) ? 1u : 0u; mine = (j == x) ? c : mine; }
        if (sum == G) break;
        __builtin_amdgcn_s_sleep(1);
        if ((++sp & 255u) == 0u) { if (xb_ld(&bar[XB_TMO])) break; if (sp > XB_SPIN_CAP) { atomicAdd(&bar[XB_TMO], 1u); break; } }
    }
    nloc = mine > 0u ? mine : 1u; nx = cnt > 0u ? cnt : 1u;
}

__device__ __forceinline__ void xcd_barrier(const XcdBarrier& b) {
    asm volatile("s_waitcnt vmcnt(0)" ::: "memory");
    __syncthreads();
    if (threadIdx.x == 0) {
        unsigned* bar = b.bar;
        __builtin_amdgcn_s_waitcnt(0);
        unsigned nloc = b.st[0], nx = b.st[1];
        if (nloc == 0u) { xcd_barrier_complete(bar, b.x, nloc, nx); b.st[0] = nloc; b.st[1] = nx; }
        const unsigned old = xb_add(&bar[XB_XSUB(b.x)], 1u);
        const unsigned gen = old / nloc;
        if (old + 1u == (gen + 1u) * nloc) {
            __builtin_amdgcn_fence(__ATOMIC_RELEASE, "agent");
            asm volatile("s_waitcnt vmcnt(0)" ::: "memory");
            const unsigned og = xb_add(&bar[XB_TOP], 1u);
            const unsigned tg = og / nx;
            if (og + 1u == (tg + 1u) * nx) xb_add(&bar[XB_TOPGEN], 1u);
            else XB_SPIN(xb_ld(&bar[XB_TOPGEN]) == tg, bar);
            __builtin_amdgcn_fence(__ATOMIC_ACQUIRE, "agent");
            xb_add(&bar[XB_XGEN(b.x)], 1u);
            asm volatile("s_waitcnt vmcnt(0)" ::: "memory");
        } else {
            XB_SPIN(xb_ld(&bar[XB_XGEN(b.x)]) == gen, bar);
            __builtin_amdgcn_fence(__ATOMIC_ACQUIRE, "agent");
            asm volatile("s_waitcnt vmcnt(0)" ::: "memory");
        }
    }
    __syncthreads();
}

namespace pg8 {
#define PG8_LAS __attribute__((address_space(3)))
constexpr int BM = 256, BK = 64, HALF = 128, HTB = HALF * BK * 2  , STAGE_BYTES = 8 * HTB, NXCD = 8, WGM = 8;

__host__ __device__ __forceinline__ int lds_byte(int r, int c) { const int st = (r >> 4) * 2 + (c >> 5), rr = r & 15, cc = c & 31, ob = rr * 64 + cc * 2; return st * 1024 + (ob ^ (((ob >> 9) & 1) << 5)); }
__host__ __device__ __forceinline__ void stage_rc(int b, int& R, int& C) { const int st = b / 1024, sb = b % 1024, swz = sb ^ (((sb >> 9) & 1) << 5); R = (st >> 1) * 16 + swz / 64; C = (st & 1) * 32 + (swz % 64) / 2; }
__host__ __device__ __forceinline__ int perm32(int rho) { const int n = rho >> 4, i = rho & 15; return 8 * (i >> 2) + 4 * n + (i & 3); }

struct Unit { int pm, pn; };
struct Gemm { const bf16_t* A; const bf16_t* Bt; int M, N, K, lda, ldb; };

struct StaticOrder {
    int nM, nN, nwg, G, c;
    __host__ __device__ void init(int M, int N, int G_, int c_) { nM = M / BM; nN = N / BM; nwg = nM * nN; G = G_; c = c_; }
    __host__ __device__ bool next(int i, Unit& u) const {
        const long L = (long)i * G + c; if (L >= nwg) return false;
        int wgid = (int)L; { const int q = nwg / NXCD, r = nwg % NXCD, xcd = wgid % NXCD, off = wgid / NXCD; wgid = (xcd < r ? xcd * (q + 1) : r * (q + 1) + (xcd - r) * q) + off; }
        const int nig = WGM * nN, gid = wgid / nig, fm = gid * WGM, gsz = (nM - fm) < WGM ? (nM - fm) : WGM;
        u.pm = fm + ((wgid % nig) % gsz); u.pn = (wgid % nig) / gsz; return true;
    }
    __device__ __forceinline__ void a_ready(const Unit&) const {}
    __device__ __forceinline__ void done(const Unit&) const {}
};
struct CountedOrder : StaticOrder {
    const unsigned* ready; unsigned need; unsigned* tmo;
    __device__ __forceinline__ void a_ready(const Unit& u) const {
        if (TIDX() < 64) {
            const unsigned long long t0 = __builtin_amdgcn_s_memrealtime(); unsigned polls = 0;
            while ((unsigned)__builtin_amdgcn_readfirstlane(__hip_atomic_load(ready + 64 * u.pm, __ATOMIC_RELAXED, __HIP_MEMORY_SCOPE_AGENT)) < need) {
                if ((++polls & 255u) == 0u && __builtin_amdgcn_readfirstlane(__hip_atomic_load(tmo, __ATOMIC_RELAXED, __HIP_MEMORY_SCOPE_AGENT)) != 0u) break;
                if (__builtin_amdgcn_s_memrealtime() - t0 > 2000000ull) {
                    if (TIDX() == 0) { unsigned expect = 0u; __hip_atomic_compare_exchange_strong(tmo + 1, &expect, 0x600u | (unsigned)(u.pm & 0xff), __ATOMIC_RELAXED, __ATOMIC_RELAXED, __HIP_MEMORY_SCOPE_AGENT); __hip_atomic_store(tmo, 1u, __ATOMIC_RELAXED, __HIP_MEMORY_SCOPE_AGENT); }
                    break; }
                __builtin_amdgcn_s_sleep(2); }
            __builtin_amdgcn_fence(__ATOMIC_ACQUIRE, "agent");
            asm volatile("s_waitcnt vmcnt(0)" ::: "memory");
        }
#if !defined(BROKEN_HOOK_NO_BARRIER)
        asm volatile("" ::: "memory"); __builtin_amdgcn_s_barrier(); asm volatile("" ::: "memory");
#endif
    }
};


template <class Epi, class Sched, bool STAMP = false>
__device__ __forceinline__ void gemm_phase(PG8_LAS unsigned char* lds, const Gemm g, const Sched& S, const Epi& E, unsigned long long* stamps) {
    const int tid = TIDX(), wid = __builtin_amdgcn_readfirstlane(tid >> 6), lane = tid & 63, wr = wid >> 2, wc = wid & 3, fr = lane & 15, fq = lane >> 4;
    const int K = g.K, nt = K / BK;
    int ts_lo = 0, ts_hi = 0, nts = 0; const unsigned long long rt_entry = STAMP ? (unsigned long long)wall_clock64() : 0ull;
#define PG8_STAMP() do { if (STAMP && wid == 0 && nts < 64) { const unsigned long long _c = (unsigned long long)clock64(); \
        ts_lo = (lane == nts) ? (int)(unsigned)_c : ts_lo; ts_hi = (lane == nts) ? (int)(unsigned)(_c >> 32) : ts_hi; ++nts; } } while (0)
    PG8_STAMP();
    unsigned voffA[2], voffB[2];
#pragma unroll
    for (int i = 0; i < 2; ++i) { int R, C; stage_rc(tid * 16 + i * 8192, R, C); const int Rb = Epi::PERM ? ((R & ~31) + perm32(R & 31)) : R;
        voffA[i] = (unsigned)(R * g.lda + C) * 2u; voffB[i] = (unsigned)(Rb * g.ldb + C) * 2u; }
    const size_t kstep = (size_t)(BK * 2);
    const size_t hstepA = (size_t)HALF * g.lda * 2, hstepB = (size_t)HALF * g.ldb * 2;
    const size_t tstepA = 2 * hstepA, tstepB = 2 * hstepB;
    const unsigned ldsw = (unsigned)wid * 1024u;
    const int aoff = lds_byte(wr * 64 + fr, fq * 8), boff = lds_byte(wc * 32 + fr, fq * 8);
#define PG8_SA(b, h) (((b) * 2 + (h)) * HTB)
#define PG8_SB(b, h) ((4 + (b) * 2 + (h)) * HTB)
#define PG8_STAGE(bufoff, gbase, voff) do { _Pragma("unroll") for (int _i = 0; _i < 2; ++_i) \
        __builtin_amdgcn_global_load_lds((const unsigned*)((const char*)(gbase) + (voff)[_i]), (PG8_LAS unsigned*)(lds + (bufoff) + ldsw + _i * 8192), 16, 0, 0); } while (0)
#define PG8_LDA(dst, b, h) do { _Pragma("unroll") for (int m = 0; m < 4; ++m) _Pragma("unroll") for (int k = 0; k < 2; ++k) dst[m][k] = *(const PG8_LAS bf16x8*)(lds + PG8_SA(b, h) + aoff + m * 2048 + k * 1024); } while (0)
#define PG8_LDB(dst, b, h) do { _Pragma("unroll") for (int n = 0; n < 2; ++n) _Pragma("unroll") for (int k = 0; k < 2; ++k) dst[n][k] = *(const PG8_LAS bf16x8*)(lds + PG8_SB(b, h) + boff + n * 2048 + k * 1024); } while (0)
#define PG8_MMA(ai, bj, At, Bt) do { __builtin_amdgcn_s_setprio(1); _Pragma("unroll") for (int m = 0; m < 4; ++m) _Pragma("unroll") for (int n = 0; n < 2; ++n) _Pragma("unroll") for (int k = 0; k < 2; ++k) \
        acc[ai][bj][m][n] = __builtin_amdgcn_mfma_f32_16x16x32_bf16(Bt[n][k], At[m][k], acc[ai][bj][m][n], 0, 0, 0); __builtin_amdgcn_s_setprio(0); } while (0)
#define PG8_WAIT_V(n) asm volatile("s_waitcnt vmcnt(" #n ")" ::: "memory")
#define PG8_WAIT_L(n) asm volatile("s_waitcnt lgkmcnt(" #n ")" ::: "memory")
#define PG8_BAR __builtin_amdgcn_s_barrier()
#define PG8_SCHED __builtin_amdgcn_sched_barrier(0)
    Unit cur, nxt; int ui = 0;
    if (!S.next(0, cur)) return;
    f32x4 acc[2][2][4][2];
#pragma unroll
    for (int a = 0; a < 2; ++a)
#pragma unroll
        for (int b = 0; b < 2; ++b)
#pragma unroll
            for (int m = 0; m < 4; ++m)
#pragma unroll
                for (int n = 0; n < 2; ++n) acc[a][b][m][n] = (f32x4){0.f, 0.f, 0.f, 0.f};
    bf16x8 At[4][2], B0[2][2], B1[2][2];
    const char* cA = (const char*)g.A + (size_t)cur.pm * tstepA; const char* cB = (const char*)g.Bt + (size_t)cur.pn * tstepB;
    S.a_ready(cur);
    PG8_STAGE(PG8_SB(0, 0), cB, voffB); PG8_STAGE(PG8_SA(0, 0), cA, voffA); PG8_STAGE(PG8_SB(0, 1), cB + hstepB, voffB); PG8_STAGE(PG8_SA(0, 1), cA + hstepA, voffA);
    if (wr == 1) PG8_BAR;
    PG8_WAIT_V(4); PG8_BAR;
    PG8_STAGE(PG8_SB(1, 0), cB + kstep, voffB); PG8_STAGE(PG8_SA(1, 0), cA + kstep, voffA); PG8_STAGE(PG8_SB(1, 1), cB + hstepB + kstep, voffB);
    PG8_WAIT_V(6); PG8_BAR;
    PG8_STAMP();
    for (;;) {
        const bool has_next = S.next(ui + 1, nxt);
        const char* nA = has_next ? (const char*)g.A + (size_t)nxt.pm * tstepA : cA; const char* nB = has_next ? (const char*)g.Bt + (size_t)nxt.pn * tstepB : cB;
        for (int t = 0; t < nt; t += 2) {
            const bool last = (t == nt - 2);
            const char* a1 = cA + (size_t)(t + 1) * kstep;
            const char* a2 = last ? nA : cA + (size_t)(t + 2) * kstep; const char* b2 = last ? nB : cB + (size_t)(t + 2) * kstep;
            const char* a3 = a2 + kstep; const char* b3 = b2 + kstep;
            if (last && has_next) S.a_ready(nxt);
            PG8_LDB(B0, 0, 0); PG8_SCHED; PG8_LDA(At, 0, 0); PG8_STAGE(PG8_SA(1, 1), a1 + hstepA, voffA);
            PG8_WAIT_L(8); PG8_BAR; PG8_WAIT_L(0); PG8_MMA(0, 0, At, B0); PG8_BAR; PG8_SCHED;
            PG8_LDB(B1, 0, 1); PG8_STAGE(PG8_SB(0, 0), b2, voffB);
            PG8_BAR; PG8_WAIT_L(0); PG8_MMA(0, 1, At, B1); PG8_BAR;
            PG8_LDA(At, 0, 1); PG8_STAGE(PG8_SA(0, 0), a2, voffA);
            PG8_BAR; PG8_WAIT_L(0); PG8_MMA(1, 0, At, B0); PG8_BAR; PG8_SCHED;
            PG8_STAGE(PG8_SB(0, 1), b2 + hstepB, voffB);
            PG8_WAIT_V(6); PG8_BAR; PG8_MMA(1, 1, At, B1); PG8_BAR;
            PG8_LDB(B0, 1, 0); PG8_SCHED; PG8_LDA(At, 1, 0); PG8_STAGE(PG8_SA(0, 1), a2 + hstepA, voffA);
            PG8_WAIT_L(8); PG8_BAR; PG8_WAIT_L(0); PG8_MMA(0, 0, At, B0); PG8_BAR; PG8_SCHED;
            PG8_LDB(B1, 1, 1); PG8_STAGE(PG8_SB(1, 0), b3, voffB);
            PG8_BAR; PG8_WAIT_L(0); PG8_MMA(0, 1, At, B1); PG8_BAR;
            PG8_LDA(At, 1, 1); PG8_STAGE(PG8_SA(1, 0), a3, voffA);
            PG8_BAR; PG8_WAIT_L(0); PG8_MMA(1, 0, At, B0); PG8_BAR; PG8_SCHED;
            PG8_STAGE(PG8_SB(1, 1), b3 + hstepB, voffB);
            PG8_WAIT_V(6); PG8_BAR; PG8_MMA(1, 1, At, B1); PG8_BAR;
        }
        PG8_STAMP();
        if constexpr (!Epi::AFTER_DRAIN) { E(acc, cur, wr, wc, fr, fq); S.done(cur); }
        PG8_STAMP();
        if (!has_next) break;
#pragma unroll
        for (int a = 0; a < 2; ++a)
#pragma unroll
            for (int b = 0; b < 2; ++b)
#pragma unroll
                for (int m = 0; m < 4; ++m)
#pragma unroll
                    for (int n = 0; n < 2; ++n) acc[a][b][m][n] = (f32x4){0.f, 0.f, 0.f, 0.f};
        cur = nxt; cA = nA; cB = nB; ++ui;
    }
    PG8_WAIT_V(0);
    if (wr == 0) PG8_BAR;
    PG8_BAR;
    if constexpr (Epi::AFTER_DRAIN) { E.fused(acc, cur, wr, wc, fr, fq, lds, wid, lane); S.done(cur); }
    PG8_STAMP();
    if (STAMP && wid == 0) { stamps[lane] = lane < nts ? (((unsigned long long)(unsigned)ts_hi << 32) | (unsigned)ts_lo) : 0ull;
        if (lane == 62) stamps[62] = rt_entry; if (lane == 63) stamps[63] = (unsigned long long)wall_clock64(); }
#undef PG8_STAMP
#undef PG8_SA
#undef PG8_SB
#undef PG8_STAGE
#undef PG8_LDA
#undef PG8_LDB
#undef PG8_MMA
#undef PG8_WAIT_V
#undef PG8_WAIT_L
#undef PG8_BAR
#undef PG8_SCHED
}
}
typedef __bf16 bf16x2_n __attribute__((ext_vector_type(2)));
DI unsigned cvt_pk_bf16(float lo, float hi) { const f32x2 v = {lo, hi}; return __builtin_bit_cast(unsigned, __builtin_convertvector(v, bf16x2_n)); }
DI float fast_sigmoid(float x) { return __builtin_amdgcn_rcpf(1.0f + __expf(-x)); }

struct EpiF32 {
    static constexpr bool PERM = false, AFTER_DRAIN = false;
    float* C; int ldc;
    DI void operator()(const f32x4 (&acc)[2][2][4][2], const pg8::Unit& u, int wr, int wc, int fr, int fq) const {
        const int row0 = u.pm * 256 + wr * 64 + fr, col0 = u.pn * 256 + wc * 32 + 4 * fq;
#pragma unroll
        for (int ai = 0; ai < 2; ++ai)
#pragma unroll
            for (int m = 0; m < 4; ++m) { float* rowp = C + (size_t)(row0 + ai * 128 + m * 16) * ldc + col0;
#pragma unroll
                for (int bj = 0; bj < 2; ++bj)
#pragma unroll
                    for (int n = 0; n < 2; ++n) *(f32x4*)(rowp + bj * 128 + n * 16) = acc[ai][bj][m][n]; }
    }
};
struct EpiF32Lo {
    static constexpr bool PERM = false, AFTER_DRAIN = false;
    float* C; int ldc;
    DI void operator()(const f32x4 (&acc)[2][2][4][2], const pg8::Unit& u, int wr, int wc, int fr, int fq) const {
        const int row0 = u.pm * 256 + wr * 64 + fr, col0 = u.pn * 256 + wc * 32 + 4 * fq;
#pragma unroll
        for (int ai = 0; ai < 2; ++ai)
#pragma unroll
            for (int m = 0; m < 4; ++m) { float* rowp = C + (size_t)(row0 + ai * 128 + m * 16) * ldc + col0;
#pragma unroll
                for (int n = 0; n < 2; ++n) *(f32x4*)(rowp + n * 16) = acc[ai][0][m][n]; }
    }
};
template <int ACT  > struct EpiBf16 {
    static constexpr bool PERM = true, AFTER_DRAIN = false;
    bf16_t* O; int ldc;
    DI void operator()(const f32x4 (&acc)[2][2][4][2], const pg8::Unit& u, int wr, int wc, int fr, int fq) const {
        const int row0 = u.pm * 256 + wr * 64 + fr, col0 = u.pn * 256 + wc * 32 + 8 * fq;
#pragma unroll
        for (int ai = 0; ai < 2; ++ai)
#pragma unroll
            for (int m = 0; m < 4; ++m) { bf16_t* rowp = O + (size_t)(row0 + ai * 128 + m * 16) * ldc + col0;
#pragma unroll
                for (int bj = 0; bj < 2; ++bj) { f32x4 v0 = acc[ai][bj][m][0], v1 = acc[ai][bj][m][1];
#if defined(NOISE_P1)
                    if (ACT == 0) { unsigned hsh = (unsigned)(row0 + ai * 128 + m * 16) * 2654435761u ^ (unsigned)(col0 + bj * 128) * 40503u;
#pragma unroll
                        for (int j = 0; j < 4; ++j) { hsh = hsh * 1664525u + 1013904223u; v0[j] *= 1.0f + NOISE_P1 * ((float)(hsh >> 8) * (1.0f / 8388608.0f) - 1.0f); hsh = hsh * 1664525u + 1013904223u; v1[j] *= 1.0f + NOISE_P1 * ((float)(hsh >> 8) * (1.0f / 8388608.0f) - 1.0f); } }
#endif
                    if (ACT == 1) {
#pragma unroll
                        for (int j = 0; j < 4; ++j) { v0[j] = fast_sigmoid(v0[j]); v1[j] = fast_sigmoid(v1[j]); } }
                    u32x4 w; w.x = cvt_pk_bf16(v0[0], v0[1]); w.y = cvt_pk_bf16(v0[2], v0[3]); w.z = cvt_pk_bf16(v1[0], v1[1]); w.w = cvt_pk_bf16(v1[2], v1[3]);
                    *(u32x4*)(rowp + bj * 128) = w; } }
    }
};
struct EpiSwiglu {
    static constexpr bool PERM = true, AFTER_DRAIN = false;
    bf16_t* H; int ldc;
    DI void operator()(const f32x4 (&acc)[2][2][4][2], const pg8::Unit& u, int wr, int wc, int fr, int fq) const {
        const int row0 = u.pm * 256 + wr * 64 + fr, col0 = u.pn * 128 + wc * 32 + 8 * fq;
#pragma unroll
        for (int ai = 0; ai < 2; ++ai)
#pragma unroll
            for (int m = 0; m < 4; ++m) { bf16_t* rowp = H + (size_t)(row0 + ai * 128 + m * 16) * ldc + col0;
                float h[8];
#pragma unroll
                for (int n = 0; n < 2; ++n)
#pragma unroll
                    for (int j = 0; j < 4; ++j) { const float g = acc[ai][0][m][n][j], up = acc[ai][1][m][n][j]; h[n * 4 + j] = g * fast_sigmoid(g) * up; }
                u32x4 w; w.x = cvt_pk_bf16(h[0], h[1]); w.y = cvt_pk_bf16(h[2], h[3]); w.z = cvt_pk_bf16(h[4], h[5]); w.w = cvt_pk_bf16(h[6], h[7]);
                *(u32x4*)rowp = w; }
    }
};
struct EpiPart {
    static constexpr bool PERM = true, AFTER_DRAIN = false;
    bf16_t* part01; bf16_t* part23;
    DI void operator()(const f32x4 (&acc)[2][2][4][2], const pg8::Unit& u, int wr, int wc, int fr, int fq) const {
        const int br = u.pm >> 6, pm = u.pm & 63, pn = u.pn & 7;
        bf16_t* O = (br < 2 ? part01 : part23) + (size_t)(br & 1) * T * 2048;
        const int row0 = pm * 256 + wr * 64 + fr, col0 = pn * 256 + wc * 32 + 8 * fq;
#pragma unroll
        for (int ai = 0; ai < 2; ++ai)
#pragma unroll
            for (int m = 0; m < 4; ++m) { bf16_t* rowp = O + (size_t)(row0 + ai * 128 + m * 16) * 2048 + col0;
#pragma unroll
                for (int bj = 0; bj < 2; ++bj) { const f32x4 v0 = acc[ai][bj][m][0], v1 = acc[ai][bj][m][1];
                    u32x4 w; w.x = cvt_pk_bf16(v0[0], v0[1]); w.y = cvt_pk_bf16(v0[2], v0[3]); w.z = cvt_pk_bf16(v1[0], v1[1]); w.w = cvt_pk_bf16(v1[2], v1[3]);
                    *(u32x4*)(rowp + bj * 128) = w; } }
    }
};
struct EpiMergeAcc {
    static constexpr bool PERM = true, AFTER_DRAIN = false;
    const bf16_t* G; bf16_t* O;
    DI void operator()(const f32x4 (&acc)[2][2][4][2], const pg8::Unit& u, int wr, int wc, int fr, int fq) const {
        const int br = u.pm >> 6, pm = u.pm & 63, pn = u.pn & 7;
        const int row0 = pm * 256 + wr * 64 + fr, col0 = pn * 256 + wc * 32 + 8 * fq;
#pragma unroll
        for (int ai = 0; ai < 2; ++ai) {
            u32x4 gw[4][2], ow[4][2];
#pragma unroll
            for (int m = 0; m < 4; ++m) { const size_t row = (size_t)(row0 + ai * 128 + m * 16);
#pragma unroll
                for (int bj = 0; bj < 2; ++bj) { gw[m][bj] = *(const u32x4*)(G + row * NGATE + br * 2048 + col0 + bj * 128);
                    ow[m][bj] = br > 0 ? *(const u32x4*)(O + row * 2048 + col0 + bj * 128) : (u32x4){0u, 0u, 0u, 0u}; } }
#pragma unroll
            for (int m = 0; m < 4; ++m) { bf16_t* op = O + (size_t)(row0 + ai * 128 + m * 16) * 2048 + col0;
#pragma unroll
                for (int bj = 0; bj < 2; ++bj) { const f32x4 v0 = acc[ai][bj][m][0], v1 = acc[ai][bj][m][1]; const u32x4 g = gw[m][bj], o = ow[m][bj];
                    float r[8];
                    r[0] = __uint_as_float(g.x << 16) * v0[0] + __uint_as_float(o.x << 16); r[1] = __uint_as_float(g.x & 0xffff0000u) * v0[1] + __uint_as_float(o.x & 0xffff0000u);
                    r[2] = __uint_as_float(g.y << 16) * v0[2] + __uint_as_float(o.y << 16); r[3] = __uint_as_float(g.y & 0xffff0000u) * v0[3] + __uint_as_float(o.y & 0xffff0000u);
                    r[4] = __uint_as_float(g.z << 16) * v1[0] + __uint_as_float(o.z << 16); r[5] = __uint_as_float(g.z & 0xffff0000u) * v1[1] + __uint_as_float(o.z & 0xffff0000u);
                    r[6] = __uint_as_float(g.w << 16) * v1[2] + __uint_as_float(o.w << 16); r[7] = __uint_as_float(g.w & 0xffff0000u) * v1[3] + __uint_as_float(o.w & 0xffff0000u);
                    u32x4 w; w.x = cvt_pk_bf16(r[0], r[1]); w.y = cvt_pk_bf16(r[2], r[3]); w.z = cvt_pk_bf16(r[4], r[5]); w.w = cvt_pk_bf16(r[6], r[7]);
                    *(u32x4*)(op + bj * 128) = w; } }
        }
    }
};
struct MergeOrder {
    int G, c;
    DI bool next(int i, pg8::Unit& u) const {
        const int ti = i >> 2, br = i & 3; const int tile = ti * G + c; if (tile >= 512) return false;
        int tm = tile >> 3, tn = tile & 7;
        if (G == 256) { const int x = c & 7, r = c >> 3; tm = ti * 32 + x * 4 + (r >> 3); tn = r & 7; }
        u.pm = br * 64 + tm; u.pn = br * 8 + tn; return true;
    }
    DI void a_ready(const pg8::Unit&) const {}
    DI void done(const pg8::Unit&) const {}
};

struct EpiGeluBias {
    static constexpr bool PERM = true, AFTER_DRAIN = false;
    bf16_t* O; int ldc; const float* bias;
    DI void operator()(const f32x4 (&acc)[2][2][4][2], const pg8::Unit& u, int wr, int wc, int fr, int fq) const {
        const int row0 = u.pm * 256 + wr * 64 + fr, col0 = u.pn * 256 + wc * 32 + 8 * fq;
#pragma unroll
        for (int ai = 0; ai < 2; ++ai)
#pragma unroll
            for (int m = 0; m < 4; ++m) { bf16_t* rowp = O + (size_t)(row0 + ai * 128 + m * 16) * ldc + col0;
#pragma unroll
                for (int bj = 0; bj < 2; ++bj) { float h[8];
#pragma unroll
                    for (int n = 0; n < 2; ++n)
#pragma unroll
                        for (int j = 0; j < 4; ++j) { const float x = acc[ai][bj][m][n][j] + bias[col0 + bj * 128 + n * 4 + j];
                            const float z = 0.7978845608028654f * (x + 0.044715f * x * x * x), th = 1.0f - 2.0f * __builtin_amdgcn_rcpf(1.0f + __expf(2.0f * z));
                            h[n * 4 + j] = 0.5f * x * (1.0f + th); }
                    u32x4 w; w.x = cvt_pk_bf16(h[0], h[1]); w.y = cvt_pk_bf16(h[2], h[3]); w.z = cvt_pk_bf16(h[4], h[5]); w.w = cvt_pk_bf16(h[6], h[7]);
                    *(u32x4*)(rowp + bj * 128) = w; } }
    }
};
struct EpiCmpOut {
    static constexpr bool PERM = false, AFTER_DRAIN = false;
    float* C;
    DI void operator()(const f32x4 (&acc)[2][2][4][2], const pg8::Unit& u, int wr, int wc, int fr, int fq) const {
        if (wc >= 2) return;
        const int row0 = u.pm * 256 + wr * 64 + fr, col0 = wc * 32 + 4 * fq;
#pragma unroll
        for (int ai = 0; ai < 2; ++ai)
#pragma unroll
            for (int m = 0; m < 4; ++m) { float* rowp = C + (size_t)(row0 + ai * 128 + m * 16) * 64 + col0;
#pragma unroll
                for (int n = 0; n < 2; ++n) *(f32x4*)(rowp + n * 16) = acc[ai][0][m][n]; }
    }
};
struct SplitOrder {
    int first, count, nN;
    DI bool next(int i, pg8::Unit& u) const { if (i >= count) return false; const int idx = first + i; u.pm = idx / nN; u.pn = idx % nN; return true; }
    DI void a_ready(const pg8::Unit&) const {}
    DI void done(const pg8::Unit&) const {}
};
struct RowWalkOrder {
    int pm, pn0, step, count;
    DI bool next(int i, pg8::Unit& u) const { if (i >= count) return false; u.pm = pm; u.pn = pn0 + i * step; return true; }
    DI void a_ready(const pg8::Unit&) const {}
    DI void done(const pg8::Unit&) const {}
};
template <class Epi>
DI void run_gemm(LAS unsigned char* lds, const bf16_t* A, int lda, const bf16_t* Bt, int ldb, int M, int N, int K, const Epi& E) {
    pg8::Gemm g; g.A = A; g.Bt = Bt; g.M = M; g.N = N; g.K = K; g.lda = lda; g.ldb = ldb;
    pg8::StaticOrder S; S.init(M, N, NBLK(), BIDX());
    pg8::gemm_phase<Epi, pg8::StaticOrder, false>((PG8_LAS unsigned char*)lds, g, S, E, nullptr);
}
#ifndef PREP_R1
#define PREP_R1 1
#endif
#ifndef PREP_R2
#define PREP_R2 1
#endif
#ifndef PREP_R3
#define PREP_R3 1
#endif
#ifndef PREP_R4
#define PREP_R4 1
#endif
#ifndef ZRWKV
#define ZRWKV 1.0f
#endif
#ifndef ZGLA
#define ZGLA 1.0f
#endif
DI void phase_setup(KParamsPtr p, LAS unsigned char* lds) {
    const int tid = TIDX(), bid = BIDX(), nb = NBLK();
    for (int i = bid * 512 + tid; i < SEQ * 48; i += nb * 512) {
        const int pos = i / 48, j = i % 48;
        const bool big = j < 32; const int jj = big ? j : j - 32;
        const double inv = exp2(-(double)jj * (13.287712379549449 / (big ? 32.0 : 16.0)));
        const double a = (double)pos * inv;
        const double r = a - 6.283185307179586 * floor(a / 6.283185307179586);
        const float cs = (float)cos(r), sn = (float)sin(r);
        if (big) { p->cos64[pos * 32 + jj] = cs; p->sin64[pos * 32 + jj] = sn; } else { p->cos32[pos * 16 + jj] = cs; p->sin32[pos * 16 + jj] = sn; }
    }
    LAS float* sc = (LAS float*)lds;
    LAS float* red = (LAS float*)(lds + 32768);
    for (int i = tid; i < NB * D; i += 512) { const float c = p->c[i]; sc[i] = c / (1.0f + __expf(-c)); }
    __syncthreads();
    const int cg = tid & 15, ks = tid >> 4;
    for (int chunk = bid; chunk < 576; chunk += nb) {
        const int ls = chunk / 96, col0 = (chunk % 96) * 64;
        const float* W = p->ada_w + (size_t)ls * D * 6144 + col0 + cg * 4;
        float acc[4][4];
#pragma unroll
        for (int b = 0; b < 4; ++b)
#pragma unroll
            for (int j = 0; j < 4; ++j) acc[b][j] = 0.f;
#pragma unroll 16
        for (int kk = 0; kk < 64; ++kk) {
            const int k = ks * 64 + kk;
            const f32x4 w = *(const f32x4*)(W + (size_t)k * 6144);
#pragma unroll
            for (int b = 0; b < 4; ++b) { const float s = sc[b * D + k];
#pragma unroll
                for (int j = 0; j < 4; ++j) acc[b][j] += s * w[j]; }
        }
#pragma unroll
        for (int b = 0; b < 4; ++b)
#pragma unroll
            for (int j = 0; j < 4; ++j) red[(ks * 4 + b) * 64 + cg * 4 + j] = acc[b][j];
        __syncthreads();
        if (tid < 256) { const int b = tid >> 6, col = tid & 63; float s = 0.f;
            for (int q = 0; q < 32; ++q) s += red[(q * 4 + b) * 64 + col];
            p->mod[(size_t)(ls * 4 + b) * 6144 + col0 + col] = s + p->ada_b[ls * 6144 + col0 + col]; }
        __syncthreads();
    }
}

template <class Map>
DI void conv_job(const float* src, int Ks, int Ns, const float* kscale, bf16_t* dst, int ldd, Map map, LAS float* tl) {
    const int tid = TIDX(), bid = BIDX(), nb = NBLK();
    const int ntk = Ks / 64, ntn = (Ns + 63) / 64, nt = ntk * ntn;
    for (int tile = bid; tile < nt; tile += nb) {
        const int k0 = (tile % ntk) * 64, n0 = (tile / ntk) * 64;
#pragma unroll
        for (int it = 0; it < 2; ++it) {
            const int kr = (tid >> 4) + 32 * it, n = n0 + 4 * (tid & 15);
            f32x4 v = (f32x4){0.f, 0.f, 0.f, 0.f};
            if (n < Ns) v = *(const f32x4*)(src + (size_t)(k0 + kr) * Ns + n);
            if (kscale) v *= kscale[k0 + kr];
#pragma unroll
            for (int j = 0; j < 4; ++j) tl[kr * 65 + 4 * (tid & 15) + j] = v[j];
        }
        __syncthreads();
        { const int nn = tid >> 3, k8 = tid & 7, n = n0 + nn;
            if (n < Ns) { float f[8];
#pragma unroll
                for (int i = 0; i < 8; ++i) f[i] = tl[(k8 * 8 + i) * 65 + nn];
                u32x4 w; w.x = pk2(f[0], f[1]); w.y = pk2(f[2], f[3]); w.z = pk2(f[4], f[5]); w.w = pk2(f[6], f[7]);
                *(u32x4*)(dst + (size_t)map(n) * ldd + k0 + k8 * 8) = w; } }
        __syncthreads();
    }
}
DI void phase_convert(KParamsPtr p, int l, LAS unsigned char* lds) {
    LAS float* tl = (LAS float*)lds;
    const int tid = TIDX(), bid = BIDX(), nb = NBLK();
    const size_t fsz = (size_t)D * DFF;
    for (int f = 0; f < 2; ++f) {
        bf16_t* Wup = f ? p->Wup1 : p->Wup0; bf16_t* Wdn = f ? p->Wdn1 : p->Wdn0;
        conv_job(p->ffn_wg + (size_t)(l * 2 + f) * fsz, D, DFF, nullptr, Wup, D, [](int n) { return 256 * (n >> 7) + (n & 127); }, tl);
        conv_job(p->ffn_wu + (size_t)(l * 2 + f) * fsz, D, DFF, nullptr, Wup, D, [](int n) { return 256 * (n >> 7) + 128 + (n & 127); }, tl);
        conv_job(p->ffn_wd + (size_t)(l * 2 + f) * fsz, DFF, D, nullptr, Wdn, DFF, [](int n) { return n; }, tl);
    }
    conv_job(p->mix_w_in + (size_t)l * D * PROJ_IN, D, PROJ_IN, nullptr, p->Win1, D, [](int n) { return n < NP1 ? n : n - NP1 + NP1P; }, tl);
    for (int i = 0; i < 4; ++i)
        conv_job(p->mix_w_branch + (size_t)(l * 4 + i) * 512 * D, 512, D, nullptr, p->Wbr + (size_t)i * D * 512, 512, [](int n) { return n; }, tl);
    conv_job(p->mix_w_out + (size_t)l * D * D, D, D, nullptr, p->Wout, D, [](int n) { return n; }, tl);
    conv_job(p->mla_wuq + (size_t)l * 384 * 768, 384, 768, p->mla_qn + l * 384, p->Wuq, 384, [](int n) { return n; }, tl);
    conv_job(p->mla_wukv + (size_t)l * 128 * 1024, 128, 1024, p->mla_kvn + l * 128, p->Wukv, 256, [](int n) { return n; }, tl);
    for (int wh = 0; wh < 2; ++wh) {
        conv_job(p->cmp_w1 + (size_t)(l * 2 + wh) * 2048 * 256, 2048, 256, nullptr, p->cW1t + (size_t)wh * 256 * 2048, 2048, [](int n) { return n; }, tl);
        conv_job(p->cmp_w2 + (size_t)(l * 2 + wh) * 256 * 64, 256, 64, nullptr, p->cW2t + (size_t)wh * 256 * 256, 256, [](int n) { return n; }, tl);
    }
    for (int i = bid * 512 + tid; i < 2 * 192 * 256 / 8; i += nb * 512) { const int wh = i / (192 * 32), r = (i % (192 * 32)) >> 5, c8 = i & 31; *(u32x4*)(p->cW2t + (size_t)wh * 256 * 256 + (size_t)(64 + r) * 256 + c8 * 8) = (u32x4){0u, 0u, 0u, 0u}; }
    __syncthreads();
    for (int job = nb - 1 - bid; job < 32; job += nb) { const int wh = job >> 4, n0 = (job & 15) * 16, c = tid & 15, ks = tid >> 4;
        const float* ps = p->cmp_pos + (l * 2 + wh) * 2048 + ks * 64; const float* w1 = p->cmp_w1 + (size_t)(l * 2 + wh) * 2048 * 256 + (size_t)ks * 64 * 256 + n0 + c;
        float a = 0.f;
#pragma unroll 16
        for (int k = 0; k < 64; ++k) a += ps[k] * w1[(size_t)k * 256];
        tl[ks * 16 + c] = a;
        __syncthreads();
        if (tid < 16) { float sm = 0.f;
            for (int q = 0; q < 32; ++q) sm += tl[q * 16 + tid];
            p->cbias[wh * 256 + n0 + tid] = sm; }
        __syncthreads(); }
    conv_job(p->rw_w_w2 + (size_t)l * 64 * 512, 64, 512, nullptr, p->rwWlT, 256, [](int n) { return n; }, tl);
    conv_job(p->rw_a_w2 + (size_t)l * 64 * 512, 64, 512, nullptr, p->rwWlT + 64, 256, [](int n) { return n; }, tl);
    conv_job(p->rw_g_w2 + (size_t)l * 128 * 512, 128, 512, nullptr, p->rwWlT + 128, 256, [](int n) { return n; }, tl);
    for (int i = bid * 512 + tid; i < (NP1P - NP1) * D / 8; i += nb * 512) ((u32x4*)(p->Win1 + (size_t)NP1 * D))[i] = (u32x4){0u, 0u, 0u, 0u};
    for (int i = bid * 512 + tid; i < 1024 * 16; i += nb * 512) { const int r = i >> 4, c8 = i & 15; *(u32x4*)(p->Wukv + (size_t)r * 256 + 128 + c8 * 8) = (u32x4){0u, 0u, 0u, 0u}; }
}

DI void ld8bf(const bf16_t* q, float (&f)[8]) { const u32x4 w = *(const u32x4*)q;
    f[0] = __uint_as_float(w.x << 16); f[1] = __uint_as_float(w.x & 0xffff0000u); f[2] = __uint_as_float(w.y << 16); f[3] = __uint_as_float(w.y & 0xffff0000u);
    f[4] = __uint_as_float(w.z << 16); f[5] = __uint_as_float(w.z & 0xffff0000u); f[6] = __uint_as_float(w.w << 16); f[7] = __uint_as_float(w.w & 0xffff0000u); }
DI u32x4 pack8bf(const float (&f)[8]) { u32x4 w; w.x = pk2(f[0], f[1]); w.y = pk2(f[2], f[3]); w.z = pk2(f[4], f[5]); w.w = pk2(f[6], f[7]); return w; }
DI void ld8f(const float* q, float (&f)[8]) { const f32x4 a = *(const f32x4*)q, b = *(const f32x4*)(q + 4); f[0] = a[0]; f[1] = a[1]; f[2] = a[2]; f[3] = a[3]; f[4] = b[0]; f[5] = b[1]; f[6] = b[2]; f[7] = b[3]; }
template <bool HAS_Y, bool HAS_U, bool XIN_BF = false, bool XOUT_BF = false>
DI void phase_norm(const void* xin_, const bf16_t* y, void* xout_, bf16_t* u, const float* g_post, const float* modPrev, float rw, const float* g_pre, const float* modNext) {
    const float* xin = (const float*)xin_; const bf16_t* xinb = (const bf16_t*)xin_; float* xout = (float*)xout_; bf16_t* xoutb = (bf16_t*)xout_;
    const int tid = TIDX(), lane = tid & 63, wave = tid >> 6;
    for (int row0 = (BIDX() * 8 + wave) * 2; row0 < T; row0 += NBLK() * 16) {
        const int b = row0 >> 12;
        float xv[2][4][8]; u32x4 yw[2][4];
#pragma unroll
        for (int r = 0; r < 2; ++r)
#pragma unroll
            for (int i = 0; i < 4; ++i) { const size_t o = (size_t)(row0 + r) * D + i * 512 + lane * 8;
                if (XIN_BF) ld8bf(xinb + o, xv[r][i]); else ld8f(xin + o, xv[r][i]);
                if (HAS_Y) yw[r][i] = *(const u32x4*)(y + o); }
        if (HAS_Y) {
            float gc[4][8];
#pragma unroll
            for (int i = 0; i < 4; ++i) { const int col = i * 512 + lane * 8; float gp[8], gt[8]; ld8f(g_post + col, gp); ld8f(modPrev + (size_t)b * 6144 + 4096 + col, gt);
#pragma unroll
                for (int e = 0; e < 8; ++e) gc[i][e] = gp[e] * gt[e]; }
#pragma unroll
            for (int r = 0; r < 2; ++r) { float yv[4][8]; float ss = 0.f;
#pragma unroll
                for (int i = 0; i < 4; ++i) { const u32x4 w = yw[r][i];
                    yv[i][0] = __uint_as_float(w.x << 16); yv[i][1] = __uint_as_float(w.x & 0xffff0000u); yv[i][2] = __uint_as_float(w.y << 16); yv[i][3] = __uint_as_float(w.y & 0xffff0000u);
                    yv[i][4] = __uint_as_float(w.z << 16); yv[i][5] = __uint_as_float(w.z & 0xffff0000u); yv[i][6] = __uint_as_float(w.w << 16); yv[i][7] = __uint_as_float(w.w & 0xffff0000u);
#pragma unroll
                    for (int e = 0; e < 8; ++e) ss += yv[i][e] * yv[i][e]; }
                ss = wsum(ss);
                const float rs = rsqrtf(ss * (1.0f / D) + NORM_EPS) * rw;
#pragma unroll
                for (int i = 0; i < 4; ++i)
#pragma unroll
                    for (int e = 0; e < 8; ++e) xv[r][i][e] += gc[i][e] * (yv[i][e] * rs); }
        }
        float cu[4][8], sh[4][8];
        if (HAS_U) {
#pragma unroll
            for (int i = 0; i < 4; ++i) { const int col = i * 512 + lane * 8; float gp[8], scl[8]; ld8f(g_pre + col, gp); ld8f(modNext + (size_t)b * 6144 + 2048 + col, scl); ld8f(modNext + (size_t)b * 6144 + col, sh[i]);
#pragma unroll
                for (int e = 0; e < 8; ++e) cu[i][e] = gp[e] * (scl[e] + 1.0f); }
        }
        if (HAS_Y) {
#pragma unroll
            for (int r = 0; r < 2; ++r)
#pragma unroll
                for (int i = 0; i < 4; ++i) { const size_t o = (size_t)(row0 + r) * D + i * 512 + lane * 8;
                    if (XOUT_BF) *(u32x4*)(xoutb + o) = pack8bf(xv[r][i]);
                    else { *(f32x4*)(xout + o) = (f32x4){xv[r][i][0], xv[r][i][1], xv[r][i][2], xv[r][i][3]}; *(f32x4*)(xout + o + 4) = (f32x4){xv[r][i][4], xv[r][i][5], xv[r][i][6], xv[r][i][7]}; } }
        }
        if (HAS_U) {
#pragma unroll
            for (int r = 0; r < 2; ++r) { float ss = 0.f;
#pragma unroll
                for (int i = 0; i < 4; ++i)
#pragma unroll
                    for (int e = 0; e < 8; ++e) ss += xv[r][i][e] * xv[r][i][e];
                ss = wsum(ss);
                const float rs = rsqrtf(ss * (1.0f / D) + NORM_EPS);
#pragma unroll
                for (int i = 0; i < 4; ++i) { float uu[8];
#pragma unroll
                    for (int e = 0; e < 8; ++e) uu[e] = (xv[r][i][e] * rs) * cu[i][e] + sh[i][e];
                    *(u32x4*)(u + (size_t)(row0 + r) * D + i * 512 + lane * 8) = pack8bf(uu); } }
        }
    }
}

DI float ldP(const bf16_t* P1, int t, int col) { return bf2f(P1[(size_t)t * NP1P + col]); }
DI void phase_prep(KParamsPtr p, int l, LAS unsigned char* lds) {
    constexpr int TT = 8;
    const int tid = TIDX(), lane = tid & 63, wave = tid >> 6;
    LAS float* wl = (LAS float*)lds;
    LAS float* al = wl + TT * 64;
    LAS float* gl = al + TT * 64;
    LAS float* ga = gl + TT * 128;
    LAS float* rsq = ga + TT * 16;
    LAS float* gw2 = rsq + TT * 2;
    for (int i = tid; i < 16 * 256; i += 512) gw2[i] = p->gla_w2[l * 16 * 256 + i];
    __syncthreads();
    const bf16_t* P1 = p->P1;
    const float* mu = p->rw_mu + l * 1792;
    const float* w_w2 = p->rw_w_w2 + l * 64 * 512; const float* a_w2 = p->rw_a_w2 + l * 64 * 512; const float* g_w2 = p->rw_g_w2 + l * 128 * 512;
    for (int tile = BIDX(); tile < T / TT; tile += NBLK()) {
        const int t0 = tile * TT;
        for (int rp1_ = 0; rp1_ < PREP_R1; ++rp1_) {
        for (int i = tid; i < TT * 256; i += 512) {
            const int tt = i >> 8, c = i & 255, t = t0 + tt, s = t & (SEQ - 1);
            const int col = c < 64 ? C_RW_WLO + c : (c < 128 ? C_RW_ALO + (c - 64) : C_RW_GLO + (c - 128));
            const float pv = ldP(P1, t, col), pp = s > 0 ? ldP(P1, t - 1, col) : 0.f;
            const float xs = pv + (pp - pv) * mu[col - C_RW];
            if (c < 64) wl[tt * 64 + c] = tanhf(xs); else if (c < 128) al[tt * 64 + c - 64] = xs; else gl[tt * 128 + c - 128] = sigmoidf_(xs);
        }
        if (tid < TT * 16) ga[tid] = ldP(P1, t0 + (tid >> 4), C_GLA_ALO + (tid & 15));
        for (int tk = wave; tk < TT; tk += 8) { const int t = t0 + tk; float sq = 0.f, skv = 0.f;
#pragma unroll
            for (int i = 0; i < 6; ++i) { const float v = ldP(P1, t, C_MLA_CQ + i * 64 + lane); sq += v * v; }
#pragma unroll
            for (int i = 0; i < 2; ++i) { const float v = ldP(P1, t, C_MLA_CKV + i * 64 + lane); skv += v * v; }
            sq = wsum(sq); skv = wsum(skv);
            if (lane == 0) { rsq[tk * 2] = rsqrtf(sq * (1.0f / 384.0f) + NORM_EPS); rsq[tk * 2 + 1] = rsqrtf(skv * (1.0f / 128.0f) + NORM_EPS); } }
        __syncthreads(); }
        for (int rp2_ = 0; rp2_ < PREP_R2; ++rp2_) { const int j = tid;
            float aw[TT], aa[TT], ag[TT];
            const float w0 = p->rw_w0[l * 512 + j], a0 = p->rw_a0[l * 512 + j];
#pragma unroll
            for (int tt = 0; tt < TT; ++tt) { aw[tt] = w0; aa[tt] = a0; ag[tt] = 0.f; }
#pragma unroll 4
            for (int i = 0; i < 64; i += 4) {
                const float ww0 = w_w2[i * 512 + j], ww1 = w_w2[(i + 1) * 512 + j], ww2 = w_w2[(i + 2) * 512 + j], ww3 = w_w2[(i + 3) * 512 + j];
                const float wa0 = a_w2[i * 512 + j], wa1 = a_w2[(i + 1) * 512 + j], wa2 = a_w2[(i + 2) * 512 + j], wa3 = a_w2[(i + 3) * 512 + j];
#pragma unroll
                for (int tt = 0; tt < TT; ++tt) { const f32x4 x = *(const LAS f32x4*)(wl + tt * 64 + i), z = *(const LAS f32x4*)(al + tt * 64 + i);
                    aw[tt] += (x[0] * ww0 + x[1] * ww1) + (x[2] * ww2 + x[3] * ww3); aa[tt] += (z[0] * wa0 + z[1] * wa1) + (z[2] * wa2 + z[3] * wa3); } }
#pragma unroll 4
            for (int i = 0; i < 128; i += 4) {
                const float wg0 = g_w2[i * 512 + j], wg1 = g_w2[(i + 1) * 512 + j], wg2 = g_w2[(i + 2) * 512 + j], wg3 = g_w2[(i + 3) * 512 + j];
#pragma unroll
                for (int tt = 0; tt < TT; ++tt) { const f32x4 x = *(const LAS f32x4*)(gl + tt * 128 + i); ag[tt] += (x[0] * wg0 + x[1] * wg1) + (x[2] * wg2 + x[3] * wg3); } }
            const float k_k = p->rw_k_k[l * 512 + j], k_a = p->rw_k_a[l * 512 + j];
            const float mur = mu[C_RW_R - C_RW + j], muk = mu[C_RW_K - C_RW + j], muv = mu[C_RW_V - C_RW + j];
#pragma unroll
            for (int tt = 0; tt < TT; ++tt) {
                const int t = t0 + tt, s = t & (SEQ - 1);
                float xr = ldP(P1, t, C_RW_R + j), xk = ldP(P1, t, C_RW_K + j), xv = ldP(P1, t, C_RW_V + j);
                const float pr = s > 0 ? ldP(P1, t - 1, C_RW_R + j) : 0.f, pk = s > 0 ? ldP(P1, t - 1, C_RW_K + j) : 0.f, pvv = s > 0 ? ldP(P1, t - 1, C_RW_V + j) : 0.f;
                xr += (pr - xr) * mur; xk += (pk - xk) * muk; xv += (pvv - xv) * muv;
                const float w = __expf(-0.6065306597126334f * sigmoidf_(aw[tt]));
                const float a = sigmoidf_(aa[tt]);
                const float kkr = xk * k_k;
                const float ss = wsum(kkr * kkr);
                const float kk = kkr / fmaxf(sqrtf(ss), 1e-12f);
                const float k2 = xk * (1.0f + (a - 1.0f) * k_a);
                const size_t o = (size_t)t * 512 + j;
                p->rw_r[o] = f2bf(xr); p->rw_w[o] = w; p->rw_k[o] = f2bf(k2); p->rw_v[o] = f2bf(xv); p->rw_kk[o] = kk; p->rw_b[o] = kk * a; p->rw_g[o] = f2bf(ag[tt]);
            } }
        for (int rp3_ = 0; rp3_ < PREP_R3; ++rp3_)
        for (int tt = 0; tt < TT; ++tt) {
            const int t = t0 + tt, s = t & (SEQ - 1), b = t >> 12;
            if (tid < 256) { const int h = tid >> 5, i = tid & 31;
                const float x1 = ldP(P1, t, C_NSA_Q + h * 64 + i), x2 = ldP(P1, t, C_NSA_Q + h * 64 + 32 + i), cs = p->cos64[s * 32 + i], sn = p->sin64[s * 32 + i];
                p->nsa_q[(size_t)t * 512 + h * 64 + i] = f2bf(x1 * cs - x2 * sn); p->nsa_q[(size_t)t * 512 + h * 64 + 32 + i] = f2bf(x1 * sn + x2 * cs);
            } else if (tid < 448) { const int r = tid - 256, which = r >> 6, hk = (r >> 5) & 1, i = r & 31;
                const int sc = (which == 0 ? C_NSA_KC : (which == 1 ? C_NSA_KS : C_NSA_KW)) + hk * 64;
                bf16_t* dst = which == 0 ? p->nsa_kc_in : (which == 1 ? p->nsa_ks : p->nsa_kw);
                const float x1 = ldP(P1, t, sc + i), x2 = ldP(P1, t, sc + 32 + i), cs = p->cos64[s * 32 + i], sn = p->sin64[s * 32 + i];
                const size_t o = ((size_t)(b * 2 + hk) * SEQ + s) * 64;
                dst[o + i] = f2bf(x1 * cs - x2 * sn); dst[o + 32 + i] = f2bf(x1 * sn + x2 * cs);
            } else if (tid < 472) { const int g = tid - 448; p->nsa_gate[(size_t)t * 24 + g] = sigmoidf_(ldP(P1, t, C_NSA_GL + g)); }
            if (tid < 384) { const int which = tid >> 7, hk = (tid >> 6) & 1, d = tid & 63;
                const int sc = (which == 0 ? C_NSA_VC : (which == 1 ? C_NSA_VS : C_NSA_VW)) + hk * 64;
                bf16_t* dst = which == 0 ? p->nsa_vc_in : (which == 1 ? p->nsa_vs : p->nsa_vw);
                dst[((size_t)(b * 2 + hk) * SEQ + s) * 64 + d] = P1[(size_t)t * NP1P + sc + d]; }
        }
        for (int rp4_ = 0; rp4_ < PREP_R4; ++rp4_) {
        for (int i = tid; i < TT * 256; i += 512) {
            const int tt = i >> 8, d = i & 255;
            float z = p->gla_b[l * 256 + d];
#pragma unroll
            for (int q = 0; q < 16; ++q) z += ga[tt * 16 + q] * gw2[q * 256 + d];
            const float ez = __expf(-fabsf(z)), ls = fminf(z, 0.f) - __logf(1.0f + ez);
            p->gla_la[(size_t)(t0 + tt) * 256 + d] = ls * (1.0f / 16.0f);
        }
        for (int i = tid; i < TT * 384; i += 512) { const int tt = i / 384, c = i % 384; p->mla_cqn[(size_t)(t0 + tt) * 384 + c] = f2bf(ldP(P1, t0 + tt, C_MLA_CQ + c) * rsq[tt * 2]); }
        for (int i = tid; i < TT * 256; i += 512) { const int tt = i >> 8, c = i & 255; p->mla_ckvn[(size_t)(t0 + tt) * 256 + c] = c < 128 ? f2bf(ldP(P1, t0 + tt, C_MLA_CKV + c) * rsq[tt * 2 + 1]) : (bf16_t)0; }
        if (tid < TT * 16) { const int tt = tid >> 4, i = tid & 15, t = t0 + tt, s = t & (SEQ - 1);
            const float x1 = ldP(P1, t, C_MLA_KR + i), x2 = ldP(P1, t, C_MLA_KR + 16 + i), cs = p->cos32[s * 16 + i], sn = p->sin32[s * 16 + i];
            p->mla_kpe[(size_t)t * 32 + i] = f2bf(x1 * cs - x2 * sn); p->mla_kpe[(size_t)t * 32 + 16 + i] = f2bf(x1 * sn + x2 * cs); }
        }
        __syncthreads();
    }
}

DI float prep_red16(float x) {
    x += __int_as_float(__builtin_amdgcn_update_dpp(0, __float_as_int(x), 0xB1, 0xF, 0xF, true)); x += __int_as_float(__builtin_amdgcn_update_dpp(0, __float_as_int(x), 0x4E, 0xF, 0xF, true));
    x += __int_as_float(__builtin_amdgcn_update_dpp(0, __float_as_int(x), 0x141, 0xF, 0xF, true)); x += __int_as_float(__builtin_amdgcn_update_dpp(0, __float_as_int(x), 0x140, 0xF, 0xF, true)); return x; }
DI void rope8(const bf16_t* src1, const bf16_t* src2, const float* cs, const float* sn, bf16_t* dst1, bf16_t* dst2) {
    float x1[8], x2[8], c[8], sgn[8], o1[8], o2[8]; ld8bf(src1, x1); ld8bf(src2, x2); ld8f(cs, c); ld8f(sn, sgn);
#pragma unroll
    for (int e = 0; e < 8; ++e) { o1[e] = x1[e] * c[e] - x2[e] * sgn[e]; o2[e] = x1[e] * sgn[e] + x2[e] * c[e]; }
    *(u32x4*)dst1 = pack8bf(o1); *(u32x4*)dst2 = pack8bf(o2); }
constexpr int P1TAIL = 5120;
DI float ldtail(const float* part, int t, int cc) { return (part[(size_t)t * 256 + cc] + part[((size_t)T + t) * 256 + cc]) + (part[((size_t)2 * T + t) * 256 + cc] + part[((size_t)3 * T + t) * 256 + cc]); }
DI void ldtail8(const float* part, int t, int cc, float (&f)[8]) { float a[8], b[8], c[8], d[8];
    ld8f(part + (size_t)t * 256 + cc, a); ld8f(part + ((size_t)T + t) * 256 + cc, b); ld8f(part + ((size_t)2 * T + t) * 256 + cc, c); ld8f(part + ((size_t)3 * T + t) * 256 + cc, d);
#pragma unroll
    for (int e = 0; e < 8; ++e) f[e] = (a[e] + b[e]) + (c[e] + d[e]); }
DI void phase_prep2(KParamsPtr p, int l, LAS unsigned char* lds) {
    constexpr int TT = 16, XS = 264;
    const int tid = TIDX(), lane = tid & 63, wave = tid >> 6, fr = lane & 15, q4 = lane >> 4;
    LAS bf16_t* xa = (LAS bf16_t*)lds;
    LAS float* ga = (LAS float*)(lds + TT * XS * 2);
    LAS float* rsq = ga + TT * 16;
    LAS float* gw2 = rsq + TT * 2;
    LAS float* tl = gw2 + 16 * 256;
    for (int i = tid; i < 16 * 256; i += 512) gw2[i] = p->gla_w2[l * 16 * 256 + i];
    __syncthreads();
    const bf16_t* P1 = p->P1; const float* ptail = (const float*)p->y;
    const float* mu = p->rw_mu + l * 1792;
    const bf16_t* WT = p->rwWlT;
    float c_w0[4], c_a0[4], c_kk[4], c_ka[4], c_mr[4], c_mk[4], c_mv[4];
#pragma unroll
    for (int nb = 0; nb < 4; ++nb) { const int ch = wave * 64 + nb * 16 + fr;
        c_w0[nb] = p->rw_w0[l * 512 + ch]; c_a0[nb] = p->rw_a0[l * 512 + ch]; c_kk[nb] = p->rw_k_k[l * 512 + ch]; c_ka[nb] = p->rw_k_a[l * 512 + ch];
        c_mr[nb] = mu[C_RW_R - C_RW + ch]; c_mk[nb] = mu[C_RW_K - C_RW + ch]; c_mv[nb] = mu[C_RW_V - C_RW + ch]; }
    for (int tile = BIDX(); tile < T / TT; tile += NBLK()) {
        const int t0 = tile * TT;
        { const int tt = tid >> 5, c = (tid & 31) * 8, t = t0 + tt, s = t & (SEQ - 1);
            const int col = c < 64 ? C_RW_WLO + c : (c < 128 ? C_RW_ALO + (c - 64) : C_RW_GLO + (c - 128));
            float pv[8], pp[8], m8[8], o[8]; ld8bf(P1 + (size_t)t * NP1P + col, pv); ld8f(mu + col - C_RW, m8);
            if (s > 0) ld8bf(P1 + (size_t)(t - 1) * NP1P + col, pp); else {
#pragma unroll
                for (int e = 0; e < 8; ++e) pp[e] = 0.f; }
#pragma unroll
            for (int e = 0; e < 8; ++e) { const float xs = pv[e] + (pp[e] - pv[e]) * m8[e];
                o[e] = c < 64 ? 1.0f - 2.0f / (__expf(2.0f * xs) + 1.0f) : (c < 128 ? xs : sigmoidf_(xs)); }
            *(LAS u32x4*)(xa + tt * XS + c) = pack8bf(o); }
        if (tid >= 512 - TT * 9) { const int k_ = tid - (512 - TT * 9), tt = k_ / 9, ch = k_ % 9; float f8[8]; ldtail8(ptail, t0 + tt, ch * 8, f8);
            *(LAS f32x4*)(tl + tt * 80 + ch * 8) = (f32x4){f8[0], f8[1], f8[2], f8[3]}; *(LAS f32x4*)(tl + tt * 80 + ch * 8 + 4) = (f32x4){f8[4], f8[5], f8[6], f8[7]}; }
        if (tid < TT * 16) ga[tid] = ldP(P1, t0 + (tid >> 4), C_GLA_ALO + (tid & 15));
        __syncthreads();
        {
            f32x4 acc[3][4];
#pragma unroll
            for (int w3 = 0; w3 < 3; ++w3)
#pragma unroll
                for (int nb = 0; nb < 4; ++nb) acc[w3][nb] = (f32x4){0.f, 0.f, 0.f, 0.f};
#pragma unroll
            for (int ks = 0; ks < 8; ++ks) {
                const bf16x8 af = *(const LAS bf16x8*)(xa + fr * XS + ks * 32 + q4 * 8);
#pragma unroll
                for (int nb = 0; nb < 4; ++nb) { const bf16x8 bfr = *(const bf16x8*)(WT + (size_t)(wave * 64 + nb * 16 + fr) * 256 + ks * 32 + q4 * 8);
                    acc[ks < 2 ? 0 : (ks < 4 ? 1 : 2)][nb] = __builtin_amdgcn_mfma_f32_16x16x32_bf16(af, bfr, acc[ks < 2 ? 0 : (ks < 4 ? 1 : 2)][nb], 0, 0, 0); }
            }
#pragma unroll
            for (int jj = 0; jj < 4; ++jj) {
                const int t = t0 + q4 * 4 + jj, s = t & (SEQ - 1);
                float xr[4], xk[4], xv[4], kkr[4]; float ss = 0.f;
#pragma unroll
                for (int nb = 0; nb < 4; ++nb) { const int ch = wave * 64 + nb * 16 + fr;
                    xr[nb] = ldP(P1, t, C_RW_R + ch); xk[nb] = ldP(P1, t, C_RW_K + ch); xv[nb] = ldP(P1, t, C_RW_V + ch);
                    const float pr = s > 0 ? ldP(P1, t - 1, C_RW_R + ch) : 0.f, pk = s > 0 ? ldP(P1, t - 1, C_RW_K + ch) : 0.f, pvv = s > 0 ? ldP(P1, t - 1, C_RW_V + ch) : 0.f;
                    xr[nb] += (pr - xr[nb]) * c_mr[nb]; xk[nb] += (pk - xk[nb]) * c_mk[nb]; xv[nb] += (pvv - xv[nb]) * c_mv[nb];
                    kkr[nb] = xk[nb] * c_kk[nb]; ss += kkr[nb] * kkr[nb]; }
                ss = prep_red16(ss);
                const float rn = 1.0f / fmaxf(sqrtf(ss), 1e-12f);
#pragma unroll
                for (int nb = 0; nb < 4; ++nb) { const int ch = wave * 64 + nb * 16 + fr;
                    const float w = __expf(-0.6065306597126334f * sigmoidf_(c_w0[nb] + acc[0][nb][jj]));
                    const float a = sigmoidf_(c_a0[nb] + acc[1][nb][jj]);
                    const float kk = kkr[nb] * rn, k2 = xk[nb] * (1.0f + (a - 1.0f) * c_ka[nb]);
                    const size_t o = (size_t)t * 512 + ch;
                    p->rw_r[o] = f2bf(xr[nb]); p->rw_w[o] = w; p->rw_k[o] = f2bf(k2); p->rw_v[o] = f2bf(xv[nb]); p->rw_kk[o] = kk; p->rw_b[o] = kk * a; p->rw_g[o] = f2bf(acc[2][nb][jj]); }
            }
        }
        for (int tk = wave; tk < TT; tk += 8) { const int t = t0 + tk; float sq = 0.f, skv = 0.f;
#pragma unroll
            for (int i = 0; i < 6; ++i) { const float v = ldP(P1, t, C_MLA_CQ + i * 64 + lane); sq += v * v; }
#pragma unroll
            for (int i = 0; i < 2; ++i) { const int col = C_MLA_CKV + i * 64 + lane; const float v = col < P1TAIL ? ldP(P1, t, col) : tl[tk * 80 + col - P1TAIL]; skv += v * v; }
            sq = wsum(sq); skv = wsum(skv);
            if (lane == 0) { rsq[tk * 2] = rsqrtf(sq * (1.0f / 384.0f) + NORM_EPS); rsq[tk * 2 + 1] = rsqrtf(skv * (1.0f / 128.0f) + NORM_EPS); } }
        __syncthreads();
        { const int tt = tid >> 5, idx = tid & 31, t = t0 + tt, s = t & (SEQ - 1), b = t >> 12;
            const bf16_t* row = P1 + (size_t)t * NP1P;
            { const int h = idx >> 2, ic = idx & 3;
              rope8(row + C_NSA_Q + h * 64 + ic * 8, row + C_NSA_Q + h * 64 + 32 + ic * 8, p->cos64 + s * 32 + ic * 8, p->sin64 + s * 32 + ic * 8,
                    p->nsa_q + (size_t)t * 512 + h * 64 + ic * 8, p->nsa_q + (size_t)t * 512 + h * 64 + 32 + ic * 8); }
            asm volatile("" ::: "memory");
            if (idx < 24) { const int which = idx >> 3, hk = (idx >> 2) & 1, ic = idx & 3;
                const int sc = (which == 0 ? C_NSA_KC : (which == 1 ? C_NSA_KS : C_NSA_KW)) + hk * 64;
                bf16_t* dst = (which == 0 ? p->nsa_kc_in : (which == 1 ? p->nsa_ks : p->nsa_kw)) + ((size_t)(b * 2 + hk) * SEQ + s) * 64;
                rope8(row + sc + ic * 8, row + sc + 32 + ic * 8, p->cos64 + s * 32 + ic * 8, p->sin64 + s * 32 + ic * 8, dst + ic * 8, dst + 32 + ic * 8); }
#pragma unroll
            for (int ps = 0; ps < 2; ++ps) { const int k = idx + 32 * ps;
                if (k < 48) { const int which = k >> 4, hk = (k >> 3) & 1, ic = k & 7;
                    const int sc = (which == 0 ? C_NSA_VC : (which == 1 ? C_NSA_VS : C_NSA_VW)) + hk * 64;
                    bf16_t* dst = (which == 0 ? p->nsa_vc_in : (which == 1 ? p->nsa_vs : p->nsa_vw)) + ((size_t)(b * 2 + hk) * SEQ + s) * 64;
                    *(u32x4*)(dst + ic * 8) = *(const u32x4*)(row + sc + ic * 8); } }
            asm volatile("" ::: "memory");
            if (idx < 3) { float g8[8]; ld8bf(row + C_NSA_GL + idx * 8, g8);
                float* gd = p->nsa_gate + (size_t)t * 24 + idx * 8;
                *(f32x4*)gd = (f32x4){sigmoidf_(g8[0]), sigmoidf_(g8[1]), sigmoidf_(g8[2]), sigmoidf_(g8[3])}; *(f32x4*)(gd + 4) = (f32x4){sigmoidf_(g8[4]), sigmoidf_(g8[5]), sigmoidf_(g8[6]), sigmoidf_(g8[7])}; }
            asm volatile("" ::: "memory");
            { const int c = idx * 8; u32x4 w = (u32x4){0u, 0u, 0u, 0u};
              if (c < 128) { float v8[8]; if (C_MLA_CKV + c < P1TAIL) ld8bf(row + C_MLA_CKV + c, v8); else { const f32x4 a_ = *(const LAS f32x4*)(tl + tt * 80 + C_MLA_CKV + c - P1TAIL), b_ = *(const LAS f32x4*)(tl + tt * 80 + C_MLA_CKV + c - P1TAIL + 4); v8[0] = a_[0]; v8[1] = a_[1]; v8[2] = a_[2]; v8[3] = a_[3]; v8[4] = b_[0]; v8[5] = b_[1]; v8[6] = b_[2]; v8[7] = b_[3]; } const float r = rsq[tt * 2 + 1];
#pragma unroll
                  for (int e = 0; e < 8; ++e) v8[e] *= r;
                  w = pack8bf(v8); }
              *(u32x4*)(p->mla_ckvn + (size_t)t * 256 + c) = w; }
            if (idx < 2) { float x1[8], x2[8], cs[8], sn[8], o1[8], o2[8]; { const f32x4 a_ = *(const LAS f32x4*)(tl + tt * 80 + C_MLA_KR - P1TAIL + idx * 8), b_ = *(const LAS f32x4*)(tl + tt * 80 + C_MLA_KR - P1TAIL + idx * 8 + 4), c_ = *(const LAS f32x4*)(tl + tt * 80 + C_MLA_KR - P1TAIL + 16 + idx * 8), d_ = *(const LAS f32x4*)(tl + tt * 80 + C_MLA_KR - P1TAIL + 16 + idx * 8 + 4);
#pragma unroll
                  for (int e = 0; e < 4; ++e) { x1[e] = a_[e]; x1[4 + e] = b_[e]; x2[e] = c_[e]; x2[4 + e] = d_[e]; } }
                ld8f(p->cos32 + s * 16 + idx * 8, cs); ld8f(p->sin32 + s * 16 + idx * 8, sn);
#pragma unroll
                for (int e = 0; e < 8; ++e) { o1[e] = x1[e] * cs[e] - x2[e] * sn[e]; o2[e] = x1[e] * sn[e] + x2[e] * cs[e]; }
                *(u32x4*)(p->mla_kpe + (size_t)t * 32 + idx * 8) = pack8bf(o1); *(u32x4*)(p->mla_kpe + (size_t)t * 32 + 16 + idx * 8) = pack8bf(o2); }
        }
            asm volatile("" ::: "memory");
        for (int i = tid; i < TT * 48; i += 512) { const int tt = i / 48, c = (i % 48) * 8; float v8[8]; ld8bf(P1 + (size_t)(t0 + tt) * NP1P + C_MLA_CQ + c, v8); const float r = rsq[tt * 2];
#pragma unroll
            for (int e = 0; e < 8; ++e) v8[e] *= r;
            *(u32x4*)(p->mla_cqn + (size_t)(t0 + tt) * 384 + c) = pack8bf(v8); }
            asm volatile("" ::: "memory");
        { const int d = tid & 255; float wq[16];
#pragma unroll
            for (int q = 0; q < 16; ++q) wq[q] = gw2[q * 256 + d];
            const float bz = p->gla_b[l * 256 + d];
#pragma unroll
            for (int k = 0; k < TT / 2; ++k) { const int tt = (tid >> 8) + 2 * k; float z = bz;
#pragma unroll
                for (int q4_ = 0; q4_ < 4; ++q4_) { const f32x4 g = *(const LAS f32x4*)(ga + tt * 16 + q4_ * 4); z += (g[0] * wq[q4_ * 4] + g[1] * wq[q4_ * 4 + 1]) + (g[2] * wq[q4_ * 4 + 2] + g[3] * wq[q4_ * 4 + 3]); }
                const float ez = __expf(-fabsf(z)), ls = fminf(z, 0.f) - __logf(1.0f + ez);
                p->gla_la[(size_t)(t0 + tt) * 256 + d] = ls * (1.0f / 16.0f); } }
        __syncthreads();
    }
}


DI float gelu_tanh(float x) { return 0.5f * x * (1.0f + tanhf(0.7978845608028654f * (x + 0.044715f * x * x * x))); }
DI void phase_compress(KParamsPtr p, int l, LAS unsigned char* lds) {
    const int tid = TIDX();
    LAS float* A = (LAS float*)lds;
    LAS float* Hd = A + 8 * 2048;
    for (int task = BIDX(); task < 512; task += NBLK()) {
        const int which = task >> 8, bh = (task >> 5) & 7, n0 = (task & 31) * 8;
        const bf16_t* base = (which ? p->nsa_vc_in : p->nsa_kc_in) + (size_t)bh * SEQ * 64;
        const float* pos = p->cmp_pos + (l * 2 + which) * 2048;
        for (int i = tid; i < 8 * 2048; i += 512) { const int r = i >> 11, k = i & 2047, n = n0 + r;
            A[i] = n < 255 ? bf2f(base[(size_t)n * 1024 + k]) + pos[k] : 0.f; }
        __syncthreads();
        const float* w1 = p->cmp_w1 + (size_t)(l * 2 + which) * 2048 * 256;
        { const int j = tid & 255, half = tid >> 8;
            float acc[4] = {0.f, 0.f, 0.f, 0.f};
            for (int k = 0; k < 2048; ++k) { const float w = w1[(size_t)k * 256 + j];
#pragma unroll
                for (int r = 0; r < 4; ++r) acc[r] += A[(half * 4 + r) * 2048 + k] * w; }
#pragma unroll
            for (int r = 0; r < 4; ++r) Hd[(half * 4 + r) * 256 + j] = gelu_tanh(acc[r]); }
        __syncthreads();
        const float* w2 = p->cmp_w2 + (size_t)(l * 2 + which) * 256 * 64;
        { const int r = tid >> 6, d = tid & 63; float o = 0.f;
            for (int j = 0; j < 256; ++j) o += Hd[r * 256 + j] * w2[j * 64 + d];
            (which ? p->nsa_vc : p->nsa_kc)[((size_t)bh * 256 + n0 + r) * 64 + d] = o; }
        __syncthreads();
    }
}

DI void phase_nsa_cmp(KParamsPtr p, LAS unsigned char* lds) {
    const int tid = TIDX(), lane = tid & 63, wave = tid >> 6;
    LAS float* qs = (LAS float*)lds + wave * (256 + 1024);
    LAS float* pl = qs + 256;
    const float scale = 0.125f;
    for (int item_ = BIDX() * 8 + wave; item_ < NB * 2 * SEQ; item_ += NBLK() * 8) {
        const int item = __builtin_amdgcn_readfirstlane(item_);
        const int s = item & (SEQ - 1), hk = (item >> 12) & 1, b = item >> 13, t = b * SEQ + s, bh = b * 2 + hk;
        const int nvalid = s >= 31 ? min(255, (s - 31) / 16 + 1) : 0;
#pragma unroll
        for (int g = 0; g < 4; ++g) qs[g * 64 + lane] = bf2f(p->nsa_q[(size_t)t * 512 + (hk * 4 + g) * 64 + lane]);
        asm volatile("s_waitcnt lgkmcnt(0)" ::: "memory");
        float sc[4][4];
#pragma unroll
        for (int c = 0; c < 4; ++c) { const int n = lane + 64 * c;
#pragma unroll
            for (int g = 0; g < 4; ++g) sc[c][g] = -1e30f;
            if (n < nvalid) { const float* kr = p->nsa_kc + ((size_t)bh * 256 + n) * 64;
                float d0 = 0.f, d1 = 0.f, d2 = 0.f, d3 = 0.f;
#pragma unroll 4
                for (int k4 = 0; k4 < 16; ++k4) { const f32x4 kv = *(const f32x4*)(kr + k4 * 4);
                    const f32x4 q0 = *(const LAS f32x4*)(qs + k4 * 4), q1 = *(const LAS f32x4*)(qs + 64 + k4 * 4), q2 = *(const LAS f32x4*)(qs + 128 + k4 * 4), q3 = *(const LAS f32x4*)(qs + 192 + k4 * 4);
                    d0 += kv[0] * q0[0] + kv[1] * q0[1] + kv[2] * q0[2] + kv[3] * q0[3]; d1 += kv[0] * q1[0] + kv[1] * q1[1] + kv[2] * q1[2] + kv[3] * q1[3];
                    d2 += kv[0] * q2[0] + kv[1] * q2[1] + kv[2] * q2[2] + kv[3] * q2[3]; d3 += kv[0] * q3[0] + kv[1] * q3[1] + kv[2] * q3[2] + kv[3] * q3[3]; }
                sc[c][0] = d0 * scale; sc[c][1] = d1 * scale; sc[c][2] = d2 * scale; sc[c][3] = d3 * scale; } }
#pragma unroll
        for (int g = 0; g < 4; ++g) {
            float mx = fmaxf(fmaxf(sc[0][g], sc[1][g]), fmaxf(sc[2][g], sc[3][g])); mx = wmax(mx);
            float e[4], sm = 0.f;
#pragma unroll
            for (int c = 0; c < 4; ++c) { e[c] = (lane + 64 * c < nvalid) ? __expf(sc[c][g] - mx) : 0.f; sm += e[c]; }
            sm = wsum(sm);
            const float inv = sm > 0.f ? 1.0f / sm : 0.f;
#pragma unroll
            for (int c = 0; c < 4; ++c) pl[g * 256 + lane + 64 * c] = e[c] * inv;
        }
        asm volatile("s_waitcnt lgkmcnt(0)" ::: "memory");
        { float o[4] = {0.f, 0.f, 0.f, 0.f};
            const float* vr = p->nsa_vc + (size_t)bh * 256 * 64 + lane;
            for (int n = 0; n < nvalid; ++n) { const float v = vr[(size_t)n * 64];
#pragma unroll
                for (int g = 0; g < 4; ++g) o[g] += pl[g * 256 + n] * v; }
#pragma unroll
            for (int g = 0; g < 4; ++g) p->nsa_ocmp[(size_t)t * 512 + (hk * 4 + g) * 64 + lane] = o[g]; }
        float imp = 0.f;
#pragma unroll
        for (int dn = -1; dn <= 3; ++dn) { const int n = 4 * lane + dn;
            if (n >= 0 && n < 255) imp += pl[n] + pl[256 + n] + pl[512 + n] + pl[768 + n]; }
        const int cur = s >> 6;
        const bool valid = lane <= cur, forced = valid && (lane == 0 || lane >= cur - 1);
        const float val = forced ? 1e30f : (valid ? imp : -1e30f);
        int rank = 0;
        for (int jj = 0; jj < 64; ++jj) { const float o = __shfl(val, jj); rank += (o > val || (o == val && jj < lane)) ? 1 : 0; }
        const unsigned long long mask = __ballot(rank < 16);
        if (lane == 0) p->nsa_sel[(size_t)bh * SEQ + s] = mask;
        asm volatile("s_waitcnt lgkmcnt(0)" ::: "memory");
    }
}

DI void dot8(const u32x4 w, LAS const float* q0, int DQ, float (&s)[4]) {
    float kf[8];
    kf[0] = __uint_as_float(w.x << 16); kf[1] = __uint_as_float(w.x & 0xffff0000u); kf[2] = __uint_as_float(w.y << 16); kf[3] = __uint_as_float(w.y & 0xffff0000u);
    kf[4] = __uint_as_float(w.z << 16); kf[5] = __uint_as_float(w.z & 0xffff0000u); kf[6] = __uint_as_float(w.w << 16); kf[7] = __uint_as_float(w.w & 0xffff0000u);
#pragma unroll
    for (int g = 0; g < 4; ++g) { const f32x4 qa = *(const LAS f32x4*)(q0 + g * DQ), qb = *(const LAS f32x4*)(q0 + g * DQ + 4);
        s[g] += kf[0] * qa[0] + kf[1] * qa[1] + kf[2] * qa[2] + kf[3] * qa[3] + kf[4] * qb[0] + kf[5] * qb[1] + kf[6] * qb[2] + kf[7] * qb[3]; }
}
template <int DQ, class KPtr, class VLoad, class Mask>
DI void naive_attn_block(int lane, LAS float* qs  , LAS float* ps  , float scale, KPtr kptr, VLoad vload, Mask mask, float (&m)[4], float (&l)[4], float (&o)[4]) {
    float s[4] = {0.f, 0.f, 0.f, 0.f};
#pragma unroll 4
    for (int c8 = 0; c8 < DQ / 8; ++c8) { const u32x4 w = *(const u32x4*)kptr(c8); dot8(w, qs + c8 * 8, DQ, s); if ((c8 & 3) == 3) asm volatile("" ::: "memory"); }
    float pr[4];
#pragma unroll
    for (int g = 0; g < 4; ++g) {
        const bool ok = mask(g, lane);
        const float sv = ok ? s[g] * scale : -1e30f;
        const float bm = wmax(sv), mn = fmaxf(m[g], bm), corr = __expf(m[g] - mn);
        pr[g] = ok ? __expf(sv - mn) : 0.f;
        l[g] = l[g] * corr + pr[g]; o[g] *= corr; m[g] = mn;
    }
    *(LAS f32x4*)(ps + lane * 4) = (f32x4){pr[0], pr[1], pr[2], pr[3]};
    asm volatile("s_waitcnt lgkmcnt(0)" ::: "memory");
#pragma unroll 4
    for (int key = 0; key < 64; ++key) { const f32x4 pv = *(const LAS f32x4*)(ps + key * 4); const float v = vload(key, lane);
        o[0] += pv[0] * v; o[1] += pv[1] * v; o[2] += pv[2] * v; o[3] += pv[3] * v; if ((key & 3) == 3) asm volatile("" ::: "memory"); }
    asm volatile("s_waitcnt lgkmcnt(0)" ::: "memory");
}

DI void phase_nsa_attn(KParamsPtr p, LAS unsigned char* lds) {
    const int tid = TIDX(), lane = tid & 63, wave = tid >> 6;
    LAS float* qs = (LAS float*)lds + wave * 512;
    LAS float* ps = qs + 256;
    for (int item_ = BIDX() * 8 + wave; item_ < NB * 2 * SEQ; item_ += NBLK() * 8) {
        const int item = __builtin_amdgcn_readfirstlane(item_);
        const int s = item & (SEQ - 1), hk = (item >> 12) & 1, b = item >> 13, t = b * SEQ + s, bh = b * 2 + hk, cur = s >> 6;
#pragma unroll
        for (int g = 0; g < 4; ++g) qs[g * 64 + lane] = bf2f(p->nsa_q[(size_t)t * 512 + (hk * 4 + g) * 64 + lane]);
        asm volatile("s_waitcnt lgkmcnt(0)" ::: "memory");
        float res[4];
        { float m[4] = {-1e30f, -1e30f, -1e30f, -1e30f}, l[4] = {0.f, 0.f, 0.f, 0.f}, o[4] = {0.f, 0.f, 0.f, 0.f};
#if defined(NSA_NO_CMP)
            unsigned long long sel = NSA_SEL0;
#else
            unsigned long long sel = p->nsa_sel[(size_t)bh * SEQ + s];
#endif
            sel &= (cur >= 63) ? ~0ull : ((1ull << (cur + 1)) - 1ull);
            sel = ((unsigned long long)(unsigned)__builtin_amdgcn_readfirstlane((int)(sel >> 32)) << 32) | (unsigned)__builtin_amdgcn_readfirstlane((int)sel);
            const bf16_t* K = p->nsa_ks + (size_t)bh * SEQ * 64; const bf16_t* V = p->nsa_vs + (size_t)bh * SEQ * 64;
#if defined(NSA_NO_SLC)
            sel &= 1ull;
#endif
            while (sel) { const int j = __builtin_ctzll(sel); sel &= sel - 1;
                const int k0 = j * 64;
                naive_attn_block<64>(lane, qs, ps, 0.125f,
                    [&](int c8) { return K + (size_t)(k0 + lane) * 64 + c8 * 8; },
                    [&](int key, int d) { return bf2f(V[(size_t)(k0 + key) * 64 + d]); },
                    [&](int, int key) { return k0 + key <= s; }, m, l, o); }
#pragma unroll
            for (int g = 0; g < 4; ++g) { const float lt = wsum(l[g]); res[g] = p->nsa_gate[(size_t)t * 24 + (hk * 4 + g) * 3 + 1] * (o[g] / lt); } }
        { float m[4] = {-1e30f, -1e30f, -1e30f, -1e30f}, l[4] = {0.f, 0.f, 0.f, 0.f}, o[4] = {0.f, 0.f, 0.f, 0.f};
#if defined(NSA_WIN_USE_S)
            const bf16_t* K = p->nsa_ks + (size_t)bh * SEQ * 64; const bf16_t* V = p->nsa_vs + (size_t)bh * SEQ * 64;
#else
            const bf16_t* K = p->nsa_kw + (size_t)bh * SEQ * 64; const bf16_t* V = p->nsa_vw + (size_t)bh * SEQ * 64;
#endif
            const int lo = s - 511 > 0 ? s - 511 : 0;
#if defined(NSA_NO_WIN)
            for (int j = cur; j <= cur; ++j) { const int k0 = j * 64;
#else
            for (int j = lo >> 6; j <= cur; ++j) { const int k0 = j * 64;
#endif
                naive_attn_block<64>(lane, qs, ps, 0.125f,
                    [&](int c8) { return K + (size_t)(k0 + lane) * 64 + c8 * 8; },
                    [&](int key, int d) { return bf2f(V[(size_t)(k0 + key) * 64 + d]); },
                    [&](int, int key) { return k0 + key <= s && k0 + key >= lo; }, m, l, o); }
#pragma unroll
            for (int g = 0; g < 4; ++g) { const float lt = wsum(l[g]); res[g] += p->nsa_gate[(size_t)t * 24 + (hk * 4 + g) * 3 + 2] * (o[g] / lt); } }
#pragma unroll
        for (int g = 0; g < 4; ++g) { const size_t oi = (size_t)t * 512 + (hk * 4 + g) * 64 + lane;
#if !defined(NSA_NO_CMP)
            res[g] += p->nsa_gate[(size_t)t * 24 + (hk * 4 + g) * 3] * p->nsa_ocmp[oi];
#endif
            p->ys[oi] = f2bf(res[g]); }
    }
}

DI void phase_mla_rope(KParamsPtr p) {
    for (int i = BIDX() * 512 + TIDX(); i < T * 128; i += NBLK() * 512) {
        const int t = i >> 7, h = (i >> 4) & 7, j = i & 15, s = t & (SEQ - 1);
        bf16_t* q = p->mla_q + (size_t)t * 768 + h * 96 + 64;
        const float x1 = bf2f(q[j]), x2 = bf2f(q[16 + j]), cs = p->cos32[s * 16 + j], sn = p->sin32[s * 16 + j];
        q[j] = f2bf(x1 * cs - x2 * sn); q[16 + j] = f2bf(x1 * sn + x2 * cs);
    }
}
DI void phase_mla_attn(KParamsPtr p, LAS unsigned char* lds) {
    const int tid = TIDX(), lane = tid & 63, wave = tid >> 6;
    LAS float* qs = (LAS float*)lds + wave * 640;
    LAS float* ps = qs + 384;
    const float scale = 0.10206207261596577f;
    for (int item_ = BIDX() * 8 + wave; item_ < NB * 8 * (SEQ / 4); item_ += NBLK() * 8) {
        const int item = __builtin_amdgcn_readfirstlane(item_);
        const int s0 = (item & 1023) * 4, h = (item >> 10) & 7, b = item >> 13, t0 = b * SEQ + s0;
        for (int i = lane; i < 384; i += 64) { const int g = i / 96, c = i % 96; qs[i] = bf2f(p->mla_q[(size_t)(t0 + g) * 768 + h * 96 + c]); }
        asm volatile("s_waitcnt lgkmcnt(0)" ::: "memory");
        float m[4] = {-1e30f, -1e30f, -1e30f, -1e30f}, l[4] = {0.f, 0.f, 0.f, 0.f}, o[4] = {0.f, 0.f, 0.f, 0.f};
        const bf16_t* KV = p->mla_kv + (size_t)b * SEQ * 1024 + h * 128; const bf16_t* PE = p->mla_kpe + (size_t)b * SEQ * 32;
        for (int j = 0; j <= (s0 + 3) >> 6; ++j) { const int k0 = j * 64;
            naive_attn_block<96>(lane, qs, ps, scale,
                [&](int c8) { return c8 < 8 ? KV + (size_t)(k0 + lane) * 1024 + c8 * 8 : PE + (size_t)(k0 + lane) * 32 + (c8 - 8) * 8; },
                [&](int key, int d) { return bf2f(KV[(size_t)(k0 + key) * 1024 + 64 + d]); },
                [&](int g, int key) { return k0 + key <= s0 + g; }, m, l, o); }
#pragma unroll
        for (int g = 0; g < 4; ++g) { const float lt = wsum(l[g]); p->ys[(size_t)3 * T * 512 + (size_t)(t0 + g) * 512 + h * 64 + lane] = f2bf(o[g] / lt); }
    }
}

DI void phase_scan_rwkv(KParamsPtr p, LAS unsigned char* lds) {
    const int tid = TIDX(), bid = BIDX();
    if (bid < 32) {
        if (tid >= 64) return;
        const int b = bid >> 3, h = bid & 7, lane = tid;
        LAS float* L = (LAS float*)lds;
        float st[64];
#pragma unroll
        for (int j = 0; j < 64; ++j) st[j] = 0.f;
        size_t o = (size_t)b * SEQ * 512 + h * 64 + lane;
        float nkk = p->rw_kk[o], nw = p->rw_w[o], nk = bf2f(p->rw_k[o]), nb = p->rw_b[o], nr = bf2f(p->rw_r[o]), nv = bf2f(p->rw_v[o]);
        for (int s = 0; s < SEQ; ++s) {
            L[lane] = nkk; L[64 + lane] = nw; L[128 + lane] = nk; L[192 + lane] = nb; L[256 + lane] = nr;
            const float v = nv; const size_t oc = o;
            if (s + 1 < SEQ) { o += 512; nkk = p->rw_kk[o]; nw = p->rw_w[o]; nk = bf2f(p->rw_k[o]); nb = p->rw_b[o]; nr = bf2f(p->rw_r[o]); nv = bf2f(p->rw_v[o]); }
            asm volatile("s_waitcnt lgkmcnt(0)" ::: "memory");
            float skk = 0.f;
#pragma unroll
            for (int j4 = 0; j4 < 16; ++j4) { const f32x4 kk = *(const LAS f32x4*)(L + j4 * 4);
                skk += st[j4 * 4] * kk[0] + st[j4 * 4 + 1] * kk[1] + st[j4 * 4 + 2] * kk[2] + st[j4 * 4 + 3] * kk[3]; }
            float y = 0.f;
#pragma unroll
            for (int j4 = 0; j4 < 16; ++j4) { const f32x4 w = *(const LAS f32x4*)(L + 64 + j4 * 4), k = *(const LAS f32x4*)(L + 128 + j4 * 4), bb = *(const LAS f32x4*)(L + 192 + j4 * 4), r = *(const LAS f32x4*)(L + 256 + j4 * 4);
#pragma unroll
                for (int q = 0; q < 4; ++q) { const float ns = st[j4 * 4 + q] * w[q] - skk * bb[q] + v * k[q]; st[j4 * 4 + q] = ns; y += ns * r[q]; }
                if ((j4 & 3) == 3) asm volatile("" ::: "memory"); }
            p->rw_y[oc] = y;
            asm volatile("s_waitcnt lgkmcnt(0)" ::: "memory");
        }
    }
}
DI void phase_scan_gla(KParamsPtr p, LAS unsigned char* lds) {
    const int tid = TIDX(), bid = BIDX();
    if (bid >= 32 && bid < 48) {
        if (tid >= 128) return;
        const int bh = bid - 32, b = bh >> 2, h = bh & 3, e = tid, lane = tid & 63, wave = tid >> 6;
        LAS float* L = (LAS float*)lds + wave * 192;
        float st[64];
#pragma unroll
        for (int j = 0; j < 64; ++j) st[j] = 0.f;
        const bf16_t* P1 = p->P1;
        for (int s = 0; s < SEQ; ++s) {
            const int t = b * SEQ + s;
            L[lane] = __expf(p->gla_la[(size_t)t * 256 + h * 64 + lane]); L[64 + lane] = ldP(P1, t, C_GLA_K + h * 64 + lane); L[128 + lane] = ldP(P1, t, C_GLA_Q + h * 64 + lane) * 0.125f;
            const float v = ldP(P1, t, C_GLA_V + h * 128 + e);
            asm volatile("s_waitcnt lgkmcnt(0)" ::: "memory");
            float y = 0.f;
#pragma unroll
            for (int j4 = 0; j4 < 16; ++j4) { const f32x4 dc = *(const LAS f32x4*)(L + j4 * 4), k = *(const LAS f32x4*)(L + 64 + j4 * 4), q = *(const LAS f32x4*)(L + 128 + j4 * 4);
#pragma unroll
                for (int qq = 0; qq < 4; ++qq) { const float ns = st[j4 * 4 + qq] * dc[qq] + k[qq] * v; st[j4 * 4 + qq] = ns; y += ns * q[qq]; }
                if ((j4 & 3) == 3) asm volatile("" ::: "memory"); }
            p->gla_o[(size_t)t * 512 + h * 128 + e] = y;
            asm volatile("s_waitcnt lgkmcnt(0)" ::: "memory");
        }
    }
}

DI void phase_scans(KParamsPtr p, LAS unsigned char* lds) { phase_scan_rwkv(p, lds); phase_scan_gla(p, lds); }

DI void phase_post(KParamsPtr p, int l, LAS unsigned char* lds, int wg_skip) {
    const int tid = TIDX(), lane = tid & 63, wave = tid >> 6;
    if (BIDX() < wg_skip) return;
    const int nw = (NBLK() - wg_skip) * 8;
    float ln_w[8], ln_b[8], r_k[8], gg[8];
    ld8f(p->rw_ln_w + l * 512 + lane * 8, ln_w); ld8f(p->rw_ln_b + l * 512 + lane * 8, ln_b); ld8f(p->rw_r_k + l * 512 + lane * 8, r_k); ld8f(p->gla_g + l * 512 + lane * 8, gg);
    for (int tb = (BIDX() - wg_skip) * 8 + wave; tb < T; tb += 2 * nw) {
        float y[2][8], rr[2][8], kk[2][8], vv[2][8], g4[2][8], ov[2][8], gr[2][8]; bool ok[2];
#pragma unroll
        for (int q = 0; q < 2; ++q) { const int t = tb + q * nw; ok[q] = t < T; const size_t o = (size_t)(ok[q] ? t : 0) * 512 + lane * 8;
            ld8f(p->rw_y + o, y[q]); ld8bf(p->rw_r + o, rr[q]); ld8bf(p->rw_k + o, kk[q]); ld8bf(p->rw_v + o, vv[q]); ld8bf(p->rw_g + o, g4[q]); ld8f(p->gla_o + o, ov[q]);
            ld8bf(p->P1 + (size_t)(ok[q] ? t : 0) * NP1P + C_GLA_R + lane * 8, gr[q]); }
#pragma unroll
        for (int q = 0; q < 2; ++q) { const size_t o = (size_t)(tb + q * nw) * 512 + lane * 8;
            float sm = 0.f, sb = 0.f, so = 0.f;
#pragma unroll
            for (int e = 0; e < 8; ++e) { sm += y[q][e]; sb += rr[q][e] * kk[q][e] * r_k[e]; so += ov[q][e] * ov[q][e]; }
#pragma unroll
            for (int m = 1; m <= 4; m <<= 1) { sm += __shfl_xor(sm, m); sb += __shfl_xor(sb, m); so += __shfl_xor(so, m); }
            so += __shfl_xor(so, 8);
            const float mean = sm * (1.0f / 64.0f);
            float sv = 0.f;
#pragma unroll
            for (int e = 0; e < 8; ++e) { y[q][e] -= mean; sv += y[q][e] * y[q][e]; }
#pragma unroll
            for (int m = 1; m <= 4; m <<= 1) sv += __shfl_xor(sv, m);
            const float rstd = rsqrtf(sv * (1.0f / 64.0f) + 64e-5f), rs = rsqrtf(so * (1.0f / 128.0f) + NORM_EPS);
            float o1[8], o2[8];
#pragma unroll
            for (int e = 0; e < 8; ++e) { o1[e] = ((y[q][e] * rstd * ln_w[e] + ln_b[e]) + sb * vv[q][e]) * g4[q][e] * ZRWKV;
                o2[e] = ov[q][e] * rs * gg[e] * (gr[q][e] * sigmoidf_(gr[q][e])) * ZGLA; }
            if (ok[q]) { *(u32x4*)(p->ys + (size_t)1 * T * 512 + o) = pack8bf(o1); *(u32x4*)(p->ys + (size_t)2 * T * 512 + o) = pack8bf(o2); } }
    }
}

DI void unpack8(const u32x4 w, float (&f)[8]) {
    f[0] = __uint_as_float(w.x << 16); f[1] = __uint_as_float(w.x & 0xffff0000u); f[2] = __uint_as_float(w.y << 16); f[3] = __uint_as_float(w.y & 0xffff0000u);
    f[4] = __uint_as_float(w.z << 16); f[5] = __uint_as_float(w.z & 0xffff0000u); f[6] = __uint_as_float(w.w << 16); f[7] = __uint_as_float(w.w & 0xffff0000u);
}
DI void phase_mergesum(const bf16_t* G, const bf16_t* part01, const bf16_t* part23, bf16_t* merged) {
    const size_t n8 = (size_t)T * 2048 / 8;
    for (size_t i = (size_t)BIDX() * 512 + TIDX(); i < n8; i += (size_t)NBLK() * 512) {
        const size_t t = i >> 8, c = (i & 255) * 8;
        float acc[8] = {0.f, 0.f, 0.f, 0.f, 0.f, 0.f, 0.f, 0.f};
#pragma unroll
        for (int br = 0; br < 4; ++br) {
            const u32x4 gw = *(const u32x4*)(G + t * NGATE + br * 2048 + c);
            const u32x4 pw = *(const u32x4*)((br < 2 ? part01 : part23) + (size_t)(br & 1) * T * 2048 + t * 2048 + c);
            float g[8], q[8]; unpack8(gw, g); unpack8(pw, q);
#pragma unroll
            for (int j = 0; j < 8; ++j) acc[j] += g[j] * q[j];
        }
        u32x4 w; w.x = pk2(acc[0], acc[1]); w.y = pk2(acc[2], acc[3]); w.z = pk2(acc[4], acc[5]); w.w = pk2(acc[6], acc[7]);
        *(u32x4*)(merged + t * 2048 + c) = w;
    }
}
#ifndef ZSLC
#define ZSLC 1.0f
#endif
#ifndef ZWIN
#define ZWIN 1.0f
#endif
#ifndef ZCMP
#define ZCMP 1.0f
#endif
#ifndef ZMLA
#define ZMLA 1.0f
#endif
typedef short v4i16_t_ __attribute__((ext_vector_type(4)));
template <int DQ, int NDV = 4> struct FlashGeo {
    static constexpr int KS = DQ * 2 + 32;
    static constexpr int VS = 160;
    static constexpr int KBYTES = 64 * KS, VBYTES = 64 * VS, BUF = KBYTES + VBYTES;
};
template <int NDV> struct FlashAccT { f32x4 O[2][NDV]; float m[2], l[2]; };
typedef FlashAccT<4> FlashAcc;
template <int NDV> DI void flash_reset(FlashAccT<NDV>& a) {
#pragma unroll
    for (int rg = 0; rg < 2; ++rg) { a.m[rg] = -1e30f; a.l[rg] = 0.f;
#pragma unroll
        for (int d = 0; d < NDV; ++d) a.O[rg][d] = (f32x4){0.f, 0.f, 0.f, 0.f}; }
}
template <int DQ> struct FlashStage { u32x4 k, k2, v; };
template <int DQ, class KRow, class PRow, class VRow>
DI void flash_stage_load(FlashStage<DQ>& st, int tid, KRow krow, PRow prow, VRow vrow) {
    int r = tid >> 3, c = tid & 7;
    asm volatile("" : "+v"(r), "+v"(c));
    st.k = *(const u32x4*)(krow(r) + c * 8);
    if (DQ == 96) { if (c < 4) st.k2 = *(const u32x4*)(prow(r) + c * 8); }
    st.v = *(const u32x4*)(vrow(r) + c * 8);
}
template <int DQ>
DI void flash_stage_write(const FlashStage<DQ>& st, int tid, LAS unsigned char* buf) {
    typedef FlashGeo<DQ> G;
    const int r = tid >> 3, c = tid & 7;
    *(LAS u32x4*)(buf + r * G::KS + c * 16) = st.k;
    if (DQ == 96) { if (c < 4) *(LAS u32x4*)(buf + r * G::KS + 128 + c * 16) = st.k2; }
    *(LAS u32x4*)(buf + G::KBYTES + r * G::VS + c * 16) = st.v;
}
#ifndef FLASH_FENCE
#define FLASH_FENCE 1
#endif
template <int DQ, int NDV, int MODE, class Mask>
DI void flash_tile_n(LAS const unsigned char* buf, const bf16x8 (&Q)[2][DQ / 32], FlashAccT<NDV>& a, float sc2, int lane, Mask mask) {
    typedef FlashGeo<DQ, NDV> G;
    const int fr = lane & 15, q4 = lane >> 4;
    f32x4 S[2][4];
#pragma unroll
    for (int rg = 0; rg < 2; ++rg)
#pragma unroll
        for (int kb = 0; kb < 4; ++kb) S[rg][kb] = (f32x4){0.f, 0.f, 0.f, 0.f};
#pragma unroll
    for (int kb = 0; kb < 4; ++kb)
#pragma unroll
        for (int ks = 0; ks < DQ / 32; ++ks) {
            const bf16x8 kf = *(const LAS bf16x8*)(buf + (kb * 16 + fr) * G::KS + (ks * 32 + q4 * 8) * 2);
#pragma unroll
            for (int rg = 0; rg < 2; ++rg) S[rg][kb] = __builtin_amdgcn_mfma_f32_16x16x32_bf16(kf, Q[rg][ks], S[rg][kb], 0, 0, 0);
            if (FLASH_FENCE && DQ == 64 && ks == DQ / 32 - 1 && (kb & 1)) asm volatile("" ::: "memory");
        }
    bf16x8 P[2][2];
#pragma unroll
    for (int rg = 0; rg < 2; ++rg) {
        constexpr bool FULL = (MODE == 1);
        float mx = -1e30f; unsigned okm = 0u; const bool rowok = (MODE == 2) ? mask(rg, 0) : true;
        if (FULL || MODE == 2) {
#pragma unroll
            for (int kb = 0; kb < 4; ++kb) mx = fmaxf(mx, fmaxf(fmaxf(S[rg][kb][0], S[rg][kb][1]), fmaxf(S[rg][kb][2], S[rg][kb][3])));
            if (MODE == 2) mx = rowok ? mx : -1e30f;
        } else {
#pragma unroll
        for (int kb = 0; kb < 4; ++kb)
#pragma unroll
            for (int j = 0; j < 4; ++j) { const bool ok = mask(rg, kb * 16 + q4 * 4 + j); okm |= ok ? (1u << (kb * 4 + j)) : 0u;
                const float sv = ok ? S[rg][kb][j] : -1e30f; S[rg][kb][j] = sv; mx = fmaxf(mx, sv); }
        }
        { auto r16 = __builtin_amdgcn_permlane16_swap(__float_as_uint(mx), __float_as_uint(mx), false, false); mx = fmaxf(__uint_as_float(r16[0]), __uint_as_float(r16[1]));
          auto r32 = __builtin_amdgcn_permlane32_swap(__float_as_uint(mx), __float_as_uint(mx), false, false); mx = fmaxf(__uint_as_float(r32[0]), __uint_as_float(r32[1])); }
        mx = fmaxf(mx * sc2, -1e30f);
        const float mo = a.m[rg]; const bool mv = mx > mo + 8.0f; const float mn = mv ? mx : mo;
        a.m[rg] = mn;
        if (__builtin_amdgcn_ballot_w64(mv) != 0ull) { const float corr = __builtin_amdgcn_exp2f(mo - mn);
            a.l[rg] *= corr;
#pragma unroll
            for (int d = 0; d < NDV; ++d) a.O[rg][d] *= corr; }
        float ps = 0.f;
#pragma unroll
        for (int kb = 0; kb < 4; ++kb)
#pragma unroll
            for (int j = 0; j < 4; ++j) { const float pv = (FULL || (MODE == 2 ? rowok : (bool)((okm >> (kb * 4 + j)) & 1u))) ? __builtin_amdgcn_exp2f(__builtin_fmaf(S[rg][kb][j], sc2, -mn)) : 0.f; S[rg][kb][j] = pv; ps += pv; }
        a.l[rg] += ps;
#pragma unroll
        for (int pb = 0; pb < 2; ++pb) { u32x4 w;
            w.x = cvt_pk_bf16(S[rg][2 * pb][0], S[rg][2 * pb][1]); w.y = cvt_pk_bf16(S[rg][2 * pb][2], S[rg][2 * pb][3]);
            w.z = cvt_pk_bf16(S[rg][2 * pb + 1][0], S[rg][2 * pb + 1][1]); w.w = cvt_pk_bf16(S[rg][2 * pb + 1][2], S[rg][2 * pb + 1][3]);
            P[rg][pb] = __builtin_bit_cast(bf16x8, w); }
    }
    LAS const unsigned char* vt = buf + G::KBYTES;
#pragma unroll
    for (int pb = 0; pb < 2; ++pb)
#pragma unroll
        for (int dvb = 0; dvb < NDV; ++dvb) {
            LAS const unsigned char* vl = vt + (4 * q4 + (fr >> 2)) * G::VS + (fr & 3) * 8;
            const u32x2 lo = __builtin_bit_cast(u32x2, __builtin_amdgcn_ds_read_tr16_b64_v4i16((LAS v4i16_t_*)(vl + (32 * pb) * G::VS + dvb * 32)));
            const u32x2 hi = __builtin_bit_cast(u32x2, __builtin_amdgcn_ds_read_tr16_b64_v4i16((LAS v4i16_t_*)(vl + (32 * pb + 16) * G::VS + dvb * 32)));
            const u32x4 w = (u32x4){lo.x, lo.y, hi.x, hi.y};
            const bf16x8 vf = __builtin_bit_cast(bf16x8, w);
#pragma unroll
            for (int rg = 0; rg < 2; ++rg) a.O[rg][dvb] = __builtin_amdgcn_mfma_f32_16x16x32_bf16(vf, P[rg][pb], a.O[rg][dvb], 0, 0, 0);
        }
}
template <int DQ, class Mask>
DI void flash_tile(LAS const unsigned char* buf, const bf16x8 (&Q)[2][DQ / 32], FlashAcc& a, float sc2, int lane, Mask mask) { flash_tile_n<DQ, 4, 0>(buf, Q, a, sc2, lane, mask); }
template <int DQ>
DI void flash_tile_full(LAS const unsigned char* buf, const bf16x8 (&Q)[2][DQ / 32], FlashAcc& a, float sc2, int lane) { flash_tile_n<DQ, 4, 1>(buf, Q, a, sc2, lane, [](int, int) { return true; }); }
template <int DQ, class Mask>
DI void flash_tile_row(LAS const unsigned char* buf, const bf16x8 (&Q)[2][DQ / 32], FlashAcc& a, float sc2, int lane, Mask mask) { flash_tile_n<DQ, 4, 2>(buf, Q, a, sc2, lane, mask); }
DI float flash_lsum(float l) { l += __shfl_xor(l, 16); l += __shfl_xor(l, 32); return l; }

DI void bf8_to_f(const u32x4 w, f32x4& a, f32x4& b);
DI void phase_mla_flash(KParamsPtr p, LAS unsigned char* lds) {
    typedef FlashGeo<96> G;
    const int tid = TIDX(), lane = tid & 63, wave = __builtin_amdgcn_readfirstlane(tid >> 6), fr = lane & 15, q4 = lane >> 4;
    const float sc2 = 0.10206207261596577f * 1.4426950408889634f;
    const bf16_t* mq = p->mla_q; const bf16_t* mkv = p->mla_kv; const bf16_t* mpe = p->mla_kpe; bf16_t* yo = p->ys + (size_t)3 * T * 512;
    for (int c0 = BIDX(); c0 < 256; c0 += NBLK()) {
        const int c = NBLK() == 256 ? ((c0 & 7) * 32 + (c0 >> 3)) : c0;
        const int bh = c >> 3, b = bh >> 3, h = bh & 7;
#pragma unroll 1
        for (int half = 0; half < 2; ++half) {
            const int qt = half ? 15 - (c & 7) : (c & 7), q0 = qt * 256;
            const int tok0 = q0 + wave * 32 + fr;
            bf16x8 Q[2][3];
#pragma unroll
            for (int rg = 0; rg < 2; ++rg)
#pragma unroll
                for (int ks = 0; ks < 3; ++ks) Q[rg][ks] = *(const bf16x8*)(mq + (size_t)(b * SEQ + tok0 + rg * 16) * 768 + h * 96 + ks * 32 + q4 * 8);
#pragma unroll
            for (int rg = 0; rg < 2; ++rg) {
                const u32x4 mine = __builtin_bit_cast(u32x4, Q[rg][2]);
                u32x4 oth; oth.x = (unsigned)__shfl_xor((int)mine.x, 32); oth.y = (unsigned)__shfl_xor((int)mine.y, 32); oth.z = (unsigned)__shfl_xor((int)mine.z, 32); oth.w = (unsigned)__shfl_xor((int)mine.w, 32);
                f32x4 ma, mb, oa, ob; bf8_to_f(mine, ma, mb); bf8_to_f(oth, oa, ob);
                const size_t ti = (size_t)(tok0 + rg * 16) * 16 + (q4 & 1) * 8;
                const f32x4 ca = *(const f32x4*)(p->cos32 + ti), cb = *(const f32x4*)(p->cos32 + ti + 4), sa = *(const f32x4*)(p->sin32 + ti), sb = *(const f32x4*)(p->sin32 + ti + 4);
                const float sg = q4 < 2 ? -1.0f : 1.0f;
                const f32x4 ra = ma * ca + oa * sa * sg, rb = mb * cb + ob * sb * sg;
                u32x4 w; w.x = cvt_pk_bf16(ra[0], ra[1]); w.y = cvt_pk_bf16(ra[2], ra[3]); w.z = cvt_pk_bf16(rb[0], rb[1]); w.w = cvt_pk_bf16(rb[2], rb[3]);
                Q[rg][2] = __builtin_bit_cast(bf16x8, w); }
            FlashAcc a; flash_reset(a);
            const int nt = (q0 + 256) / 64;
            const bf16_t* kvb = mkv + (size_t)b * SEQ * 1024 + h * 128; const bf16_t* peb = mpe + (size_t)b * SEQ * 32;
            FlashStage<96> st;
            flash_stage_load<96>(st, tid, [&](int r) { return kvb + (size_t)r * 1024; }, [&](int r) { return peb + (size_t)r * 32; }, [&](int r) { return kvb + (size_t)r * 1024 + 64; });
            __syncthreads();
            flash_stage_write<96>(st, tid, lds);
            __syncthreads();
            for (int i = 0; i < nt; ++i) {
                const int k0 = i * 64;
                if (i + 1 < nt) flash_stage_load<96>(st, tid, [&](int r) { return kvb + (size_t)(k0 + 64 + r) * 1024; }, [&](int r) { return peb + (size_t)(k0 + 64 + r) * 32; }, [&](int r) { return kvb + (size_t)(k0 + 64 + r) * 1024 + 64; });
                if (k0 <= q0 + wave * 32 + 31) {
                    int d0 = tok0 - k0, d1 = tok0 - k0 + 16;
                    asm volatile("" : "+v"(d0), "+v"(d1));
                    if (k0 + 63 <= q0 + wave * 32) flash_tile_full<96>(lds + (i & 1) * G::BUF, Q, a, sc2, lane);
                    else flash_tile<96>(lds + (i & 1) * G::BUF, Q, a, sc2, lane, [&](int rg, int kidx) { return kidx <= (rg ? d1 : d0); });
                }
                if (i + 1 < nt) flash_stage_write<96>(st, tid, lds + ((i + 1) & 1) * G::BUF);
                __syncthreads();
            }
#pragma unroll
            for (int rg = 0; rg < 2; ++rg) { const float inv = 1.0f / flash_lsum(a.l[rg]);
                bf16_t* op = yo + (size_t)(b * SEQ + tok0 + rg * 16) * 512 + h * 64 + q4 * 4;
#pragma unroll
                for (int d = 0; d < 4; ++d) { u32x2 w; w.x = cvt_pk_bf16(a.O[rg][d][0] * inv * ZMLA, a.O[rg][d][1] * inv * ZMLA); w.y = cvt_pk_bf16(a.O[rg][d][2] * inv * ZMLA, a.O[rg][d][3] * inv * ZMLA);
                    *(u32x2*)(op + d * 16) = w; } }
        }
    }
}

DI void phase_nsa_flash(KParamsPtr p, LAS unsigned char* lds) {
    typedef FlashGeo<64> G;
    const int tid = TIDX(), lane = tid & 63, wave = __builtin_amdgcn_readfirstlane(tid >> 6), fr = lane & 15, q4 = lane >> 4;
    const float sc2 = 0.125f * 1.4426950408889634f;
    LAS unsigned* um = (LAS unsigned*)(lds + 2 * G::BUF);
    const bf16_t* nq = p->nsa_q; const unsigned long long* selp = p->nsa_sel; const float* gat = p->nsa_gate; const float* ocmp = p->nsa_ocmp; bf16_t* yo = p->ys;
    for (int c = BIDX(); c < 256; c += NBLK()) {
        const int bh = c >> 5, b = bh >> 1, hk = bh & 1;
        const bf16_t* Ks = p->nsa_ks + (size_t)bh * SEQ * 64; const bf16_t* Vs = p->nsa_vs + (size_t)bh * SEQ * 64;
        const bf16_t* Kw = p->nsa_kw + (size_t)bh * SEQ * 64; const bf16_t* Vw = p->nsa_vw + (size_t)bh * SEQ * 64;
#pragma unroll 1
        for (int half = 0; half < 2; ++half) {
            const int cur = half ? 63 - (c & 31) : (c & 31), s0 = cur * 64, g = wave >> 1, head = hk * 4 + g;
            const int qi0 = (wave & 1) * 32 + fr;
            const size_t t0 = (size_t)b * SEQ + s0 + qi0;
            bf16x8 Q[2][2];
#pragma unroll
            for (int rg = 0; rg < 2; ++rg)
#pragma unroll
                for (int ks = 0; ks < 2; ++ks) Q[rg][ks] = *(const bf16x8*)(nq + (t0 + rg * 16) * 512 + head * 64 + ks * 32 + q4 * 8);
            unsigned long long sel[2];
#pragma unroll
            for (int rg = 0; rg < 2; ++rg) sel[rg] = selp[(size_t)bh * SEQ + s0 + qi0 + rg * 16];
            if (wave == 0) {
                unsigned long long u = selp[(size_t)bh * SEQ + s0 + lane];
                unsigned lo = (unsigned)u, hi = (unsigned)(u >> 32);
#pragma unroll
                for (int o = 32; o >= 1; o >>= 1) { lo |= (unsigned)__shfl_xor((int)lo, o); hi |= (unsigned)__shfl_xor((int)hi, o); }
                if (lane == 0) { um[0] = lo; um[1] = hi; }
            }
            __syncthreads();
            unsigned long long uni = ((unsigned long long)um[1] << 32) | um[0];
            uni &= (cur >= 63) ? ~0ull : ((1ull << (cur + 1)) - 1ull);
            uni = ((unsigned long long)(unsigned)__builtin_amdgcn_readfirstlane((int)(uni >> 32)) << 32) | (unsigned)__builtin_amdgcn_readfirstlane((int)uni);
            float res[2][4][4];
            {
                FlashAcc a; flash_reset(a);
                FlashStage<64> st;
                unsigned long long rem = uni;
                int j = __builtin_ctzll(rem); rem &= rem - 1;
                flash_stage_load<64>(st, tid, [&](int r) { return Ks + (size_t)(j * 64 + r) * 64; }, [&](int r) { return Ks; }, [&](int r) { return Vs + (size_t)(j * 64 + r) * 64; });
                flash_stage_write<64>(st, tid, lds);
                __syncthreads();
                int i = 0;
                for (;;) {
                    const bool more = rem != 0ull;
                    int jn = 0;
                    if (more) { jn = __builtin_ctzll(rem); rem &= rem - 1;
                        flash_stage_load<64>(st, tid, [&](int r) { return Ks + (size_t)(jn * 64 + r) * 64; }, [&](int r) { return Ks; }, [&](int r) { return Vs + (size_t)(jn * 64 + r) * 64; }); }
                    { const bool diag = (j == cur);
                      const bool in0 = (sel[0] >> j) & 1ull, in1 = (sel[1] >> j) & 1ull;
                      int l0 = in0 ? (diag ? qi0 : 64) : -1, l1 = in1 ? (diag ? qi0 + 16 : 64) : -1;
                      asm volatile("" : "+v"(l0), "+v"(l1));
                      if (diag) flash_tile<64>(lds + (i & 1) * G::BUF, Q, a, sc2, lane, [&](int rg, int kidx) { return kidx <= (rg ? l1 : l0); });
                      else flash_tile_row<64>(lds + (i & 1) * G::BUF, Q, a, sc2, lane, [&](int rg, int) { return (rg ? l1 : l0) >= 0; }); }
                    if (more) flash_stage_write<64>(st, tid, lds + ((i + 1) & 1) * G::BUF);
                    __syncthreads();
                    if (!more) break;
                    j = jn; ++i;
                }
#pragma unroll
                for (int rg = 0; rg < 2; ++rg) { const float gt = gat[(t0 + rg * 16) * 24 + head * 3 + 1] / flash_lsum(a.l[rg]);
#pragma unroll
                    for (int d = 0; d < 4; ++d)
#pragma unroll
                        for (int e = 0; e < 4; ++e) res[rg][d][e] = a.O[rg][d][e] * gt * ZSLC; }
            }
            {
                FlashAcc a; flash_reset(a);
                FlashStage<64> st;
                const int jlo = cur >= 8 ? cur - 8 : 0;
                flash_stage_load<64>(st, tid, [&](int r) { return Kw + (size_t)(jlo * 64 + r) * 64; }, [&](int r) { return Kw; }, [&](int r) { return Vw + (size_t)(jlo * 64 + r) * 64; });
                flash_stage_write<64>(st, tid, lds);
                __syncthreads();
                for (int j = jlo, i = 0; j <= cur; ++j, ++i) {
                    if (j < cur) flash_stage_load<64>(st, tid, [&](int r) { return Kw + (size_t)((j + 1) * 64 + r) * 64; }, [&](int r) { return Kw; }, [&](int r) { return Vw + (size_t)((j + 1) * 64 + r) * 64; });
                    { const bool diag = (j == cur), tail = (j == cur - 8);
                      int h0 = diag ? qi0 : 64, h1 = diag ? qi0 + 16 : 64, t0_ = tail ? qi0 : -1, t1_ = tail ? qi0 + 16 : -1;
                      asm volatile("" : "+v"(h0), "+v"(h1), "+v"(t0_), "+v"(t1_));
                      flash_tile<64>(lds + (i & 1) * G::BUF, Q, a, sc2, lane, [&](int rg, int kidx) { return kidx <= (rg ? h1 : h0) && kidx > (rg ? t1_ : t0_); }); }
                    if (j < cur) flash_stage_write<64>(st, tid, lds + ((i + 1) & 1) * G::BUF);
                    __syncthreads();
                }
#pragma unroll
                for (int rg = 0; rg < 2; ++rg) { const float gt = gat[(t0 + rg * 16) * 24 + head * 3 + 2] / flash_lsum(a.l[rg]);
#pragma unroll
                    for (int d = 0; d < 4; ++d)
#pragma unroll
                        for (int e = 0; e < 4; ++e) res[rg][d][e] += a.O[rg][d][e] * gt * ZWIN; }
            }
#pragma unroll
            for (int rg = 0; rg < 2; ++rg) { const float g0 = gat[(t0 + rg * 16) * 24 + head * 3] * ZCMP;
                const size_t ob = (t0 + rg * 16) * 512 + head * 64 + q4 * 4;
#pragma unroll
                for (int d = 0; d < 4; ++d) { const f32x4 oc = *(const f32x4*)(ocmp + ob + d * 16);
                    u32x2 w; w.x = cvt_pk_bf16(res[rg][d][0] + g0 * oc[0], res[rg][d][1] + g0 * oc[1]); w.y = cvt_pk_bf16(res[rg][d][2] + g0 * oc[2], res[rg][d][3] + g0 * oc[3]);
                    *(u32x2*)(yo + ob + d * 16) = w; } }
            __syncthreads();
        }
    }
}

DI void phase_nsa_full(KParamsPtr p, LAS unsigned char* lds) {
    typedef FlashGeo<64> G;
    const int tid = TIDX(), lane = tid & 63, wave = __builtin_amdgcn_readfirstlane(tid >> 6), fr = lane & 15, q4 = lane >> 4;
    const float sc2 = 0.125f * 1.4426950408889634f;
    LAS float* impbuf = (LAS float*)(lds + 2 * G::BUF);
    LAS unsigned long long* selbuf = (LAS unsigned long long*)(lds + 2 * G::BUF + 65536);
    LAS unsigned* um = (LAS unsigned*)(lds + 2 * G::BUF + 65536 + 512);
    const float* kcp = p->nsa_kc; const float* vcp = p->nsa_vc;
    LAS float* rs = impbuf + tid;
    const bf16_t* nq = p->nsa_q; const float* gat = p->nsa_gate; bf16_t* yo = p->ys;
    for (int c0 = BIDX(); c0 < 256; c0 += NBLK()) {
        const int c = NBLK() == 256 ? ((c0 & 7) * 32 + (c0 >> 3)) : c0;
        const int bh = c >> 5, b = bh >> 1, hk = bh & 1;
        const bf16_t* Ks = p->nsa_ks + (size_t)bh * SEQ * 64; const bf16_t* Vs = p->nsa_vs + (size_t)bh * SEQ * 64;
        const bf16_t* Kw = p->nsa_kw + (size_t)bh * SEQ * 64; const bf16_t* Vw = p->nsa_vw + (size_t)bh * SEQ * 64;
#pragma unroll 1
        for (int half = 0; half < 2; ++half) {
            const int cur = half ? 63 - (c & 31) : (c & 31), s0 = cur * 64, g = wave >> 1, head = hk * 4 + g;
            const int qi0 = (wave & 1) * 32 + fr;
            const size_t t0 = (size_t)b * SEQ + s0 + qi0;
            int q4l = q4; asm volatile("" : "+v"(q4l));
            bf16x8 Q[2][2];
#pragma unroll
            for (int rg = 0; rg < 2; ++rg)
#pragma unroll
                for (int ks = 0; ks < 2; ++ks) Q[rg][ks] = *(const bf16x8*)(nq + (t0 + rg * 16) * 512 + head * 64 + ks * 32 + q4l * 8);
            unsigned long long sel[2];
            {
                const int nvmax = min(255, (s0 + 32) / 16 + 1), ntc = (nvmax + 63) >> 6;
                int nv[2];
#pragma unroll
                for (int rg = 0; rg < 2; ++rg) { const int tk = s0 + qi0 + rg * 16; nv[rg] = tk >= 31 ? min(255, (tk - 31) / 16 + 1) : 0; }
#pragma unroll 1
                for (int it = 0; it < 2; ++it) { const int pz = 1 - it;
                    FlashAcc a0; flash_reset(a0);
                    u32x4 sk, sv;
                    auto ld0 = [&](int tl) { int r = tid >> 3, c8 = tid & 7; asm volatile("" : "+v"(r), "+v"(c8)); const size_t o = ((size_t)bh * 256 + tl * 64 + r) * 64 + c8 * 8;
                        const f32x4 k0 = *(const f32x4*)(kcp + o), k1 = *(const f32x4*)(kcp + o + 4);
                        sk = (u32x4){cvt_pk_bf16(k0[0], k0[1]), cvt_pk_bf16(k0[2], k0[3]), cvt_pk_bf16(k1[0], k1[1]), cvt_pk_bf16(k1[2], k1[3])};
                        if (pz == 0) { const f32x4 v0 = *(const f32x4*)(vcp + o), v1 = *(const f32x4*)(vcp + o + 4);
                            sv = (u32x4){cvt_pk_bf16(v0[0], v0[1]), cvt_pk_bf16(v0[2], v0[3]), cvt_pk_bf16(v1[0], v1[1]), cvt_pk_bf16(v1[2], v1[3])}; }
                        else { int n = tl * 64 + r; asm volatile("" : "+v"(n)); unsigned w[4];
#pragma unroll
                            for (int e2 = 0; e2 < 4; ++e2) { const int J0 = c8 * 8 + 2 * e2, J1 = J0 + 1;
                                const unsigned lo = (n >= 4 * J0 - 1 && n <= 4 * J0 + 3 && n < 255) ? 0x3F80u : 0u, hi = (n >= 4 * J1 - 1 && n <= 4 * J1 + 3 && n < 255) ? 0x3F80u : 0u; w[e2] = lo | (hi << 16); }
                            sv = (u32x4){w[0], w[1], w[2], w[3]}; } };
                    FlashStage<64> st0;
                    ld0(0); st0.k = sk; st0.v = sv;
                    flash_stage_write<64>(st0, tid, lds);
                    __syncthreads();
                    for (int tl = 0; tl < ntc; ++tl) {
                        if (tl + 1 < ntc) { ld0(tl + 1); st0.k = sk; st0.v = sv; }
                        { int n0 = nv[0] - tl * 64, n1 = nv[1] - tl * 64;
                          asm volatile("" : "+v"(n0), "+v"(n1));
                          flash_tile<64>(lds + (tl & 1) * G::BUF, Q, a0, sc2, lane, [&](int rg, int kidx) { return kidx < (rg ? n1 : n0); }); }
                        if (tl + 1 < ntc) flash_stage_write<64>(st0, tid, lds + ((tl + 1) & 1) * G::BUF);
                        __syncthreads();
                    }
#pragma unroll
                    for (int rg = 0; rg < 2; ++rg) { const float lt = flash_lsum(a0.l[rg]), inv = lt > 0.f ? 1.0f / lt : 0.f;
                        if (pz == 0) { const float g0 = gat[(t0 + rg * 16) * 24 + head * 3] * inv * ZCMP;
#pragma unroll
                            for (int d = 0; d < 4; ++d)
#pragma unroll
                                for (int e = 0; e < 4; ++e) rs[((rg * 4 + d) * 4 + e) * 512] = a0.O[rg][d][e] * g0; }
                        else {
#pragma unroll
                            for (int d = 0; d < 4; ++d) *(LAS f32x4*)(impbuf + ((size_t)(g * 64 + qi0 + rg * 16)) * 64 + d * 16 + q4 * 4) = a0.O[rg][d] * inv; } }
                    if (it == 0) {
            __syncthreads();
            for (int k = 0; k < 8; ++k) { const int tokl = wave * 8 + k;
                const float im = (impbuf[(0 * 64 + tokl) * 64 + lane] + impbuf[(1 * 64 + tokl) * 64 + lane]) + (impbuf[(2 * 64 + tokl) * 64 + lane] + impbuf[(3 * 64 + tokl) * 64 + lane]);
                const bool valid = lane <= cur, forced = valid && (lane == 0 || lane >= cur - 1);
                const float val = forced ? 1e30f : (valid ? im : -1e30f);
                int rank = 0;
                for (int jj = 0; jj < 64; ++jj) { const float o = __shfl(val, jj); rank += (o > val || (o == val && jj < lane)) ? 1 : 0; }
                const unsigned long long mk = __ballot(rank < 16);
                if (lane == 0) selbuf[tokl] = mk; }
            __syncthreads();
#pragma unroll
            for (int rg = 0; rg < 2; ++rg) sel[rg] = selbuf[qi0 + rg * 16];
            if (wave == 0) {
                unsigned long long u = selbuf[lane];
                unsigned lo = (unsigned)u, hi = (unsigned)(u >> 32);
#pragma unroll
                for (int o = 32; o >= 1; o >>= 1) { lo |= (unsigned)__shfl_xor((int)lo, o); hi |= (unsigned)__shfl_xor((int)hi, o); }
                if (lane == 0) { um[0] = lo; um[1] = hi; }
            }
            __syncthreads();
                    }
                }
            }
            __syncthreads();
            unsigned long long uni = ((unsigned long long)um[1] << 32) | um[0];
            uni &= (cur >= 63) ? ~0ull : ((1ull << (cur + 1)) - 1ull);
            uni = ((unsigned long long)(unsigned)__builtin_amdgcn_readfirstlane((int)(uni >> 32)) << 32) | (unsigned)__builtin_amdgcn_readfirstlane((int)uni);
            FlashAcc a; flash_reset(a);
            {
                FlashStage<64> st;
                unsigned long long rem = uni & ~(1ull << cur);
                if (rem != 0ull) {
                    int j = __builtin_ctzll(rem); rem &= rem - 1;
                    flash_stage_load<64>(st, tid, [&](int r) { return Ks + (size_t)(j * 64 + r) * 64; }, [&](int r) { return Ks; }, [&](int r) { return Vs + (size_t)(j * 64 + r) * 64; });
                    flash_stage_write<64>(st, tid, lds);
                    __syncthreads();
                    int i = 0;
                    for (;;) {
                        const bool more = rem != 0ull;
                        int jn = 0;
                        if (more) { jn = __builtin_ctzll(rem); rem &= rem - 1;
                            flash_stage_load<64>(st, tid, [&](int r) { return Ks + (size_t)(jn * 64 + r) * 64; }, [&](int r) { return Ks; }, [&](int r) { return Vs + (size_t)(jn * 64 + r) * 64; }); }
                        { int l0 = (int)((sel[0] >> j) & 1ull), l1 = (int)((sel[1] >> j) & 1ull);
                          asm volatile("" : "+v"(l0), "+v"(l1));
                          flash_tile_row<64>(lds + (i & 1) * G::BUF, Q, a, sc2, lane, [&](int rg, int) { return (rg ? l1 : l0) != 0; }); }
                        if (more) flash_stage_write<64>(st, tid, lds + ((i + 1) & 1) * G::BUF);
                        __syncthreads();
                        if (!more) break;
                        j = jn; ++i;
                    }
                }
            }
            {
                FlashStage<64> st;
                const int jlo = cur >= 8 ? cur - 8 : 0, ntw = cur - jlo + 1;
                flash_stage_load<64>(st, tid, [&](int r) { return Ks + (size_t)(cur * 64 + r) * 64; }, [&](int r) { return Ks; }, [&](int r) { return Vs + (size_t)(cur * 64 + r) * 64; });
                flash_stage_write<64>(st, tid, lds);
                __syncthreads();
                for (int i2 = 0; i2 <= ntw; ++i2) {
                    if (i2 < ntw) { const int jn = jlo + i2;
                        flash_stage_load<64>(st, tid, [&](int r) { return Kw + (size_t)(jn * 64 + r) * 64; }, [&](int r) { return Kw; }, [&](int r) { return Vw + (size_t)(jn * 64 + r) * 64; }); }
                    { const int j = i2 == 0 ? cur : jlo + i2 - 1; const bool diag = (j == cur), tail = (i2 > 0 && j == cur - 8);
                      int h0 = diag ? qi0 : 64, h1 = diag ? qi0 + 16 : 64, t0_ = tail ? qi0 : -1, t1_ = tail ? qi0 + 16 : -1;
                      asm volatile("" : "+v"(h0), "+v"(h1), "+v"(t0_), "+v"(t1_));
                      if (diag || tail) flash_tile<64>(lds + (i2 & 1) * G::BUF, Q, a, sc2, lane, [&](int rg, int kidx) { return kidx <= (rg ? h1 : h0) && kidx > (rg ? t1_ : t0_); });
                      else flash_tile_row<64>(lds + (i2 & 1) * G::BUF, Q, a, sc2, lane, [&](int rg, int) { return (rg ? h1 : h0) > 0; }); }
                    if (i2 < ntw) flash_stage_write<64>(st, tid, lds + ((i2 + 1) & 1) * G::BUF);
                    __syncthreads();
                    if (i2 == 0) {
#pragma unroll
                        for (int rg = 0; rg < 2; ++rg) { const float gt = gat[(t0 + rg * 16) * 24 + head * 3 + 1] / flash_lsum(a.l[rg]);
#pragma unroll
                            for (int d = 0; d < 4; ++d)
#pragma unroll
                                for (int e = 0; e < 4; ++e) rs[((rg * 4 + d) * 4 + e) * 512] += a.O[rg][d][e] * gt * ZSLC; }
                        flash_reset(a); }
                }
#pragma unroll
                for (int rg = 0; rg < 2; ++rg) { const float gt = gat[(t0 + rg * 16) * 24 + head * 3 + 2] / flash_lsum(a.l[rg]);
#pragma unroll
                    for (int d = 0; d < 4; ++d)
#pragma unroll
                        for (int e = 0; e < 4; ++e) rs[((rg * 4 + d) * 4 + e) * 512] += a.O[rg][d][e] * gt * ZWIN; }
            }
#pragma unroll
            for (int rg = 0; rg < 2; ++rg) { const size_t ob = (t0 + rg * 16) * 512 + head * 64 + q4l * 4;
#pragma unroll
                for (int d = 0; d < 4; ++d) { u32x2 w; w.x = cvt_pk_bf16(rs[((rg * 4 + d) * 4 + 0) * 512], rs[((rg * 4 + d) * 4 + 1) * 512]); w.y = cvt_pk_bf16(rs[((rg * 4 + d) * 4 + 2) * 512], rs[((rg * 4 + d) * 4 + 3) * 512]);
                    *(u32x2*)(yo + ob + d * 16) = w; } }
            __syncthreads();
        }
    }
}
#define DPPF(x, ctrl) __int_as_float(__builtin_amdgcn_update_dpp(0, __float_as_int(x), ctrl, 0xF, 0xF, true))
DI float red16(float x) { x += DPPF(x, 0xB1); x += DPPF(x, 0x4E); x += DPPF(x, 0x141); x += DPPF(x, 0x140); return x; }
DI float dot4(const f32x4 a, const f32x4 b) { f32x2 t = (f32x2){a[0], a[1]} * (f32x2){b[0], b[1]}; t = (f32x2){a[2], a[3]} * (f32x2){b[2], b[3]} + t; return t[0] + t[1]; }
DI void bf8_to_f(const u32x4 w, f32x4& a, f32x4& b) {
    a = (f32x4){__uint_as_float(w.x << 16), __uint_as_float(w.x & 0xffff0000u), __uint_as_float(w.y << 16), __uint_as_float(w.y & 0xffff0000u)};
    b = (f32x4){__uint_as_float(w.z << 16), __uint_as_float(w.z & 0xffff0000u), __uint_as_float(w.w << 16), __uint_as_float(w.w & 0xffff0000u)};
}
template <int MODE>
DI void rowscan_unit(KParamsPtr p, LAS unsigned char* lds, int unit) {
    constexpr int TC = 32, NV = MODE == 0 ? 5 : 3;
    constexpr int NR = 32;
    constexpr int BUFF = NV * TC * 64 + TC * NR + TC * NR;
    const int tid = TIDX(), lane = tid & 63, wave = __builtin_amdgcn_readfirstlane(tid >> 6);
    LAS float* L = (LAS float*)lds;
    int b, h, sub;
    if (MODE == 0) { const int bh = unit >> 1; b = bh >> 3; h = bh & 7; sub = unit & 1; } else { const int bh = unit >> 2; b = bh >> 2; h = bh & 3; sub = unit & 3; }
    const size_t tb = (size_t)b * SEQ;
    f32x4 f0, f1, f2; u32x4 h0, hv;
    auto stage_load = [&](int t0) {
        const int s = tid >> 4, c4 = tid & 15, s2 = (tid & 255) >> 3, c8 = tid & 7;
        if (MODE == 0) {
            const size_t o = (tb + t0 + s) * 512 + h * 64 + c4 * 4;
            f0 = *(const f32x4*)(p->rw_kk + o); f1 = *(const f32x4*)(p->rw_w + o); f2 = *(const f32x4*)(p->rw_b + o);
            const size_t o2 = (tb + t0 + s2) * 512 + h * 64 + c8 * 8;
            h0 = *(const u32x4*)((tid < 256 ? p->rw_k : p->rw_r) + o2);
            if (tid < 128) hv = *(const u32x4*)(p->rw_v + (tb + t0 + (tid >> 2)) * 512 + h * 64 + sub * NR + (tid & 3) * 8);
        } else {
            f0 = *(const f32x4*)(p->gla_la + (tb + t0 + s) * 256 + h * 64 + c4 * 4);
            const bf16_t* row = p->P1 + (tb + t0 + s2) * NP1P;
            h0 = *(const u32x4*)(row + (tid < 256 ? C_GLA_K : C_GLA_Q) + h * 64 + c8 * 8);
            if (tid < 128) hv = *(const u32x4*)(p->P1 + (tb + t0 + (tid >> 2)) * NP1P + C_GLA_V + h * 128 + sub * NR + (tid & 3) * 8);
        }
    };
    auto stage_write = [&](int buf) {
        LAS float* B = L + buf * BUFF;
        const int s = tid >> 4, c4 = tid & 15, s2 = (tid & 255) >> 3, c8 = tid & 7;
        f32x4 a, c; bf8_to_f(h0, a, c);
        if (MODE == 0) {
            *(LAS f32x4*)(B + (0 * TC + s) * 64 + c4 * 4) = f0; *(LAS f32x4*)(B + (1 * TC + s) * 64 + c4 * 4) = f1; *(LAS f32x4*)(B + (3 * TC + s) * 64 + c4 * 4) = f2;
            LAS float* d = B + ((tid < 256 ? 2 : 4) * TC + s2) * 64 + c8 * 8;
            *(LAS f32x4*)d = a; *(LAS f32x4*)(d + 4) = c;
        } else {
            *(LAS f32x4*)(B + (0 * TC + s) * 64 + c4 * 4) = (f32x4){__expf(f0[0]), __expf(f0[1]), __expf(f0[2]), __expf(f0[3])};
            if (tid >= 256) { a *= 0.125f; c *= 0.125f; }
            LAS float* d = B + ((tid < 256 ? 1 : 2) * TC + s2) * 64 + c8 * 8;
            *(LAS f32x4*)d = a; *(LAS f32x4*)(d + 4) = c;
        }
        if (tid < 128) { f32x4 va, vc; bf8_to_f(hv, va, vc); LAS float* d = B + NV * TC * 64 + (tid >> 2) * NR + (tid & 3) * 8; *(LAS f32x4*)d = va; *(LAS f32x4*)(d + 4) = vc; }
    };
    auto flush_y = [&](int buf, int t0) {
        if (tid < TC * 8) { const int s = tid >> 3, q = tid & 7;
            const f32x4 v = *(const LAS f32x4*)(L + buf * BUFF + NV * TC * 64 + TC * NR + s * NR + q * 4);
            float* dst = (MODE == 0 ? p->rw_y + (tb + t0 + s) * 512 + h * 64 : p->gla_o + (tb + t0 + s) * 512 + h * 128) + sub * NR + q * 4;
            *(f32x4*)dst = v; }
    };
    const int row = wave * 4 + (lane >> 4), j = lane & 15;
    f32x4 st = (f32x4){0.f, 0.f, 0.f, 0.f};
    stage_load(0);
    __syncthreads();
    stage_write(0);
    __syncthreads();
    constexpr int NCH = SEQ / TC;
    for (int c = 0; c < NCH; ++c) {
        if (c + 1 < NCH) stage_load((c + 1) * TC);
        if (c > 0) flush_y((c - 1) & 1, (c - 1) * TC);
        {
            LAS const float* B = L + (c & 1) * BUFF;
            LAS float* Y = L + (c & 1) * BUFF + NV * TC * 64 + TC * NR;
#pragma unroll 1
            for (int s0 = 0; s0 < TC; s0 += 4) {
                float v[4]; f32x4 x0[4], x1[4], x2[4], x3[4], x4[4];
#pragma unroll
                for (int u = 0; u < 4; ++u) { const int s = s0 + u;
                    v[u] = B[NV * TC * 64 + s * NR + row];
                    x0[u] = *(const LAS f32x4*)(B + (0 * TC + s) * 64 + j * 4); x1[u] = *(const LAS f32x4*)(B + (1 * TC + s) * 64 + j * 4); x2[u] = *(const LAS f32x4*)(B + (2 * TC + s) * 64 + j * 4);
                    if (MODE == 0) { x3[u] = *(const LAS f32x4*)(B + (3 * TC + s) * 64 + j * 4); x4[u] = *(const LAS f32x4*)(B + (4 * TC + s) * 64 + j * 4); } }
#pragma unroll
                for (int u = 0; u < 4; ++u) { const int s = s0 + u;
                    if (MODE == 0) {
                        const float skk = red16(dot4(st, x0[u]));
                        st = st * x1[u] + (x2[u] * v[u] - x3[u] * skk);
                        const float y = red16(dot4(st, x4[u]));
                        Y[s * NR + row] = y;
                    } else {
                        st = st * x0[u] + x1[u] * v[u];
                        const float y = red16(dot4(st, x2[u]));
                        Y[s * NR + row] = y;
                    } }
            }
        }
        if (c + 1 < NCH) stage_write((c + 1) & 1);
        __syncthreads();
    }
    flush_y((NCH - 1) & 1, (NCH - 1) * TC);
    __syncthreads();
}
DI void phase_rowscans(KParamsPtr p, LAS unsigned char* lds) {
    for (int u = BIDX(); u < 128; u += NBLK()) { if (u < 64) rowscan_unit<0>(p, lds, u); else rowscan_unit<1>(p, lds, u - 64); }
}

template <int MODE>
DI void rowscan_half(KParamsPtr p, LAS float* L, int unit, int tl, int wl, int lane) {
    constexpr int TC = 16, NV = MODE == 0 ? 5 : 3, NR = 16;
    constexpr int BUFF = NV * TC * 64 + TC * NR + TC * NR;
    int b, h, sub;
    if (MODE == 0) { const int bh = unit >> 2; b = bh >> 3; h = bh & 7; sub = unit & 3; } else { const int bh = unit >> 3; b = bh >> 2; h = bh & 3; sub = unit & 7; }
    const size_t tb = (size_t)b * SEQ;
    f32x4 f0, f1, f2; u32x4 h0, hv;
    auto stage_load = [&](int t0) {
        const int s = tl >> 4, c4 = tl & 15, s2 = (tl & 127) >> 3, c8 = tl & 7;
        if (MODE == 0) {
            const size_t o = (tb + t0 + s) * 512 + h * 64 + c4 * 4;
            f0 = *(const f32x4*)(p->rw_kk + o); f1 = *(const f32x4*)(p->rw_w + o); f2 = *(const f32x4*)(p->rw_b + o);
            h0 = *(const u32x4*)((tl < 128 ? p->rw_k : p->rw_r) + (tb + t0 + s2) * 512 + h * 64 + c8 * 8);
            if (tl < 32) hv = *(const u32x4*)(p->rw_v + (tb + t0 + (tl >> 1)) * 512 + h * 64 + sub * NR + (tl & 1) * 8);
        } else {
            f0 = *(const f32x4*)(p->gla_la + (tb + t0 + s) * 256 + h * 64 + c4 * 4);
            h0 = *(const u32x4*)(p->P1 + (tb + t0 + s2) * NP1P + (tl < 128 ? C_GLA_K : C_GLA_Q) + h * 64 + c8 * 8);
            if (tl < 32) hv = *(const u32x4*)(p->P1 + (tb + t0 + (tl >> 1)) * NP1P + C_GLA_V + h * 128 + sub * NR + (tl & 1) * 8);
        }
    };
    auto stage_write = [&](int buf) {
        LAS float* B = L + buf * BUFF;
        const int s = tl >> 4, c4 = tl & 15, s2 = (tl & 127) >> 3, c8 = tl & 7;
        f32x4 a, c; bf8_to_f(h0, a, c);
        if (MODE == 0) {
            *(LAS f32x4*)(B + (0 * TC + s) * 64 + c4 * 4) = f0; *(LAS f32x4*)(B + (1 * TC + s) * 64 + c4 * 4) = f1; *(LAS f32x4*)(B + (3 * TC + s) * 64 + c4 * 4) = f2;
            LAS float* d = B + ((tl < 128 ? 2 : 4) * TC + s2) * 64 + c8 * 8; *(LAS f32x4*)d = a; *(LAS f32x4*)(d + 4) = c;
        } else {
            *(LAS f32x4*)(B + (0 * TC + s) * 64 + c4 * 4) = (f32x4){__expf(f0[0]), __expf(f0[1]), __expf(f0[2]), __expf(f0[3])};
            if (tl >= 128) { a *= 0.125f; c *= 0.125f; }
            LAS float* d = B + ((tl < 128 ? 1 : 2) * TC + s2) * 64 + c8 * 8; *(LAS f32x4*)d = a; *(LAS f32x4*)(d + 4) = c;
        }
        if (tl < 32) { f32x4 va, vc; bf8_to_f(hv, va, vc); LAS float* d = B + NV * TC * 64 + (tl >> 1) * NR + (tl & 1) * 8; *(LAS f32x4*)d = va; *(LAS f32x4*)(d + 4) = vc; }
    };
    auto flush_y = [&](int buf, int t0) {
        if (tl < TC * 4) { const int s = tl >> 2, q = tl & 3;
            const f32x4 v = *(const LAS f32x4*)(L + buf * BUFF + NV * TC * 64 + TC * NR + s * NR + q * 4);
            float* dst = (MODE == 0 ? p->rw_y + (tb + t0 + s) * 512 + h * 64 : p->gla_o + (tb + t0 + s) * 512 + h * 128) + sub * NR + q * 4;
            *(f32x4*)dst = v; }
    };
    const int row = wl * 4 + (lane >> 4), j = lane & 15;
    f32x4 st = (f32x4){0.f, 0.f, 0.f, 0.f};
    stage_load(0);
    __syncthreads();
    stage_write(0);
    __syncthreads();
    constexpr int NCH = SEQ / TC;
    for (int c = 0; c < NCH; ++c) {
        if (c + 1 < NCH) stage_load((c + 1) * TC);
        if (c > 0) flush_y((c - 1) & 1, (c - 1) * TC);
        LAS const float* B = L + (c & 1) * BUFF;
        LAS float* Y = L + (c & 1) * BUFF + NV * TC * 64 + TC * NR;
        {
            float va[4], vb[4]; f32x4 pa0[4], pa1[4], pb0[4], pb1[4];
            auto ldh = [&](int s0, float (&v)[4], f32x4 (&h0)[4], f32x4 (&h1)[4]) {
#pragma unroll
                for (int u = 0; u < 4; ++u) { const int s = s0 + u;
                    v[u] = B[NV * TC * 64 + s * NR + row];
                    h0[u] = *(const LAS f32x4*)(B + (0 * TC + s) * 64 + j * 4);
                    h1[u] = *(const LAS f32x4*)(B + ((MODE == 0 ? 3 : 1) * TC + s) * 64 + j * 4); } };
            auto run = [&](int s0, const float (&v)[4], const f32x4 (&h0)[4], const f32x4 (&h1)[4]) {
                f32x4 x1[4], x2[4], x4[4];
#pragma unroll
                for (int u = 0; u < 4; ++u) { const int s = s0 + u;
                    if (MODE == 0) { x1[u] = *(const LAS f32x4*)(B + (1 * TC + s) * 64 + j * 4); x2[u] = *(const LAS f32x4*)(B + (2 * TC + s) * 64 + j * 4); x4[u] = *(const LAS f32x4*)(B + (4 * TC + s) * 64 + j * 4); }
                    else x2[u] = *(const LAS f32x4*)(B + (2 * TC + s) * 64 + j * 4); }
#pragma unroll
                for (int u = 0; u < 4; ++u) { const int s = s0 + u;
                    if (MODE == 0) { const float skk = red16(dot4(st, h0[u])); st = st * x1[u] + (x2[u] * v[u] - h1[u] * skk); Y[s * NR + row] = red16(dot4(st, x4[u])); }
                    else { st = st * h0[u] + h1[u] * v[u]; Y[s * NR + row] = red16(dot4(st, x2[u])); } } };
            ldh(0, va, pa0, pa1);
            ldh(4, vb, pb0, pb1);  run(0, va, pa0, pa1);
            ldh(8, va, pa0, pa1);  run(4, vb, pb0, pb1);
            ldh(12, vb, pb0, pb1); run(8, va, pa0, pa1);
            run(12, vb, pb0, pb1);
        }
        if (c + 1 < NCH) stage_write((c + 1) & 1);
        __syncthreads();
    }
    flush_y((NCH - 1) & 1, (NCH - 1) * TC);
    __syncthreads();
}
DI void phase_rowscans_paired(KParamsPtr p, LAS unsigned char* lds) {
    const int tid = TIDX(), lane = tid & 63, wave = __builtin_amdgcn_readfirstlane(tid >> 6);
    for (int u0 = BIDX(); u0 < 128; u0 += NBLK()) {
        const int u = NBLK() == 256 ? ((u0 & 7) * 16 + (u0 >> 3)) : u0;
        if (wave < 4) rowscan_half<0>(p, (LAS float*)lds, u, tid, wave, lane);
        else rowscan_half<1>(p, (LAS float*)(lds + 49152), u, tid - 256, wave - 4, lane);
    }
}
constexpr int LDS_BYTES = 147456;
constexpr int LDS_XB_OFF = 131072;

#ifndef REP_SETUP
#define REP_SETUP 1
#endif
#ifndef REP_CONV
#define REP_CONV 1
#endif
#ifndef REP_PREP
#define REP_PREP 1
#endif
#ifndef REP_CMPR
#define REP_CMPR 1
#endif
#ifndef REP_MLAUP
#define REP_MLAUP 1
#endif
#ifndef REP_NSACMP
#define REP_NSACMP 1
#endif
#ifndef REP_NSAF
#define REP_NSAF 1
#endif
#ifndef REP_MLAF
#define REP_MLAF 1
#endif
#ifndef REP_SCAN
#define REP_SCAN 1
#endif
#ifndef REP_POST
#define REP_POST 1
#endif
#ifndef REP_MSUM
#define REP_MSUM 1
#endif
#ifndef REP_NORM0
#define REP_NORM0 1
#endif
#ifndef REP_GATE
#define REP_GATE 1
#endif
#ifndef REP_MERGE
#define REP_MERGE 1
#endif
#ifndef REP_UP
#define REP_UP 1
#endif
#ifndef REP_DN
#define REP_DN 1
#endif
#ifndef REP_PROJ
#define REP_PROJ 1
#endif
#ifndef SCAN_GATE_UNITS
#define SCAN_GATE_UNITS 3
#endif
#define REPEAT(n) for (int r_ = 0; r_ < (n); ++r_)
__global__ void __launch_bounds__(512, 2) mega(Params p_arg, int ph_lo, int ph_hi) {
    extern __shared__ __attribute__((aligned(16))) unsigned char lds_raw[];
    LAS unsigned char* lds = (LAS unsigned char*)lds_raw;
    volatile LAS unsigned* xbw = (volatile LAS unsigned*)(lds + LDS_XB_OFF);
    if (threadIdx.x == 0) { xbw[0] = 0u; xbw[1] = 0u; xbw[2] = 0u; xbw[3] = 0u; }
    __syncthreads();
    XcdBarrier bar; bar.bar = p_arg.bar; bar.x = 0; bar.st = xbw;
    if (ph_hi - ph_lo > 1) bar = xcd_barrier_post(p_arg.bar, xbw);
    int ph = 0;
#define PHASE_BEGIN if (ph >= ph_lo && ph < ph_hi) { KParamsPtr p = (KParamsPtr)__builtin_amdgcn_kernarg_segment_ptr(); asm volatile("" : "+s"(p));
#define PHASE_END   __syncthreads(); if (ph + 1 < ph_hi) xcd_barrier(bar); } ++ph;

    PHASE_BEGIN REPEAT(REP_SETUP) { phase_setup(p, lds); __syncthreads(); } REPEAT(REP_CONV) { phase_convert(p, 0, lds); __syncthreads(); } PHASE_END
    PHASE_BEGIN REPEAT(REP_NORM0) phase_norm<false, true>(p->x, nullptr, nullptr, p->u, nullptr, nullptr, 0.f, p->pre_g, p->mod); PHASE_END

    { constexpr int l = 0;

#define modA (p->mod + (size_t)(l * 3 + 0) * 4 * 6144)
#define modB (p->mod + (size_t)(l * 3 + 1) * 4 * 6144)
#define modC (p->mod + (size_t)(l * 3 + 2) * 4 * 6144)
        PHASE_BEGIN REPEAT(REP_UP) { EpiSwiglu E; E.H = p->P1; E.ldc = DFF; run_gemm(lds, p->u, D, p->Wup0, D, T, 2 * DFF, D, E); __syncthreads(); } PHASE_END
        PHASE_BEGIN REPEAT(REP_DN) { EpiBf16<0> E; E.O = (bf16_t*)p->y; E.ldc = D; run_gemm(lds, p->P1, DFF, p->Wdn0, DFF, T, D, DFF, E); __syncthreads(); } PHASE_END
        PHASE_BEGIN phase_norm<true, true, (l != 0), true>(l == 0 ? (const void*)p->x : (const void*)p->out, (const bf16_t*)p->y, p->out, p->u, p->post_g + (l * 3 + 0) * D, modA, 0.5f, p->pre_g + (l * 3 + 1) * D, modB); PHASE_END
        PHASE_BEGIN REPEAT(REP_PROJ) {
            { EpiBf16<0> E; E.O = p->P1; E.ldc = NP1P; run_gemm(lds, p->u, D, p->Win1, D, T, P1TAIL, D, E); } __syncthreads();
            for (int i_ = BIDX(); i_ < 256; i_ += NBLK()) { const int pm_ = i_ >> 2, kp_ = i_ & 3;
                EpiF32Lo E; E.C = p->y + (size_t)kp_ * T * 256; E.ldc = 256;
                pg8::Gemm g; g.A = p->u + kp_ * 512; g.Bt = p->Win1 + (size_t)P1TAIL * D + kp_ * 512; g.M = T; g.N = 256; g.K = 512; g.lda = D; g.ldb = D;
                SplitOrder S; S.first = pm_; S.count = 1; S.nN = 1;
                pg8::gemm_phase<EpiF32Lo, SplitOrder, false>((PG8_LAS unsigned char*)lds, g, S, E, nullptr); __syncthreads(); }
            __syncthreads(); } PHASE_END
        PHASE_BEGIN REPEAT(REP_PREP) { phase_prep2(p, l, lds); __syncthreads(); } PHASE_END
        PHASE_BEGIN {
            REPEAT(REP_SCAN) { phase_rowscans_paired(p, lds); __syncthreads(); }
            EpiBf16<1> E; E.O = p->G; E.ldc = NGATE;
            pg8::Gemm g; g.A = p->u; g.Bt = p->Wg; g.M = T; g.N = NGATE; g.K = D; g.lda = D; g.ldb = D;
            const int nb_ = NBLK(), bid_ = BIDX();
            if (nb_ == 256 && SCAN_GATE_UNITS == 3) {
                const int x_ = bid_ & 7; RowWalkOrder S;
                if (bid_ < 128) { const int r_ = bid_ >> 3; S.pm = 8 * x_ + (r_ & 7); S.pn0 = (r_ >> 3) * 3; S.step = 1; S.count = 3; }
                else { const int r_ = (bid_ - 128) >> 3; S.pm = 8 * x_ + (r_ & 7); S.pn0 = 6 + (r_ >> 3); S.step = 2; S.count = 13; }
                pg8::gemm_phase<EpiBf16<1>, RowWalkOrder, false>((PG8_LAS unsigned char*)lds, g, S, E, nullptr); }
            else if (nb_ == 256) { SplitOrder S; S.nN = 32; if (bid_ < 128) { S.first = bid_ * SCAN_GATE_UNITS; S.count = SCAN_GATE_UNITS; } else { S.first = 128 * SCAN_GATE_UNITS + (bid_ - 128) * (16 - SCAN_GATE_UNITS); S.count = 16 - SCAN_GATE_UNITS; }
                pg8::gemm_phase<EpiBf16<1>, SplitOrder, false>((PG8_LAS unsigned char*)lds, g, S, E, nullptr); }
            else { pg8::StaticOrder S; S.init(T, NGATE, nb_, bid_); pg8::gemm_phase<EpiBf16<1>, pg8::StaticOrder, false>((PG8_LAS unsigned char*)lds, g, S, E, nullptr); }
        } PHASE_END
        PHASE_BEGIN REPEAT(REP_CMPR) {
            const int c_ = BIDX();
            if (c_ < 16) { const int wh = c_ >> 3, pan = c_ & 7;
                { EpiGeluBias E; E.O = p->chid + (size_t)wh * 2048 * 256; E.ldc = 256; E.bias = p->cbias + wh * 256;
                  pg8::Gemm g; g.A = wh ? p->nsa_vc_in : p->nsa_kc_in; g.Bt = p->cW1t + (size_t)wh * 256 * 2048; g.M = 2048; g.N = 256; g.K = 2048; g.lda = 1024; g.ldb = 2048;
                  SplitOrder S; S.first = pan; S.count = 1; S.nN = 1;
                  pg8::gemm_phase<EpiGeluBias, SplitOrder, false>((PG8_LAS unsigned char*)lds, g, S, E, nullptr); }
                asm volatile("s_waitcnt vmcnt(0)" ::: "memory"); __syncthreads();
                { EpiCmpOut E; E.C = wh ? p->nsa_vc : p->nsa_kc;
                  pg8::Gemm g; g.A = p->chid + (size_t)wh * 2048 * 256; g.Bt = p->cW2t + (size_t)wh * 256 * 256; g.M = 2048; g.N = 256; g.K = 256; g.lda = 256; g.ldb = 256;
                  SplitOrder S; S.first = pan; S.count = 1; S.nN = 1;
                  pg8::gemm_phase<EpiCmpOut, SplitOrder, false>((PG8_LAS unsigned char*)lds, g, S, E, nullptr); }
            }
            __syncthreads(); } REPEAT(REP_MLAUP) {
            const int skip_ = NBLK() == 256 ? 16 : 0, G_ = NBLK() - skip_, c2_ = BIDX() - skip_;
            if (c2_ >= 0) {
                { EpiBf16<0> E; E.O = p->mla_q; E.ldc = 768; pg8::Gemm g; g.A = p->mla_cqn; g.Bt = p->Wuq; g.M = T; g.N = 768; g.K = 384; g.lda = 384; g.ldb = 384;
                  pg8::StaticOrder S; S.init(T, 768, G_, c2_); pg8::gemm_phase<EpiBf16<0>, pg8::StaticOrder, false>((PG8_LAS unsigned char*)lds, g, S, E, nullptr); } __syncthreads();
                { EpiBf16<0> E; E.O = p->mla_kv; E.ldc = 1024; pg8::Gemm g; g.A = p->mla_ckvn; g.Bt = p->Wukv; g.M = T; g.N = 1024; g.K = 256; g.lda = 256; g.ldb = 256;
                  pg8::StaticOrder S; S.init(T, 1024, G_, (c2_ + 48) % G_); pg8::gemm_phase<EpiBf16<0>, pg8::StaticOrder, false>((PG8_LAS unsigned char*)lds, g, S, E, nullptr); } __syncthreads(); } } __syncthreads(); REPEAT(REP_POST) { phase_post(p, l, lds, NBLK() == 256 ? 16 : 0); __syncthreads(); } PHASE_END
        PHASE_BEGIN REPEAT(REP_NSAF) { phase_nsa_full(p, lds); __syncthreads(); } REPEAT(REP_MLAF) { phase_mla_flash(p, lds); __syncthreads(); } PHASE_END
        PHASE_BEGIN { EpiMergeAcc E; E.G = p->G; E.O = p->mg;
            pg8::Gemm g; g.A = p->ys; g.Bt = p->Wbr; g.M = 4 * T; g.N = 4 * D; g.K = 512; g.lda = 512; g.ldb = 512;
            MergeOrder S; S.G = NBLK(); S.c = BIDX();
            REPEAT(REP_MERGE) { pg8::gemm_phase<EpiMergeAcc, MergeOrder, false>((PG8_LAS unsigned char*)lds, g, S, E, nullptr); __syncthreads(); } } PHASE_END
        PHASE_BEGIN { EpiBf16<0> E; E.O = (bf16_t*)p->y; E.ldc = D; run_gemm(lds, p->mg, D, p->Wout, D, T, D, D, E); } PHASE_END
        PHASE_BEGIN phase_norm<true, true, true, true>(p->out, (const bf16_t*)p->y, p->G, p->u, p->post_g + (l * 3 + 1) * D, modB, 1.0f, p->pre_g + (l * 3 + 2) * D, modC); PHASE_END
        PHASE_BEGIN { EpiSwiglu E; E.H = p->P1; E.ldc = DFF; run_gemm(lds, p->u, D, p->Wup1, D, T, 2 * DFF, D, E); } PHASE_END
        PHASE_BEGIN { EpiBf16<0> E; E.O = (bf16_t*)p->y; E.ldc = D; run_gemm(lds, p->P1, DFF, p->Wdn1, DFF, T, D, DFF, E); } PHASE_END
        if (l == 0) { PHASE_BEGIN phase_norm<true, true, true, true>(p->G, (const bf16_t*)p->y, p->out, p->u, p->post_g + (l * 3 + 2) * D, modC, 0.5f, p->pre_g + ((l + 1) * 3) * D, p->mod + (size_t)((l + 1) * 3) * 4 * 6144);
            __syncthreads(); REPEAT(REP_CONV) { phase_convert(p, 1, lds); __syncthreads(); } PHASE_END }
        else        { PHASE_BEGIN phase_norm<true, false, true, false>(p->G, (const bf16_t*)p->y, p->out, nullptr, p->post_g + (l * 3 + 2) * D, modC, 0.5f, nullptr, nullptr); PHASE_END }
    }
    { constexpr int l = 1;

#define modA (p->mod + (size_t)(l * 3 + 0) * 4 * 6144)
#define modB (p->mod + (size_t)(l * 3 + 1) * 4 * 6144)
#define modC (p->mod + (size_t)(l * 3 + 2) * 4 * 6144)
        PHASE_BEGIN REPEAT(REP_UP) { EpiSwiglu E; E.H = p->P1; E.ldc = DFF; run_gemm(lds, p->u, D, p->Wup0, D, T, 2 * DFF, D, E); __syncthreads(); } PHASE_END
        PHASE_BEGIN REPEAT(REP_DN) { EpiBf16<0> E; E.O = (bf16_t*)p->y; E.ldc = D; run_gemm(lds, p->P1, DFF, p->Wdn0, DFF, T, D, DFF, E); __syncthreads(); } PHASE_END
        PHASE_BEGIN phase_norm<true, true, (l != 0), true>(l == 0 ? (const void*)p->x : (const void*)p->out, (const bf16_t*)p->y, p->out, p->u, p->post_g + (l * 3 + 0) * D, modA, 0.5f, p->pre_g + (l * 3 + 1) * D, modB); PHASE_END
        PHASE_BEGIN REPEAT(REP_PROJ) {
            { EpiBf16<0> E; E.O = p->P1; E.ldc = NP1P; run_gemm(lds, p->u, D, p->Win1, D, T, P1TAIL, D, E); } __syncthreads();
            for (int i_ = BIDX(); i_ < 256; i_ += NBLK()) { const int pm_ = i_ >> 2, kp_ = i_ & 3;
                EpiF32Lo E; E.C = p->y + (size_t)kp_ * T * 256; E.ldc = 256;
                pg8::Gemm g; g.A = p->u + kp_ * 512; g.Bt = p->Win1 + (size_t)P1TAIL * D + kp_ * 512; g.M = T; g.N = 256; g.K = 512; g.lda = D; g.ldb = D;
                SplitOrder S; S.first = pm_; S.count = 1; S.nN = 1;
                pg8::gemm_phase<EpiF32Lo, SplitOrder, false>((PG8_LAS unsigned char*)lds, g, S, E, nullptr); __syncthreads(); }
            __syncthreads(); } PHASE_END
        PHASE_BEGIN REPEAT(REP_PREP) { phase_prep2(p, l, lds); __syncthreads(); } PHASE_END
        PHASE_BEGIN {
            REPEAT(REP_SCAN) { phase_rowscans_paired(p, lds); __syncthreads(); }
            EpiBf16<1> E; E.O = p->G; E.ldc = NGATE;
            pg8::Gemm g; g.A = p->u; g.Bt = p->Wg; g.M = T; g.N = NGATE; g.K = D; g.lda = D; g.ldb = D;
            const int nb_ = NBLK(), bid_ = BIDX();
            if (nb_ == 256 && SCAN_GATE_UNITS == 3) {
                const int x_ = bid_ & 7; RowWalkOrder S;
                if (bid_ < 128) { const int r_ = bid_ >> 3; S.pm = 8 * x_ + (r_ & 7); S.pn0 = (r_ >> 3) * 3; S.step = 1; S.count = 3; }
                else { const int r_ = (bid_ - 128) >> 3; S.pm = 8 * x_ + (r_ & 7); S.pn0 = 6 + (r_ >> 3); S.step = 2; S.count = 13; }
                pg8::gemm_phase<EpiBf16<1>, RowWalkOrder, false>((PG8_LAS unsigned char*)lds, g, S, E, nullptr); }
            else if (nb_ == 256) { SplitOrder S; S.nN = 32; if (bid_ < 128) { S.first = bid_ * SCAN_GATE_UNITS; S.count = SCAN_GATE_UNITS; } else { S.first = 128 * SCAN_GATE_UNITS + (bid_ - 128) * (16 - SCAN_GATE_UNITS); S.count = 16 - SCAN_GATE_UNITS; }
                pg8::gemm_phase<EpiBf16<1>, SplitOrder, false>((PG8_LAS unsigned char*)lds, g, S, E, nullptr); }
            else { pg8::StaticOrder S; S.init(T, NGATE, nb_, bid_); pg8::gemm_phase<EpiBf16<1>, pg8::StaticOrder, false>((PG8_LAS unsigned char*)lds, g, S, E, nullptr); }
        } PHASE_END
        PHASE_BEGIN REPEAT(REP_CMPR) {
            const int c_ = BIDX();
            if (c_ < 16) { const int wh = c_ >> 3, pan = c_ & 7;
                { EpiGeluBias E; E.O = p->chid + (size_t)wh * 2048 * 256; E.ldc = 256; E.bias = p->cbias + wh * 256;
                  pg8::Gemm g; g.A = wh ? p->nsa_vc_in : p->nsa_kc_in; g.Bt = p->cW1t + (size_t)wh * 256 * 2048; g.M = 2048; g.N = 256; g.K = 2048; g.lda = 1024; g.ldb = 2048;
                  SplitOrder S; S.first = pan; S.count = 1; S.nN = 1;
                  pg8::gemm_phase<EpiGeluBias, SplitOrder, false>((PG8_LAS unsigned char*)lds, g, S, E, nullptr); }
                asm volatile("s_waitcnt vmcnt(0)" ::: "memory"); __syncthreads();
                { EpiCmpOut E; E.C = wh ? p->nsa_vc : p->nsa_kc;
                  pg8::Gemm g; g.A = p->chid + (size_t)wh * 2048 * 256; g.Bt = p->cW2t + (size_t)wh * 256 * 256; g.M = 2048; g.N = 256; g.K = 256; g.lda = 256; g.ldb = 256;
                  SplitOrder S; S.first = pan; S.count = 1; S.nN = 1;
                  pg8::gemm_phase<EpiCmpOut, SplitOrder, false>((PG8_LAS unsigned char*)lds, g, S, E, nullptr); }
            }
            __syncthreads(); } REPEAT(REP_MLAUP) {
            const int skip_ = NBLK() == 256 ? 16 : 0, G_ = NBLK() - skip_, c2_ = BIDX() - skip_;
            if (c2_ >= 0) {
                { EpiBf16<0> E; E.O = p->mla_q; E.ldc = 768; pg8::Gemm g; g.A = p->mla_cqn; g.Bt = p->Wuq; g.M = T; g.N = 768; g.K = 384; g.lda = 384; g.ldb = 384;
                  pg8::StaticOrder S; S.init(T, 768, G_, c2_); pg8::gemm_phase<EpiBf16<0>, pg8::StaticOrder, false>((PG8_LAS unsigned char*)lds, g, S, E, nullptr); } __syncthreads();
                { EpiBf16<0> E; E.O = p->mla_kv; E.ldc = 1024; pg8::Gemm g; g.A = p->mla_ckvn; g.Bt = p->Wukv; g.M = T; g.N = 1024; g.K = 256; g.lda = 256; g.ldb = 256;
                  pg8::StaticOrder S; S.init(T, 1024, G_, (c2_ + 48) % G_); pg8::gemm_phase<EpiBf16<0>, pg8::StaticOrder, false>((PG8_LAS unsigned char*)lds, g, S, E, nullptr); } __syncthreads(); } } __syncthreads(); REPEAT(REP_POST) { phase_post(p, l, lds, NBLK() == 256 ? 16 : 0); __syncthreads(); } PHASE_END
        PHASE_BEGIN REPEAT(REP_NSAF) { phase_nsa_full(p, lds); __syncthreads(); } REPEAT(REP_MLAF) { phase_mla_flash(p, lds); __syncthreads(); } PHASE_END
        PHASE_BEGIN { EpiMergeAcc E; E.G = p->G; E.O = p->mg;
            pg8::Gemm g; g.A = p->ys; g.Bt = p->Wbr; g.M = 4 * T; g.N = 4 * D; g.K = 512; g.lda = 512; g.ldb = 512;
            MergeOrder S; S.G = NBLK(); S.c = BIDX();
            REPEAT(REP_MERGE) { pg8::gemm_phase<EpiMergeAcc, MergeOrder, false>((PG8_LAS unsigned char*)lds, g, S, E, nullptr); __syncthreads(); } } PHASE_END
        PHASE_BEGIN { EpiBf16<0> E; E.O = (bf16_t*)p->y; E.ldc = D; run_gemm(lds, p->mg, D, p->Wout, D, T, D, D, E); } PHASE_END
        PHASE_BEGIN phase_norm<true, true, true, true>(p->out, (const bf16_t*)p->y, p->G, p->u, p->post_g + (l * 3 + 1) * D, modB, 1.0f, p->pre_g + (l * 3 + 2) * D, modC); PHASE_END
        PHASE_BEGIN { EpiSwiglu E; E.H = p->P1; E.ldc = DFF; run_gemm(lds, p->u, D, p->Wup1, D, T, 2 * DFF, D, E); } PHASE_END
        PHASE_BEGIN { EpiBf16<0> E; E.O = (bf16_t*)p->y; E.ldc = D; run_gemm(lds, p->P1, DFF, p->Wdn1, DFF, T, D, DFF, E); } PHASE_END
        if (l == 0) { PHASE_BEGIN phase_norm<true, true, true, true>(p->G, (const bf16_t*)p->y, p->out, p->u, p->post_g + (l * 3 + 2) * D, modC, 0.5f, p->pre_g + ((l + 1) * 3) * D, p->mod + (size_t)((l + 1) * 3) * 4 * 6144);
            __syncthreads(); REPEAT(REP_CONV) { phase_convert(p, 1, lds); __syncthreads(); } PHASE_END }
        else        { PHASE_BEGIN phase_norm<true, false, true, false>(p->G, (const bf16_t*)p->y, p->out, nullptr, p->post_g + (l * 3 + 2) * D, modC, 0.5f, nullptr, nullptr); PHASE_END }
    }

}
constexpr int N_PHASES = 2 + 2 * 14;

extern "C" void kernel_launch(void* const* d_in, const int* in_sizes, int n_in, void* d_out, int out_size, void* d_ws, size_t ws_size, hipStream_t stream) {
    static int grid = 0;
    if (grid == 0) {
        int dev = 0, cus = 0;
        if (hipGetDevice(&dev) != hipSuccess || hipDeviceGetAttribute(&cus, hipDeviceAttributeMultiprocessorCount, dev) != hipSuccess) { fprintf(stderr, "kernel_launch: device query failed\n"); grid = -1; return; }
        if (hipFuncSetAttribute((const void*)mega, hipFuncAttributeMaxDynamicSharedMemorySize, LDS_BYTES) != hipSuccess) { fprintf(stderr, "kernel_launch: hipFuncSetAttribute failed\n"); grid = -1; return; }
        int per_cu = 0;
        if (hipOccupancyMaxActiveBlocksPerMultiprocessor(&per_cu, (const void*)mega, 512, LDS_BYTES) != hipSuccess || per_cu < 1) fprintf(stderr, "kernel_launch: occupancy query says %d\n", per_cu);
        (void)hipGetLastError();
        grid = cus;
    }
    if (grid < 0) return;
    Params p{};
    const float* const* in = (const float* const*)d_in;
    p.x = in[0]; p.c = in[1]; p.ada_w = in[2]; p.ada_b = in[3]; p.pre_g = in[4]; p.post_g = in[5]; p.ffn_wg = in[6]; p.ffn_wu = in[7]; p.ffn_wd = in[8];
    p.mix_w_in = in[9]; p.mix_w_branch = in[10]; p.mix_w_out = in[11]; p.cmp_pos = in[12]; p.cmp_w1 = in[13]; p.cmp_w2 = in[14];
    p.rw_mu = in[15]; p.rw_w0 = in[16]; p.rw_w_w2 = in[17]; p.rw_a0 = in[18]; p.rw_a_w2 = in[19]; p.rw_g_w2 = in[20]; p.rw_k_k = in[21]; p.rw_k_a = in[22];
    p.rw_r_k = in[23]; p.rw_ln_w = in[24]; p.rw_ln_b = in[25]; p.gla_w2 = in[26]; p.gla_b = in[27]; p.gla_g = in[28];
    p.mla_qn = in[29]; p.mla_wuq = in[30]; p.mla_kvn = in[31]; p.mla_wukv = in[32];
    p.out = (float*)d_out;
    unsigned char* ws = (unsigned char*)d_ws; size_t off = 0;
    auto take = [&](size_t bytes) { unsigned char* r = ws + off; off += (bytes + 255) & ~(size_t)255; return r; };
    p.bar = (unsigned*)take(16384);
    p.mod = (float*)take((size_t)6 * 4 * 6144 * 4);
    p.cos64 = (float*)take((size_t)SEQ * 32 * 4); p.sin64 = (float*)take((size_t)SEQ * 32 * 4); p.cos32 = (float*)take((size_t)SEQ * 16 * 4); p.sin32 = (float*)take((size_t)SEQ * 16 * 4);
    p.Wup0 = (bf16_t*)take((size_t)2 * DFF * D * 2); p.Wup1 = (bf16_t*)take((size_t)2 * DFF * D * 2);
    p.Wdn0 = (bf16_t*)take((size_t)D * DFF * 2); p.Wdn1 = (bf16_t*)take((size_t)D * DFF * 2);
    p.Win1 = (bf16_t*)take((size_t)(NP1P + NGATE) * D * 2); p.Wg = p.Win1 + (size_t)NP1P * D;
    p.Wbr = (bf16_t*)take((size_t)4 * D * 512 * 2); p.Wout = (bf16_t*)take((size_t)D * D * 2);
    p.Wuq = (bf16_t*)take((size_t)768 * 384 * 2); p.Wukv = (bf16_t*)take((size_t)1024 * 256 * 2);
    p.u = (bf16_t*)take((size_t)T * D * 2);
    p.P1 = (bf16_t*)take((size_t)T * DFF * 2);
    p.y = (float*)take((size_t)T * D * 4);
    p.G = (bf16_t*)take((size_t)T * NGATE * 2);
    { unsigned char* yb = (unsigned char*)p.y; size_t yo = 0;
      auto ytake = [&](size_t bytes) { unsigned char* r = yb + yo; yo += (bytes + 255) & ~(size_t)255; return r; };
      p.mla_q = (bf16_t*)ytake((size_t)T * 768 * 2); p.mla_kv = (bf16_t*)ytake((size_t)T * 1024 * 2); p.gla_o = (float*)ytake((size_t)T * 512 * 4); p.nsa_ocmp = (float*)ytake((size_t)T * 512 * 4);
      if (yo > (size_t)T * D * 4) { fprintf(stderr, "kernel_launch: y aliases overflow\n"); return; } }
    p.nsa_q = (bf16_t*)take((size_t)T * 512 * 2);
    p.nsa_kc_in = (bf16_t*)take((size_t)T * 128 * 2 + 4096); p.nsa_vc_in = (bf16_t*)take((size_t)T * 128 * 2 + 4096);
    p.nsa_ks = (bf16_t*)take((size_t)T * 128 * 2); p.nsa_vs = (bf16_t*)take((size_t)T * 128 * 2); p.nsa_kw = (bf16_t*)take((size_t)T * 128 * 2); p.nsa_vw = (bf16_t*)take((size_t)T * 128 * 2);
    p.nsa_gate = (float*)take((size_t)T * 24 * 4); p.nsa_kc = (float*)take((size_t)8 * 256 * 64 * 4); p.nsa_vc = (float*)take((size_t)8 * 256 * 64 * 4);
    p.nsa_sel = (unsigned long long*)take((size_t)8 * SEQ * 8);
    p.rw_r = (bf16_t*)take((size_t)T * 512 * 2); p.rw_k = (bf16_t*)take((size_t)T * 512 * 2); p.rw_v = (bf16_t*)take((size_t)T * 512 * 2); p.rw_g = (bf16_t*)take((size_t)T * 512 * 2);
    p.rw_w = (float*)take((size_t)T * 512 * 4); p.rw_kk = (float*)take((size_t)T * 512 * 4); p.rw_b = (float*)take((size_t)T * 512 * 4); p.rw_y = (float*)take((size_t)T * 512 * 4);
    p.gla_la = (float*)take((size_t)T * 256 * 4);
    p.mla_cqn = (bf16_t*)take((size_t)T * 384 * 2); p.mla_ckvn = (bf16_t*)take((size_t)T * 256 * 2); p.mla_kpe = (bf16_t*)take((size_t)T * 32 * 2);
    p.ys = (bf16_t*)take((size_t)4 * T * 512 * 2);
    p.mg = p.u;
    p.cW1t = (bf16_t*)take((size_t)2 * 256 * 2048 * 2); p.cW2t = (bf16_t*)take((size_t)2 * 256 * 256 * 2); p.chid = (bf16_t*)take((size_t)2 * 2048 * 256 * 2); p.cbias = (float*)take(2 * 256 * 4); p.rwWlT = (bf16_t*)take((size_t)512 * 256 * 2);
    if (off > ws_size) { fprintf(stderr, "kernel_launch: workspace too small: need %zu, have %zu\n", off, ws_size); return; }
    if (hipMemsetAsync(p.bar, 0, 16384, stream) != hipSuccess) { fprintf(stderr, "kernel_launch: memset failed\n"); return; }
#if defined(ONE_LAUNCH)
    hipLaunchKernelGGL(mega, dim3(grid), dim3(512), LDS_BYTES, stream, p, 0, N_PHASES);
#else
    for (int ph = 0; ph < N_PHASES; ++ph) hipLaunchKernelGGL(mega, dim3(grid), dim3(512), LDS_BYTES, stream, p, ph, ph + 1);
#endif
}
```

```cpp
#define ONE_LAUNCH 1
#include <hip/hip_runtime.h>
#include <stdint.h>
#include <stdio.h>

#define LAS __attribute__((address_space(3)))
#define DI __device__ __forceinline__
typedef unsigned short bf16_t;
typedef short bf16x8 __attribute__((ext_vector_type(8)));
typedef float f32x4 __attribute__((ext_vector_type(4)));
typedef float f32x2 __attribute__((ext_vector_type(2)));
typedef unsigned u32x4 __attribute__((ext_vector_type(4)));
typedef unsigned u32x2 __attribute__((ext_vector_type(2)));

constexpr int NB = 4, SEQ = 4096, T = NB * SEQ, D = 2048, DFF = 5632;
constexpr int NP1 = 5192, NP1P = 5376, NGATE = 8192, PROJ_IN = 13384;
constexpr int C_NSA_Q = 0, C_NSA_KC = 512, C_NSA_VC = 640, C_NSA_KS = 768, C_NSA_VS = 896, C_NSA_KW = 1024, C_NSA_VW = 1152, C_NSA_GL = 1280;
constexpr int C_RW = 1304, C_RW_R = 1304, C_RW_WLO = 1816, C_RW_K = 1880, C_RW_V = 2392, C_RW_ALO = 2904, C_RW_GLO = 2968;
constexpr int C_GLA_Q = 3096, C_GLA_K = 3352, C_GLA_V = 3608, C_GLA_ALO = 4120, C_GLA_R = 4136;
constexpr int C_MLA_CQ = 4648, C_MLA_CKV = 5032, C_MLA_KR = 5160;
constexpr float NORM_EPS = 1e-6f;

DI float bf2f(bf16_t v) { return __uint_as_float(((unsigned)v) << 16); }
DI bf16_t f2bf(float f) { unsigned u = __float_as_uint(f); u += 0x7FFFu + ((u >> 16) & 1u); return (bf16_t)(u >> 16); }
typedef __bf16 bf16x2_t_ __attribute__((ext_vector_type(2)));
DI unsigned pk2(float lo, float hi) { const f32x2 v = {lo, hi}; return __builtin_bit_cast(unsigned, __builtin_convertvector(v, bf16x2_t_)); }
DI float sigmoidf_(float x) { return 1.0f / (1.0f + __expf(-x)); }
DI float wsum(float v) {
#pragma unroll
    for (int o = 32; o >= 1; o >>= 1) v += __shfl_xor(v, o);
    return v;
}
DI float wmax(float v) {
#pragma unroll
    for (int o = 32; o >= 1; o >>= 1) v = fmaxf(v, __shfl_xor(v, o));
    return v;
}

DI int TIDX() { int t = (int)threadIdx.x; asm volatile("" : "+v"(t)); return t; }
DI int BIDX() { int t = __builtin_amdgcn_readfirstlane((int)blockIdx.x); asm volatile("" : "+s"(t)); return t; }
DI int NBLK() { int t = __builtin_amdgcn_readfirstlane((int)gridDim.x); asm volatile("" : "+s"(t)); return t; }

struct Params {
    const float *x, *c, *ada_w, *ada_b, *pre_g, *post_g, *ffn_wg, *ffn_wu, *ffn_wd, *mix_w_in, *mix_w_branch, *mix_w_out;
    const float *cmp_pos, *cmp_w1, *cmp_w2;
    const float *rw_mu, *rw_w0, *rw_w_w2, *rw_a0, *rw_a_w2, *rw_g_w2, *rw_k_k, *rw_k_a, *rw_r_k, *rw_ln_w, *rw_ln_b;
    const float *gla_w2, *gla_b, *gla_g;
    const float *mla_qn, *mla_wuq, *mla_kvn, *mla_wukv;
    float* out;
    unsigned* bar;
    float *mod, *cos64, *sin64, *cos32, *sin32;
    bf16_t *Wup0, *Wup1, *Wdn0, *Wdn1, *Win1, *Wg, *Wbr, *Wout, *Wuq, *Wukv;
    bf16_t *u, *P1, *G;
    float* y;
    bf16_t *nsa_q, *nsa_kc_in, *nsa_vc_in, *nsa_ks, *nsa_vs, *nsa_kw, *nsa_vw;
    float *nsa_gate, *nsa_kc, *nsa_vc, *nsa_ocmp;
    unsigned long long* nsa_sel;
    bf16_t *rw_r, *rw_k, *rw_v, *rw_g;
    float *rw_w, *rw_kk, *rw_b, *rw_y;
    float *gla_la, *gla_o;
    bf16_t *mla_cqn, *mla_ckvn, *mla_kpe, *mla_q, *mla_kv;
    bf16_t* ys;
    bf16_t* mg;
    bf16_t *cW1t, *cW2t, *chid;
    float* cbias;
    bf16_t* rwWlT;
};
typedef const __attribute__((address_space(4))) Params* KParamsPtr;
#define XB_TMO      128
#define XB_XCNT(j)  (256  + 64 * (j))
#define XB_XSUB(j)  (1280 + 64 * (j))
#define XB_XGEN(j)  (2304 + 64 * (j))
#define XB_TOP      3328
#define XB_TOPGEN   3392
#define XCD_BAR_WORDS 3456
#define XB_SPIN_CAP (1u << 18)

__device__ __forceinline__ unsigned xb_ld(unsigned* p)              { return __hip_atomic_load(p, __ATOMIC_RELAXED, __HIP_MEMORY_SCOPE_AGENT); }
__device__ __forceinline__ unsigned xb_add(unsigned* p, unsigned v) { return __hip_atomic_fetch_add(p, v, __ATOMIC_RELAXED, __HIP_MEMORY_SCOPE_AGENT); }
__device__ __forceinline__ unsigned xb_xcc_id() { return (unsigned)__builtin_amdgcn_s_getreg((3 << 11) | 20) & 0xFu; }
#define XB_SPIN(cond, bar) do { unsigned _sp = 0; while (cond) { __builtin_amdgcn_s_sleep(1); \
    if ((++_sp & 255u) == 0u) { if (xb_ld(&(bar)[XB_TMO])) break; if (_sp > XB_SPIN_CAP) { atomicAdd(&(bar)[XB_TMO], 1u); break; } } } } while (0)

struct XcdBarrier {
    unsigned* bar; unsigned x;
    volatile LAS unsigned* st;
};

__device__ __forceinline__ XcdBarrier xcd_barrier_post(unsigned* bar, volatile LAS unsigned* st) {
    XcdBarrier b; b.bar = bar; b.x = xb_xcc_id(); b.st = st;
    if (threadIdx.x == 0) (void)xb_add(&bar[XB_XCNT(b.x)], 1u);
    return b;
}
__device__ __forceinline__ void xcd_barrier_complete(unsigned* bar, unsigned x, unsigned& nloc, unsigned& nx) {
    const unsigned G = gridDim.x * gridDim.y * gridDim.z;
    unsigned sum, cnt, mine, sp = 0u;
    for (;;) {
        sum = 0u; cnt = 0u; mine = 0u;
#pragma unroll
        for (unsigned j = 0; j < 16; ++j) { const unsigned c = xb_ld(&bar[XB_XCNT(j)]); sum += c; cnt += (c > 0u) ? 1u : 0u; mine = (j == x) ? c : mine; }
        if (sum == G) break;
        __builtin_amdgcn_s_sleep(1);
        if ((++sp & 255u) == 0u) { if (xb_ld(&bar[XB_TMO])) break; if (sp > XB_SPIN_CAP) { atomicAdd(&bar[XB_TMO], 1u); break; } }
    }
    nloc = mine > 0u ? mine : 1u; nx = cnt > 0u ? cnt : 1u;
}

__device__ __forceinline__ void xcd_barrier(const XcdBarrier& b) {
    asm volatile("s_waitcnt vmcnt(0)" ::: "memory");
    __syncthreads();
    if (threadIdx.x == 0) {
        unsigned* bar = b.bar;
        __builtin_amdgcn_s_waitcnt(0);
        unsigned nloc = b.st[0], nx = b.st[1];
        if (nloc == 0u) { xcd_barrier_complete(bar, b.x, nloc, nx); b.st[0] = nloc; b.st[1] = nx; }
        const unsigned old = xb_add(&bar[XB_XSUB(b.x)], 1u);
        const unsigned gen = old / nloc;
        if (old + 1u == (gen + 1u) * nloc) {
            __builtin_amdgcn_fence(__ATOMIC_RELEASE, "agent");
            asm volatile("s_waitcnt vmcnt(0)" ::: "memory");
            const unsigned og = xb_add(&bar[XB_TOP], 1u);
            const unsigned tg = og / nx;
            if (og + 1u == (tg + 1u) * nx) xb_add(&bar[XB_TOPGEN], 1u);
            else XB_SPIN(xb_ld(&bar[XB_TOPGEN]) == tg, bar);
            __builtin_amdgcn_fence(__ATOMIC_ACQUIRE, "agent");
            xb_add(&bar[XB_XGEN(b.x)], 1u);
            asm volatile("s_waitcnt vmcnt(0)" ::: "memory");
        } else {
            XB_SPIN(xb_ld(&bar[XB_XGEN(b.x)]) == gen, bar);
            __builtin_amdgcn_fence(__ATOMIC_ACQUIRE, "agent");
            asm volatile("s_waitcnt vmcnt(0)" ::: "memory");
        }
    }
    __syncthreads();
}

namespace pg8 {
#define PG8_LAS __attribute__((address_space(3)))
constexpr int BM = 256, BK = 64, HALF = 128, HTB = HALF * BK * 2  , STAGE_BYTES = 8 * HTB, NXCD = 8, WGM = 8;

__host__ __device__ __forceinline__ int lds_byte(int r, int c) { const int st = (r >> 4) * 2 + (c >> 5), rr = r & 15, cc = c & 31, ob = rr * 64 + cc * 2; return st * 1024 + (ob ^ (((ob >> 9) & 1) << 5)); }
__host__ __device__ __forceinline__ void stage_rc(int b, int& R, int& C) { const int st = b / 1024, sb = b % 1024, swz = sb ^ (((sb >> 9) & 1) << 5); R = (st >> 1) * 16 + swz / 64; C = (st & 1) * 32 + (swz % 64) / 2; }
__host__ __device__ __forceinline__ int perm32(int rho) { const int n = rho >> 4, i = rho & 15; return 8 * (i >> 2) + 4 * n + (i & 3); }

struct Unit { int pm, pn; };
struct Gemm { const bf16_t* A; const bf16_t* Bt; int M, N, K, lda, ldb; };

struct StaticOrder {
    int nM, nN, nwg, G, c;
    __host__ __device__ void init(int M, int N, int G_, int c_) { nM = M / BM; nN = N / BM; nwg = nM * nN; G = G_; c = c_; }
    __host__ __device__ bool next(int i, Unit& u) const {
        const long L = (long)i * G + c; if (L >= nwg) return false;
        int wgid = (int)L; { const int q = nwg / NXCD, r = nwg % NXCD, xcd = wgid % NXCD, off = wgid / NXCD; wgid = (xcd < r ? xcd * (q + 1) : r * (q + 1) + (xcd - r) * q) + off; }
        const int nig = WGM * nN, gid = wgid / nig, fm = gid * WGM, gsz = (nM - fm) < WGM ? (nM - fm) : WGM;
        u.pm = fm + ((wgid % nig) % gsz); u.pn = (wgid % nig) / gsz; return true;
    }
    __device__ __forceinline__ void a_ready(const Unit&) const {}
    __device__ __forceinline__ void done(const Unit&) const {}
};
struct CountedOrder : StaticOrder {
    const unsigned* ready; unsigned need; unsigned* tmo;
    __device__ __forceinline__ void a_ready(const Unit& u) const {
        if (TIDX() < 64) {
            const unsigned long long t0 = __builtin_amdgcn_s_memrealtime(); unsigned polls = 0;
            while ((unsigned)__builtin_amdgcn_readfirstlane(__hip_atomic_load(ready + 64 * u.pm, __ATOMIC_RELAXED, __HIP_MEMORY_SCOPE_AGENT)) < need) {
                if ((++polls & 255u) == 0u && __builtin_amdgcn_readfirstlane(__hip_atomic_load(tmo, __ATOMIC_RELAXED, __HIP_MEMORY_SCOPE_AGENT)) != 0u) break;
                if (__builtin_amdgcn_s_memrealtime() - t0 > 2000000ull) {
                    if (TIDX() == 0) { unsigned expect = 0u; __hip_atomic_compare_exchange_strong(tmo + 1, &expect, 0x600u | (unsigned)(u.pm & 0xff), __ATOMIC_RELAXED, __ATOMIC_RELAXED, __HIP_MEMORY_SCOPE_AGENT); __hip_atomic_store(tmo, 1u, __ATOMIC_RELAXED, __HIP_MEMORY_SCOPE_AGENT); }
                    break; }
                __builtin_amdgcn_s_sleep(2); }
            __builtin_amdgcn_fence(__ATOMIC_ACQUIRE, "agent");
            asm volatile("s_waitcnt vmcnt(0)" ::: "memory");
        }
#if !defined(BROKEN_HOOK_NO_BARRIER)
        asm volatile("" ::: "memory"); __builtin_amdgcn_s_barrier(); asm volatile("" ::: "memory");
#endif
    }
};


template <class Epi, class Sched, bool STAMP = false>
__device__ __forceinline__ void gemm_phase(PG8_LAS unsigned char* lds, const Gemm g, const Sched& S, const Epi& E, unsigned long long* stamps) {
    const int tid = TIDX(), wid = __builtin_amdgcn_readfirstlane(tid >> 6), lane = tid & 63, wr = wid >> 2, wc = wid & 3, fr = lane & 15, fq = lane >> 4;
    const int K = g.K, nt = K / BK;
    int ts_lo = 0, ts_hi = 0, nts = 0; const unsigned long long rt_entry = STAMP ? (unsigned long long)wall_clock64() : 0ull;
#define PG8_STAMP() do { if (STAMP && wid == 0 && nts < 64) { const unsigned long long _c = (unsigned long long)clock64(); \
        ts_lo = (lane == nts) ? (int)(unsigned)_c : ts_lo; ts_hi = (lane == nts) ? (int)(unsigned)(_c >> 32) : ts_hi; ++nts; } } while (0)
    PG8_STAMP();
    unsigned voffA[2], voffB[2];
#pragma unroll
    for (int i = 0; i < 2; ++i) { int R, C; stage_rc(tid * 16 + i * 8192, R, C); const int Rb = Epi::PERM ? ((R & ~31) + perm32(R & 31)) : R;
        voffA[i] = (unsigned)(R * g.lda + C) * 2u; voffB[i] = (unsigned)(Rb * g.ldb + C) * 2u; }
    const size_t kstep = (size_t)(BK * 2);
    const size_t hstepA = (size_t)HALF * g.lda * 2, hstepB = (size_t)HALF * g.ldb * 2;
    const size_t tstepA = 2 * hstepA, tstepB = 2 * hstepB;
    const unsigned ldsw = (unsigned)wid * 1024u;
    const int aoff = lds_byte(wr * 64 + fr, fq * 8), boff = lds_byte(wc * 32 + fr, fq * 8);
#define PG8_SA(b, h) (((b) * 2 + (h)) * HTB)
#define PG8_SB(b, h) ((4 + (b) * 2 + (h)) * HTB)
#define PG8_STAGE(bufoff, gbase, voff) do { _Pragma("unroll") for (int _i = 0; _i < 2; ++_i) \
        __builtin_amdgcn_global_load_lds((const unsigned*)((const char*)(gbase) + (voff)[_i]), (PG8_LAS unsigned*)(lds + (bufoff) + ldsw + _i * 8192), 16, 0, 0); } while (0)
#define PG8_LDA(dst, b, h) do { _Pragma("unroll") for (int m = 0; m < 4; ++m) _Pragma("unroll") for (int k = 0; k < 2; ++k) dst[m][k] = *(const PG8_LAS bf16x8*)(lds + PG8_SA(b, h) + aoff + m * 2048 + k * 1024); } while (0)
#define PG8_LDB(dst, b, h) do { _Pragma("unroll") for (int n = 0; n < 2; ++n) _Pragma("unroll") for (int k = 0; k < 2; ++k) dst[n][k] = *(const PG8_LAS bf16x8*)(lds + PG8_SB(b, h) + boff + n * 2048 + k * 1024); } while (0)
#define PG8_MMA(ai, bj, At, Bt) do { __builtin_amdgcn_s_setprio(1); _Pragma("unroll") for (int m = 0; m < 4; ++m) _Pragma("unroll") for (int n = 0; n < 2; ++n) _Pragma("unroll") for (int k = 0; k < 2; ++k) \
        acc[ai][bj][m][n] = __builtin_amdgcn_mfma_f32_16x16x32_bf16(Bt[n][k], At[m][k], acc[ai][bj][m][n], 0, 0, 0); __builtin_amdgcn_s_setprio(0); } while (0)
#define PG8_WAIT_V(n) asm volatile("s_waitcnt vmcnt(" #n ")" ::: "memory")
#define PG8_WAIT_L(n) asm volatile("s_waitcnt lgkmcnt(" #n ")" ::: "memory")
#define PG8_BAR __builtin_amdgcn_s_barrier()
#define PG8_SCHED __builtin_amdgcn_sched_barrier(0)
    Unit cur, nxt; int ui = 0;
    if (!S.next(0, cur)) return;
    f32x4 acc[2][2][4][2];
#pragma unroll
    for (int a = 0; a < 2; ++a)
#pragma unroll
        for (int b = 0; b < 2; ++b)
#pragma unroll
            for (int m = 0; m < 4; ++m)
#pragma unroll
                for (int n = 0; n < 2; ++n) acc[a][b][m][n] = (f32x4){0.f, 0.f, 0.f, 0.f};
    bf16x8 At[4][2], B0[2][2], B1[2][2];
    const char* cA = (const char*)g.A + (size_t)cur.pm * tstepA; const char* cB = (const char*)g.Bt + (size_t)cur.pn * tstepB;
    S.a_ready(cur);
    PG8_STAGE(PG8_SB(0, 0), cB, voffB); PG8_STAGE(PG8_SA(0, 0), cA, voffA); PG8_STAGE(PG8_SB(0, 1), cB + hstepB, voffB); PG8_STAGE(PG8_SA(0, 1), cA + hstepA, voffA);
    if (wr == 1) PG8_BAR;
    PG8_WAIT_V(4); PG8_BAR;
    PG8_STAGE(PG8_SB(1, 0), cB + kstep, voffB); PG8_STAGE(PG8_SA(1, 0), cA + kstep, voffA); PG8_STAGE(PG8_SB(1, 1), cB + hstepB + kstep, voffB);
    PG8_WAIT_V(6); PG8_BAR;
    PG8_STAMP();
    for (;;) {
        const bool has_next = S.next(ui + 1, nxt);
        const char* nA = has_next ? (const char*)g.A + (size_t)nxt.pm * tstepA : cA; const char* nB = has_next ? (const char*)g.Bt + (size_t)nxt.pn * tstepB : cB;
        for (int t = 0; t < nt; t += 2) {
            const bool last = (t == nt - 2);
            const char* a1 = cA + (size_t)(t + 1) * kstep;
            const char* a2 = last ? nA : cA + (size_t)(t + 2) * kstep; const char* b2 = last ? nB : cB + (size_t)(t + 2) * kstep;
            const char* a3 = a2 + kstep; const char* b3 = b2 + kstep;
            if (last && has_next) S.a_ready(nxt);
            PG8_LDB(B0, 0, 0); PG8_SCHED; PG8_LDA(At, 0, 0); PG8_STAGE(PG8_SA(1, 1), a1 + hstepA, voffA);
            PG8_WAIT_L(8); PG8_BAR; PG8_WAIT_L(0); PG8_MMA(0, 0, At, B0); PG8_BAR; PG8_SCHED;
            PG8_LDB(B1, 0, 1); PG8_STAGE(PG8_SB(0, 0), b2, voffB);
            PG8_BAR; PG8_WAIT_L(0); PG8_MMA(0, 1, At, B1); PG8_BAR;
            PG8_LDA(At, 0, 1); PG8_STAGE(PG8_SA(0, 0), a2, voffA);
            PG8_BAR; PG8_WAIT_L(0); PG8_MMA(1, 0, At, B0); PG8_BAR; PG8_SCHED;
            PG8_STAGE(PG8_SB(0, 1), b2 + hstepB, voffB);
            PG8_WAIT_V(6); PG8_BAR; PG8_MMA(1, 1, At, B1); PG8_BAR;
            PG8_LDB(B0, 1, 0); PG8_SCHED; PG8_LDA(At, 1, 0); PG8_STAGE(PG8_SA(0, 1), a2 + hstepA, voffA);
            PG8_WAIT_L(8); PG8_BAR; PG8_WAIT_L(0); PG8_MMA(0, 0, At, B0); PG8_BAR; PG8_SCHED;
            PG8_LDB(B1, 1, 1); PG8_STAGE(PG8_SB(1, 0), b3, voffB);
            PG8_BAR; PG8_WAIT_L(0); PG8_MMA(0, 1, At, B1); PG8_BAR;
            PG8_LDA(At, 1, 1); PG8_STAGE(PG8_SA(1, 0), a3, voffA);
            PG8_BAR; PG8_WAIT_L(0); PG8_MMA(1, 0, At, B0); PG8_BAR; PG8_SCHED;
            PG8_STAGE(PG8_SB(1, 1), b3 + hstepB, voffB);
            PG8_WAIT_V(6); PG8_BAR; PG8_MMA(1, 1, At, B1); PG8_BAR;
        }
        PG8_STAMP();
        if constexpr (!Epi::AFTER_DRAIN) { E(acc, cur, wr, wc, fr, fq); S.done(cur); }
        PG8_STAMP();
        if (!has_next) break;
#pragma unroll
        for (int a = 0; a < 2; ++a)
#pragma unroll
            for (int b = 0; b < 2; ++b)
#pragma unroll
                for (int m = 0; m < 4; ++m)
#pragma unroll
                    for (int n = 0; n < 2; ++n) acc[a][b][m][n] = (f32x4){0.f, 0.f, 0.f, 0.f};
        cur = nxt; cA = nA; cB = nB; ++ui;
    }
    PG8_WAIT_V(0);
    if (wr == 0) PG8_BAR;
    PG8_BAR;
    if constexpr (Epi::AFTER_DRAIN) { E.fused(acc, cur, wr, wc, fr, fq, lds, wid, lane); S.done(cur); }
    PG8_STAMP();
    if (STAMP && wid == 0) { stamps[lane] = lane < nts ? (((unsigned long long)(unsigned)ts_hi << 32) | (unsigned)ts_lo) : 0ull;
        if (lane == 62) stamps[62] = rt_entry; if (lane == 63) stamps[63] = (unsigned long long)wall_clock64(); }
#undef PG8_STAMP
#undef PG8_SA
#undef PG8_SB
#undef PG8_STAGE
#undef PG8_LDA
#undef PG8_LDB
#undef PG8_MMA
#undef PG8_WAIT_V
#undef PG8_WAIT_L
#undef PG8_BAR
#undef PG8_SCHED
}
}
typedef __bf16 bf16x2_n __attribute__((ext_vector_type(2)));
DI unsigned cvt_pk_bf16(float lo, float hi) { const f32x2 v = {lo, hi}; return __builtin_bit_cast(unsigned, __builtin_convertvector(v, bf16x2_n)); }
DI float fast_sigmoid(float x) { return __builtin_amdgcn_rcpf(1.0f + __expf(-x)); }

struct EpiF32 {
    static constexpr bool PERM = false, AFTER_DRAIN = false;
    float* C; int ldc;
    DI void operator()(const f32x4 (&acc)[2][2][4][2], const pg8::Unit& u, int wr, int wc, int fr, int fq) const {
        const int row0 = u.pm * 256 + wr * 64 + fr, col0 = u.pn * 256 + wc * 32 + 4 * fq;
#pragma unroll
        for (int ai = 0; ai < 2; ++ai)
#pragma unroll
            for (int m = 0; m < 4; ++m) { float* rowp = C + (size_t)(row0 + ai * 128 + m * 16) * ldc + col0;
#pragma unroll
                for (int bj = 0; bj < 2; ++bj)
#pragma unroll
                    for (int n = 0; n < 2; ++n) *(f32x4*)(rowp + bj * 128 + n * 16) = acc[ai][bj][m][n]; }
    }
};
struct EpiF32Lo {
    static constexpr bool PERM = false, AFTER_DRAIN = false;
    float* C; int ldc;
    DI void operator()(const f32x4 (&acc)[2][2][4][2], const pg8::Unit& u, int wr, int wc, int fr, int fq) const {
        const int row0 = u.pm * 256 + wr * 64 + fr, col0 = u.pn * 256 + wc * 32 + 4 * fq;
#pragma unroll
        for (int ai = 0; ai < 2; ++ai)
#pragma unroll
            for (int m = 0; m < 4; ++m) { float* rowp = C + (size_t)(row0 + ai * 128 + m * 16) * ldc + col0;
#pragma unroll
                for (int n = 0; n < 2; ++n) *(f32x4*)(rowp + n * 16) = acc[ai][0][m][n]; }
    }
};
template <int ACT  > struct EpiBf16 {
    static constexpr bool PERM = true, AFTER_DRAIN = false;
    bf16_t* O; int ldc;
    DI void operator()(const f32x4 (&acc)[2][2][4][2], const pg8::Unit& u, int wr, int wc, int fr, int fq) const {
        const int row0 = u.pm * 256 + wr * 64 + fr, col0 = u.pn * 256 + wc * 32 + 8 * fq;
#pragma unroll
        for (int ai = 0; ai < 2; ++ai)
#pragma unroll
            for (int m = 0; m < 4; ++m) { bf16_t* rowp = O + (size_t)(row0 + ai * 128 + m * 16) * ldc + col0;
#pragma unroll
                for (int bj = 0; bj < 2; ++bj) { f32x4 v0 = acc[ai][bj][m][0], v1 = acc[ai][bj][m][1];
#if defined(NOISE_P1)
                    if (ACT == 0) { unsigned hsh = (unsigned)(row0 + ai * 128 + m * 16) * 2654435761u ^ (unsigned)(col0 + bj * 128) * 40503u;
#pragma unroll
                        for (int j = 0; j < 4; ++j) { hsh = hsh * 1664525u + 1013904223u; v0[j] *= 1.0f + NOISE_P1 * ((float)(hsh >> 8) * (1.0f / 8388608.0f) - 1.0f); hsh = hsh * 1664525u + 1013904223u; v1[j] *= 1.0f + NOISE_P1 * ((float)(hsh >> 8) * (1.0f / 8388608.0f) - 1.0f); } }
#endif
                    if (ACT == 1) {
#pragma unroll
                        for (int j = 0; j < 4; ++j) { v0[j] = fast_sigmoid(v0[j]); v1[j] = fast_sigmoid(v1[j]); } }
                    u32x4 w; w.x = cvt_pk_bf16(v0[0], v0[1]); w.y = cvt_pk_bf16(v0[2], v0[3]); w.z = cvt_pk_bf16(v1[0], v1[1]); w.w = cvt_pk_bf16(v1[2], v1[3]);
                    *(u32x4*)(rowp + bj * 128) = w; } }
    }
};
struct EpiSwiglu {
    static constexpr bool PERM = true, AFTER_DRAIN = false;
    bf16_t* H; int ldc;
    DI void operator()(const f32x4 (&acc)[2][2][4][2], const pg8::Unit& u, int wr, int wc, int fr, int fq) const {
        const int row0 = u.pm * 256 + wr * 64 + fr, col0 = u.pn * 128 + wc * 32 + 8 * fq;
#pragma unroll
        for (int ai = 0; ai < 2; ++ai)
#pragma unroll
            for (int m = 0; m < 4; ++m) { bf16_t* rowp = H + (size_t)(row0 + ai * 128 + m * 16) * ldc + col0;
                float h[8];
#pragma unroll
                for (int n = 0; n < 2; ++n)
#pragma unroll
                    for (int j = 0; j < 4; ++j) { const float g = acc[ai][0][m][n][j], up = acc[ai][1][m][n][j]; h[n * 4 + j] = g * fast_sigmoid(g) * up; }
                u32x4 w; w.x = cvt_pk_bf16(h[0], h[1]); w.y = cvt_pk_bf16(h[2], h[3]); w.z = cvt_pk_bf16(h[4], h[5]); w.w = cvt_pk_bf16(h[6], h[7]);
                *(u32x4*)rowp = w; }
    }
};
struct EpiPart {
    static constexpr bool PERM = true, AFTER_DRAIN = false;
    bf16_t* part01; bf16_t* part23;
    DI void operator()(const f32x4 (&acc)[2][2][4][2], const pg8::Unit& u, int wr, int wc, int fr, int fq) const {
        const int br = u.pm >> 6, pm = u.pm & 63, pn = u.pn & 7;
        bf16_t* O = (br < 2 ? part01 : part23) + (size_t)(br & 1) * T * 2048;
        const int row0 = pm * 256 + wr * 64 + fr, col0 = pn * 256 + wc * 32 + 8 * fq;
#pragma unroll
        for (int ai = 0; ai < 2; ++ai)
#pragma unroll
            for (int m = 0; m < 4; ++m) { bf16_t* rowp = O + (size_t)(row0 + ai * 128 + m * 16) * 2048 + col0;
#pragma unroll
                for (int bj = 0; bj < 2; ++bj) { const f32x4 v0 = acc[ai][bj][m][0], v1 = acc[ai][bj][m][1];
                    u32x4 w; w.x = cvt_pk_bf16(v0[0], v0[1]); w.y = cvt_pk_bf16(v0[2], v0[3]); w.z = cvt_pk_bf16(v1[0], v1[1]); w.w = cvt_pk_bf16(v1[2], v1[3]);
                    *(u32x4*)(rowp + bj * 128) = w; } }
    }
};
struct EpiMergeAcc {
    static constexpr bool PERM = true, AFTER_DRAIN = false;
    const bf16_t* G; bf16_t* O;
    DI void operator()(const f32x4 (&acc)[2][2][4][2], const pg8::Unit& u, int wr, int wc, int fr, int fq) const {
        const int br = u.pm >> 6, pm = u.pm & 63, pn = u.pn & 7;
        const int row0 = pm * 256 + wr * 64 + fr, col0 = pn * 256 + wc * 32 + 8 * fq;
#pragma unroll
        for (int ai = 0; ai < 2; ++ai) {
            u32x4 gw[4][2], ow[4][2];
#pragma unroll
            for (int m = 0; m < 4; ++m) { const size_t row = (size_t)(row0 + ai * 128 + m * 16);
#pragma unroll
                for (int bj = 0; bj < 2; ++bj) { gw[m][bj] = *(const u32x4*)(G + row * NGATE + br * 2048 + col0 + bj * 128);
                    ow[m][bj] = br > 0 ? *(const u32x4*)(O + row * 2048 + col0 + bj * 128) : (u32x4){0u, 0u, 0u, 0u}; } }
#pragma unroll
            for (int m = 0; m < 4; ++m) { bf16_t* op = O + (size_t)(row0 + ai * 128 + m * 16) * 2048 + col0;
#pragma unroll
                for (int bj = 0; bj < 2; ++bj) { const f32x4 v0 = acc[ai][bj][m][0], v1 = acc[ai][bj][m][1]; const u32x4 g = gw[m][bj], o = ow[m][bj];
                    float r[8];
                    r[0] = __uint_as_float(g.x << 16) * v0[0] + __uint_as_float(o.x << 16); r[1] = __uint_as_float(g.x & 0xffff0000u) * v0[1] + __uint_as_float(o.x & 0xffff0000u);
                    r[2] = __uint_as_float(g.y << 16) * v0[2] + __uint_as_float(o.y << 16); r[3] = __uint_as_float(g.y & 0xffff0000u) * v0[3] + __uint_as_float(o.y & 0xffff0000u);
                    r[4] = __uint_as_float(g.z << 16) * v1[0] + __uint_as_float(o.z << 16); r[5] = __uint_as_float(g.z & 0xffff0000u) * v1[1] + __uint_as_float(o.z & 0xffff0000u);
                    r[6] = __uint_as_float(g.w << 16) * v1[2] + __uint_as_float(o.w << 16); r[7] = __uint_as_float(g.w & 0xffff0000u) * v1[3] + __uint_as_float(o.w & 0xffff0000u);
                    u32x4 w; w.x = cvt_pk_bf16(r[0], r[1]); w.y = cvt_pk_bf16(r[2], r[3]); w.z = cvt_pk_bf16(r[4], r[5]); w.w = cvt_pk_bf16(r[6], r[7]);
                    *(u32x4*)(op + bj * 128) = w; } }
        }
    }
};
struct MergeOrder {
    int G, c;
    DI bool next(int i, pg8::Unit& u) const {
        const int ti = i >> 2, br = i & 3; const int tile = ti * G + c; if (tile >= 512) return false;
        int tm = tile >> 3, tn = tile & 7;
        if (G == 256) { const int x = c & 7, r = c >> 3; tm = ti * 32 + x * 4 + (r >> 3); tn = r & 7; }
        u.pm = br * 64 + tm; u.pn = br * 8 + tn; return true;
    }
    DI void a_ready(const pg8::Unit&) const {}
    DI void done(const pg8::Unit&) const {}
};

struct EpiGeluBias {
    static constexpr bool PERM = true, AFTER_DRAIN = false;
    bf16_t* O; int ldc; const float* bias;
    DI void operator()(const f32x4 (&acc)[2][2][4][2], const pg8::Unit& u, int wr, int wc, int fr, int fq) const {
        const int row0 = u.pm * 256 + wr * 64 + fr, col0 = u.pn * 256 + wc * 32 + 8 * fq;
#pragma unroll
        for (int ai = 0; ai < 2; ++ai)
#pragma unroll
            for (int m = 0; m < 4; ++m) { bf16_t* rowp = O + (size_t)(row0 + ai * 128 + m * 16) * ldc + col0;
#pragma unroll
                for (int bj = 0; bj < 2; ++bj) { float h[8];
#pragma unroll
                    for (int n = 0; n < 2; ++n)
#pragma unroll
                        for (int j = 0; j < 4; ++j) { const float x = acc[ai][bj][m][n][j] + bias[col0 + bj * 128 + n * 4 + j];
                            const float z = 0.7978845608028654f * (x + 0.044715f * x * x * x), th = 1.0f - 2.0f * __builtin_amdgcn_rcpf(1.0f + __expf(2.0f * z));
                            h[n * 4 + j] = 0.5f * x * (1.0f + th); }
                    u32x4 w; w.x = cvt_pk_bf16(h[0], h[1]); w.y = cvt_pk_bf16(h[2], h[3]); w.z = cvt_pk_bf16(h[4], h[5]); w.w = cvt_pk_bf16(h[6], h[7]);
                    *(u32x4*)(rowp + bj * 128) = w; } }
    }
};
struct EpiCmpOut {
    static constexpr bool PERM = false, AFTER_DRAIN = false;
    float* C;
    DI void operator()(const f32x4 (&acc)[2][2][4][2], const pg8::Unit& u, int wr, int wc, int fr, int fq) const {
        if (wc >= 2) return;
        const int row0 = u.pm * 256 + wr * 64 + fr, col0 = wc * 32 + 4 * fq;
#pragma unroll
        for (int ai = 0; ai < 2; ++ai)
#pragma unroll
            for (int m = 0; m < 4; ++m) { float* rowp = C + (size_t)(row0 + ai * 128 + m * 16) * 64 + col0;
#pragma unroll
                for (int n = 0; n < 2; ++n) *(f32x4*)(rowp + n * 16) = acc[ai][0][m][n]; }
    }
};
struct SplitOrder {
    int first, count, nN;
    DI bool next(int i, pg8::Unit& u) const { if (i >= count) return false; const int idx = first + i; u.pm = idx / nN; u.pn = idx % nN; return true; }
    DI void a_ready(const pg8::Unit&) const {}
    DI void done(const pg8::Unit&) const {}
};
struct RowWalkOrder {
    int pm, pn0, step, count;
    DI bool next(int i, pg8::Unit& u) const { if (i >= count) return false; u.pm = pm; u.pn = pn0 + i * step; return true; }
    DI void a_ready(const pg8::Unit&) const {}
    DI void done(const pg8::Unit&) const {}
};
template <class Epi>
DI void run_gemm(LAS unsigned char* lds, const bf16_t* A, int lda, const bf16_t* Bt, int ldb, int M, int N, int K, const Epi& E) {
    pg8::Gemm g; g.A = A; g.Bt = Bt; g.M = M; g.N = N; g.K = K; g.lda = lda; g.ldb = ldb;
    pg8::StaticOrder S; S.init(M, N, NBLK(), BIDX());
    pg8::gemm_phase<Epi, pg8::StaticOrder, false>((PG8_LAS unsigned char*)lds, g, S, E, nullptr);
}
#ifndef PREP_R1
#define PREP_R1 1
#endif
#ifndef PREP_R2
#define PREP_R2 1
#endif
#ifndef PREP_R3
#define PREP_R3 1
#endif
#ifndef PREP_R4
#define PREP_R4 1
#endif
#ifndef ZRWKV
#define ZRWKV 1.0f
#endif
#ifndef ZGLA
#define ZGLA 1.0f
#endif
DI void phase_setup(KParamsPtr p, LAS unsigned char* lds) {
    const int tid = TIDX(), bid = BIDX(), nb = NBLK();
    for (int i = bid * 512 + tid; i < SEQ * 48; i += nb * 512) {
        const int pos = i / 48, j = i % 48;
        const bool big = j < 32; const int jj = big ? j : j - 32;
        const double inv = exp2(-(double)jj * (13.287712379549449 / (big ? 32.0 : 16.0)));
        const double a = (double)pos * inv;
        const double r = a - 6.283185307179586 * floor(a / 6.283185307179586);
        const float cs = (float)cos(r), sn = (float)sin(r);
        if (big) { p->cos64[pos * 32 + jj] = cs; p->sin64[pos * 32 + jj] = sn; } else { p->cos32[pos * 16 + jj] = cs; p->sin32[pos * 16 + jj] = sn; }
    }
    LAS float* sc = (LAS float*)lds;
    LAS float* red = (LAS float*)(lds + 32768);
    for (int i = tid; i < NB * D; i += 512) { const float c = p->c[i]; sc[i] = c / (1.0f + __expf(-c)); }
    __syncthreads();
    const int cg = tid & 15, ks = tid >> 4;
    for (int chunk = bid; chunk < 576; chunk += nb) {
        const int ls = chunk / 96, col0 = (chunk % 96) * 64;
        const float* W = p->ada_w + (size_t)ls * D * 6144 + col0 + cg * 4;
        float acc[4][4];
#pragma unroll
        for (int b = 0; b < 4; ++b)
#pragma unroll
            for (int j = 0; j < 4; ++j) acc[b][j] = 0.f;
#pragma unroll 16
        for (int kk = 0; kk < 64; ++kk) {
            const int k = ks * 64 + kk;
            const f32x4 w = *(const f32x4*)(W + (size_t)k * 6144);
#pragma unroll
            for (int b = 0; b < 4; ++b) { const float s = sc[b * D + k];
#pragma unroll
                for (int j = 0; j < 4; ++j) acc[b][j] += s * w[j]; }
        }
#pragma unroll
        for (int b = 0; b < 4; ++b)
#pragma unroll
            for (int j = 0; j < 4; ++j) red[(ks * 4 + b) * 64 + cg * 4 + j] = acc[b][j];
        __syncthreads();
        if (tid < 256) { const int b = tid >> 6, col = tid & 63; float s = 0.f;
            for (int q = 0; q < 32; ++q) s += red[(q * 4 + b) * 64 + col];
            p->mod[(size_t)(ls * 4 + b) * 6144 + col0 + col] = s + p->ada_b[ls * 6144 + col0 + col]; }
        __syncthreads();
    }
}

template <class Map>
DI void conv_job(const float* src, int Ks, int Ns, const float* kscale, bf16_t* dst, int ldd, Map map, LAS float* tl) {
    const int tid = TIDX(), bid = BIDX(), nb = NBLK();
    const int ntk = Ks / 64, ntn = (Ns + 63) / 64, nt = ntk * ntn;
    for (int tile = bid; tile < nt; tile += nb) {
        const int k0 = (tile % ntk) * 64, n0 = (tile / ntk) * 64;
#pragma unroll
        for (int it = 0; it < 2; ++it) {
            const int kr = (tid >> 4) + 32 * it, n = n0 + 4 * (tid & 15);
            f32x4 v = (f32x4){0.f, 0.f, 0.f, 0.f};
            if (n < Ns) v = *(const f32x4*)(src + (size_t)(k0 + kr) * Ns + n);
            if (kscale) v *= kscale[k0 + kr];
#pragma unroll
            for (int j = 0; j < 4; ++j) tl[kr * 65 + 4 * (tid & 15) + j] = v[j];
        }
        __syncthreads();
        { const int nn = tid >> 3, k8 = tid & 7, n = n0 + nn;
            if (n < Ns) { float f[8];
#pragma unroll
                for (int i = 0; i < 8; ++i) f[i] = tl[(k8 * 8 + i) * 65 + nn];
                u32x4 w; w.x = pk2(f[0], f[1]); w.y = pk2(f[2], f[3]); w.z = pk2(f[4], f[5]); w.w = pk2(f[6], f[7]);
                *(u32x4*)(dst + (size_t)map(n) * ldd + k0 + k8 * 8) = w; } }
        __syncthreads();
    }
}
DI void phase_convert(KParamsPtr p, int l, LAS unsigned char* lds) {
    LAS float* tl = (LAS float*)lds;
    const int tid = TIDX(), bid = BIDX(), nb = NBLK();
    const size_t fsz = (size_t)D * DFF;
    for (int f = 0; f < 2; ++f) {
        bf16_t* Wup = f ? p->Wup1 : p->Wup0; bf16_t* Wdn = f ? p->Wdn1 : p->Wdn0;
        conv_job(p->ffn_wg + (size_t)(l * 2 + f) * fsz, D, DFF, nullptr, Wup, D, [](int n) { return 256 * (n >> 7) + (n & 127); }, tl);
        conv_job(p->ffn_wu + (size_t)(l * 2 + f) * fsz, D, DFF, nullptr, Wup, D, [](int n) { return 256 * (n >> 7) + 128 + (n & 127); }, tl);
        conv_job(p->ffn_wd + (size_t)(l * 2 + f) * fsz, DFF, D, nullptr, Wdn, DFF, [](int n) { return n; }, tl);
    }
    conv_job(p->mix_w_in + (size_t)l * D * PROJ_IN, D, PROJ_IN, nullptr, p->Win1, D, [](int n) { return n < NP1 ? n : n - NP1 + NP1P; }, tl);
    for (int i = 0; i < 4; ++i)
        conv_job(p->mix_w_branch + (size_t)(l * 4 + i) * 512 * D, 512, D, nullptr, p->Wbr + (size_t)i * D * 512, 512, [](int n) { return n; }, tl);
    conv_job(p->mix_w_out + (size_t)l * D * D, D, D, nullptr, p->Wout, D, [](int n) { return n; }, tl);
    conv_job(p->mla_wuq + (size_t)l * 384 * 768, 384, 768, p->mla_qn + l * 384, p->Wuq, 384, [](int n) { return n; }, tl);
    conv_job(p->mla_wukv + (size_t)l * 128 * 1024, 128, 1024, p->mla_kvn + l * 128, p->Wukv, 256, [](int n) { return n; }, tl);
    for (int wh = 0; wh < 2; ++wh) {
        conv_job(p->cmp_w1 + (size_t)(l * 2 + wh) * 2048 * 256, 2048, 256, nullptr, p->cW1t + (size_t)wh * 256 * 2048, 2048, [](int n) { return n; }, tl);
        conv_job(p->cmp_w2 + (size_t)(l * 2 + wh) * 256 * 64, 256, 64, nullptr, p->cW2t + (size_t)wh * 256 * 256, 256, [](int n) { return n; }, tl);
    }
    for (int i = bid * 512 + tid; i < 2 * 192 * 256 / 8; i += nb * 512) { const int wh = i / (192 * 32), r = (i % (192 * 32)) >> 5, c8 = i & 31; *(u32x4*)(p->cW2t + (size_t)wh * 256 * 256 + (size_t)(64 + r) * 256 + c8 * 8) = (u32x4){0u, 0u, 0u, 0u}; }
    __syncthreads();
    for (int job = nb - 1 - bid; job < 32; job += nb) { const int wh = job >> 4, n0 = (job & 15) * 16, c = tid & 15, ks = tid >> 4;
        const float* ps = p->cmp_pos + (l * 2 + wh) * 2048 + ks * 64; const float* w1 = p->cmp_w1 + (size_t)(l * 2 + wh) * 2048 * 256 + (size_t)ks * 64 * 256 + n0 + c;
        float a = 0.f;
#pragma unroll 16
        for (int k = 0; k < 64; ++k) a += ps[k] * w1[(size_t)k * 256];
        tl[ks * 16 + c] = a;
        __syncthreads();
        if (tid < 16) { float sm = 0.f;
            for (int q = 0; q < 32; ++q) sm += tl[q * 16 + tid];
            p->cbias[wh * 256 + n0 + tid] = sm; }
        __syncthreads(); }
    conv_job(p->rw_w_w2 + (size_t)l * 64 * 512, 64, 512, nullptr, p->rwWlT, 256, [](int n) { return n; }, tl);
    conv_job(p->rw_a_w2 + (size_t)l * 64 * 512, 64, 512, nullptr, p->rwWlT + 64, 256, [](int n) { return n; }, tl);
    conv_job(p->rw_g_w2 + (size_t)l * 128 * 512, 128, 512, nullptr, p->rwWlT + 128, 256, [](int n) { return n; }, tl);
    for (int i = bid * 512 + tid; i < (NP1P - NP1) * D / 8; i += nb * 512) ((u32x4*)(p->Win1 + (size_t)NP1 * D))[i] = (u32x4){0u, 0u, 0u, 0u};
    for (int i = bid * 512 + tid; i < 1024 * 16; i += nb * 512) { const int r = i >> 4, c8 = i & 15; *(u32x4*)(p->Wukv + (size_t)r * 256 + 128 + c8 * 8) = (u32x4){0u, 0u, 0u, 0u}; }
}

DI void ld8bf(const bf16_t* q, float (&f)[8]) { const u32x4 w = *(const u32x4*)q;
    f[0] = __uint_as_float(w.x << 16); f[1] = __uint_as_float(w.x & 0xffff0000u); f[2] = __uint_as_float(w.y << 16); f[3] = __uint_as_float(w.y & 0xffff0000u);
    f[4] = __uint_as_float(w.z << 16); f[5] = __uint_as_float(w.z & 0xffff0000u); f[6] = __uint_as_float(w.w << 16); f[7] = __uint_as_float(w.w & 0xffff0000u); }
DI u32x4 pack8bf(const float (&f)[8]) { u32x4 w; w.x = pk2(f[0], f[1]); w.y = pk2(f[2], f[3]); w.z = pk2(f[4], f[5]); w.w = pk2(f[6], f[7]); return w; }
DI void ld8f(const float* q, float (&f)[8]) { const f32x4 a = *(const f32x4*)q, b = *(const f32x4*)(q + 4); f[0] = a[0]; f[1] = a[1]; f[2] = a[2]; f[3] = a[3]; f[4] = b[0]; f[5] = b[1]; f[6] = b[2]; f[7] = b[3]; }
template <bool HAS_Y, bool HAS_U, bool XIN_BF = false, bool XOUT_BF = false>
DI void phase_norm(const void* xin_, const bf16_t* y, void* xout_, bf16_t* u, const float* g_post, const float* modPrev, float rw, const float* g_pre, const float* modNext) {
    const float* xin = (const float*)xin_; const bf16_t* xinb = (const bf16_t*)xin_; float* xout = (float*)xout_; bf16_t* xoutb = (bf16_t*)xout_;
    const int tid = TIDX(), lane = tid & 63, wave = tid >> 6;
    for (int row0 = (BIDX() * 8 + wave) * 2; row0 < T; row0 += NBLK() * 16) {
        const int b = row0 >> 12;
        float xv[2][4][8]; u32x4 yw[2][4];
#pragma unroll
        for (int r = 0; r < 2; ++r)
#pragma unroll
            for (int i = 0; i < 4; ++i) { const size_t o = (size_t)(row0 + r) * D + i * 512 + lane * 8;
                if (XIN_BF) ld8bf(xinb + o, xv[r][i]); else ld8f(xin + o, xv[r][i]);
                if (HAS_Y) yw[r][i] = *(const u32x4*)(y + o); }
        if (HAS_Y) {
            float gc[4][8];
#pragma unroll
            for (int i = 0; i < 4; ++i) { const int col = i * 512 + lane * 8; float gp[8], gt[8]; ld8f(g_post + col, gp); ld8f(modPrev + (size_t)b * 6144 + 4096 + col, gt);
#pragma unroll
                for (int e = 0; e < 8; ++e) gc[i][e] = gp[e] * gt[e]; }
#pragma unroll
            for (int r = 0; r < 2; ++r) { float yv[4][8]; float ss = 0.f;
#pragma unroll
                for (int i = 0; i < 4; ++i) { const u32x4 w = yw[r][i];
                    yv[i][0] = __uint_as_float(w.x << 16); yv[i][1] = __uint_as_float(w.x & 0xffff0000u); yv[i][2] = __uint_as_float(w.y << 16); yv[i][3] = __uint_as_float(w.y & 0xffff0000u);
                    yv[i][4] = __uint_as_float(w.z << 16); yv[i][5] = __uint_as_float(w.z & 0xffff0000u); yv[i][6] = __uint_as_float(w.w << 16); yv[i][7] = __uint_as_float(w.w & 0xffff0000u);
#pragma unroll
                    for (int e = 0; e < 8; ++e) ss += yv[i][e] * yv[i][e]; }
                ss = wsum(ss);
                const float rs = rsqrtf(ss * (1.0f / D) + NORM_EPS) * rw;
#pragma unroll
                for (int i = 0; i < 4; ++i)
#pragma unroll
                    for (int e = 0; e < 8; ++e) xv[r][i][e] += gc[i][e] * (yv[i][e] * rs); }
        }
        float cu[4][8], sh[4][8];
        if (HAS_U) {
#pragma unroll
            for (int i = 0; i < 4; ++i) { const int col = i * 512 + lane * 8; float gp[8], scl[8]; ld8f(g_pre + col, gp); ld8f(modNext + (size_t)b * 6144 + 2048 + col, scl); ld8f(modNext + (size_t)b * 6144 + col, sh[i]);
#pragma unroll
                for (int e = 0; e < 8; ++e) cu[i][e] = gp[e] * (scl[e] + 1.0f); }
        }
        if (HAS_Y) {
#pragma unroll
            for (int r = 0; r < 2; ++r)
#pragma unroll
                for (int i = 0; i < 4; ++i) { const size_t o = (size_t)(row0 + r) * D + i * 512 + lane * 8;
                    if (XOUT_BF) *(u32x4*)(xoutb + o) = pack8bf(xv[r][i]);
                    else { *(f32x4*)(xout + o) = (f32x4){xv[r][i][0], xv[r][i][1], xv[r][i][2], xv[r][i][3]}; *(f32x4*)(xout + o + 4) = (f32x4){xv[r][i][4], xv[r][i][5], xv[r][i][6], xv[r][i][7]}; } }
        }
        if (HAS_U) {
#pragma unroll
            for (int r = 0; r < 2; ++r) { float ss = 0.f;
#pragma unroll
                for (int i = 0; i < 4; ++i)
#pragma unroll
                    for (int e = 0; e < 8; ++e) ss += xv[r][i][e] * xv[r][i][e];
                ss = wsum(ss);
                const float rs = rsqrtf(ss * (1.0f / D) + NORM_EPS);
#pragma unroll
                for (int i = 0; i < 4; ++i) { float uu[8];
#pragma unroll
                    for (int e = 0; e < 8; ++e) uu[e] = (xv[r][i][e] * rs) * cu[i][e] + sh[i][e];
                    *(u32x4*)(u + (size_t)(row0 + r) * D + i * 512 + lane * 8) = pack8bf(uu); } }
        }
    }
}

DI float ldP(const bf16_t* P1, int t, int col) { return bf2f(P1[(size_t)t * NP1P + col]); }
DI void phase_prep(KParamsPtr p, int l, LAS unsigned char* lds) {
    constexpr int TT = 8;
    const int tid = TIDX(), lane = tid & 63, wave = tid >> 6;
    LAS float* wl = (LAS float*)lds;
    LAS float* al = wl + TT * 64;
    LAS float* gl = al + TT * 64;
    LAS float* ga = gl + TT * 128;
    LAS float* rsq = ga + TT * 16;
    LAS float* gw2 = rsq + TT * 2;
    for (int i = tid; i < 16 * 256; i += 512) gw2[i] = p->gla_w2[l * 16 * 256 + i];
    __syncthreads();
    const bf16_t* P1 = p->P1;
    const float* mu = p->rw_mu + l * 1792;
    const float* w_w2 = p->rw_w_w2 + l * 64 * 512; const float* a_w2 = p->rw_a_w2 + l * 64 * 512; const float* g_w2 = p->rw_g_w2 + l * 128 * 512;
    for (int tile = BIDX(); tile < T / TT; tile += NBLK()) {
        const int t0 = tile * TT;
        for (int rp1_ = 0; rp1_ < PREP_R1; ++rp1_) {
        for (int i = tid; i < TT * 256; i += 512) {
            const int tt = i >> 8, c = i & 255, t = t0 + tt, s = t & (SEQ - 1);
            const int col = c < 64 ? C_RW_WLO + c : (c < 128 ? C_RW_ALO + (c - 64) : C_RW_GLO + (c - 128));
            const float pv = ldP(P1, t, col), pp = s > 0 ? ldP(P1, t - 1, col) : 0.f;
            const float xs = pv + (pp - pv) * mu[col - C_RW];
            if (c < 64) wl[tt * 64 + c] = tanhf(xs); else if (c < 128) al[tt * 64 + c - 64] = xs; else gl[tt * 128 + c - 128] = sigmoidf_(xs);
        }
        if (tid < TT * 16) ga[tid] = ldP(P1, t0 + (tid >> 4), C_GLA_ALO + (tid & 15));
        for (int tk = wave; tk < TT; tk += 8) { const int t = t0 + tk; float sq = 0.f, skv = 0.f;
#pragma unroll
            for (int i = 0; i < 6; ++i) { const float v = ldP(P1, t, C_MLA_CQ + i * 64 + lane); sq += v * v; }
#pragma unroll
            for (int i = 0; i < 2; ++i) { const float v = ldP(P1, t, C_MLA_CKV + i * 64 + lane); skv += v * v; }
            sq = wsum(sq); skv = wsum(skv);
            if (lane == 0) { rsq[tk * 2] = rsqrtf(sq * (1.0f / 384.0f) + NORM_EPS); rsq[tk * 2 + 1] = rsqrtf(skv * (1.0f / 128.0f) + NORM_EPS); } }
        __syncthreads(); }
        for (int rp2_ = 0; rp2_ < PREP_R2; ++rp2_) { const int j = tid;
            float aw[TT], aa[TT], ag[TT];
            const float w0 = p->rw_w0[l * 512 + j], a0 = p->rw_a0[l * 512 + j];
#pragma unroll
            for (int tt = 0; tt < TT; ++tt) { aw[tt] = w0; aa[tt] = a0; ag[tt] = 0.f; }
#pragma unroll 4
            for (int i = 0; i < 64; i += 4) {
                const float ww0 = w_w2[i * 512 + j], ww1 = w_w2[(i + 1) * 512 + j], ww2 = w_w2[(i + 2) * 512 + j], ww3 = w_w2[(i + 3) * 512 + j];
                const float wa0 = a_w2[i * 512 + j], wa1 = a_w2[(i + 1) * 512 + j], wa2 = a_w2[(i + 2) * 512 + j], wa3 = a_w2[(i + 3) * 512 + j];
#pragma unroll
                for (int tt = 0; tt < TT; ++tt) { const f32x4 x = *(const LAS f32x4*)(wl + tt * 64 + i), z = *(const LAS f32x4*)(al + tt * 64 + i);
                    aw[tt] += (x[0] * ww0 + x[1] * ww1) + (x[2] * ww2 + x[3] * ww3); aa[tt] += (z[0] * wa0 + z[1] * wa1) + (z[2] * wa2 + z[3] * wa3); } }
#pragma unroll 4
            for (int i = 0; i < 128; i += 4) {
                const float wg0 = g_w2[i * 512 + j], wg1 = g_w2[(i + 1) * 512 + j], wg2 = g_w2[(i + 2) * 512 + j], wg3 = g_w2[(i + 3) * 512 + j];
#pragma unroll
                for (int tt = 0; tt < TT; ++tt) { const f32x4 x = *(const LAS f32x4*)(gl + tt * 128 + i); ag[tt] += (x[0] * wg0 + x[1] * wg1) + (x[2] * wg2 + x[3] * wg3); } }
            const float k_k = p->rw_k_k[l * 512 + j], k_a = p->rw_k_a[l * 512 + j];
            const float mur = mu[C_RW_R - C_RW + j], muk = mu[C_RW_K - C_RW + j], muv = mu[C_RW_V - C_RW + j];
#pragma unroll
            for (int tt = 0; tt < TT; ++tt) {
                const int t = t0 + tt, s = t & (SEQ - 1);
                float xr = ldP(P1, t, C_RW_R + j), xk = ldP(P1, t, C_RW_K + j), xv = ldP(P1, t, C_RW_V + j);
                const float pr = s > 0 ? ldP(P1, t - 1, C_RW_R + j) : 0.f, pk = s > 0 ? ldP(P1, t - 1, C_RW_K + j) : 0.f, pvv = s > 0 ? ldP(P1, t - 1, C_RW_V + j) : 0.f;
                xr += (pr - xr) * mur; xk += (pk - xk) * muk; xv += (pvv - xv) * muv;
                const float w = __expf(-0.6065306597126334f * sigmoidf_(aw[tt]));
                const float a = sigmoidf_(aa[tt]);
                const float kkr = xk * k_k;
                const float ss = wsum(kkr * kkr);
                const float kk = kkr / fmaxf(sqrtf(ss), 1e-12f);
                const float k2 = xk * (1.0f + (a - 1.0f) * k_a);
                const size_t o = (size_t)t * 512 + j;
                p->rw_r[o] = f2bf(xr); p->rw_w[o] = w; p->rw_k[o] = f2bf(k2); p->rw_v[o] = f2bf(xv); p->rw_kk[o] = kk; p->rw_b[o] = kk * a; p->rw_g[o] = f2bf(ag[tt]);
            } }
        for (int rp3_ = 0; rp3_ < PREP_R3; ++rp3_)
        for (int tt = 0; tt < TT; ++tt) {
            const int t = t0 + tt, s = t & (SEQ - 1), b = t >> 12;
            if (tid < 256) { const int h = tid >> 5, i = tid & 31;
                const float x1 = ldP(P1, t, C_NSA_Q + h * 64 + i), x2 = ldP(P1, t, C_NSA_Q + h * 64 + 32 + i), cs = p->cos64[s * 32 + i], sn = p->sin64[s * 32 + i];
                p->nsa_q[(size_t)t * 512 + h * 64 + i] = f2bf(x1 * cs - x2 * sn); p->nsa_q[(size_t)t * 512 + h * 64 + 32 + i] = f2bf(x1 * sn + x2 * cs);
            } else if (tid < 448) { const int r = tid - 256, which = r >> 6, hk = (r >> 5) & 1, i = r & 31;
                const int sc = (which == 0 ? C_NSA_KC : (which == 1 ? C_NSA_KS : C_NSA_KW)) + hk * 64;
                bf16_t* dst = which == 0 ? p->nsa_kc_in : (which == 1 ? p->nsa_ks : p->nsa_kw);
                const float x1 = ldP(P1, t, sc + i), x2 = ldP(P1, t, sc + 32 + i), cs = p->cos64[s * 32 + i], sn = p->sin64[s * 32 + i];
                const size_t o = ((size_t)(b * 2 + hk) * SEQ + s) * 64;
                dst[o + i] = f2bf(x1 * cs - x2 * sn); dst[o + 32 + i] = f2bf(x1 * sn + x2 * cs);
            } else if (tid < 472) { const int g = tid - 448; p->nsa_gate[(size_t)t * 24 + g] = sigmoidf_(ldP(P1, t, C_NSA_GL + g)); }
            if (tid < 384) { const int which = tid >> 7, hk = (tid >> 6) & 1, d = tid & 63;
                const int sc = (which == 0 ? C_NSA_VC : (which == 1 ? C_NSA_VS : C_NSA_VW)) + hk * 64;
                bf16_t* dst = which == 0 ? p->nsa_vc_in : (which == 1 ? p->nsa_vs : p->nsa_vw);
                dst[((size_t)(b * 2 + hk) * SEQ + s) * 64 + d] = P1[(size_t)t * NP1P + sc + d]; }
        }
        for (int rp4_ = 0; rp4_ < PREP_R4; ++rp4_) {
        for (int i = tid; i < TT * 256; i += 512) {
            const int tt = i >> 8, d = i & 255;
            float z = p->gla_b[l * 256 + d];
#pragma unroll
            for (int q = 0; q < 16; ++q) z += ga[tt * 16 + q] * gw2[q * 256 + d];
            const float ez = __expf(-fabsf(z)), ls = fminf(z, 0.f) - __logf(1.0f + ez);
            p->gla_la[(size_t)(t0 + tt) * 256 + d] = ls * (1.0f / 16.0f);
        }
        for (int i = tid; i < TT * 384; i += 512) { const int tt = i / 384, c = i % 384; p->mla_cqn[(size_t)(t0 + tt) * 384 + c] = f2bf(ldP(P1, t0 + tt, C_MLA_CQ + c) * rsq[tt * 2]); }
        for (int i = tid; i < TT * 256; i += 512) { const int tt = i >> 8, c = i & 255; p->mla_ckvn[(size_t)(t0 + tt) * 256 + c] = c < 128 ? f2bf(ldP(P1, t0 + tt, C_MLA_CKV + c) * rsq[tt * 2 + 1]) : (bf16_t)0; }
        if (tid < TT * 16) { const int tt = tid >> 4, i = tid & 15, t = t0 + tt, s = t & (SEQ - 1);
            const float x1 = ldP(P1, t, C_MLA_KR + i), x2 = ldP(P1, t, C_MLA_KR + 16 + i), cs = p->cos32[s * 16 + i], sn = p->sin32[s * 16 + i];
            p->mla_kpe[(size_t)t * 32 + i] = f2bf(x1 * cs - x2 * sn); p->mla_kpe[(size_t)t * 32 + 16 + i] = f2bf(x1 * sn + x2 * cs); }
        }
        __syncthreads();
    }
}

DI float prep_red16(float x) {
    x += __int_as_float(__builtin_amdgcn_update_dpp(0, __float_as_int(x), 0xB1, 0xF, 0xF, true)); x += __int_as_float(__builtin_amdgcn_update_dpp(0, __float_as_int(x), 0x4E, 0xF, 0xF, true));
    x += __int_as_float(__builtin_amdgcn_update_dpp(0, __float_as_int(x), 0x141, 0xF, 0xF, true)); x += __int_as_float(__builtin_amdgcn_update_dpp(0, __float_as_int(x), 0x140, 0xF, 0xF, true)); return x; }
DI void rope8(const bf16_t* src1, const bf16_t* src2, const float* cs, const float* sn, bf16_t* dst1, bf16_t* dst2) {
    float x1[8], x2[8], c[8], sgn[8], o1[8], o2[8]; ld8bf(src1, x1); ld8bf(src2, x2); ld8f(cs, c); ld8f(sn, sgn);
#pragma unroll
    for (int e = 0; e < 8; ++e) { o1[e] = x1[e] * c[e] - x2[e] * sgn[e]; o2[e] = x1[e] * sgn[e] + x2[e] * c[e]; }
    *(u32x4*)dst1 = pack8bf(o1); *(u32x4*)dst2 = pack8bf(o2); }
constexpr int P1TAIL = 5120;
DI float ldtail(const float* part, int t, int cc) { return (part[(size_t)t * 256 + cc] + part[((size_t)T + t) * 256 + cc]) + (part[((size_t)2 * T + t) * 256 + cc] + part[((size_t)3 * T + t) * 256 + cc]); }
DI void ldtail8(const float* part, int t, int cc, float (&f)[8]) { float a[8], b[8], c[8], d[8];
    ld8f(part + (size_t)t * 256 + cc, a); ld8f(part + ((size_t)T + t) * 256 + cc, b); ld8f(part + ((size_t)2 * T + t) * 256 + cc, c); ld8f(part + ((size_t)3 * T + t) * 256 + cc, d);
#pragma unroll
    for (int e = 0; e < 8; ++e) f[e] = (a[e] + b[e]) + (c[e] + d[e]); }
DI void phase_prep2(KParamsPtr p, int l, LAS unsigned char* lds) {
    constexpr int TT = 16, XS = 264;
    const int tid = TIDX(), lane = tid & 63, wave = tid >> 6, fr = lane & 15, q4 = lane >> 4;
    LAS bf16_t* xa = (LAS bf16_t*)lds;
    LAS float* ga = (LAS float*)(lds + TT * XS * 2);
    LAS float* rsq = ga + TT * 16;
    LAS float* gw2 = rsq + TT * 2;
    LAS float* tl = gw2 + 16 * 256;
    for (int i = tid; i < 16 * 256; i += 512) gw2[i] = p->gla_w2[l * 16 * 256 + i];
    __syncthreads();
    const bf16_t* P1 = p->P1; const float* ptail = (const float*)p->y;
    const float* mu = p->rw_mu + l * 1792;
    const bf16_t* WT = p->rwWlT;
    float c_w0[4], c_a0[4], c_kk[4], c_ka[4], c_mr[4], c_mk[4], c_mv[4];
#pragma unroll
    for (int nb = 0; nb < 4; ++nb) { const int ch = wave * 64 + nb * 16 + fr;
        c_w0[nb] = p->rw_w0[l * 512 + ch]; c_a0[nb] = p->rw_a0[l * 512 + ch]; c_kk[nb] = p->rw_k_k[l * 512 + ch]; c_ka[nb] = p->rw_k_a[l * 512 + ch];
        c_mr[nb] = mu[C_RW_R - C_RW + ch]; c_mk[nb] = mu[C_RW_K - C_RW + ch]; c_mv[nb] = mu[C_RW_V - C_RW + ch]; }
    for (int tile = BIDX(); tile < T / TT; tile += NBLK()) {
        const int t0 = tile * TT;
        { const int tt = tid >> 5, c = (tid & 31) * 8, t = t0 + tt, s = t & (SEQ - 1);
            const int col = c < 64 ? C_RW_WLO + c : (c < 128 ? C_RW_ALO + (c - 64) : C_RW_GLO + (c - 128));
            float pv[8], pp[8], m8[8], o[8]; ld8bf(P1 + (size_t)t * NP1P + col, pv); ld8f(mu + col - C_RW, m8);
            if (s > 0) ld8bf(P1 + (size_t)(t - 1) * NP1P + col, pp); else {
#pragma unroll
                for (int e = 0; e < 8; ++e) pp[e] = 0.f; }
#pragma unroll
            for (int e = 0; e < 8; ++e) { const float xs = pv[e] + (pp[e] - pv[e]) * m8[e];
                o[e] = c < 64 ? 1.0f - 2.0f / (__expf(2.0f * xs) + 1.0f) : (c < 128 ? xs : sigmoidf_(xs)); }
            *(LAS u32x4*)(xa + tt * XS + c) = pack8bf(o); }
        if (tid >= 512 - TT * 9) { const int k_ = tid - (512 - TT * 9), tt = k_ / 9, ch = k_ % 9; float f8[8]; ldtail8(ptail, t0 + tt, ch * 8, f8);
            *(LAS f32x4*)(tl + tt * 80 + ch * 8) = (f32x4){f8[0], f8[1], f8[2], f8[3]}; *(LAS f32x4*)(tl + tt * 80 + ch * 8 + 4) = (f32x4){f8[4], f8[5], f8[6], f8[7]}; }
        if (tid < TT * 16) ga[tid] = ldP(P1, t0 + (tid >> 4), C_GLA_ALO + (tid & 15));
        __syncthreads();
        {
            f32x4 acc[3][4];
#pragma unroll
            for (int w3 = 0; w3 < 3; ++w3)
#pragma unroll
                for (int nb = 0; nb < 4; ++nb) acc[w3][nb] = (f32x4){0.f, 0.f, 0.f, 0.f};
#pragma unroll
            for (int ks = 0; ks < 8; ++ks) {
                const bf16x8 af = *(const LAS bf16x8*)(xa + fr * XS + ks * 32 + q4 * 8);
#pragma unroll
                for (int nb = 0; nb < 4; ++nb) { const bf16x8 bfr = *(const bf16x8*)(WT + (size_t)(wave * 64 + nb * 16 + fr) * 256 + ks * 32 + q4 * 8);
                    acc[ks < 2 ? 0 : (ks < 4 ? 1 : 2)][nb] = __builtin_amdgcn_mfma_f32_16x16x32_bf16(af, bfr, acc[ks < 2 ? 0 : (ks < 4 ? 1 : 2)][nb], 0, 0, 0); }
            }
#pragma unroll
            for (int jj = 0; jj < 4; ++jj) {
                const int t = t0 + q4 * 4 + jj, s = t & (SEQ - 1);
                float xr[4], xk[4], xv[4], kkr[4]; float ss = 0.f;
#pragma unroll
                for (int nb = 0; nb < 4; ++nb) { const int ch = wave * 64 + nb * 16 + fr;
                    xr[nb] = ldP(P1, t, C_RW_R + ch); xk[nb] = ldP(P1, t, C_RW_K + ch); xv[nb] = ldP(P1, t, C_RW_V + ch);
                    const float pr = s > 0 ? ldP(P1, t - 1, C_RW_R + ch) : 0.f, pk = s > 0 ? ldP(P1, t - 1, C_RW_K + ch) : 0.f, pvv = s > 0 ? ldP(P1, t - 1, C_RW_V + ch) : 0.f;
                    xr[nb] += (pr - xr[nb]) * c_mr[nb]; xk[nb] += (pk - xk[nb]) * c_mk[nb]; xv[nb] += (pvv - xv[nb]) * c_mv[nb];
                    kkr[nb] = xk[nb] * c_kk[nb]; ss += kkr[nb] * kkr[nb]; }
                ss = prep_red16(ss);
                const float rn = 1.0f / fmaxf(sqrtf(ss), 1e-12f);
#pragma unroll
                for (int nb = 0; nb < 4; ++nb) { const int ch = wave * 64 + nb * 16 + fr;
                    const float w = __expf(-0.6065306597126334f * sigmoidf_(c_w0[nb] + acc[0][nb][jj]));
                    const float a = sigmoidf_(c_a0[nb] + acc[1][nb][jj]);
                    const float kk = kkr[nb] * rn, k2 = xk[nb] * (1.0f + (a - 1.0f) * c_ka[nb]);
                    const size_t o = (size_t)t * 512 + ch;
                    p->rw_r[o] = f2bf(xr[nb]); p->rw_w[o] = w; p->rw_k[o] = f2bf(k2); p->rw_v[o] = f2bf(xv[nb]); p->rw_kk[o] = kk; p->rw_b[o] = kk * a; p->rw_g[o] = f2bf(acc[2][nb][jj]); }
            }
        }
        for (int tk = wave; tk < TT; tk += 8) { const int t = t0 + tk; float sq = 0.f, skv = 0.f;
#pragma unroll
            for (int i = 0; i < 6; ++i) { const float v = ldP(P1, t, C_MLA_CQ + i * 64 + lane); sq += v * v; }
#pragma unroll
            for (int i = 0; i < 2; ++i) { const int col = C_MLA_CKV + i * 64 + lane; const float v = col < P1TAIL ? ldP(P1, t, col) : tl[tk * 80 + col - P1TAIL]; skv += v * v; }
            sq = wsum(sq); skv = wsum(skv);
            if (lane == 0) { rsq[tk * 2] = rsqrtf(sq * (1.0f / 384.0f) + NORM_EPS); rsq[tk * 2 + 1] = rsqrtf(skv * (1.0f / 128.0f) + NORM_EPS); } }
        __syncthreads();
        { const int tt = tid >> 5, idx = tid & 31, t = t0 + tt, s = t & (SEQ - 1), b = t >> 12;
            const bf16_t* row = P1 + (size_t)t * NP1P;
            { const int h = idx >> 2, ic = idx & 3;
              rope8(row + C_NSA_Q + h * 64 + ic * 8, row + C_NSA_Q + h * 64 + 32 + ic * 8, p->cos64 + s * 32 + ic * 8, p->sin64 + s * 32 + ic * 8,
                    p->nsa_q + (size_t)t * 512 + h * 64 + ic * 8, p->nsa_q + (size_t)t * 512 + h * 64 + 32 + ic * 8); }
            asm volatile("" ::: "memory");
            if (idx < 24) { const int which = idx >> 3, hk = (idx >> 2) & 1, ic = idx & 3;
                const int sc = (which == 0 ? C_NSA_KC : (which == 1 ? C_NSA_KS : C_NSA_KW)) + hk * 64;
                bf16_t* dst = (which == 0 ? p->nsa_kc_in : (which == 1 ? p->nsa_ks : p->nsa_kw)) + ((size_t)(b * 2 + hk) * SEQ + s) * 64;
                rope8(row + sc + ic * 8, row + sc + 32 + ic * 8, p->cos64 + s * 32 + ic * 8, p->sin64 + s * 32 + ic * 8, dst + ic * 8, dst + 32 + ic * 8); }
#pragma unroll
            for (int ps = 0; ps < 2; ++ps) { const int k = idx + 32 * ps;
                if (k < 48) { const int which = k >> 4, hk = (k >> 3) & 1, ic = k & 7;
                    const int sc = (which == 0 ? C_NSA_VC : (which == 1 ? C_NSA_VS : C_NSA_VW)) + hk * 64;
                    bf16_t* dst = (which == 0 ? p->nsa_vc_in : (which == 1 ? p->nsa_vs : p->nsa_vw)) + ((size_t)(b * 2 + hk) * SEQ + s) * 64;
                    *(u32x4*)(dst + ic * 8) = *(const u32x4*)(row + sc + ic * 8); } }
            asm volatile("" ::: "memory");
            if (idx < 3) { float g8[8]; ld8bf(row + C_NSA_GL + idx * 8, g8);
                float* gd = p->nsa_gate + (size_t)t * 24 + idx * 8;
                *(f32x4*)gd = (f32x4){sigmoidf_(g8[0]), sigmoidf_(g8[1]), sigmoidf_(g8[2]), sigmoidf_(g8[3])}; *(f32x4*)(gd + 4) = (f32x4){sigmoidf_(g8[4]), sigmoidf_(g8[5]), sigmoidf_(g8[6]), sigmoidf_(g8[7])}; }
            asm volatile("" ::: "memory");
            { const int c = idx * 8; u32x4 w = (u32x4){0u, 0u, 0u, 0u};
              if (c < 128) { float v8[8]; if (C_MLA_CKV + c < P1TAIL) ld8bf(row + C_MLA_CKV + c, v8); else { const f32x4 a_ = *(const LAS f32x4*)(tl + tt * 80 + C_MLA_CKV + c - P1TAIL), b_ = *(const LAS f32x4*)(tl + tt * 80 + C_MLA_CKV + c - P1TAIL + 4); v8[0] = a_[0]; v8[1] = a_[1]; v8[2] = a_[2]; v8[3] = a_[3]; v8[4] = b_[0]; v8[5] = b_[1]; v8[6] = b_[2]; v8[7] = b_[3]; } const float r = rsq[tt * 2 + 1];
#pragma unroll
                  for (int e = 0; e < 8; ++e) v8[e] *= r;
                  w = pack8bf(v8); }
              *(u32x4*)(p->mla_ckvn + (size_t)t * 256 + c) = w; }
            if (idx < 2) { float x1[8], x2[8], cs[8], sn[8], o1[8], o2[8]; { const f32x4 a_ = *(const LAS f32x4*)(tl + tt * 80 + C_MLA_KR - P1TAIL + idx * 8), b_ = *(const LAS f32x4*)(tl + tt * 80 + C_MLA_KR - P1TAIL + idx * 8 + 4), c_ = *(const LAS f32x4*)(tl + tt * 80 + C_MLA_KR - P1TAIL + 16 + idx * 8), d_ = *(const LAS f32x4*)(tl + tt * 80 + C_MLA_KR - P1TAIL + 16 + idx * 8 + 4);
#pragma unroll
                  for (int e = 0; e < 4; ++e) { x1[e] = a_[e]; x1[4 + e] = b_[e]; x2[e] = c_[e]; x2[4 + e] = d_[e]; } }
                ld8f(p->cos32 + s * 16 + idx * 8, cs); ld8f(p->sin32 + s * 16 + idx * 8, sn);
#pragma unroll
                for (int e = 0; e < 8; ++e) { o1[e] = x1[e] * cs[e] - x2[e] * sn[e]; o2[e] = x1[e] * sn[e] + x2[e] * cs[e]; }
                *(u32x4*)(p->mla_kpe + (size_t)t * 32 + idx * 8) = pack8bf(o1); *(u32x4*)(p->mla_kpe + (size_t)t * 32 + 16 + idx * 8) = pack8bf(o2); }
        }
            asm volatile("" ::: "memory");
        for (int i = tid; i < TT * 48; i += 512) { const int tt = i / 48, c = (i % 48) * 8; float v8[8]; ld8bf(P1 + (size_t)(t0 + tt) * NP1P + C_MLA_CQ + c, v8); const float r = rsq[tt * 2];
#pragma unroll
            for (int e = 0; e < 8; ++e) v8[e] *= r;
            *(u32x4*)(p->mla_cqn + (size_t)(t0 + tt) * 384 + c) = pack8bf(v8); }
            asm volatile("" ::: "memory");
        { const int d = tid & 255; float wq[16];
#pragma unroll
            for (int q = 0; q < 16; ++q) wq[q] = gw2[q * 256 + d];
            const float bz = p->gla_b[l * 256 + d];
#pragma unroll
            for (int k = 0; k < TT / 2; ++k) { const int tt = (tid >> 8) + 2 * k; float z = bz;
#pragma unroll
                for (int q4_ = 0; q4_ < 4; ++q4_) { const f32x4 g = *(const LAS f32x4*)(ga + tt * 16 + q4_ * 4); z += (g[0] * wq[q4_ * 4] + g[1] * wq[q4_ * 4 + 1]) + (g[2] * wq[q4_ * 4 + 2] + g[3] * wq[q4_ * 4 + 3]); }
                const float ez = __expf(-fabsf(z)), ls = fminf(z, 0.f) - __logf(1.0f + ez);
                p->gla_la[(size_t)(t0 + tt) * 256 + d] = ls * (1.0f / 16.0f); } }
        __syncthreads();
    }
}


DI float gelu_tanh(float x) { return 0.5f * x * (1.0f + tanhf(0.7978845608028654f * (x + 0.044715f * x * x * x))); }
DI void phase_compress(KParamsPtr p, int l, LAS unsigned char* lds) {
    const int tid = TIDX();
    LAS float* A = (LAS float*)lds;
    LAS float* Hd = A + 8 * 2048;
    for (int task = BIDX(); task < 512; task += NBLK()) {
        const int which = task >> 8, bh = (task >> 5) & 7, n0 = (task & 31) * 8;
        const bf16_t* base = (which ? p->nsa_vc_in : p->nsa_kc_in) + (size_t)bh * SEQ * 64;
        const float* pos = p->cmp_pos + (l * 2 + which) * 2048;
        for (int i = tid; i < 8 * 2048; i += 512) { const int r = i >> 11, k = i & 2047, n = n0 + r;
            A[i] = n < 255 ? bf2f(base[(size_t)n * 1024 + k]) + pos[k] : 0.f; }
        __syncthreads();
        const float* w1 = p->cmp_w1 + (size_t)(l * 2 + which) * 2048 * 256;
        { const int j = tid & 255, half = tid >> 8;
            float acc[4] = {0.f, 0.f, 0.f, 0.f};
            for (int k = 0; k < 2048; ++k) { const float w = w1[(size_t)k * 256 + j];
#pragma unroll
                for (int r = 0; r < 4; ++r) acc[r] += A[(half * 4 + r) * 2048 + k] * w; }
#pragma unroll
            for (int r = 0; r < 4; ++r) Hd[(half * 4 + r) * 256 + j] = gelu_tanh(acc[r]); }
        __syncthreads();
        const float* w2 = p->cmp_w2 + (size_t)(l * 2 + which) * 256 * 64;
        { const int r = tid >> 6, d = tid & 63; float o = 0.f;
            for (int j = 0; j < 256; ++j) o += Hd[r * 256 + j] * w2[j * 64 + d];
            (which ? p->nsa_vc : p->nsa_kc)[((size_t)bh * 256 + n0 + r) * 64 + d] = o; }
        __syncthreads();
    }
}

DI void phase_nsa_cmp(KParamsPtr p, LAS unsigned char* lds) {
    const int tid = TIDX(), lane = tid & 63, wave = tid >> 6;
    LAS float* qs = (LAS float*)lds + wave * (256 + 1024);
    LAS float* pl = qs + 256;
    const float scale = 0.125f;
    for (int item_ = BIDX() * 8 + wave; item_ < NB * 2 * SEQ; item_ += NBLK() * 8) {
        const int item = __builtin_amdgcn_readfirstlane(item_);
        const int s = item & (SEQ - 1), hk = (item >> 12) & 1, b = item >> 13, t = b * SEQ + s, bh = b * 2 + hk;
        const int nvalid = s >= 31 ? min(255, (s - 31) / 16 + 1) : 0;
#pragma unroll
        for (int g = 0; g < 4; ++g) qs[g * 64 + lane] = bf2f(p->nsa_q[(size_t)t * 512 + (hk * 4 + g) * 64 + lane]);
        asm volatile("s_waitcnt lgkmcnt(0)" ::: "memory");
        float sc[4][4];
#pragma unroll
        for (int c = 0; c < 4; ++c) { const int n = lane + 64 * c;
#pragma unroll
            for (int g = 0; g < 4; ++g) sc[c][g] = -1e30f;
            if (n < nvalid) { const float* kr = p->nsa_kc + ((size_t)bh * 256 + n) * 64;
                float d0 = 0.f, d1 = 0.f, d2 = 0.f, d3 = 0.f;
#pragma unroll 4
                for (int k4 = 0; k4 < 16; ++k4) { const f32x4 kv = *(const f32x4*)(kr + k4 * 4);
                    const f32x4 q0 = *(const LAS f32x4*)(qs + k4 * 4), q1 = *(const LAS f32x4*)(qs + 64 + k4 * 4), q2 = *(const LAS f32x4*)(qs + 128 + k4 * 4), q3 = *(const LAS f32x4*)(qs + 192 + k4 * 4);
                    d0 += kv[0] * q0[0] + kv[1] * q0[1] + kv[2] * q0[2] + kv[3] * q0[3]; d1 += kv[0] * q1[0] + kv[1] * q1[1] + kv[2] * q1[2] + kv[3] * q1[3];
                    d2 += kv[0] * q2[0] + kv[1] * q2[1] + kv[2] * q2[2] + kv[3] * q2[3]; d3 += kv[0] * q3[0] + kv[1] * q3[1] + kv[2] * q3[2] + kv[3] * q3[3]; }
                sc[c][0] = d0 * scale; sc[c][1] = d1 * scale; sc[c][2] = d2 * scale; sc[c][3] = d3 * scale; } }
#pragma unroll
        for (int g = 0; g < 4; ++g) {
            float mx = fmaxf(fmaxf(sc[0][g], sc[1][g]), fmaxf(sc[2][g], sc[3][g])); mx = wmax(mx);
            float e[4], sm = 0.f;
#pragma unroll
            for (int c = 0; c < 4; ++c) { e[c] = (lane + 64 * c < nvalid) ? __expf(sc[c][g] - mx) : 0.f; sm += e[c]; }
            sm = wsum(sm);
            const float inv = sm > 0.f ? 1.0f / sm : 0.f;
#pragma unroll
            for (int c = 0; c < 4; ++c) pl[g * 256 + lane + 64 * c] = e[c] * inv;
        }
        asm volatile("s_waitcnt lgkmcnt(0)" ::: "memory");
        { float o[4] = {0.f, 0.f, 0.f, 0.f};
            const float* vr = p->nsa_vc + (size_t)bh * 256 * 64 + lane;
            for (int n = 0; n < nvalid; ++n) { const float v = vr[(size_t)n * 64];
#pragma unroll
                for (int g = 0; g < 4; ++g) o[g] += pl[g * 256 + n] * v; }
#pragma unroll
            for (int g = 0; g < 4; ++g) p->nsa_ocmp[(size_t)t * 512 + (hk * 4 + g) * 64 + lane] = o[g]; }
        float imp = 0.f;
#pragma unroll
        for (int dn = -1; dn <= 3; ++dn) { const int n = 4 * lane + dn;
            if (n >= 0 && n < 255) imp += pl[n] + pl[256 + n] + pl[512 + n] + pl[768 + n]; }
        const int cur = s >> 6;
        const bool valid = lane <= cur, forced = valid && (lane == 0 || lane >= cur - 1);
        const float val = forced ? 1e30f : (valid ? imp : -1e30f);
        int rank = 0;
        for (int jj = 0; jj < 64; ++jj) { const float o = __shfl(val, jj); rank += (o > val || (o == val && jj < lane)) ? 1 : 0; }
        const unsigned long long mask = __ballot(rank < 16);
        if (lane == 0) p->nsa_sel[(size_t)bh * SEQ + s] = mask;
        asm volatile("s_waitcnt lgkmcnt(0)" ::: "memory");
    }
}

DI void dot8(const u32x4 w, LAS const float* q0, int DQ, float (&s)[4]) {
    float kf[8];
    kf[0] = __uint_as_float(w.x << 16); kf[1] = __uint_as_float(w.x & 0xffff0000u); kf[2] = __uint_as_float(w.y << 16); kf[3] = __uint_as_float(w.y & 0xffff0000u);
    kf[4] = __uint_as_float(w.z << 16); kf[5] = __uint_as_float(w.z & 0xffff0000u); kf[6] = __uint_as_float(w.w << 16); kf[7] = __uint_as_float(w.w & 0xffff0000u);
#pragma unroll
    for (int g = 0; g < 4; ++g) { const f32x4 qa = *(const LAS f32x4*)(q0 + g * DQ), qb = *(const LAS f32x4*)(q0 + g * DQ + 4);
        s[g] += kf[0] * qa[0] + kf[1] * qa[1] + kf[2] * qa[2] + kf[3] * qa[3] + kf[4] * qb[0] + kf[5] * qb[1] + kf[6] * qb[2] + kf[7] * qb[3]; }
}
template <int DQ, class KPtr, class VLoad, class Mask>
DI void naive_attn_block(int lane, LAS float* qs  , LAS float* ps  , float scale, KPtr kptr, VLoad vload, Mask mask, float (&m)[4], float (&l)[4], float (&o)[4]) {
    float s[4] = {0.f, 0.f, 0.f, 0.f};
#pragma unroll 4
    for (int c8 = 0; c8 < DQ / 8; ++c8) { const u32x4 w = *(const u32x4*)kptr(c8); dot8(w, qs + c8 * 8, DQ, s); if ((c8 & 3) == 3) asm volatile("" ::: "memory"); }
    float pr[4];
#pragma unroll
    for (int g = 0; g < 4; ++g) {
        const bool ok = mask(g, lane);
        const float sv = ok ? s[g] * scale : -1e30f;
        const float bm = wmax(sv), mn = fmaxf(m[g], bm), corr = __expf(m[g] - mn);
        pr[g] = ok ? __expf(sv - mn) : 0.f;
        l[g] = l[g] * corr + pr[g]; o[g] *= corr; m[g] = mn;
    }
    *(LAS f32x4*)(ps + lane * 4) = (f32x4){pr[0], pr[1], pr[2], pr[3]};
    asm volatile("s_waitcnt lgkmcnt(0)" ::: "memory");
#pragma unroll 4
    for (int key = 0; key < 64; ++key) { const f32x4 pv = *(const LAS f32x4*)(ps + key * 4); const float v = vload(key, lane);
        o[0] += pv[0] * v; o[1] += pv[1] * v; o[2] += pv[2] * v; o[3] += pv[3] * v; if ((key & 3) == 3) asm volatile("" ::: "memory"); }
    asm volatile("s_waitcnt lgkmcnt(0)" ::: "memory");
}

DI void phase_nsa_attn(KParamsPtr p, LAS unsigned char* lds) {
    const int tid = TIDX(), lane = tid & 63, wave = tid >> 6;
    LAS float* qs = (LAS float*)lds + wave * 512;
    LAS float* ps = qs + 256;
    for (int item_ = BIDX() * 8 + wave; item_ < NB * 2 * SEQ; item_ += NBLK() * 8) {
        const int item = __builtin_amdgcn_readfirstlane(item_);
        const int s = item & (SEQ - 1), hk = (item >> 12) & 1, b = item >> 13, t = b * SEQ + s, bh = b * 2 + hk, cur = s >> 6;
#pragma unroll
        for (int g = 0; g < 4; ++g) qs[g * 64 + lane] = bf2f(p->nsa_q[(size_t)t * 512 + (hk * 4 + g) * 64 + lane]);
        asm volatile("s_waitcnt lgkmcnt(0)" ::: "memory");
        float res[4];
        { float m[4] = {-1e30f, -1e30f, -1e30f, -1e30f}, l[4] = {0.f, 0.f, 0.f, 0.f}, o[4] = {0.f, 0.f, 0.f, 0.f};
#if defined(NSA_NO_CMP)
            unsigned long long sel = NSA_SEL0;
#else
            unsigned long long sel = p->nsa_sel[(size_t)bh * SEQ + s];
#endif
            sel &= (cur >= 63) ? ~0ull : ((1ull << (cur + 1)) - 1ull);
            sel = ((unsigned long long)(unsigned)__builtin_amdgcn_readfirstlane((int)(sel >> 32)) << 32) | (unsigned)__builtin_amdgcn_readfirstlane((int)sel);
            const bf16_t* K = p->nsa_ks + (size_t)bh * SEQ * 64; const bf16_t* V = p->nsa_vs + (size_t)bh * SEQ * 64;
#if defined(NSA_NO_SLC)
            sel &= 1ull;
#endif
            while (sel) { const int j = __builtin_ctzll(sel); sel &= sel - 1;
                const int k0 = j * 64;
                naive_attn_block<64>(lane, qs, ps, 0.125f,
                    [&](int c8) { return K + (size_t)(k0 + lane) * 64 + c8 * 8; },
                    [&](int key, int d) { return bf2f(V[(size_t)(k0 + key) * 64 + d]); },
                    [&](int, int key) { return k0 + key <= s; }, m, l, o); }
#pragma unroll
            for (int g = 0; g < 4; ++g) { const float lt = wsum(l[g]); res[g] = p->nsa_gate[(size_t)t * 24 + (hk * 4 + g) * 3 + 1] * (o[g] / lt); } }
        { float m[4] = {-1e30f, -1e30f, -1e30f, -1e30f}, l[4] = {0.f, 0.f, 0.f, 0.f}, o[4] = {0.f, 0.f, 0.f, 0.f};
#if defined(NSA_WIN_USE_S)
            const bf16_t* K = p->nsa_ks + (size_t)bh * SEQ * 64; const bf16_t* V = p->nsa_vs + (size_t)bh * SEQ * 64;
#else
            const bf16_t* K = p->nsa_kw + (size_t)bh * SEQ * 64; const bf16_t* V = p->nsa_vw + (size_t)bh * SEQ * 64;
#endif
            const int lo = s - 511 > 0 ? s - 511 : 0;
#if defined(NSA_NO_WIN)
            for (int j = cur; j <= cur; ++j) { const int k0 = j * 64;
#else
            for (int j = lo >> 6; j <= cur; ++j) { const int k0 = j * 64;
#endif
                naive_attn_block<64>(lane, qs, ps, 0.125f,
                    [&](int c8) { return K + (size_t)(k0 + lane) * 64 + c8 * 8; },
                    [&](int key, int d) { return bf2f(V[(size_t)(k0 + key) * 64 + d]); },
                    [&](int, int key) { return k0 + key <= s && k0 + key >= lo; }, m, l, o); }
#pragma unroll
            for (int g = 0; g < 4; ++g) { const float lt = wsum(l[g]); res[g] += p->nsa_gate[(size_t)t * 24 + (hk * 4 + g) * 3 + 2] * (o[g] / lt); } }
#pragma unroll
        for (int g = 0; g < 4; ++g) { const size_t oi = (size_t)t * 512 + (hk * 4 + g) * 64 + lane;
#if !defined(NSA_NO_CMP)
            res[g] += p->nsa_gate[(size_t)t * 24 + (hk * 4 + g) * 3] * p->nsa_ocmp[oi];
#endif
            p->ys[oi] = f2bf(res[g]); }
    }
}

DI void phase_mla_rope(KParamsPtr p) {
    for (int i = BIDX() * 512 + TIDX(); i < T * 128; i += NBLK() * 512) {
        const int t = i >> 7, h = (i >> 4) & 7, j = i & 15, s = t & (SEQ - 1);
        bf16_t* q = p->mla_q + (size_t)t * 768 + h * 96 + 64;
        const float x1 = bf2f(q[j]), x2 = bf2f(q[16 + j]), cs = p->cos32[s * 16 + j], sn = p->sin32[s * 16 + j];
        q[j] = f2bf(x1 * cs - x2 * sn); q[16 + j] = f2bf(x1 * sn + x2 * cs);
    }
}
DI void phase_mla_attn(KParamsPtr p, LAS unsigned char* lds) {
    const int tid = TIDX(), lane = tid & 63, wave = tid >> 6;
    LAS float* qs = (LAS float*)lds + wave * 640;
    LAS float* ps = qs + 384;
    const float scale = 0.10206207261596577f;
    for (int item_ = BIDX() * 8 + wave; item_ < NB * 8 * (SEQ / 4); item_ += NBLK() * 8) {
        const int item = __builtin_amdgcn_readfirstlane(item_);
        const int s0 = (item & 1023) * 4, h = (item >> 10) & 7, b = item >> 13, t0 = b * SEQ + s0;
        for (int i = lane; i < 384; i += 64) { const int g = i / 96, c = i % 96; qs[i] = bf2f(p->mla_q[(size_t)(t0 + g) * 768 + h * 96 + c]); }
        asm volatile("s_waitcnt lgkmcnt(0)" ::: "memory");
        float m[4] = {-1e30f, -1e30f, -1e30f, -1e30f}, l[4] = {0.f, 0.f, 0.f, 0.f}, o[4] = {0.f, 0.f, 0.f, 0.f};
        const bf16_t* KV = p->mla_kv + (size_t)b * SEQ * 1024 + h * 128; const bf16_t* PE = p->mla_kpe + (size_t)b * SEQ * 32;
        for (int j = 0; j <= (s0 + 3) >> 6; ++j) { const int k0 = j * 64;
            naive_attn_block<96>(lane, qs, ps, scale,
                [&](int c8) { return c8 < 8 ? KV + (size_t)(k0 + lane) * 1024 + c8 * 8 : PE + (size_t)(k0 + lane) * 32 + (c8 - 8) * 8; },
                [&](int key, int d) { return bf2f(KV[(size_t)(k0 + key) * 1024 + 64 + d]); },
                [&](int g, int key) { return k0 + key <= s0 + g; }, m, l, o); }
#pragma unroll
        for (int g = 0; g < 4; ++g) { const float lt = wsum(l[g]); p->ys[(size_t)3 * T * 512 + (size_t)(t0 + g) * 512 + h * 64 + lane] = f2bf(o[g] / lt); }
    }
}

DI void phase_scan_rwkv(KParamsPtr p, LAS unsigned char* lds) {
    const int tid = TIDX(), bid = BIDX();
    if (bid < 32) {
        if (tid >= 64) return;
        const int b = bid >> 3, h = bid & 7, lane = tid;
        LAS float* L = (LAS float*)lds;
        float st[64];
#pragma unroll
        for (int j = 0; j < 64; ++j) st[j] = 0.f;
        size_t o = (size_t)b * SEQ * 512 + h * 64 + lane;
        float nkk = p->rw_kk[o], nw = p->rw_w[o], nk = bf2f(p->rw_k[o]), nb = p->rw_b[o], nr = bf2f(p->rw_r[o]), nv = bf2f(p->rw_v[o]);
        for (int s = 0; s < SEQ; ++s) {
            L[lane] = nkk; L[64 + lane] = nw; L[128 + lane] = nk; L[192 + lane] = nb; L[256 + lane] = nr;
            const float v = nv; const size_t oc = o;
            if (s + 1 < SEQ) { o += 512; nkk = p->rw_kk[o]; nw = p->rw_w[o]; nk = bf2f(p->rw_k[o]); nb = p->rw_b[o]; nr = bf2f(p->rw_r[o]); nv = bf2f(p->rw_v[o]); }
            asm volatile("s_waitcnt lgkmcnt(0)" ::: "memory");
            float skk = 0.f;
#pragma unroll
            for (int j4 = 0; j4 < 16; ++j4) { const f32x4 kk = *(const LAS f32x4*)(L + j4 * 4);
                skk += st[j4 * 4] * kk[0] + st[j4 * 4 + 1] * kk[1] + st[j4 * 4 + 2] * kk[2] + st[j4 * 4 + 3] * kk[3]; }
            float y = 0.f;
#pragma unroll
            for (int j4 = 0; j4 < 16; ++j4) { const f32x4 w = *(const LAS f32x4*)(L + 64 + j4 * 4), k = *(const LAS f32x4*)(L + 128 + j4 * 4), bb = *(const LAS f32x4*)(L + 192 + j4 * 4), r = *(const LAS f32x4*)(L + 256 + j4 * 4);
#pragma unroll
                for (int q = 0; q < 4; ++q) { const float ns = st[j4 * 4 + q] * w[q] - skk * bb[q] + v * k[q]; st[j4 * 4 + q] = ns; y += ns * r[q]; }
                if ((j4 & 3) == 3) asm volatile("" ::: "memory"); }
            p->rw_y[oc] = y;
            asm volatile("s_waitcnt lgkmcnt(0)" ::: "memory");
        }
    }
}
DI void phase_scan_gla(KParamsPtr p, LAS unsigned char* lds) {
    const int tid = TIDX(), bid = BIDX();
    if (bid >= 32 && bid < 48) {
        if (tid >= 128) return;
        const int bh = bid - 32, b = bh >> 2, h = bh & 3, e = tid, lane = tid & 63, wave = tid >> 6;
        LAS float* L = (LAS float*)lds + wave * 192;
        float st[64];
#pragma unroll
        for (int j = 0; j < 64; ++j) st[j] = 0.f;
        const bf16_t* P1 = p->P1;
        for (int s = 0; s < SEQ; ++s) {
            const int t = b * SEQ + s;
            L[lane] = __expf(p->gla_la[(size_t)t * 256 + h * 64 + lane]); L[64 + lane] = ldP(P1, t, C_GLA_K + h * 64 + lane); L[128 + lane] = ldP(P1, t, C_GLA_Q + h * 64 + lane) * 0.125f;
            const float v = ldP(P1, t, C_GLA_V + h * 128 + e);
            asm volatile("s_waitcnt lgkmcnt(0)" ::: "memory");
            float y = 0.f;
#pragma unroll
            for (int j4 = 0; j4 < 16; ++j4) { const f32x4 dc = *(const LAS f32x4*)(L + j4 * 4), k = *(const LAS f32x4*)(L + 64 + j4 * 4), q = *(const LAS f32x4*)(L + 128 + j4 * 4);
#pragma unroll
                for (int qq = 0; qq < 4; ++qq) { const float ns = st[j4 * 4 + qq] * dc[qq] + k[qq] * v; st[j4 * 4 + qq] = ns; y += ns * q[qq]; }
                if ((j4 & 3) == 3) asm volatile("" ::: "memory"); }
            p->gla_o[(size_t)t * 512 + h * 128 + e] = y;
            asm volatile("s_waitcnt lgkmcnt(0)" ::: "memory");
        }
    }
}

DI void phase_scans(KParamsPtr p, LAS unsigned char* lds) { phase_scan_rwkv(p, lds); phase_scan_gla(p, lds); }

DI void phase_post(KParamsPtr p, int l, LAS unsigned char* lds, int wg_skip) {
    const int tid = TIDX(), lane = tid & 63, wave = tid >> 6;
    if (BIDX() < wg_skip) return;
    const int nw = (NBLK() - wg_skip) * 8;
    float ln_w[8], ln_b[8], r_k[8], gg[8];
    ld8f(p->rw_ln_w + l * 512 + lane * 8, ln_w); ld8f(p->rw_ln_b + l * 512 + lane * 8, ln_b); ld8f(p->rw_r_k + l * 512 + lane * 8, r_k); ld8f(p->gla_g + l * 512 + lane * 8, gg);
    for (int tb = (BIDX() - wg_skip) * 8 + wave; tb < T; tb += 2 * nw) {
        float y[2][8], rr[2][8], kk[2][8], vv[2][8], g4[2][8], ov[2][8], gr[2][8]; bool ok[2];
#pragma unroll
        for (int q = 0; q < 2; ++q) { const int t = tb + q * nw; ok[q] = t < T; const size_t o = (size_t)(ok[q] ? t : 0) * 512 + lane * 8;
            ld8f(p->rw_y + o, y[q]); ld8bf(p->rw_r + o, rr[q]); ld8bf(p->rw_k + o, kk[q]); ld8bf(p->rw_v + o, vv[q]); ld8bf(p->rw_g + o, g4[q]); ld8f(p->gla_o + o, ov[q]);
            ld8bf(p->P1 + (size_t)(ok[q] ? t : 0) * NP1P + C_GLA_R + lane * 8, gr[q]); }
#pragma unroll
        for (int q = 0; q < 2; ++q) { const size_t o = (size_t)(tb + q * nw) * 512 + lane * 8;
            float sm = 0.f, sb = 0.f, so = 0.f;
#pragma unroll
            for (int e = 0; e < 8; ++e) { sm += y[q][e]; sb += rr[q][e] * kk[q][e] * r_k[e]; so += ov[q][e] * ov[q][e]; }
#pragma unroll
            for (int m = 1; m <= 4; m <<= 1) { sm += __shfl_xor(sm, m); sb += __shfl_xor(sb, m); so += __shfl_xor(so, m); }
            so += __shfl_xor(so, 8);
            const float mean = sm * (1.0f / 64.0f);
            float sv = 0.f;
#pragma unroll
            for (int e = 0; e < 8; ++e) { y[q][e] -= mean; sv += y[q][e] * y[q][e]; }
#pragma unroll
            for (int m = 1; m <= 4; m <<= 1) sv += __shfl_xor(sv, m);
            const float rstd = rsqrtf(sv * (1.0f / 64.0f) + 64e-5f), rs = rsqrtf(so * (1.0f / 128.0f) + NORM_EPS);
            float o1[8], o2[8];
#pragma unroll
            for (int e = 0; e < 8; ++e) { o1[e] = ((y[q][e] * rstd * ln_w[e] + ln_b[e]) + sb * vv[q][e]) * g4[q][e] * ZRWKV;
                o2[e] = ov[q][e] * rs * gg[e] * (gr[q][e] * sigmoidf_(gr[q][e])) * ZGLA; }
            if (ok[q]) { *(u32x4*)(p->ys + (size_t)1 * T * 512 + o) = pack8bf(o1); *(u32x4*)(p->ys + (size_t)2 * T * 512 + o) = pack8bf(o2); } }
    }
}

DI void unpack8(const u32x4 w, float (&f)[8]) {
    f[0] = __uint_as_float(w.x << 16); f[1] = __uint_as_float(w.x & 0xffff0000u); f[2] = __uint_as_float(w.y << 16); f[3] = __uint_as_float(w.y & 0xffff0000u);
    f[4] = __uint_as_float(w.z << 16); f[5] = __uint_as_float(w.z & 0xffff0000u); f[6] = __uint_as_float(w.w << 16); f[7] = __uint_as_float(w.w & 0xffff0000u);
}
DI void phase_mergesum(const bf16_t* G, const bf16_t* part01, const bf16_t* part23, bf16_t* merged) {
    const size_t n8 = (size_t)T * 2048 / 8;
    for (size_t i = (size_t)BIDX() * 512 + TIDX(); i < n8; i += (size_t)NBLK() * 512) {
        const size_t t = i >> 8, c = (i & 255) * 8;
        float acc[8] = {0.f, 0.f, 0.f, 0.f, 0.f, 0.f, 0.f, 0.f};
#pragma unroll
        for (int br = 0; br < 4; ++br) {
            const u32x4 gw = *(const u32x4*)(G + t * NGATE + br * 2048 + c);
            const u32x4 pw = *(const u32x4*)((br < 2 ? part01 : part23) + (size_t)(br & 1) * T * 2048 + t * 2048 + c);
            float g[8], q[8]; unpack8(gw, g); unpack8(pw, q);
#pragma unroll
            for (int j = 0; j < 8; ++j) acc[j] += g[j] * q[j];
        }
        u32x4 w; w.x = pk2(acc[0], acc[1]); w.y = pk2(acc[2], acc[3]); w.z = pk2(acc[4], acc[5]); w.w = pk2(acc[6], acc[7]);
        *(u32x4*)(merged + t * 2048 + c) = w;
    }
}
#ifndef ZSLC
#define ZSLC 1.0f
#endif
#ifndef ZWIN
#define ZWIN 1.0f
#endif
#ifndef ZCMP
#define ZCMP 1.0f
#endif
#ifndef ZMLA
#define ZMLA 1.0f
#endif
typedef short v4i16_t_ __attribute__((ext_vector_type(4)));
template <int DQ, int NDV = 4> struct FlashGeo {
    static constexpr int KS = DQ * 2 + 32;
    static constexpr int VS = 160;
    static constexpr int KBYTES = 64 * KS, VBYTES = 64 * VS, BUF = KBYTES + VBYTES;
};
template <int NDV> struct FlashAccT { f32x4 O[2][NDV]; float m[2], l[2]; };
typedef FlashAccT<4> FlashAcc;
template <int NDV> DI void flash_reset(FlashAccT<NDV>& a) {
#pragma unroll
    for (int rg = 0; rg < 2; ++rg) { a.m[rg] = -1e30f; a.l[rg] = 0.f;
#pragma unroll
        for (int d = 0; d < NDV; ++d) a.O[rg][d] = (f32x4){0.f, 0.f, 0.f, 0.f}; }
}
template <int DQ> struct FlashStage { u32x4 k, k2, v; };
template <int DQ, class KRow, class PRow, class VRow>
DI void flash_stage_load(FlashStage<DQ>& st, int tid, KRow krow, PRow prow, VRow vrow) {
    int r = tid >> 3, c = tid & 7;
    asm volatile("" : "+v"(r), "+v"(c));
    st.k = *(const u32x4*)(krow(r) + c * 8);
    if (DQ == 96) { if (c < 4) st.k2 = *(const u32x4*)(prow(r) + c * 8); }
    st.v = *(const u32x4*)(vrow(r) + c * 8);
}
template <int DQ>
DI void flash_stage_write(const FlashStage<DQ>& st, int tid, LAS unsigned char* buf) {
    typedef FlashGeo<DQ> G;
    const int r = tid >> 3, c = tid & 7;
    *(LAS u32x4*)(buf + r * G::KS + c * 16) = st.k;
    if (DQ == 96) { if (c < 4) *(LAS u32x4*)(buf + r * G::KS + 128 + c * 16) = st.k2; }
    *(LAS u32x4*)(buf + G::KBYTES + r * G::VS + c * 16) = st.v;
}
#ifndef FLASH_FENCE
#define FLASH_FENCE 1
#endif
template <int DQ, int NDV, int MODE, class Mask>
DI void flash_tile_n(LAS const unsigned char* buf, const bf16x8 (&Q)[2][DQ / 32], FlashAccT<NDV>& a, float sc2, int lane, Mask mask) {
    typedef FlashGeo<DQ, NDV> G;
    const int fr = lane & 15, q4 = lane >> 4;
    f32x4 S[2][4];
#pragma unroll
    for (int rg = 0; rg < 2; ++rg)
#pragma unroll
        for (int kb = 0; kb < 4; ++kb) S[rg][kb] = (f32x4){0.f, 0.f, 0.f, 0.f};
#pragma unroll
    for (int kb = 0; kb < 4; ++kb)
#pragma unroll
        for (int ks = 0; ks < DQ / 32; ++ks) {
            const bf16x8 kf = *(const LAS bf16x8*)(buf + (kb * 16 + fr) * G::KS + (ks * 32 + q4 * 8) * 2);
#pragma unroll
            for (int rg = 0; rg < 2; ++rg) S[rg][kb] = __builtin_amdgcn_mfma_f32_16x16x32_bf16(kf, Q[rg][ks], S[rg][kb], 0, 0, 0);
            if (false && FLASH_FENCE && DQ == 64 && ks == DQ / 32 - 1 && (kb & 1)) asm volatile("" ::: "memory");
        }
    bf16x8 P[2][2];
#pragma unroll
    for (int rg = 0; rg < 2; ++rg) {
        constexpr bool FULL = (MODE == 1);
        float mx = -1e30f; const bool rowok = (MODE == 2) ? mask(rg, 0) : true;
        if (FULL || MODE == 2) {
#pragma unroll
            for (int kb = 0; kb < 4; ++kb) mx = fmaxf(mx, fmaxf(fmaxf(S[rg][kb][0], S[rg][kb][1]), fmaxf(S[rg][kb][2], S[rg][kb][3])));
            if (MODE == 2) mx = rowok ? mx : -1e30f;
        } else {
#pragma unroll
        for (int kb = 0; kb < 4; ++kb)
#pragma unroll
            for (int j = 0; j < 4; ++j) { const float sv = mask(rg, kb * 16 + q4 * 4 + j) ? S[rg][kb][j] : -1e30f; S[rg][kb][j] = sv; mx = fmaxf(mx, sv); }
        }
        { auto r16 = __builtin_amdgcn_permlane16_swap(__float_as_uint(mx), __float_as_uint(mx), false, false); mx = fmaxf(__uint_as_float(r16[0]), __uint_as_float(r16[1]));
          auto r32 = __builtin_amdgcn_permlane32_swap(__float_as_uint(mx), __float_as_uint(mx), false, false); mx = fmaxf(__uint_as_float(r32[0]), __uint_as_float(r32[1])); }
        mx = fmaxf(mx * sc2, -1e30f);
        const bool dead = mx < -1e29f;
        const float mo = a.m[rg]; const bool mv = !dead && mx > mo + 8.0f; const float mn = mv ? mx : mo;
        a.m[rg] = mn;
        const float mexp = dead ? 1e30f : mn;
        if (__builtin_amdgcn_ballot_w64(mv) != 0ull) { const float corr = __builtin_amdgcn_exp2f(mo - mn);
            a.l[rg] *= corr;
#pragma unroll
            for (int d = 0; d < NDV; ++d) a.O[rg][d] *= corr; }
        float ps = 0.f;
#pragma unroll
        for (int kb = 0; kb < 4; ++kb)
#pragma unroll
            for (int j = 0; j < 4; ++j) { const float pv = __builtin_amdgcn_exp2f(__builtin_fmaf(S[rg][kb][j], sc2, -(FULL ? mn : mexp))); S[rg][kb][j] = pv; ps += pv; }
        a.l[rg] += ps;
#pragma unroll
        for (int pb = 0; pb < 2; ++pb) { u32x4 w;
            w.x = cvt_pk_bf16(S[rg][2 * pb][0], S[rg][2 * pb][1]); w.y = cvt_pk_bf16(S[rg][2 * pb][2], S[rg][2 * pb][3]);
            w.z = cvt_pk_bf16(S[rg][2 * pb + 1][0], S[rg][2 * pb + 1][1]); w.w = cvt_pk_bf16(S[rg][2 * pb + 1][2], S[rg][2 * pb + 1][3]);
            P[rg][pb] = __builtin_bit_cast(bf16x8, w); }
    }
    LAS const unsigned char* vt = buf + G::KBYTES;
#pragma unroll
    for (int pb = 0; pb < 2; ++pb)
#pragma unroll
        for (int dvb = 0; dvb < NDV; ++dvb) {
            LAS const unsigned char* vl = vt + (4 * q4 + (fr >> 2)) * G::VS + (fr & 3) * 8;
            const u32x2 lo = __builtin_bit_cast(u32x2, __builtin_amdgcn_ds_read_tr16_b64_v4i16((LAS v4i16_t_*)(vl + (32 * pb) * G::VS + dvb * 32)));
            const u32x2 hi = __builtin_bit_cast(u32x2, __builtin_amdgcn_ds_read_tr16_b64_v4i16((LAS v4i16_t_*)(vl + (32 * pb + 16) * G::VS + dvb * 32)));
            const u32x4 w = (u32x4){lo.x, lo.y, hi.x, hi.y};
            const bf16x8 vf = __builtin_bit_cast(bf16x8, w);
#pragma unroll
            for (int rg = 0; rg < 2; ++rg) a.O[rg][dvb] = __builtin_amdgcn_mfma_f32_16x16x32_bf16(vf, P[rg][pb], a.O[rg][dvb], 0, 0, 0);
        }
}
template <int DQ, class Mask>
DI void flash_tile(LAS const unsigned char* buf, const bf16x8 (&Q)[2][DQ / 32], FlashAcc& a, float sc2, int lane, Mask mask) { flash_tile_n<DQ, 4, 0>(buf, Q, a, sc2, lane, mask); }
template <int DQ>
DI void flash_tile_full(LAS const unsigned char* buf, const bf16x8 (&Q)[2][DQ / 32], FlashAcc& a, float sc2, int lane) { flash_tile_n<DQ, 4, 1>(buf, Q, a, sc2, lane, [](int, int) { return true; }); }
template <int DQ, class Mask>
DI void flash_tile_row(LAS const unsigned char* buf, const bf16x8 (&Q)[2][DQ / 32], FlashAcc& a, float sc2, int lane, Mask mask) { flash_tile_n<DQ, 4, 2>(buf, Q, a, sc2, lane, mask); }
DI float flash_lsum(float l) { l += __shfl_xor(l, 16); l += __shfl_xor(l, 32); return l; }

DI void bf8_to_f(const u32x4 w, f32x4& a, f32x4& b);
DI void phase_mla_flash(KParamsPtr p, LAS unsigned char* lds) {
    typedef FlashGeo<96> G;
    const int tid = TIDX(), lane = tid & 63, wave = __builtin_amdgcn_readfirstlane(tid >> 6), fr = lane & 15, q4 = lane >> 4;
    const float sc2 = 0.10206207261596577f * 1.4426950408889634f;
    const bf16_t* mq = p->mla_q; const bf16_t* mkv = p->mla_kv; const bf16_t* mpe = p->mla_kpe; bf16_t* yo = p->ys + (size_t)3 * T * 512;
    for (int c0 = BIDX(); c0 < 256; c0 += NBLK()) {
        const int c = NBLK() == 256 ? ((c0 & 7) * 32 + (c0 >> 3)) : c0;
        const int bh = c >> 3, b = bh >> 3, h = bh & 7;
#pragma unroll 1
        for (int half = 0; half < 2; ++half) {
            const int qt = half ? 15 - (c & 7) : (c & 7), q0 = qt * 256;
            const int tok0 = q0 + wave * 32 + fr;
            bf16x8 Q[2][3];
#pragma unroll
            for (int rg = 0; rg < 2; ++rg)
#pragma unroll
                for (int ks = 0; ks < 3; ++ks) Q[rg][ks] = *(const bf16x8*)(mq + (size_t)(b * SEQ + tok0 + rg * 16) * 768 + h * 96 + ks * 32 + q4 * 8);
#pragma unroll
            for (int rg = 0; rg < 2; ++rg) {
                const u32x4 mine = __builtin_bit_cast(u32x4, Q[rg][2]);
                u32x4 oth; oth.x = (unsigned)__shfl_xor((int)mine.x, 32); oth.y = (unsigned)__shfl_xor((int)mine.y, 32); oth.z = (unsigned)__shfl_xor((int)mine.z, 32); oth.w = (unsigned)__shfl_xor((int)mine.w, 32);
                f32x4 ma, mb, oa, ob; bf8_to_f(mine, ma, mb); bf8_to_f(oth, oa, ob);
                const size_t ti = (size_t)(tok0 + rg * 16) * 16 + (q4 & 1) * 8;
                const f32x4 ca = *(const f32x4*)(p->cos32 + ti), cb = *(const f32x4*)(p->cos32 + ti + 4), sa = *(const f32x4*)(p->sin32 + ti), sb = *(const f32x4*)(p->sin32 + ti + 4);
                const float sg = q4 < 2 ? -1.0f : 1.0f;
                const f32x4 ra = ma * ca + oa * sa * sg, rb = mb * cb + ob * sb * sg;
                u32x4 w; w.x = cvt_pk_bf16(ra[0], ra[1]); w.y = cvt_pk_bf16(ra[2], ra[3]); w.z = cvt_pk_bf16(rb[0], rb[1]); w.w = cvt_pk_bf16(rb[2], rb[3]);
                Q[rg][2] = __builtin_bit_cast(bf16x8, w); }
            FlashAcc a; flash_reset(a);
            const int nt = (q0 + 256) / 64;
            const bf16_t* kvb = mkv + (size_t)b * SEQ * 1024 + h * 128; const bf16_t* peb = mpe + (size_t)b * SEQ * 32;
            FlashStage<96> st;
            flash_stage_load<96>(st, tid, [&](int r) { return kvb + (size_t)r * 1024; }, [&](int r) { return peb + (size_t)r * 32; }, [&](int r) { return kvb + (size_t)r * 1024 + 64; });
            __syncthreads();
            flash_stage_write<96>(st, tid, lds);
            __syncthreads();
            for (int i = 0; i < nt; ++i) {
                const int k0 = i * 64;
                if (i + 1 < nt) flash_stage_load<96>(st, tid, [&](int r) { return kvb + (size_t)(k0 + 64 + r) * 1024; }, [&](int r) { return peb + (size_t)(k0 + 64 + r) * 32; }, [&](int r) { return kvb + (size_t)(k0 + 64 + r) * 1024 + 64; });
                if (k0 <= q0 + wave * 32 + 31) {
                    int d0 = tok0 - k0, d1 = tok0 - k0 + 16;
                    asm volatile("" : "+v"(d0), "+v"(d1));
                    if (k0 + 63 <= q0 + wave * 32) flash_tile_full<96>(lds + (i & 1) * G::BUF, Q, a, sc2, lane);
                    else flash_tile<96>(lds + (i & 1) * G::BUF, Q, a, sc2, lane, [&](int rg, int kidx) { return kidx <= (rg ? d1 : d0); });
                }
                if (i + 1 < nt) flash_stage_write<96>(st, tid, lds + ((i + 1) & 1) * G::BUF);
                __syncthreads();
            }
#pragma unroll
            for (int rg = 0; rg < 2; ++rg) { const float inv = 1.0f / flash_lsum(a.l[rg]);
                bf16_t* op = yo + (size_t)(b * SEQ + tok0 + rg * 16) * 512 + h * 64 + q4 * 4;
#pragma unroll
                for (int d = 0; d < 4; ++d) { u32x2 w; w.x = cvt_pk_bf16(a.O[rg][d][0] * inv * ZMLA, a.O[rg][d][1] * inv * ZMLA); w.y = cvt_pk_bf16(a.O[rg][d][2] * inv * ZMLA, a.O[rg][d][3] * inv * ZMLA);
                    *(u32x2*)(op + d * 16) = w; } }
        }
    }
}

DI void phase_nsa_flash(KParamsPtr p, LAS unsigned char* lds) {
    typedef FlashGeo<64> G;
    const int tid = TIDX(), lane = tid & 63, wave = __builtin_amdgcn_readfirstlane(tid >> 6), fr = lane & 15, q4 = lane >> 4;
    const float sc2 = 0.125f * 1.4426950408889634f;
    LAS unsigned* um = (LAS unsigned*)(lds + 2 * G::BUF);
    const bf16_t* nq = p->nsa_q; const unsigned long long* selp = p->nsa_sel; const float* gat = p->nsa_gate; const float* ocmp = p->nsa_ocmp; bf16_t* yo = p->ys;
    for (int c = BIDX(); c < 256; c += NBLK()) {
        const int bh = c >> 5, b = bh >> 1, hk = bh & 1;
        const bf16_t* Ks = p->nsa_ks + (size_t)bh * SEQ * 64; const bf16_t* Vs = p->nsa_vs + (size_t)bh * SEQ * 64;
        const bf16_t* Kw = p->nsa_kw + (size_t)bh * SEQ * 64; const bf16_t* Vw = p->nsa_vw + (size_t)bh * SEQ * 64;
#pragma unroll 1
        for (int half = 0; half < 2; ++half) {
            const int cur = half ? 63 - (c & 31) : (c & 31), s0 = cur * 64, g = wave >> 1, head = hk * 4 + g;
            const int qi0 = (wave & 1) * 32 + fr;
            const size_t t0 = (size_t)b * SEQ + s0 + qi0;
            bf16x8 Q[2][2];
#pragma unroll
            for (int rg = 0; rg < 2; ++rg)
#pragma unroll
                for (int ks = 0; ks < 2; ++ks) Q[rg][ks] = *(const bf16x8*)(nq + (t0 + rg * 16) * 512 + head * 64 + ks * 32 + q4 * 8);
            unsigned long long sel[2];
#pragma unroll
            for (int rg = 0; rg < 2; ++rg) sel[rg] = selp[(size_t)bh * SEQ + s0 + qi0 + rg * 16];
            if (wave == 0) {
                unsigned long long u = selp[(size_t)bh * SEQ + s0 + lane];
                unsigned lo = (unsigned)u, hi = (unsigned)(u >> 32);
#pragma unroll
                for (int o = 32; o >= 1; o >>= 1) { lo |= (unsigned)__shfl_xor((int)lo, o); hi |= (unsigned)__shfl_xor((int)hi, o); }
                if (lane == 0) { um[0] = lo; um[1] = hi; }
            }
            __syncthreads();
            unsigned long long uni = ((unsigned long long)um[1] << 32) | um[0];
            uni &= (cur >= 63) ? ~0ull : ((1ull << (cur + 1)) - 1ull);
            uni = ((unsigned long long)(unsigned)__builtin_amdgcn_readfirstlane((int)(uni >> 32)) << 32) | (unsigned)__builtin_amdgcn_readfirstlane((int)uni);
            float res[2][4][4];
            {
                FlashAcc a; flash_reset(a);
                FlashStage<64> st;
                unsigned long long rem = uni;
                int j = __builtin_ctzll(rem); rem &= rem - 1;
                flash_stage_load<64>(st, tid, [&](int r) { return Ks + (size_t)(j * 64 + r) * 64; }, [&](int r) { return Ks; }, [&](int r) { return Vs + (size_t)(j * 64 + r) * 64; });
                flash_stage_write<64>(st, tid, lds);
                __syncthreads();
                int i = 0;
                for (;;) {
                    const bool more = rem != 0ull;
                    int jn = 0;
                    if (more) { jn = __builtin_ctzll(rem); rem &= rem - 1;
                        flash_stage_load<64>(st, tid, [&](int r) { return Ks + (size_t)(jn * 64 + r) * 64; }, [&](int r) { return Ks; }, [&](int r) { return Vs + (size_t)(jn * 64 + r) * 64; }); }
                    { const bool diag = (j == cur);
                      const bool in0 = (sel[0] >> j) & 1ull, in1 = (sel[1] >> j) & 1ull;
                      int l0 = in0 ? (diag ? qi0 : 64) : -1, l1 = in1 ? (diag ? qi0 + 16 : 64) : -1;
                      asm volatile("" : "+v"(l0), "+v"(l1));
                      if (diag) flash_tile<64>(lds + (i & 1) * G::BUF, Q, a, sc2, lane, [&](int rg, int kidx) { return kidx <= (rg ? l1 : l0); });
                      else flash_tile_row<64>(lds + (i & 1) * G::BUF, Q, a, sc2, lane, [&](int rg, int) { return (rg ? l1 : l0) >= 0; }); }
                    if (more) flash_stage_write<64>(st, tid, lds + ((i + 1) & 1) * G::BUF);
                    __syncthreads();
                    if (!more) break;
                    j = jn; ++i;
                }
#pragma unroll
                for (int rg = 0; rg < 2; ++rg) { const float gt = gat[(t0 + rg * 16) * 24 + head * 3 + 1] / flash_lsum(a.l[rg]);
#pragma unroll
                    for (int d = 0; d < 4; ++d)
#pragma unroll
                        for (int e = 0; e < 4; ++e) res[rg][d][e] = a.O[rg][d][e] * gt * ZSLC; }
            }
            {
                FlashAcc a; flash_reset(a);
                FlashStage<64> st;
                const int jlo = cur >= 8 ? cur - 8 : 0;
                flash_stage_load<64>(st, tid, [&](int r) { return Kw + (size_t)(jlo * 64 + r) * 64; }, [&](int r) { return Kw; }, [&](int r) { return Vw + (size_t)(jlo * 64 + r) * 64; });
                flash_stage_write<64>(st, tid, lds);
                __syncthreads();
                for (int j = jlo, i = 0; j <= cur; ++j, ++i) {
                    if (j < cur) flash_stage_load<64>(st, tid, [&](int r) { return Kw + (size_t)((j + 1) * 64 + r) * 64; }, [&](int r) { return Kw; }, [&](int r) { return Vw + (size_t)((j + 1) * 64 + r) * 64; });
                    { const bool diag = (j == cur), tail = (j == cur - 8);
                      int h0 = diag ? qi0 : 64, h1 = diag ? qi0 + 16 : 64, t0_ = tail ? qi0 : -1, t1_ = tail ? qi0 + 16 : -1;
                      asm volatile("" : "+v"(h0), "+v"(h1), "+v"(t0_), "+v"(t1_));
                      flash_tile<64>(lds + (i & 1) * G::BUF, Q, a, sc2, lane, [&](int rg, int kidx) { return kidx <= (rg ? h1 : h0) && kidx > (rg ? t1_ : t0_); }); }
                    if (j < cur) flash_stage_write<64>(st, tid, lds + ((i + 1) & 1) * G::BUF);
                    __syncthreads();
                }
#pragma unroll
                for (int rg = 0; rg < 2; ++rg) { const float gt = gat[(t0 + rg * 16) * 24 + head * 3 + 2] / flash_lsum(a.l[rg]);
#pragma unroll
                    for (int d = 0; d < 4; ++d)
#pragma unroll
                        for (int e = 0; e < 4; ++e) res[rg][d][e] += a.O[rg][d][e] * gt * ZWIN; }
            }
#pragma unroll
            for (int rg = 0; rg < 2; ++rg) { const float g0 = gat[(t0 + rg * 16) * 24 + head * 3] * ZCMP;
                const size_t ob = (t0 + rg * 16) * 512 + head * 64 + q4 * 4;
#pragma unroll
                for (int d = 0; d < 4; ++d) { const f32x4 oc = *(const f32x4*)(ocmp + ob + d * 16);
                    u32x2 w; w.x = cvt_pk_bf16(res[rg][d][0] + g0 * oc[0], res[rg][d][1] + g0 * oc[1]); w.y = cvt_pk_bf16(res[rg][d][2] + g0 * oc[2], res[rg][d][3] + g0 * oc[3]);
                    *(u32x2*)(yo + ob + d * 16) = w; } }
            __syncthreads();
        }
    }
}

DI void phase_nsa_full(KParamsPtr p, LAS unsigned char* lds) {
    typedef FlashGeo<64> G;
    const int tid = TIDX(), lane = tid & 63, wave = __builtin_amdgcn_readfirstlane(tid >> 6), fr = lane & 15, q4 = lane >> 4;
    const float sc2 = 0.125f * 1.4426950408889634f;
    LAS float* impbuf = (LAS float*)(lds + 2 * G::BUF);
    LAS unsigned long long* selbuf = (LAS unsigned long long*)(lds + 2 * G::BUF + 65536);
    LAS unsigned* um = (LAS unsigned*)(lds + 2 * G::BUF + 65536 + 512);
    const float* kcp = p->nsa_kc; const float* vcp = p->nsa_vc;
    LAS float* rs = impbuf + tid;
    const bf16_t* nq = p->nsa_q; const float* gat = p->nsa_gate; bf16_t* yo = p->ys;
    for (int c0 = BIDX(); c0 < 256; c0 += NBLK()) {
        const int c = NBLK() == 256 ? ((c0 & 7) * 32 + (c0 >> 3)) : c0;
        const int bh = c >> 5, b = bh >> 1, hk = bh & 1;
        const bf16_t* Ks = p->nsa_ks + (size_t)bh * SEQ * 64; const bf16_t* Vs = p->nsa_vs + (size_t)bh * SEQ * 64;
        const bf16_t* Kw = p->nsa_kw + (size_t)bh * SEQ * 64; const bf16_t* Vw = p->nsa_vw + (size_t)bh * SEQ * 64;
#pragma unroll 1
        for (int half = 0; half < 2; ++half) {
            const int cur = half ? 63 - (c & 31) : (c & 31), s0 = cur * 64, g = wave >> 1, head = hk * 4 + g;
            const int qi0 = (wave & 1) * 32 + fr;
            const size_t t0 = (size_t)b * SEQ + s0 + qi0;
            int q4l = q4; asm volatile("" : "+v"(q4l));
            bf16x8 Q[2][2];
#pragma unroll
            for (int rg = 0; rg < 2; ++rg)
#pragma unroll
                for (int ks = 0; ks < 2; ++ks) Q[rg][ks] = *(const bf16x8*)(nq + (t0 + rg * 16) * 512 + head * 64 + ks * 32 + q4l * 8);
            unsigned long long sel[2];
            {
                const int nvmax = min(255, (s0 + 32) / 16 + 1), ntc = (nvmax + 63) >> 6;
                int nv[2];
#pragma unroll
                for (int rg = 0; rg < 2; ++rg) { const int tk = s0 + qi0 + rg * 16; nv[rg] = tk >= 31 ? min(255, (tk - 31) / 16 + 1) : 0; }
#pragma unroll 1
                for (int it = 0; it < 2; ++it) { const int pz = 1 - it;
                    FlashAcc a0; flash_reset(a0);
                    u32x4 sk, sv;
                    auto ld0 = [&](int tl) { int r = tid >> 3, c8 = tid & 7; asm volatile("" : "+v"(r), "+v"(c8)); const size_t o = ((size_t)bh * 256 + tl * 64 + r) * 64 + c8 * 8;
                        const f32x4 k0 = *(const f32x4*)(kcp + o), k1 = *(const f32x4*)(kcp + o + 4);
                        sk = (u32x4){cvt_pk_bf16(k0[0], k0[1]), cvt_pk_bf16(k0[2], k0[3]), cvt_pk_bf16(k1[0], k1[1]), cvt_pk_bf16(k1[2], k1[3])};
                        if (pz == 0) { const f32x4 v0 = *(const f32x4*)(vcp + o), v1 = *(const f32x4*)(vcp + o + 4);
                            sv = (u32x4){cvt_pk_bf16(v0[0], v0[1]), cvt_pk_bf16(v0[2], v0[3]), cvt_pk_bf16(v1[0], v1[1]), cvt_pk_bf16(v1[2], v1[3])}; }
                        else { int n = tl * 64 + r; asm volatile("" : "+v"(n)); unsigned w[4];
#pragma unroll
                            for (int e2 = 0; e2 < 4; ++e2) { const int J0 = c8 * 8 + 2 * e2, J1 = J0 + 1;
                                const unsigned lo = (n >= 4 * J0 - 1 && n <= 4 * J0 + 3 && n < 255) ? 0x3F80u : 0u, hi = (n >= 4 * J1 - 1 && n <= 4 * J1 + 3 && n < 255) ? 0x3F80u : 0u; w[e2] = lo | (hi << 16); }
                            sv = (u32x4){w[0], w[1], w[2], w[3]}; } };
                    FlashStage<64> st0;
                    ld0(0); st0.k = sk; st0.v = sv;
                    flash_stage_write<64>(st0, tid, lds);
                    __syncthreads();
                    for (int tl = 0; tl < ntc; ++tl) {
                        if (tl + 1 < ntc) { ld0(tl + 1); st0.k = sk; st0.v = sv; }
                        { int n0 = nv[0] - tl * 64, n1 = nv[1] - tl * 64;
                          asm volatile("" : "+v"(n0), "+v"(n1));
                          flash_tile<64>(lds + (tl & 1) * G::BUF, Q, a0, sc2, lane, [&](int rg, int kidx) { return kidx < (rg ? n1 : n0); }); }
                        if (tl + 1 < ntc) flash_stage_write<64>(st0, tid, lds + ((tl + 1) & 1) * G::BUF);
                        __syncthreads();
                    }
#pragma unroll
                    for (int rg = 0; rg < 2; ++rg) { const float lt = flash_lsum(a0.l[rg]), inv = lt > 0.f ? 1.0f / lt : 0.f;
                        if (pz == 0) { const float g0 = gat[(t0 + rg * 16) * 24 + head * 3] * inv * ZCMP;
#pragma unroll
                            for (int d = 0; d < 4; ++d)
#pragma unroll
                                for (int e = 0; e < 4; ++e) rs[((rg * 4 + d) * 4 + e) * 512] = a0.O[rg][d][e] * g0; }
                        else {
#pragma unroll
                            for (int d = 0; d < 4; ++d) *(LAS f32x4*)(impbuf + ((size_t)(g * 64 + qi0 + rg * 16)) * 64 + d * 16 + q4 * 4) = a0.O[rg][d] * inv; } }
                    if (it == 0) {
            __syncthreads();
            for (int k = 0; k < 8; ++k) { const int tokl = wave * 8 + k;
                const float im = (impbuf[(0 * 64 + tokl) * 64 + lane] + impbuf[(1 * 64 + tokl) * 64 + lane]) + (impbuf[(2 * 64 + tokl) * 64 + lane] + impbuf[(3 * 64 + tokl) * 64 + lane]);
                const bool valid = lane <= cur, forced = valid && (lane == 0 || lane >= cur - 1);
                const float val = forced ? 1e30f : (valid ? im : -1e30f);
                int rank = 0;
                for (int jj = 0; jj < 64; ++jj) { const float o = __shfl(val, jj); rank += (o > val || (o == val && jj < lane)) ? 1 : 0; }
                const unsigned long long mk = __ballot(rank < 16);
                if (lane == 0) selbuf[tokl] = mk; }
            __syncthreads();
#pragma unroll
            for (int rg = 0; rg < 2; ++rg) sel[rg] = selbuf[qi0 + rg * 16];
            if (wave == 0) {
                unsigned long long u = selbuf[lane];
                unsigned lo = (unsigned)u, hi = (unsigned)(u >> 32);
#pragma unroll
                for (int o = 32; o >= 1; o >>= 1) { lo |= (unsigned)__shfl_xor((int)lo, o); hi |= (unsigned)__shfl_xor((int)hi, o); }
                if (lane == 0) { um[0] = lo; um[1] = hi; }
            }
            __syncthreads();
                    }
                }
            }
            __syncthreads();
            unsigned long long uni = ((unsigned long long)um[1] << 32) | um[0];
            uni &= (cur >= 63) ? ~0ull : ((1ull << (cur + 1)) - 1ull);
            uni = ((unsigned long long)(unsigned)__builtin_amdgcn_readfirstlane((int)(uni >> 32)) << 32) | (unsigned)__builtin_amdgcn_readfirstlane((int)uni);
            FlashAcc a; flash_reset(a);
            {
                FlashStage<64> st;
                unsigned long long rem = uni & ~(1ull << cur);
                if (rem != 0ull) {
                    int j = __builtin_ctzll(rem); rem &= rem - 1;
                    flash_stage_load<64>(st, tid, [&](int r) { return Ks + (size_t)(j * 64 + r) * 64; }, [&](int r) { return Ks; }, [&](int r) { return Vs + (size_t)(j * 64 + r) * 64; });
                    flash_stage_write<64>(st, tid, lds);
                    __syncthreads();
                    int i = 0;
                    for (;;) {
                        const bool more = rem != 0ull;
                        int jn = 0;
                        if (more) { jn = __builtin_ctzll(rem); rem &= rem - 1;
                            flash_stage_load<64>(st, tid, [&](int r) { return Ks + (size_t)(jn * 64 + r) * 64; }, [&](int r) { return Ks; }, [&](int r) { return Vs + (size_t)(jn * 64 + r) * 64; }); }
                        { int l0 = (int)((sel[0] >> j) & 1ull), l1 = (int)((sel[1] >> j) & 1ull);
                          asm volatile("" : "+v"(l0), "+v"(l1));
                          flash_tile_row<64>(lds + (i & 1) * G::BUF, Q, a, sc2, lane, [&](int rg, int) { return (rg ? l1 : l0) != 0; }); }
                        if (more) flash_stage_write<64>(st, tid, lds + ((i + 1) & 1) * G::BUF);
                        __syncthreads();
                        if (!more) break;
                        j = jn; ++i;
                    }
                }
            }
            {
                FlashStage<64> st;
                const int jlo = cur >= 8 ? cur - 8 : 0, ntw = cur - jlo + 1;
                flash_stage_load<64>(st, tid, [&](int r) { return Ks + (size_t)(cur * 64 + r) * 64; }, [&](int r) { return Ks; }, [&](int r) { return Vs + (size_t)(cur * 64 + r) * 64; });
                flash_stage_write<64>(st, tid, lds);
                __syncthreads();
                for (int i2 = 0; i2 <= ntw; ++i2) {
                    if (i2 < ntw) { const int jn = jlo + i2;
                        flash_stage_load<64>(st, tid, [&](int r) { return Kw + (size_t)(jn * 64 + r) * 64; }, [&](int r) { return Kw; }, [&](int r) { return Vw + (size_t)(jn * 64 + r) * 64; }); }
                    { const int j = i2 == 0 ? cur : jlo + i2 - 1; const bool diag = (j == cur), tail = (i2 > 0 && j == cur - 8);
                      int h0 = diag ? qi0 : 64, h1 = diag ? qi0 + 16 : 64, t0_ = tail ? qi0 : -1, t1_ = tail ? qi0 + 16 : -1;
                      asm volatile("" : "+v"(h0), "+v"(h1), "+v"(t0_), "+v"(t1_));
                      if (diag || tail) flash_tile<64>(lds + (i2 & 1) * G::BUF, Q, a, sc2, lane, [&](int rg, int kidx) { return kidx <= (rg ? h1 : h0) && kidx > (rg ? t1_ : t0_); });
                      else flash_tile_row<64>(lds + (i2 & 1) * G::BUF, Q, a, sc2, lane, [&](int rg, int) { return (rg ? h1 : h0) > 0; }); }
                    if (i2 < ntw) flash_stage_write<64>(st, tid, lds + ((i2 + 1) & 1) * G::BUF);
                    __syncthreads();
                    if (i2 == 0) {
#pragma unroll
                        for (int rg = 0; rg < 2; ++rg) { const float gt = gat[(t0 + rg * 16) * 24 + head * 3 + 1] / flash_lsum(a.l[rg]);
#pragma unroll
                            for (int d = 0; d < 4; ++d)
#pragma unroll
                                for (int e = 0; e < 4; ++e) rs[((rg * 4 + d) * 4 + e) * 512] += a.O[rg][d][e] * gt * ZSLC; }
                        flash_reset(a); }
                }
#pragma unroll
                for (int rg = 0; rg < 2; ++rg) { const float gt = gat[(t0 + rg * 16) * 24 + head * 3 + 2] / flash_lsum(a.l[rg]);
#pragma unroll
                    for (int d = 0; d < 4; ++d)
#pragma unroll
                        for (int e = 0; e < 4; ++e) rs[((rg * 4 + d) * 4 + e) * 512] += a.O[rg][d][e] * gt * ZWIN; }
            }
#pragma unroll
            for (int rg = 0; rg < 2; ++rg) { const size_t ob = (t0 + rg * 16) * 512 + head * 64 + q4l * 4;
#pragma unroll
                for (int d = 0; d < 4; ++d) { u32x2 w; w.x = cvt_pk_bf16(rs[((rg * 4 + d) * 4 + 0) * 512], rs[((rg * 4 + d) * 4 + 1) * 512]); w.y = cvt_pk_bf16(rs[((rg * 4 + d) * 4 + 2) * 512], rs[((rg * 4 + d) * 4 + 3) * 512]);
                    *(u32x2*)(yo + ob + d * 16) = w; } }
            __syncthreads();
        }
    }
}
#define DPPF(x, ctrl) __int_as_float(__builtin_amdgcn_update_dpp(0, __float_as_int(x), ctrl, 0xF, 0xF, true))
DI float red16(float x) { x += DPPF(x, 0xB1); x += DPPF(x, 0x4E); x += DPPF(x, 0x141); x += DPPF(x, 0x140); return x; }
DI float dot4(const f32x4 a, const f32x4 b) { f32x2 t = (f32x2){a[0], a[1]} * (f32x2){b[0], b[1]}; t = (f32x2){a[2], a[3]} * (f32x2){b[2], b[3]} + t; return t[0] + t[1]; }
DI void bf8_to_f(const u32x4 w, f32x4& a, f32x4& b) {
    a = (f32x4){__uint_as_float(w.x << 16), __uint_as_float(w.x & 0xffff0000u), __uint_as_float(w.y << 16), __uint_as_float(w.y & 0xffff0000u)};
    b = (f32x4){__uint_as_float(w.z << 16), __uint_as_float(w.z & 0xffff0000u), __uint_as_float(w.w << 16), __uint_as_float(w.w & 0xffff0000u)};
}
template <int MODE>
DI void rowscan_unit(KParamsPtr p, LAS unsigned char* lds, int unit) {
    constexpr int TC = 32, NV = MODE == 0 ? 5 : 3;
    constexpr int NR = 32;
    constexpr int BUFF = NV * TC * 64 + TC * NR + TC * NR;
    const int tid = TIDX(), lane = tid & 63, wave = __builtin_amdgcn_readfirstlane(tid >> 6);
    LAS float* L = (LAS float*)lds;
    int b, h, sub;
    if (MODE == 0) { const int bh = unit >> 1; b = bh >> 3; h = bh & 7; sub = unit & 1; } else { const int bh = unit >> 2; b = bh >> 2; h = bh & 3; sub = unit & 3; }
    const size_t tb = (size_t)b * SEQ;
    f32x4 f0, f1, f2; u32x4 h0, hv;
    auto stage_load = [&](int t0) {
        const int s = tid >> 4, c4 = tid & 15, s2 = (tid & 255) >> 3, c8 = tid & 7;
        if (MODE == 0) {
            const size_t o = (tb + t0 + s) * 512 + h * 64 + c4 * 4;
            f0 = *(const f32x4*)(p->rw_kk + o); f1 = *(const f32x4*)(p->rw_w + o); f2 = *(const f32x4*)(p->rw_b + o);
            const size_t o2 = (tb + t0 + s2) * 512 + h * 64 + c8 * 8;
            h0 = *(const u32x4*)((tid < 256 ? p->rw_k : p->rw_r) + o2);
            if (tid < 128) hv = *(const u32x4*)(p->rw_v + (tb + t0 + (tid >> 2)) * 512 + h * 64 + sub * NR + (tid & 3) * 8);
        } else {
            f0 = *(const f32x4*)(p->gla_la + (tb + t0 + s) * 256 + h * 64 + c4 * 4);
            const bf16_t* row = p->P1 + (tb + t0 + s2) * NP1P;
            h0 = *(const u32x4*)(row + (tid < 256 ? C_GLA_K : C_GLA_Q) + h * 64 + c8 * 8);
            if (tid < 128) hv = *(const u32x4*)(p->P1 + (tb + t0 + (tid >> 2)) * NP1P + C_GLA_V + h * 128 + sub * NR + (tid & 3) * 8);
        }
    };
    auto stage_write = [&](int buf) {
        LAS float* B = L + buf * BUFF;
        const int s = tid >> 4, c4 = tid & 15, s2 = (tid & 255) >> 3, c8 = tid & 7;
        f32x4 a, c; bf8_to_f(h0, a, c);
        if (MODE == 0) {
            *(LAS f32x4*)(B + (0 * TC + s) * 64 + c4 * 4) = f0; *(LAS f32x4*)(B + (1 * TC + s) * 64 + c4 * 4) = f1; *(LAS f32x4*)(B + (3 * TC + s) * 64 + c4 * 4) = f2;
            LAS float* d = B + ((tid < 256 ? 2 : 4) * TC + s2) * 64 + c8 * 8;
            *(LAS f32x4*)d = a; *(LAS f32x4*)(d + 4) = c;
        } else {
            *(LAS f32x4*)(B + (0 * TC + s) * 64 + c4 * 4) = (f32x4){__expf(f0[0]), __expf(f0[1]), __expf(f0[2]), __expf(f0[3])};
            if (tid >= 256) { a *= 0.125f; c *= 0.125f; }
            LAS float* d = B + ((tid < 256 ? 1 : 2) * TC + s2) * 64 + c8 * 8;
            *(LAS f32x4*)d = a; *(LAS f32x4*)(d + 4) = c;
        }
        if (tid < 128) { f32x4 va, vc; bf8_to_f(hv, va, vc); LAS float* d = B + NV * TC * 64 + (tid >> 2) * NR + (tid & 3) * 8; *(LAS f32x4*)d = va; *(LAS f32x4*)(d + 4) = vc; }
    };
    auto flush_y = [&](int buf, int t0) {
        if (tid < TC * 8) { const int s = tid >> 3, q = tid & 7;
            const f32x4 v = *(const LAS f32x4*)(L + buf * BUFF + NV * TC * 64 + TC * NR + s * NR + q * 4);
            float* dst = (MODE == 0 ? p->rw_y + (tb + t0 + s) * 512 + h * 64 : p->gla_o + (tb + t0 + s) * 512 + h * 128) + sub * NR + q * 4;
            *(f32x4*)dst = v; }
    };
    const int row = wave * 4 + (lane >> 4), j = lane & 15;
    f32x4 st = (f32x4){0.f, 0.f, 0.f, 0.f};
    stage_load(0);
    __syncthreads();
    stage_write(0);
    __syncthreads();
    constexpr int NCH = SEQ / TC;
    for (int c = 0; c < NCH; ++c) {
        if (c + 1 < NCH) stage_load((c + 1) * TC);
        if (c > 0) flush_y((c - 1) & 1, (c - 1) * TC);
        {
            LAS const float* B = L + (c & 1) * BUFF;
            LAS float* Y = L + (c & 1) * BUFF + NV * TC * 64 + TC * NR;
#pragma unroll 1
            for (int s0 = 0; s0 < TC; s0 += 4) {
                float v[4]; f32x4 x0[4], x1[4], x2[4], x3[4], x4[4];
#pragma unroll
                for (int u = 0; u < 4; ++u) { const int s = s0 + u;
                    v[u] = B[NV * TC * 64 + s * NR + row];
                    x0[u] = *(const LAS f32x4*)(B + (0 * TC + s) * 64 + j * 4); x1[u] = *(const LAS f32x4*)(B + (1 * TC + s) * 64 + j * 4); x2[u] = *(const LAS f32x4*)(B + (2 * TC + s) * 64 + j * 4);
                    if (MODE == 0) { x3[u] = *(const LAS f32x4*)(B + (3 * TC + s) * 64 + j * 4); x4[u] = *(const LAS f32x4*)(B + (4 * TC + s) * 64 + j * 4); } }
#pragma unroll
                for (int u = 0; u < 4; ++u) { const int s = s0 + u;
                    if (MODE == 0) {
                        const float skk = red16(dot4(st, x0[u]));
                        st = st * x1[u] + (x2[u] * v[u] - x3[u] * skk);
                        const float y = red16(dot4(st, x4[u]));
                        Y[s * NR + row] = y;
                    } else {
                        st = st * x0[u] + x1[u] * v[u];
                        const float y = red16(dot4(st, x2[u]));
                        Y[s * NR + row] = y;
                    } }
            }
        }
        if (c + 1 < NCH) stage_write((c + 1) & 1);
        __syncthreads();
    }
    flush_y((NCH - 1) & 1, (NCH - 1) * TC);
    __syncthreads();
}
DI void phase_rowscans(KParamsPtr p, LAS unsigned char* lds) {
    for (int u = BIDX(); u < 128; u += NBLK()) { if (u < 64) rowscan_unit<0>(p, lds, u); else rowscan_unit<1>(p, lds, u - 64); }
}

template <int MODE>
DI void rowscan_half(KParamsPtr p, LAS float* L, int unit, int tl, int wl, int lane) {
    constexpr int TC = 16, NV = MODE == 0 ? 5 : 3, NR = 16;
    constexpr int BUFF = NV * TC * 64 + TC * NR + TC * NR;
    int b, h, sub;
    if (MODE == 0) { const int bh = unit >> 2; b = bh >> 3; h = bh & 7; sub = unit & 3; } else { const int bh = unit >> 3; b = bh >> 2; h = bh & 3; sub = unit & 7; }
    const size_t tb = (size_t)b * SEQ;
    f32x4 f0, f1, f2; u32x4 h0, hv;
    auto stage_load = [&](int t0) {
        const int s = tl >> 4, c4 = tl & 15, s2 = (tl & 127) >> 3, c8 = tl & 7;
        if (MODE == 0) {
            const size_t o = (tb + t0 + s) * 512 + h * 64 + c4 * 4;
            f0 = *(const f32x4*)(p->rw_kk + o); f1 = *(const f32x4*)(p->rw_w + o); f2 = *(const f32x4*)(p->rw_b + o);
            h0 = *(const u32x4*)((tl < 128 ? p->rw_k : p->rw_r) + (tb + t0 + s2) * 512 + h * 64 + c8 * 8);
            if (tl < 32) hv = *(const u32x4*)(p->rw_v + (tb + t0 + (tl >> 1)) * 512 + h * 64 + sub * NR + (tl & 1) * 8);
        } else {
            f0 = *(const f32x4*)(p->gla_la + (tb + t0 + s) * 256 + h * 64 + c4 * 4);
            h0 = *(const u32x4*)(p->P1 + (tb + t0 + s2) * NP1P + (tl < 128 ? C_GLA_K : C_GLA_Q) + h * 64 + c8 * 8);
            if (tl < 32) hv = *(const u32x4*)(p->P1 + (tb + t0 + (tl >> 1)) * NP1P + C_GLA_V + h * 128 + sub * NR + (tl & 1) * 8);
        }
    };
    auto stage_write = [&](int buf) {
        LAS float* B = L + buf * BUFF;
        const int s = tl >> 4, c4 = tl & 15, s2 = (tl & 127) >> 3, c8 = tl & 7;
        f32x4 a, c; bf8_to_f(h0, a, c);
        if (MODE == 0) {
            *(LAS f32x4*)(B + (0 * TC + s) * 64 + c4 * 4) = f0; *(LAS f32x4*)(B + (1 * TC + s) * 64 + c4 * 4) = f1; *(LAS f32x4*)(B + (3 * TC + s) * 64 + c4 * 4) = f2;
            LAS float* d = B + ((tl < 128 ? 2 : 4) * TC + s2) * 64 + c8 * 8; *(LAS f32x4*)d = a; *(LAS f32x4*)(d + 4) = c;
        } else {
            *(LAS f32x4*)(B + (0 * TC + s) * 64 + c4 * 4) = (f32x4){__expf(f0[0]), __expf(f0[1]), __expf(f0[2]), __expf(f0[3])};
            if (tl >= 128) { a *= 0.125f; c *= 0.125f; }
            LAS float* d = B + ((tl < 128 ? 1 : 2) * TC + s2) * 64 + c8 * 8; *(LAS f32x4*)d = a; *(LAS f32x4*)(d + 4) = c;
        }
        if (tl < 32) { f32x4 va, vc; bf8_to_f(hv, va, vc); LAS float* d = B + NV * TC * 64 + (tl >> 1) * NR + (tl & 1) * 8; *(LAS f32x4*)d = va; *(LAS f32x4*)(d + 4) = vc; }
    };
    auto flush_y = [&](int buf, int t0) {
        if (tl < TC * 4) { const int s = tl >> 2, q = tl & 3;
            const f32x4 v = *(const LAS f32x4*)(L + buf * BUFF + NV * TC * 64 + TC * NR + s * NR + q * 4);
            float* dst = (MODE == 0 ? p->rw_y + (tb + t0 + s) * 512 + h * 64 : p->gla_o + (tb + t0 + s) * 512 + h * 128) + sub * NR + q * 4;
            *(f32x4*)dst = v; }
    };
    const int row = wl * 4 + (lane >> 4), j = lane & 15;
    f32x4 st = (f32x4){0.f, 0.f, 0.f, 0.f};
    stage_load(0);
    __syncthreads();
    stage_write(0);
    __syncthreads();
    constexpr int NCH = SEQ / TC;
    for (int c = 0; c < NCH; ++c) {
        if (c + 1 < NCH) stage_load((c + 1) * TC);
        if (c > 0) flush_y((c - 1) & 1, (c - 1) * TC);
        LAS const float* B = L + (c & 1) * BUFF;
        LAS float* Y = L + (c & 1) * BUFF + NV * TC * 64 + TC * NR;
#pragma unroll 1
        for (int s0 = 0; s0 < TC; s0 += 4) {
            float v[4]; f32x4 x0[4], x1[4], x2[4], x3[4], x4[4];
#pragma unroll
            for (int u = 0; u < 4; ++u) { const int s = s0 + u;
                v[u] = B[NV * TC * 64 + s * NR + row];
                x0[u] = *(const LAS f32x4*)(B + (0 * TC + s) * 64 + j * 4); x1[u] = *(const LAS f32x4*)(B + (1 * TC + s) * 64 + j * 4); x2[u] = *(const LAS f32x4*)(B + (2 * TC + s) * 64 + j * 4);
                if (MODE == 0) { x3[u] = *(const LAS f32x4*)(B + (3 * TC + s) * 64 + j * 4); x4[u] = *(const LAS f32x4*)(B + (4 * TC + s) * 64 + j * 4); } }
#pragma unroll
            for (int u = 0; u < 4; ++u) { const int s = s0 + u;
                if (MODE == 0) { const float skk = red16(dot4(st, x0[u])); st = st * x1[u] + (x2[u] * v[u] - x3[u] * skk); Y[s * NR + row] = red16(dot4(st, x4[u])); }
                else { st = st * x0[u] + x1[u] * v[u]; Y[s * NR + row] = red16(dot4(st, x2[u])); } }
        }
        if (c + 1 < NCH) stage_write((c + 1) & 1);
        __syncthreads();
    }
    flush_y((NCH - 1) & 1, (NCH - 1) * TC);
    __syncthreads();
}
DI void phase_rowscans_paired(KParamsPtr p, LAS unsigned char* lds) {
    const int tid = TIDX(), lane = tid & 63, wave = __builtin_amdgcn_readfirstlane(tid >> 6);
    for (int u0 = BIDX(); u0 < 128; u0 += NBLK()) {
        const int u = NBLK() == 256 ? ((u0 & 7) * 16 + (u0 >> 3)) : u0;
        if (wave < 4) rowscan_half<0>(p, (LAS float*)lds, u, tid, wave, lane);
        else rowscan_half<1>(p, (LAS float*)(lds + 49152), u, tid - 256, wave - 4, lane);
    }
}
constexpr int LDS_BYTES = 147456;
constexpr int LDS_XB_OFF = 131072;

#ifndef REP_SETUP
#define REP_SETUP 1
#endif
#ifndef REP_CONV
#define REP_CONV 1
#endif
#ifndef REP_PREP
#define REP_PREP 1
#endif
#ifndef REP_CMPR
#define REP_CMPR 1
#endif
#ifndef REP_MLAUP
#define REP_MLAUP 1
#endif
#ifndef REP_NSACMP
#define REP_NSACMP 1
#endif
#ifndef REP_NSAF
#define REP_NSAF 1
#endif
#ifndef REP_MLAF
#define REP_MLAF 1
#endif
#ifndef REP_SCAN
#define REP_SCAN 1
#endif
#ifndef REP_POST
#define REP_POST 1
#endif
#ifndef REP_MSUM
#define REP_MSUM 1
#endif
#ifndef REP_NORM0
#define REP_NORM0 1
#endif
#ifndef REP_GATE
#define REP_GATE 1
#endif
#ifndef REP_MERGE
#define REP_MERGE 1
#endif
#ifndef REP_UP
#define REP_UP 1
#endif
#ifndef REP_DN
#define REP_DN 1
#endif
#ifndef REP_PROJ
#define REP_PROJ 1
#endif
#ifndef SCAN_GATE_UNITS
#define SCAN_GATE_UNITS 3
#endif
#define REPEAT(n) for (int r_ = 0; r_ < (n); ++r_)
__global__ void __launch_bounds__(512, 2) mega(Params p_arg, int ph_lo, int ph_hi) {
    extern __shared__ __attribute__((aligned(16))) unsigned char lds_raw[];
    LAS unsigned char* lds = (LAS unsigned char*)lds_raw;
    volatile LAS unsigned* xbw = (volatile LAS unsigned*)(lds + LDS_XB_OFF);
    if (threadIdx.x == 0) { xbw[0] = 0u; xbw[1] = 0u; xbw[2] = 0u; xbw[3] = 0u; }
    __syncthreads();
    XcdBarrier bar; bar.bar = p_arg.bar; bar.x = 0; bar.st = xbw;
    if (ph_hi - ph_lo > 1) bar = xcd_barrier_post(p_arg.bar, xbw);
    int ph = 0;
#define PHASE_BEGIN if (ph >= ph_lo && ph < ph_hi) { KParamsPtr p = (KParamsPtr)__builtin_amdgcn_kernarg_segment_ptr(); asm volatile("" : "+s"(p));
#define PHASE_END   __syncthreads(); if (ph + 1 < ph_hi) xcd_barrier(bar); } ++ph;

    PHASE_BEGIN REPEAT(REP_SETUP) { phase_setup(p, lds); __syncthreads(); } REPEAT(REP_CONV) { phase_convert(p, 0, lds); __syncthreads(); } PHASE_END
    PHASE_BEGIN REPEAT(REP_NORM0) phase_norm<false, true>(p->x, nullptr, nullptr, p->u, nullptr, nullptr, 0.f, p->pre_g, p->mod); PHASE_END

    { constexpr int l = 0;

#define modA (p->mod + (size_t)(l * 3 + 0) * 4 * 6144)
#define modB (p->mod + (size_t)(l * 3 + 1) * 4 * 6144)
#define modC (p->mod + (size_t)(l * 3 + 2) * 4 * 6144)
        PHASE_BEGIN REPEAT(REP_UP) { EpiSwiglu E; E.H = p->P1; E.ldc = DFF; run_gemm(lds, p->u, D, p->Wup0, D, T, 2 * DFF, D, E); __syncthreads(); } PHASE_END
        PHASE_BEGIN REPEAT(REP_DN) { EpiBf16<0> E; E.O = (bf16_t*)p->y; E.ldc = D; run_gemm(lds, p->P1, DFF, p->Wdn0, DFF, T, D, DFF, E); __syncthreads(); } PHASE_END
        PHASE_BEGIN phase_norm<true, true, (l != 0), true>(l == 0 ? (const void*)p->x : (const void*)p->out, (const bf16_t*)p->y, p->out, p->u, p->post_g + (l * 3 + 0) * D, modA, 0.5f, p->pre_g + (l * 3 + 1) * D, modB); PHASE_END
        PHASE_BEGIN REPEAT(REP_PROJ) {
            { EpiBf16<0> E; E.O = p->P1; E.ldc = NP1P; run_gemm(lds, p->u, D, p->Win1, D, T, P1TAIL, D, E); } __syncthreads();
            for (int i_ = BIDX(); i_ < 256; i_ += NBLK()) { const int pm_ = i_ >> 2, kp_ = i_ & 3;
                EpiF32Lo E; E.C = p->y + (size_t)kp_ * T * 256; E.ldc = 256;
                pg8::Gemm g; g.A = p->u + kp_ * 512; g.Bt = p->Win1 + (size_t)P1TAIL * D + kp_ * 512; g.M = T; g.N = 256; g.K = 512; g.lda = D; g.ldb = D;
                SplitOrder S; S.first = pm_; S.count = 1; S.nN = 1;
                pg8::gemm_phase<EpiF32Lo, SplitOrder, false>((PG8_LAS unsigned char*)lds, g, S, E, nullptr); __syncthreads(); }
            __syncthreads(); } PHASE_END
        PHASE_BEGIN REPEAT(REP_PREP) { phase_prep2(p, l, lds); __syncthreads(); } PHASE_END
        PHASE_BEGIN {
            REPEAT(REP_SCAN) { phase_rowscans_paired(p, lds); __syncthreads(); }
            EpiBf16<1> E; E.O = p->G; E.ldc = NGATE;
            pg8::Gemm g; g.A = p->u; g.Bt = p->Wg; g.M = T; g.N = NGATE; g.K = D; g.lda = D; g.ldb = D;
            const int nb_ = NBLK(), bid_ = BIDX();
            if (nb_ == 256 && SCAN_GATE_UNITS == 3) {
                const int x_ = bid_ & 7; RowWalkOrder S;
                if (bid_ < 128) { const int r_ = bid_ >> 3; S.pm = 8 * x_ + (r_ & 7); S.pn0 = (r_ >> 3) * 3; S.step = 1; S.count = 3; }
                else { const int r_ = (bid_ - 128) >> 3; S.pm = 8 * x_ + (r_ & 7); S.pn0 = 6 + (r_ >> 3); S.step = 2; S.count = 13; }
                pg8::gemm_phase<EpiBf16<1>, RowWalkOrder, false>((PG8_LAS unsigned char*)lds, g, S, E, nullptr); }
            else if (nb_ == 256) { SplitOrder S; S.nN = 32; if (bid_ < 128) { S.first = bid_ * SCAN_GATE_UNITS; S.count = SCAN_GATE_UNITS; } else { S.first = 128 * SCAN_GATE_UNITS + (bid_ - 128) * (16 - SCAN_GATE_UNITS); S.count = 16 - SCAN_GATE_UNITS; }
                pg8::gemm_phase<EpiBf16<1>, SplitOrder, false>((PG8_LAS unsigned char*)lds, g, S, E, nullptr); }
            else { pg8::StaticOrder S; S.init(T, NGATE, nb_, bid_); pg8::gemm_phase<EpiBf16<1>, pg8::StaticOrder, false>((PG8_LAS unsigned char*)lds, g, S, E, nullptr); }
        } PHASE_END
        PHASE_BEGIN REPEAT(REP_CMPR) {
            const int c_ = BIDX();
            if (c_ < 16) { const int wh = c_ >> 3, pan = c_ & 7;
                { EpiGeluBias E; E.O = p->chid + (size_t)wh * 2048 * 256; E.ldc = 256; E.bias = p->cbias + wh * 256;
                  pg8::Gemm g; g.A = wh ? p->nsa_vc_in : p->nsa_kc_in; g.Bt = p->cW1t + (size_t)wh * 256 * 2048; g.M = 2048; g.N = 256; g.K = 2048; g.lda = 1024; g.ldb = 2048;
                  SplitOrder S; S.first = pan; S.count = 1; S.nN = 1;
                  pg8::gemm_phase<EpiGeluBias, SplitOrder, false>((PG8_LAS unsigned char*)lds, g, S, E, nullptr); }
                asm volatile("s_waitcnt vmcnt(0)" ::: "memory"); __syncthreads();
                { EpiCmpOut E; E.C = wh ? p->nsa_vc : p->nsa_kc;
                  pg8::Gemm g; g.A = p->chid + (size_t)wh * 2048 * 256; g.Bt = p->cW2t + (size_t)wh * 256 * 256; g.M = 2048; g.N = 256; g.K = 256; g.lda = 256; g.ldb = 256;
                  SplitOrder S; S.first = pan; S.count = 1; S.nN = 1;
                  pg8::gemm_phase<EpiCmpOut, SplitOrder, false>((PG8_LAS unsigned char*)lds, g, S, E, nullptr); }
            }
            __syncthreads(); } REPEAT(REP_MLAUP) {
            const int skip_ = NBLK() == 256 ? 16 : 0, G_ = NBLK() - skip_, c2_ = BIDX() - skip_;
            if (c2_ >= 0) {
                { EpiBf16<0> E; E.O = p->mla_q; E.ldc = 768; pg8::Gemm g; g.A = p->mla_cqn; g.Bt = p->Wuq; g.M = T; g.N = 768; g.K = 384; g.lda = 384; g.ldb = 384;
                  pg8::StaticOrder S; S.init(T, 768, G_, c2_); pg8::gemm_phase<EpiBf16<0>, pg8::StaticOrder, false>((PG8_LAS unsigned char*)lds, g, S, E, nullptr); } __syncthreads();
                { EpiBf16<0> E; E.O = p->mla_kv; E.ldc = 1024; pg8::Gemm g; g.A = p->mla_ckvn; g.Bt = p->Wukv; g.M = T; g.N = 1024; g.K = 256; g.lda = 256; g.ldb = 256;
                  pg8::StaticOrder S; S.init(T, 1024, G_, (c2_ + 48) % G_); pg8::gemm_phase<EpiBf16<0>, pg8::StaticOrder, false>((PG8_LAS unsigned char*)lds, g, S, E, nullptr); } __syncthreads(); } } __syncthreads(); REPEAT(REP_POST) { phase_post(p, l, lds, NBLK() == 256 ? 16 : 0); __syncthreads(); } PHASE_END
        PHASE_BEGIN REPEAT(REP_NSAF) { phase_nsa_full(p, lds); __syncthreads(); } REPEAT(REP_MLAF) { phase_mla_flash(p, lds); __syncthreads(); } PHASE_END
        PHASE_BEGIN { EpiMergeAcc E; E.G = p->G; E.O = p->mg;
            pg8::Gemm g; g.A = p->ys; g.Bt = p->Wbr; g.M = 4 * T; g.N = 4 * D; g.K = 512; g.lda = 512; g.ldb = 512;
            MergeOrder S; S.G = NBLK(); S.c = BIDX();
            REPEAT(REP_MERGE) { pg8::gemm_phase<EpiMergeAcc, MergeOrder, false>((PG8_LAS unsigned char*)lds, g, S, E, nullptr); __syncthreads(); } } PHASE_END
        PHASE_BEGIN { EpiBf16<0> E; E.O = (bf16_t*)p->y; E.ldc = D; run_gemm(lds, p->mg, D, p->Wout, D, T, D, D, E); } PHASE_END
        PHASE_BEGIN phase_norm<true, true, true, true>(p->out, (const bf16_t*)p->y, p->G, p->u, p->post_g + (l * 3 + 1) * D, modB, 1.0f, p->pre_g + (l * 3 + 2) * D, modC); PHASE_END
        PHASE_BEGIN { EpiSwiglu E; E.H = p->P1; E.ldc = DFF; run_gemm(lds, p->u, D, p->Wup1, D, T, 2 * DFF, D, E); } PHASE_END
        PHASE_BEGIN { EpiBf16<0> E; E.O = (bf16_t*)p->y; E.ldc = D; run_gemm(lds, p->P1, DFF, p->Wdn1, DFF, T, D, DFF, E); } PHASE_END
        if (l == 0) { PHASE_BEGIN phase_norm<true, true, true, true>(p->G, (const bf16_t*)p->y, p->out, p->u, p->post_g + (l * 3 + 2) * D, modC, 0.5f, p->pre_g + ((l + 1) * 3) * D, p->mod + (size_t)((l + 1) * 3) * 4 * 6144);
            __syncthreads(); REPEAT(REP_CONV) { phase_convert(p, 1, lds); __syncthreads(); } PHASE_END }
        else        { PHASE_BEGIN phase_norm<true, false, true, false>(p->G, (const bf16_t*)p->y, p->out, nullptr, p->post_g + (l * 3 + 2) * D, modC, 0.5f, nullptr, nullptr); PHASE_END }
    }
    { constexpr int l = 1;

#define modA (p->mod + (size_t)(l * 3 + 0) * 4 * 6144)
#define modB (p->mod + (size_t)(l * 3 + 1) * 4 * 6144)
#define modC (p->mod + (size_t)(l * 3 + 2) * 4 * 6144)
        PHASE_BEGIN REPEAT(REP_UP) { EpiSwiglu E; E.H = p->P1; E.ldc = DFF; run_gemm(lds, p->u, D, p->Wup0, D, T, 2 * DFF, D, E); __syncthreads(); } PHASE_END
        PHASE_BEGIN REPEAT(REP_DN) { EpiBf16<0> E; E.O = (bf16_t*)p->y; E.ldc = D; run_gemm(lds, p->P1, DFF, p->Wdn0, DFF, T, D, DFF, E); __syncthreads(); } PHASE_END
        PHASE_BEGIN phase_norm<true, true, (l != 0), true>(l == 0 ? (const void*)p->x : (const void*)p->out, (const bf16_t*)p->y, p->out, p->u, p->post_g + (l * 3 + 0) * D, modA, 0.5f, p->pre_g + (l * 3 + 1) * D, modB); PHASE_END
        PHASE_BEGIN REPEAT(REP_PROJ) {
            { EpiBf16<0> E; E.O = p->P1; E.ldc = NP1P; run_gemm(lds, p->u, D, p->Win1, D, T, P1TAIL, D, E); } __syncthreads();
            for (int i_ = BIDX(); i_ < 256; i_ += NBLK()) { const int pm_ = i_ >> 2, kp_ = i_ & 3;
                EpiF32Lo E; E.C = p->y + (size_t)kp_ * T * 256; E.ldc = 256;
                pg8::Gemm g; g.A = p->u + kp_ * 512; g.Bt = p->Win1 + (size_t)P1TAIL * D + kp_ * 512; g.M = T; g.N = 256; g.K = 512; g.lda = D; g.ldb = D;
                SplitOrder S; S.first = pm_; S.count = 1; S.nN = 1;
                pg8::gemm_phase<EpiF32Lo, SplitOrder, false>((PG8_LAS unsigned char*)lds, g, S, E, nullptr); __syncthreads(); }
            __syncthreads(); } PHASE_END
        PHASE_BEGIN REPEAT(REP_PREP) { phase_prep2(p, l, lds); __syncthreads(); } PHASE_END
        PHASE_BEGIN {
            REPEAT(REP_SCAN) { phase_rowscans_paired(p, lds); __syncthreads(); }
            EpiBf16<1> E; E.O = p->G; E.ldc = NGATE;
            pg8::Gemm g; g.A = p->u; g.Bt = p->Wg; g.M = T; g.N = NGATE; g.K = D; g.lda = D; g.ldb = D;
            const int nb_ = NBLK(), bid_ = BIDX();
            if (nb_ == 256 && SCAN_GATE_UNITS == 3) {
                const int x_ = bid_ & 7; RowWalkOrder S;
                if (bid_ < 128) { const int r_ = bid_ >> 3; S.pm = 8 * x_ + (r_ & 7); S.pn0 = (r_ >> 3) * 3; S.step = 1; S.count = 3; }
                else { const int r_ = (bid_ - 128) >> 3; S.pm = 8 * x_ + (r_ & 7); S.pn0 = 6 + (r_ >> 3); S.step = 2; S.count = 13; }
                pg8::gemm_phase<EpiBf16<1>, RowWalkOrder, false>((PG8_LAS unsigned char*)lds, g, S, E, nullptr); }
            else if (nb_ == 256) { SplitOrder S; S.nN = 32; if (bid_ < 128) { S.first = bid_ * SCAN_GATE_UNITS; S.count = SCAN_GATE_UNITS; } else { S.first = 128 * SCAN_GATE_UNITS + (bid_ - 128) * (16 - SCAN_GATE_UNITS); S.count = 16 - SCAN_GATE_UNITS; }
                pg8::gemm_phase<EpiBf16<1>, SplitOrder, false>((PG8_LAS unsigned char*)lds, g, S, E, nullptr); }
            else { pg8::StaticOrder S; S.init(T, NGATE, nb_, bid_); pg8::gemm_phase<EpiBf16<1>, pg8::StaticOrder, false>((PG8_LAS unsigned char*)lds, g, S, E, nullptr); }
        } PHASE_END
        PHASE_BEGIN REPEAT(REP_CMPR) {
            const int c_ = BIDX();
            if (c_ < 16) { const int wh = c_ >> 3, pan = c_ & 7;
                { EpiGeluBias E; E.O = p->chid + (size_t)wh * 2048 * 256; E.ldc = 256; E.bias = p->cbias + wh * 256;
                  pg8::Gemm g; g.A = wh ? p->nsa_vc_in : p->nsa_kc_in; g.Bt = p->cW1t + (size_t)wh * 256 * 2048; g.M = 2048; g.N = 256; g.K = 2048; g.lda = 1024; g.ldb = 2048;
                  SplitOrder S; S.first = pan; S.count = 1; S.nN = 1;
                  pg8::gemm_phase<EpiGeluBias, SplitOrder, false>((PG8_LAS unsigned char*)lds, g, S, E, nullptr); }
                asm volatile("s_waitcnt vmcnt(0)" ::: "memory"); __syncthreads();
                { EpiCmpOut E; E.C = wh ? p->nsa_vc : p->nsa_kc;
                  pg8::Gemm g; g.A = p->chid + (size_t)wh * 2048 * 256; g.Bt = p->cW2t + (size_t)wh * 256 * 256; g.M = 2048; g.N = 256; g.K = 256; g.lda = 256; g.ldb = 256;
                  SplitOrder S; S.first = pan; S.count = 1; S.nN = 1;
                  pg8::gemm_phase<EpiCmpOut, SplitOrder, false>((PG8_LAS unsigned char*)lds, g, S, E, nullptr); }
            }
            __syncthreads(); } REPEAT(REP_MLAUP) {
            const int skip_ = NBLK() == 256 ? 16 : 0, G_ = NBLK() - skip_, c2_ = BIDX() - skip_;
            if (c2_ >= 0) {
                { EpiBf16<0> E; E.O = p->mla_q; E.ldc = 768; pg8::Gemm g; g.A = p->mla_cqn; g.Bt = p->Wuq; g.M = T; g.N = 768; g.K = 384; g.lda = 384; g.ldb = 384;
                  pg8::StaticOrder S; S.init(T, 768, G_, c2_); pg8::gemm_phase<EpiBf16<0>, pg8::StaticOrder, false>((PG8_LAS unsigned char*)lds, g, S, E, nullptr); } __syncthreads();
                { EpiBf16<0> E; E.O = p->mla_kv; E.ldc = 1024; pg8::Gemm g; g.A = p->mla_ckvn; g.Bt = p->Wukv; g.M = T; g.N = 1024; g.K = 256; g.lda = 256; g.ldb = 256;
                  pg8::StaticOrder S; S.init(T, 1024, G_, (c2_ + 48) % G_); pg8::gemm_phase<EpiBf16<0>, pg8::StaticOrder, false>((PG8_LAS unsigned char*)lds, g, S, E, nullptr); } __syncthreads(); } } __syncthreads(); REPEAT(REP_POST) { phase_post(p, l, lds, NBLK() == 256 ? 16 : 0); __syncthreads(); } PHASE_END
        PHASE_BEGIN REPEAT(REP_NSAF) { phase_nsa_full(p, lds); __syncthreads(); } REPEAT(REP_MLAF) { phase_mla_flash(p, lds); __syncthreads(); } PHASE_END
        PHASE_BEGIN { EpiMergeAcc E; E.G = p->G; E.O = p->mg;
            pg8::Gemm g; g.A = p->ys; g.Bt = p->Wbr; g.M = 4 * T; g.N = 4 * D; g.K = 512; g.lda = 512; g.ldb = 512;
            MergeOrder S; S.G = NBLK(); S.c = BIDX();
            REPEAT(REP_MERGE) { pg8::gemm_phase<EpiMergeAcc, MergeOrder, false>((PG8_LAS unsigned char*)lds, g, S, E, nullptr); __syncthreads(); } } PHASE_END
        PHASE_BEGIN { EpiBf16<0> E; E.O = (bf16_t*)p->y; E.ldc = D; run_gemm(lds, p->mg, D, p->Wout, D, T, D, D, E); } PHASE_END
        PHASE_BEGIN phase_norm<true, true, true, true>(p->out, (const bf16_t*)p->y, p->G, p->u, p->post_g + (l * 3 + 1) * D, modB, 1.0f, p->pre_g + (l * 3 + 2) * D, modC); PHASE_END
        PHASE_BEGIN { EpiSwiglu E; E.H = p->P1; E.ldc = DFF; run_gemm(lds, p->u, D, p->Wup1, D, T, 2 * DFF, D, E); } PHASE_END
        PHASE_BEGIN { EpiBf16<0> E; E.O = (bf16_t*)p->y; E.ldc = D; run_gemm(lds, p->P1, DFF, p->Wdn1, DFF, T, D, DFF, E); } PHASE_END
        if (l == 0) { PHASE_BEGIN phase_norm<true, true, true, true>(p->G, (const bf16_t*)p->y, p->out, p->u, p->post_g + (l * 3 + 2) * D, modC, 0.5f, p->pre_g + ((l + 1) * 3) * D, p->mod + (size_t)((l + 1) * 3) * 4 * 6144);
            __syncthreads(); REPEAT(REP_CONV) { phase_convert(p, 1, lds); __syncthreads(); } PHASE_END }
        else        { PHASE_BEGIN phase_norm<true, false, true, false>(p->G, (const bf16_t*)p->y, p->out, nullptr, p->post_g + (l * 3 + 2) * D, modC, 0.5f, nullptr, nullptr); PHASE_END }
    }

}
constexpr int N_PHASES = 2 + 2 * 14;

extern "C" void kernel_launch(void* const* d_in, const int* in_sizes, int n_in, void* d_out, int out_size, void* d_ws, size_t ws_size, hipStream_t stream) {
    static int grid = 0;
    if (grid == 0) {
        int dev = 0, cus = 0;
        if (hipGetDevice(&dev) != hipSuccess || hipDeviceGetAttribute(&cus, hipDeviceAttributeMultiprocessorCount, dev) != hipSuccess) { fprintf(stderr, "kernel_launch: device query failed\n"); grid = -1; return; }
        if (hipFuncSetAttribute((const void*)mega, hipFuncAttributeMaxDynamicSharedMemorySize, LDS_BYTES) != hipSuccess) { fprintf(stderr, "kernel_launch: hipFuncSetAttribute failed\n"); grid = -1; return; }
        int per_cu = 0;
        if (hipOccupancyMaxActiveBlocksPerMultiprocessor(&per_cu, (const void*)mega, 512, LDS_BYTES) != hipSuccess || per_cu < 1) fprintf(stderr, "kernel_launch: occupancy query says %d\n", per_cu);
        (void)hipGetLastError();
        grid = cus;
    }
    if (grid < 0) return;
    Params p{};
    const float* const* in = (const float* const*)d_in;
    p.x = in[0]; p.c = in[1]; p.ada_w = in[2]; p.ada_b = in[3]; p.pre_g = in[4]; p.post_g = in[5]; p.ffn_wg = in[6]; p.ffn_wu = in[7]; p.ffn_wd = in[8];
    p.mix_w_in = in[9]; p.mix_w_branch = in[10]; p.mix_w_out = in[11]; p.cmp_pos = in[12]; p.cmp_w1 = in[13]; p.cmp_w2 = in[14];
    p.rw_mu = in[15]; p.rw_w0 = in[16]; p.rw_w_w2 = in[17]; p.rw_a0 = in[18]; p.rw_a_w2 = in[19]; p.rw_g_w2 = in[20]; p.rw_k_k = in[21]; p.rw_k_a = in[22];
    p.rw_r_k = in[23]; p.rw_ln_w = in[24]; p.rw_ln_b = in[25]; p.gla_w2 = in[26]; p.gla_b = in[27]; p.gla_g = in[28];
    p.mla_qn = in[29]; p.mla_wuq = in[30]; p.mla_kvn = in[31]; p.mla_wukv = in[32];
    p.out = (float*)d_out;
    unsigned char* ws = (unsigned char*)d_ws; size_t off = 0;
    auto take = [&](size_t bytes) { unsigned char* r = ws + off; off += (bytes + 255) & ~(size_t)255; return r; };
    p.bar = (unsigned*)take(16384);
    p.mod = (float*)take((size_t)6 * 4 * 6144 * 4);
    p.cos64 = (float*)take((size_t)SEQ * 32 * 4); p.sin64 = (float*)take((size_t)SEQ * 32 * 4); p.cos32 = (float*)take((size_t)SEQ * 16 * 4); p.sin32 = (float*)take((size_t)SEQ * 16 * 4);
    p.Wup0 = (bf16_t*)take((size_t)2 * DFF * D * 2); p.Wup1 = (bf16_t*)take((size_t)2 * DFF * D * 2);
    p.Wdn0 = (bf16_t*)take((size_t)D * DFF * 2); p.Wdn1 = (bf16_t*)take((size_t)D * DFF * 2);
    p.Win1 = (bf16_t*)take((size_t)(NP1P + NGATE) * D * 2); p.Wg = p.Win1 + (size_t)NP1P * D;
    p.Wbr = (bf16_t*)take((size_t)4 * D * 512 * 2); p.Wout = (bf16_t*)take((size_t)D * D * 2);
    p.Wuq = (bf16_t*)take((size_t)768 * 384 * 2); p.Wukv = (bf16_t*)take((size_t)1024 * 256 * 2);
    p.u = (bf16_t*)take((size_t)T * D * 2);
    p.P1 = (bf16_t*)take((size_t)T * DFF * 2);
    p.y = (float*)take((size_t)T * D * 4);
    p.G = (bf16_t*)take((size_t)T * NGATE * 2);
    { unsigned char* yb = (unsigned char*)p.y; size_t yo = 0;
      auto ytake = [&](size_t bytes) { unsigned char* r = yb + yo; yo += (bytes + 255) & ~(size_t)255; return r; };
      p.mla_q = (bf16_t*)ytake((size_t)T * 768 * 2); p.mla_kv = (bf16_t*)ytake((size_t)T * 1024 * 2); p.gla_o = (float*)ytake((size_t)T * 512 * 4); p.nsa_ocmp = (float*)ytake((size_t)T * 512 * 4);
      if (yo > (size_t)T * D * 4) { fprintf(stderr, "kernel_launch: y aliases overflow\n"); return; } }
    p.nsa_q = (bf16_t*)take((size_t)T * 512 * 2);
    p.nsa_kc_in = (bf16_t*)take((size_t)T * 128 * 2 + 4096); p.nsa_vc_in = (bf16_t*)take((size_t)T * 128 * 2 + 4096);
    p.nsa_ks = (bf16_t*)take((size_t)T * 128 * 2); p.nsa_vs = (bf16_t*)take((size_t)T * 128 * 2); p.nsa_kw = (bf16_t*)take((size_t)T * 128 * 2); p.nsa_vw = (bf16_t*)take((size_t)T * 128 * 2);
    p.nsa_gate = (float*)take((size_t)T * 24 * 4); p.nsa_kc = (float*)take((size_t)8 * 256 * 64 * 4); p.nsa_vc = (float*)take((size_t)8 * 256 * 64 * 4);
    p.nsa_sel = (unsigned long long*)take((size_t)8 * SEQ * 8);
    p.rw_r = (bf16_t*)take((size_t)T * 512 * 2); p.rw_k = (bf16_t*)take((size_t)T * 512 * 2); p.rw_v = (bf16_t*)take((size_t)T * 512 * 2); p.rw_g = (bf16_t*)take((size_t)T * 512 * 2);
    p.rw_w = (float*)take((size_t)T * 512 * 4); p.rw_kk = (float*)take((size_t)T * 512 * 4); p.rw_b = (float*)take((size_t)T * 512 * 4); p.rw_y = (float*)take((size_t)T * 512 * 4);
    p.gla_la = (float*)take((size_t)T * 256 * 4);
    p.mla_cqn = (bf16_t*)take((size_t)T * 384 * 2); p.mla_ckvn = (bf16_t*)take((size_t)T * 256 * 2); p.mla_kpe = (bf16_t*)take((size_t)T * 32 * 2);
    p.ys = (bf16_t*)take((size_t)4 * T * 512 * 2);
    p.mg = p.u;
    p.cW1t = (bf16_t*)take((size_t)2 * 256 * 2048 * 2); p.cW2t = (bf16_t*)take((size_t)2 * 256 * 256 * 2); p.chid = (bf16_t*)take((size_t)2 * 2048 * 256 * 2); p.cbias = (float*)take(2 * 256 * 4); p.rwWlT = (bf16_t*)take((size_t)512 * 256 * 2);
    if (off > ws_size) { fprintf(stderr, "kernel_launch: workspace too small: need %zu, have %zu\n", off, ws_size); return; }
    if (hipMemsetAsync(p.bar, 0, 16384, stream) != hipSuccess) { fprintf(stderr, "kernel_launch: memset failed\n"); return; }
#if defined(ONE_LAUNCH)
    hipLaunchKernelGGL(mega, dim3(grid), dim3(512), LDS_BYTES, stream, p, 0, N_PHASES);
#else
    for (int ph = 0; ph < N_PHASES; ++ph) hipLaunchKernelGGL(mega, dim3(grid), dim3(512), LDS_BYTES, stream, p, ph, ph + 1);
#endif
}
```

```cpp
#define ONE_LAUNCH 1
#include <hip/hip_runtime.h>
#include <stdint.h>
#include <stdio.h>

#define LAS __attribute__((address_space(3)))
#define DI __device__ __forceinline__
typedef unsigned short bf16_t;
typedef short bf16x8 __attribute__((ext_vector_type(8)));
typedef float f32x4 __attribute__((ext_vector_type(4)));
typedef float f32x2 __attribute__((ext_vector_type(2)));
typedef unsigned u32x4 __attribute__((ext_vector_type(4)));
typedef unsigned u32x2 __attribute__((ext_vector_type(2)));

constexpr int NB = 4, SEQ = 4096, T = NB * SEQ, D = 2048, DFF = 5632;
constexpr int NP1 = 5192, NP1P = 5376, NGATE = 8192, PROJ_IN = 13384;
constexpr int C_NSA_Q = 0, C_NSA_KC = 512, C_NSA_VC = 640, C_NSA_KS = 768, C_NSA_VS = 896, C_NSA_KW = 1024, C_NSA_VW = 1152, C_NSA_GL = 1280;
constexpr int C_RW = 1304, C_RW_R = 1304, C_RW_WLO = 1816, C_RW_K = 1880, C_RW_V = 2392, C_RW_ALO = 2904, C_RW_GLO = 2968;
constexpr int C_GLA_Q = 3096, C_GLA_K = 3352, C_GLA_V = 3608, C_GLA_ALO = 4120, C_GLA_R = 4136;
constexpr int C_MLA_CQ = 4648, C_MLA_CKV = 5032, C_MLA_KR = 5160;
constexpr float NORM_EPS = 1e-6f;

DI float bf2f(bf16_t v) { return __uint_as_float(((unsigned)v) << 16); }
DI bf16_t f2bf(float f) { unsigned u = __float_as_uint(f); u += 0x7FFFu + ((u >> 16) & 1u); return (bf16_t)(u >> 16); }
typedef __bf16 bf16x2_t_ __attribute__((ext_vector_type(2)));
DI unsigned pk2(float lo, float hi) { const f32x2 v = {lo, hi}; return __builtin_bit_cast(unsigned, __builtin_convertvector(v, bf16x2_t_)); }
DI float sigmoidf_(float x) { return 1.0f / (1.0f + __expf(-x)); }
DI float wsum(float v) {
#pragma unroll
    for (int o = 32; o >= 1; o >>= 1) v += __shfl_xor(v, o);
    return v;
}
DI float wmax(float v) {
#pragma unroll
    for (int o = 32; o >= 1; o >>= 1) v = fmaxf(v, __shfl_xor(v, o));
    return v;
}

DI int TIDX() { int t = (int)threadIdx.x; asm volatile("" : "+v"(t)); return t; }
DI int BIDX() { int t = __builtin_amdgcn_readfirstlane((int)blockIdx.x); asm volatile("" : "+s"(t)); return t; }
DI int NBLK() { int t = __builtin_amdgcn_readfirstlane((int)gridDim.x); asm volatile("" : "+s"(t)); return t; }

struct Params {
    const float *x, *c, *ada_w, *ada_b, *pre_g, *post_g, *ffn_wg, *ffn_wu, *ffn_wd, *mix_w_in, *mix_w_branch, *mix_w_out;
    const float *cmp_pos, *cmp_w1, *cmp_w2;
    const float *rw_mu, *rw_w0, *rw_w_w2, *rw_a0, *rw_a_w2, *rw_g_w2, *rw_k_k, *rw_k_a, *rw_r_k, *rw_ln_w, *rw_ln_b;
    const float *gla_w2, *gla_b, *gla_g;
    const float *mla_qn, *mla_wuq, *mla_kvn, *mla_wukv;
    float* out;
    unsigned* bar;
    float *mod, *cos64, *sin64, *cos32, *sin32;
    bf16_t *Wup0, *Wup1, *Wdn0, *Wdn1, *Win1, *Wg, *Wbr, *Wout, *Wuq, *Wukv;
    bf16_t *u, *P1, *G;
    float* y;
    bf16_t *nsa_q, *nsa_kc_in, *nsa_vc_in, *nsa_ks, *nsa_vs, *nsa_kw, *nsa_vw;
    float *nsa_gate, *nsa_kc, *nsa_vc, *nsa_ocmp;
    unsigned long long* nsa_sel;
    bf16_t *rw_r, *rw_k, *rw_v, *rw_g;
    float *rw_w, *rw_kk, *rw_b, *rw_y;
    float *gla_la, *gla_o;
    bf16_t *mla_cqn, *mla_ckvn, *mla_kpe, *mla_q, *mla_kv;
    bf16_t* ys;
    bf16_t* mg;
    bf16_t *cW1t, *cW2t, *chid;
    float* cbias;
    bf16_t* rwWlT;
};
typedef const __attribute__((address_space(4))) Params* KParamsPtr;
#define XB_TMO      128
#define XB_XCNT(j)  (256  + 64 * (j))
#define XB_XSUB(j)  (1280 + 64 * (j))
#define XB_XGEN(j)  (2304 + 64 * (j))
#define XB_TOP      3328
#define XB_TOPGEN   3392
#define XCD_BAR_WORDS 3456
#define XB_SPIN_CAP (1u << 18)

__device__ __forceinline__ unsigned xb_ld(unsigned* p)              { return __hip_atomic_load(p, __ATOMIC_RELAXED, __HIP_MEMORY_SCOPE_AGENT); }
__device__ __forceinline__ unsigned xb_add(unsigned* p, unsigned v) { return __hip_atomic_fetch_add(p, v, __ATOMIC_RELAXED, __HIP_MEMORY_SCOPE_AGENT); }
__device__ __forceinline__ unsigned xb_xcc_id() { return (unsigned)__builtin_amdgcn_s_getreg((3 << 11) | 20) & 0xFu; }
#define XB_SPIN(cond, bar) do { unsigned _sp = 0; while (cond) { __builtin_amdgcn_s_sleep(1); \
    if ((++_sp & 255u) == 0u) { if (xb_ld(&(bar)[XB_TMO])) break; if (_sp > XB_SPIN_CAP) { atomicAdd(&(bar)[XB_TMO], 1u); break; } } } } while (0)

struct XcdBarrier {
    unsigned* bar; unsigned x;
    volatile LAS unsigned* st;
};

__device__ __forceinline__ XcdBarrier xcd_barrier_post(unsigned* bar, volatile LAS unsigned* st) {
    XcdBarrier b; b.bar = bar; b.x = xb_xcc_id(); b.st = st;
    if (threadIdx.x == 0) (void)xb_add(&bar[XB_XCNT(b.x)], 1u);
    return b;
}
__device__ __forceinline__ void xcd_barrier_complete(unsigned* bar, unsigned x, unsigned& nloc, unsigned& nx) {
    const unsigned G = gridDim.x * gridDim.y * gridDim.z;
    unsigned sum, cnt, mine, sp = 0u;
    for (;;) {
        sum = 0u; cnt = 0u; mine = 0u;
#pragma unroll
        for (unsigned j = 0; j < 16; ++j) { const unsigned c = xb_ld(&bar[XB_XCNT(j)]); sum += c; cnt += (c > 0u) ? 1u : 0u; mine = (j == x) ? c : mine; }
        if (sum == G) break;
        __builtin_amdgcn_s_sleep(1);
        if ((++sp & 255u) == 0u) { if (xb_ld(&bar[XB_TMO])) break; if (sp > XB_SPIN_CAP) { atomicAdd(&bar[XB_TMO], 1u); break; } }
    }
    nloc = mine > 0u ? mine : 1u; nx = cnt > 0u ? cnt : 1u;
}

__device__ __forceinline__ void xcd_barrier(const XcdBarrier& b) {
    asm volatile("s_waitcnt vmcnt(0)" ::: "memory");
    __syncthreads();
    if (threadIdx.x == 0) {
        unsigned* bar = b.bar;
        __builtin_amdgcn_s_waitcnt(0);
        unsigned nloc = b.st[0], nx = b.st[1];
        if (nloc == 0u) { xcd_barrier_complete(bar, b.x, nloc, nx); b.st[0] = nloc; b.st[1] = nx; }
        const unsigned old = xb_add(&bar[XB_XSUB(b.x)], 1u);
        const unsigned gen = old / nloc;
        if (old + 1u == (gen + 1u) * nloc) {
            __builtin_amdgcn_fence(__ATOMIC_RELEASE, "agent");
            asm volatile("s_waitcnt vmcnt(0)" ::: "memory");
            const unsigned og = xb_add(&bar[XB_TOP], 1u);
            const unsigned tg = og / nx;
            if (og + 1u == (tg + 1u) * nx) xb_add(&bar[XB_TOPGEN], 1u);
            else XB_SPIN(xb_ld(&bar[XB_TOPGEN]) == tg, bar);
            __builtin_amdgcn_fence(__ATOMIC_ACQUIRE, "agent");
            xb_add(&bar[XB_XGEN(b.x)], 1u);
            asm volatile("s_waitcnt vmcnt(0)" ::: "memory");
        } else {
            XB_SPIN(xb_ld(&bar[XB_XGEN(b.x)]) == gen, bar);
            __builtin_amdgcn_fence(__ATOMIC_ACQUIRE, "agent");
            asm volatile("s_waitcnt vmcnt(0)" ::: "memory");
        }
    }
    __syncthreads();
}

namespace pg8 {
#define PG8_LAS __attribute__((address_space(3)))
constexpr int BM = 256, BK = 64, HALF = 128, HTB = HALF * BK * 2  , STAGE_BYTES = 8 * HTB, NXCD = 8, WGM = 8;

__host__ __device__ __forceinline__ int lds_byte(int r, int c) { const int st = (r >> 4) * 2 + (c >> 5), rr = r & 15, cc = c & 31, ob = rr * 64 + cc * 2; return st * 1024 + (ob ^ (((ob >> 9) & 1) << 5)); }
__host__ __device__ __forceinline__ void stage_rc(int b, int& R, int& C) { const int st = b / 1024, sb = b % 1024, swz = sb ^ (((sb >> 9) & 1) << 5); R = (st >> 1) * 16 + swz / 64; C = (st & 1) * 32 + (swz % 64) / 2; }
__host__ __device__ __forceinline__ int perm32(int rho) { const int n = rho >> 4, i = rho & 15; return 8 * (i >> 2) + 4 * n + (i & 3); }

struct Unit { int pm, pn; };
struct Gemm { const bf16_t* A; const bf16_t* Bt; int M, N, K, lda, ldb; };

struct StaticOrder {
    int nM, nN, nwg, G, c;
    __host__ __device__ void init(int M, int N, int G_, int c_) { nM = M / BM; nN = N / BM; nwg = nM * nN; G = G_; c = c_; }
    __host__ __device__ bool next(int i, Unit& u) const {
        const long L = (long)i * G + c; if (L >= nwg) return false;
        int wgid = (int)L; { const int q = nwg / NXCD, r = nwg % NXCD, xcd = wgid % NXCD, off = wgid / NXCD; wgid = (xcd < r ? xcd * (q + 1) : r * (q + 1) + (xcd - r) * q) + off; }
        const int nig = WGM * nN, gid = wgid / nig, fm = gid * WGM, gsz = (nM - fm) < WGM ? (nM - fm) : WGM;
        u.pm = fm + ((wgid % nig) % gsz); u.pn = (wgid % nig) / gsz; return true;
    }
    __device__ __forceinline__ void a_ready(const Unit&) const {}
    __device__ __forceinline__ void done(const Unit&) const {}
};
struct CountedOrder : StaticOrder {
    const unsigned* ready; unsigned need; unsigned* tmo;
    __device__ __forceinline__ void a_ready(const Unit& u) const {
        if (TIDX() < 64) {
            const unsigned long long t0 = __builtin_amdgcn_s_memrealtime(); unsigned polls = 0;
            while ((unsigned)__builtin_amdgcn_readfirstlane(__hip_atomic_load(ready + 64 * u.pm, __ATOMIC_RELAXED, __HIP_MEMORY_SCOPE_AGENT)) < need) {
                if ((++polls & 255u) == 0u && __builtin_amdgcn_readfirstlane(__hip_atomic_load(tmo, __ATOMIC_RELAXED, __HIP_MEMORY_SCOPE_AGENT)) != 0u) break;
                if (__builtin_amdgcn_s_memrealtime() - t0 > 2000000ull) {
                    if (TIDX() == 0) { unsigned expect = 0u; __hip_atomic_compare_exchange_strong(tmo + 1, &expect, 0x600u | (unsigned)(u.pm & 0xff), __ATOMIC_RELAXED, __ATOMIC_RELAXED, __HIP_MEMORY_SCOPE_AGENT); __hip_atomic_store(tmo, 1u, __ATOMIC_RELAXED, __HIP_MEMORY_SCOPE_AGENT); }
                    break; }
                __builtin_amdgcn_s_sleep(2); }
            __builtin_amdgcn_fence(__ATOMIC_ACQUIRE, "agent");
            asm volatile("s_waitcnt vmcnt(0)" ::: "memory");
        }
#if !defined(BROKEN_HOOK_NO_BARRIER)
        asm volatile("" ::: "memory"); __builtin_amdgcn_s_barrier(); asm volatile("" ::: "memory");
#endif
    }
};


template <class Epi, class Sched, bool STAMP = false>
__device__ __forceinline__ void gemm_phase(PG8_LAS unsigned char* lds, const Gemm g, const Sched& S, const Epi& E, unsigned long long* stamps) {
    const int tid = TIDX(), wid = __builtin_amdgcn_readfirstlane(tid >> 6), lane = tid & 63, wr = wid >> 2, wc = wid & 3, fr = lane & 15, fq = lane >> 4;
    const int K = g.K, nt = K / BK;
    int ts_lo = 0, ts_hi = 0, nts = 0; const unsigned long long rt_entry = STAMP ? (unsigned long long)wall_clock64() : 0ull;
#define PG8_STAMP() do { if (STAMP && wid == 0 && nts < 64) { const unsigned long long _c = (unsigned long long)clock64(); \
        ts_lo = (lane == nts) ? (int)(unsigned)_c : ts_lo; ts_hi = (lane == nts) ? (int)(unsigned)(_c >> 32) : ts_hi; ++nts; } } while (0)
    PG8_STAMP();
    unsigned voffA[2], voffB[2];
#pragma unroll
    for (int i = 0; i < 2; ++i) { int R, C; stage_rc(tid * 16 + i * 8192, R, C); const int Rb = Epi::PERM ? ((R & ~31) + perm32(R & 31)) : R;
        voffA[i] = (unsigned)(R * g.lda + C) * 2u; voffB[i] = (unsigned)(Rb * g.ldb + C) * 2u; }
    const size_t kstep = (size_t)(BK * 2);
    const size_t hstepA = (size_t)HALF * g.lda * 2, hstepB = (size_t)HALF * g.ldb * 2;
    const size_t tstepA = 2 * hstepA, tstepB = 2 * hstepB;
    const unsigned ldsw = (unsigned)wid * 1024u;
    const int aoff = lds_byte(wr * 64 + fr, fq * 8), boff = lds_byte(wc * 32 + fr, fq * 8);
#define PG8_SA(b, h) (((b) * 2 + (h)) * HTB)
#define PG8_SB(b, h) ((4 + (b) * 2 + (h)) * HTB)
#define PG8_STAGE(bufoff, gbase, voff) do { _Pragma("unroll") for (int _i = 0; _i < 2; ++_i) \
        __builtin_amdgcn_global_load_lds((const unsigned*)((const char*)(gbase) + (voff)[_i]), (PG8_LAS unsigned*)(lds + (bufoff) + ldsw + _i * 8192), 16, 0, 0); } while (0)
#define PG8_LDA(dst, b, h) do { _Pragma("unroll") for (int m = 0; m < 4; ++m) _Pragma("unroll") for (int k = 0; k < 2; ++k) dst[m][k] = *(const PG8_LAS bf16x8*)(lds + PG8_SA(b, h) + aoff + m * 2048 + k * 1024); } while (0)
#define PG8_LDB(dst, b, h) do { _Pragma("unroll") for (int n = 0; n < 2; ++n) _Pragma("unroll") for (int k = 0; k < 2; ++k) dst[n][k] = *(const PG8_LAS bf16x8*)(lds + PG8_SB(b, h) + boff + n * 2048 + k * 1024); } while (0)
#define PG8_MMA(ai, bj, At, Bt) do { __builtin_amdgcn_s_setprio(1); _Pragma("unroll") for (int m = 0; m < 4; ++m) _Pragma("unroll") for (int n = 0; n < 2; ++n) _Pragma("unroll") for (int k = 0; k < 2; ++k) \
        acc[ai][bj][m][n] = __builtin_amdgcn_mfma_f32_16x16x32_bf16(Bt[n][k], At[m][k], acc[ai][bj][m][n], 0, 0, 0); __builtin_amdgcn_s_setprio(0); } while (0)
#define PG8_WAIT_V(n) asm volatile("s_waitcnt vmcnt(" #n ")" ::: "memory")
#define PG8_WAIT_L(n) asm volatile("s_waitcnt lgkmcnt(" #n ")" ::: "memory")
#define PG8_BAR __builtin_amdgcn_s_barrier()
#define PG8_SCHED __builtin_amdgcn_sched_barrier(0)
    Unit cur, nxt; int ui = 0;
    if (!S.next(0, cur)) return;
    f32x4 acc[2][2][4][2];
#pragma unroll
    for (int a = 0; a < 2; ++a)
#pragma unroll
        for (int b = 0; b < 2; ++b)
#pragma unroll
            for (int m = 0; m < 4; ++m)
#pragma unroll
                for (int n = 0; n < 2; ++n) acc[a][b][m][n] = (f32x4){0.f, 0.f, 0.f, 0.f};
    bf16x8 At[4][2], B0[2][2], B1[2][2];
    const char* cA = (const char*)g.A + (size_t)cur.pm * tstepA; const char* cB = (const char*)g.Bt + (size_t)cur.pn * tstepB;
    S.a_ready(cur);
    PG8_STAGE(PG8_SB(0, 0), cB, voffB); PG8_STAGE(PG8_SA(0, 0), cA, voffA); PG8_STAGE(PG8_SB(0, 1), cB + hstepB, voffB); PG8_STAGE(PG8_SA(0, 1), cA + hstepA, voffA);
    if (wr == 1) PG8_BAR;
    PG8_WAIT_V(4); PG8_BAR;
    PG8_STAGE(PG8_SB(1, 0), cB + kstep, voffB); PG8_STAGE(PG8_SA(1, 0), cA + kstep, voffA); PG8_STAGE(PG8_SB(1, 1), cB + hstepB + kstep, voffB);
    PG8_WAIT_V(6); PG8_BAR;
    PG8_STAMP();
    for (;;) {
        const bool has_next = S.next(ui + 1, nxt);
        const char* nA = has_next ? (const char*)g.A + (size_t)nxt.pm * tstepA : cA; const char* nB = has_next ? (const char*)g.Bt + (size_t)nxt.pn * tstepB : cB;
        for (int t = 0; t < nt; t += 2) {
            const bool last = (t == nt - 2);
            const char* a1 = cA + (size_t)(t + 1) * kstep;
            const char* a2 = last ? nA : cA + (size_t)(t + 2) * kstep; const char* b2 = last ? nB : cB + (size_t)(t + 2) * kstep;
            const char* a3 = a2 + kstep; const char* b3 = b2 + kstep;
            if (last && has_next) S.a_ready(nxt);
            PG8_LDB(B0, 0, 0); PG8_SCHED; PG8_LDA(At, 0, 0); PG8_STAGE(PG8_SA(1, 1), a1 + hstepA, voffA);
            PG8_WAIT_L(8); PG8_BAR; PG8_WAIT_L(0); PG8_MMA(0, 0, At, B0); PG8_BAR; PG8_SCHED;
            PG8_LDB(B1, 0, 1); PG8_STAGE(PG8_SB(0, 0), b2, voffB);
            PG8_BAR; PG8_WAIT_L(0); PG8_MMA(0, 1, At, B1); PG8_BAR;
            PG8_LDA(At, 0, 1); PG8_STAGE(PG8_SA(0, 0), a2, voffA);
            PG8_BAR; PG8_WAIT_L(0); PG8_MMA(1, 0, At, B0); PG8_BAR; PG8_SCHED;
            PG8_STAGE(PG8_SB(0, 1), b2 + hstepB, voffB);
            PG8_WAIT_V(6); PG8_BAR; PG8_MMA(1, 1, At, B1); PG8_BAR;
            PG8_LDB(B0, 1, 0); PG8_SCHED; PG8_LDA(At, 1, 0); PG8_STAGE(PG8_SA(0, 1), a2 + hstepA, voffA);
            PG8_WAIT_L(8); PG8_BAR; PG8_WAIT_L(0); PG8_MMA(0, 0, At, B0); PG8_BAR; PG8_SCHED;
            PG8_LDB(B1, 1, 1); PG8_STAGE(PG8_SB(1, 0), b3, voffB);
            PG8_BAR; PG8_WAIT_L(0); PG8_MMA(0, 1, At, B1); PG8_BAR;
            PG8_LDA(At, 1, 1); PG8_STAGE(PG8_SA(1, 0), a3, voffA);
            PG8_BAR; PG8_WAIT_L(0); PG8_MMA(1, 0, At, B0); PG8_BAR; PG8_SCHED;
            PG8_STAGE(PG8_SB(1, 1), b3 + hstepB, voffB);
            PG8_WAIT_V(6); PG8_BAR; PG8_MMA(1, 1, At, B1); PG8_BAR;
        }
        PG8_STAMP();
        if constexpr (!Epi::AFTER_DRAIN) { E(acc, cur, wr, wc, fr, fq); S.done(cur); }
        PG8_STAMP();
        if (!has_next) break;
#pragma unroll
        for (int a = 0; a < 2; ++a)
#pragma unroll
            for (int b = 0; b < 2; ++b)
#pragma unroll
                for (int m = 0; m < 4; ++m)
#pragma unroll
                    for (int n = 0; n < 2; ++n) acc[a][b][m][n] = (f32x4){0.f, 0.f, 0.f, 0.f};
        cur = nxt; cA = nA; cB = nB; ++ui;
    }
    PG8_WAIT_V(0);
    if (wr == 0) PG8_BAR;
    PG8_BAR;
    if constexpr (Epi::AFTER_DRAIN) { E.fused(acc, cur, wr, wc, fr, fq, lds, wid, lane); S.done(cur); }
    PG8_STAMP();
    if (STAMP && wid == 0) { stamps[lane] = lane < nts ? (((unsigned long long)(unsigned)ts_hi << 32) | (unsigned)ts_lo) : 0ull;
        if (lane == 62) stamps[62] = rt_entry; if (lane == 63) stamps[63] = (unsigned long long)wall_clock64(); }
#undef PG8_STAMP
#undef PG8_SA
#undef PG8_SB
#undef PG8_STAGE
#undef PG8_LDA
#undef PG8_LDB
#undef PG8_MMA
#undef PG8_WAIT_V
#undef PG8_WAIT_L
#undef PG8_BAR
#undef PG8_SCHED
}
}
typedef __bf16 bf16x2_n __attribute__((ext_vector_type(2)));
DI unsigned cvt_pk_bf16(float lo, float hi) { const f32x2 v = {lo, hi}; return __builtin_bit_cast(unsigned, __builtin_convertvector(v, bf16x2_n)); }
DI float fast_sigmoid(float x) { return __builtin_amdgcn_rcpf(1.0f + __expf(-x)); }

struct EpiF32 {
    static constexpr bool PERM = false, AFTER_DRAIN = false;
    float* C; int ldc;
    DI void operator()(const f32x4 (&acc)[2][2][4][2], const pg8::Unit& u, int wr, int wc, int fr, int fq) const {
        const int row0 = u.pm * 256 + wr * 64 + fr, col0 = u.pn * 256 + wc * 32 + 4 * fq;
#pragma unroll
        for (int ai = 0; ai < 2; ++ai)
#pragma unroll
            for (int m = 0; m < 4; ++m) { float* rowp = C + (size_t)(row0 + ai * 128 + m * 16) * ldc + col0;
#pragma unroll
                for (int bj = 0; bj < 2; ++bj)
#pragma unroll
                    for (int n = 0; n < 2; ++n) *(f32x4*)(rowp + bj * 128 + n * 16) = acc[ai][bj][m][n]; }
    }
};
struct EpiF32Lo {
    static constexpr bool PERM = false, AFTER_DRAIN = false;
    float* C; int ldc;
    DI void operator()(const f32x4 (&acc)[2][2][4][2], const pg8::Unit& u, int wr, int wc, int fr, int fq) const {
        const int row0 = u.pm * 256 + wr * 64 + fr, col0 = u.pn * 256 + wc * 32 + 4 * fq;
#pragma unroll
        for (int ai = 0; ai < 2; ++ai)
#pragma unroll
            for (int m = 0; m < 4; ++m) { float* rowp = C + (size_t)(row0 + ai * 128 + m * 16) * ldc + col0;
#pragma unroll
                for (int n = 0; n < 2; ++n) *(f32x4*)(rowp + n * 16) = acc[ai][0][m][n]; }
    }
};
template <int ACT  > struct EpiBf16 {
    static constexpr bool PERM = true, AFTER_DRAIN = false;
    bf16_t* O; int ldc;
    DI void operator()(const f32x4 (&acc)[2][2][4][2], const pg8::Unit& u, int wr, int wc, int fr, int fq) const {
        const int row0 = u.pm * 256 + wr * 64 + fr, col0 = u.pn * 256 + wc * 32 + 8 * fq;
#pragma unroll
        for (int ai = 0; ai < 2; ++ai)
#pragma unroll
            for (int m = 0; m < 4; ++m) { bf16_t* rowp = O + (size_t)(row0 + ai * 128 + m * 16) * ldc + col0;
#pragma unroll
                for (int bj = 0; bj < 2; ++bj) { f32x4 v0 = acc[ai][bj][m][0], v1 = acc[ai][bj][m][1];
#if defined(NOISE_P1)
                    if (ACT == 0) { unsigned hsh = (unsigned)(row0 + ai * 128 + m * 16) * 2654435761u ^ (unsigned)(col0 + bj * 128) * 40503u;
#pragma unroll
                        for (int j = 0; j < 4; ++j) { hsh = hsh * 1664525u + 1013904223u; v0[j] *= 1.0f + NOISE_P1 * ((float)(hsh >> 8) * (1.0f / 8388608.0f) - 1.0f); hsh = hsh * 1664525u + 1013904223u; v1[j] *= 1.0f + NOISE_P1 * ((float)(hsh >> 8) * (1.0f / 8388608.0f) - 1.0f); } }
#endif
                    if (ACT == 1) {
#pragma unroll
                        for (int j = 0; j < 4; ++j) { v0[j] = fast_sigmoid(v0[j]); v1[j] = fast_sigmoid(v1[j]); } }
                    u32x4 w; w.x = cvt_pk_bf16(v0[0], v0[1]); w.y = cvt_pk_bf16(v0[2], v0[3]); w.z = cvt_pk_bf16(v1[0], v1[1]); w.w = cvt_pk_bf16(v1[2], v1[3]);
                    *(u32x4*)(rowp + bj * 128) = w; } }
    }
};
struct EpiSwiglu {
    static constexpr bool PERM = true, AFTER_DRAIN = false;
    bf16_t* H; int ldc;
    DI void operator()(const f32x4 (&acc)[2][2][4][2], const pg8::Unit& u, int wr, int wc, int fr, int fq) const {
        const int row0 = u.pm * 256 + wr * 64 + fr, col0 = u.pn * 128 + wc * 32 + 8 * fq;
#pragma unroll
        for (int ai = 0; ai < 2; ++ai)
#pragma unroll
            for (int m = 0; m < 4; ++m) { bf16_t* rowp = H + (size_t)(row0 + ai * 128 + m * 16) * ldc + col0;
                float h[8];
#pragma unroll
                for (int n = 0; n < 2; ++n)
#pragma unroll
                    for (int j = 0; j < 4; ++j) { const float g = acc[ai][0][m][n][j], up = acc[ai][1][m][n][j]; h[n * 4 + j] = g * fast_sigmoid(g) * up; }
                u32x4 w; w.x = cvt_pk_bf16(h[0], h[1]); w.y = cvt_pk_bf16(h[2], h[3]); w.z = cvt_pk_bf16(h[4], h[5]); w.w = cvt_pk_bf16(h[6], h[7]);
                *(u32x4*)rowp = w; }
    }
};
struct EpiPart {
    static constexpr bool PERM = true, AFTER_DRAIN = false;
    bf16_t* part01; bf16_t* part23;
    DI void operator()(const f32x4 (&acc)[2][2][4][2], const pg8::Unit& u, int wr, int wc, int fr, int fq) const {
        const int br = u.pm >> 6, pm = u.pm & 63, pn = u.pn & 7;
        bf16_t* O = (br < 2 ? part01 : part23) + (size_t)(br & 1) * T * 2048;
        const int row0 = pm * 256 + wr * 64 + fr, col0 = pn * 256 + wc * 32 + 8 * fq;
#pragma unroll
        for (int ai = 0; ai < 2; ++ai)
#pragma unroll
            for (int m = 0; m < 4; ++m) { bf16_t* rowp = O + (size_t)(row0 + ai * 128 + m * 16) * 2048 + col0;
#pragma unroll
                for (int bj = 0; bj < 2; ++bj) { const f32x4 v0 = acc[ai][bj][m][0], v1 = acc[ai][bj][m][1];
                    u32x4 w; w.x = cvt_pk_bf16(v0[0], v0[1]); w.y = cvt_pk_bf16(v0[2], v0[3]); w.z = cvt_pk_bf16(v1[0], v1[1]); w.w = cvt_pk_bf16(v1[2], v1[3]);
                    *(u32x4*)(rowp + bj * 128) = w; } }
    }
};
struct EpiMergeAcc {
    static constexpr bool PERM = true, AFTER_DRAIN = false;
    const bf16_t* G; bf16_t* O;
    DI void operator()(const f32x4 (&acc)[2][2][4][2], const pg8::Unit& u, int wr, int wc, int fr, int fq) const {
        const int br = u.pm >> 6, pm = u.pm & 63, pn = u.pn & 7;
        const int row0 = pm * 256 + wr * 64 + fr, col0 = pn * 256 + wc * 32 + 8 * fq;
#pragma unroll
        for (int ai = 0; ai < 2; ++ai) {
            u32x4 gw[4][2], ow[4][2];
#pragma unroll
            for (int m = 0; m < 4; ++m) { const size_t row = (size_t)(row0 + ai * 128 + m * 16);
#pragma unroll
                for (int bj = 0; bj < 2; ++bj) { gw[m][bj] = *(const u32x4*)(G + row * NGATE + br * 2048 + col0 + bj * 128);
                    ow[m][bj] = br > 0 ? *(const u32x4*)(O + row * 2048 + col0 + bj * 128) : (u32x4){0u, 0u, 0u, 0u}; } }
#pragma unroll
            for (int m = 0; m < 4; ++m) { bf16_t* op = O + (size_t)(row0 + ai * 128 + m * 16) * 2048 + col0;
#pragma unroll
                for (int bj = 0; bj < 2; ++bj) { const f32x4 v0 = acc[ai][bj][m][0], v1 = acc[ai][bj][m][1]; const u32x4 g = gw[m][bj], o = ow[m][bj];
                    float r[8];
                    r[0] = __uint_as_float(g.x << 16) * v0[0] + __uint_as_float(o.x << 16); r[1] = __uint_as_float(g.x & 0xffff0000u) * v0[1] + __uint_as_float(o.x & 0xffff0000u);
                    r[2] = __uint_as_float(g.y << 16) * v0[2] + __uint_as_float(o.y << 16); r[3] = __uint_as_float(g.y & 0xffff0000u) * v0[3] + __uint_as_float(o.y & 0xffff0000u);
                    r[4] = __uint_as_float(g.z << 16) * v1[0] + __uint_as_float(o.z << 16); r[5] = __uint_as_float(g.z & 0xffff0000u) * v1[1] + __uint_as_float(o.z & 0xffff0000u);
                    r[6] = __uint_as_float(g.w << 16) * v1[2] + __uint_as_float(o.w << 16); r[7] = __uint_as_float(g.w & 0xffff0000u) * v1[3] + __uint_as_float(o.w & 0xffff0000u);
                    u32x4 w; w.x = cvt_pk_bf16(r[0], r[1]); w.y = cvt_pk_bf16(r[2], r[3]); w.z = cvt_pk_bf16(r[4], r[5]); w.w = cvt_pk_bf16(r[6], r[7]);
                    *(u32x4*)(op + bj * 128) = w; } }
        }
    }
};
struct MergeOrder {
    int G, c;
    DI bool next(int i, pg8::Unit& u) const {
        const int ti = i >> 2, br = i & 3; const int tile = ti * G + c; if (tile >= 512) return false;
        int tm = tile >> 3, tn = tile & 7;
        if (G == 256) { const int x = c & 7, r = c >> 3; tm = ti * 32 + x * 4 + (r >> 3); tn = r & 7; }
        u.pm = br * 64 + tm; u.pn = br * 8 + tn; return true;
    }
    DI void a_ready(const pg8::Unit&) const {}
    DI void done(const pg8::Unit&) const {}
};

struct EpiGeluBias {
    static constexpr bool PERM = true, AFTER_DRAIN = false;
    bf16_t* O; int ldc; const float* bias;
    DI void operator()(const f32x4 (&acc)[2][2][4][2], const pg8::Unit& u, int wr, int wc, int fr, int fq) const {
        const int row0 = u.pm * 256 + wr * 64 + fr, col0 = u.pn * 256 + wc * 32 + 8 * fq;
#pragma unroll
        for (int ai = 0; ai < 2; ++ai)
#pragma unroll
            for (int m = 0; m < 4; ++m) { bf16_t* rowp = O + (size_t)(row0 + ai * 128 + m * 16) * ldc + col0;
#pragma unroll
                for (int bj = 0; bj < 2; ++bj) { float h[8];
#pragma unroll
                    for (int n = 0; n < 2; ++n)
#pragma unroll
                        for (int j = 0; j < 4; ++j) { const float x = acc[ai][bj][m][n][j] + bias[col0 + bj * 128 + n * 4 + j];
                            const float z = 0.7978845608028654f * (x + 0.044715f * x * x * x), th = 1.0f - 2.0f * __builtin_amdgcn_rcpf(1.0f + __expf(2.0f * z));
                            h[n * 4 + j] = 0.5f * x * (1.0f + th); }
                    u32x4 w; w.x = cvt_pk_bf16(h[0], h[1]); w.y = cvt_pk_bf16(h[2], h[3]); w.z = cvt_pk_bf16(h[4], h[5]); w.w = cvt_pk_bf16(h[6], h[7]);
                    *(u32x4*)(rowp + bj * 128) = w; } }
    }
};
struct EpiCmpOut {
    static constexpr bool PERM = false, AFTER_DRAIN = false;
    float* C;
    DI void operator()(const f32x4 (&acc)[2][2][4][2], const pg8::Unit& u, int wr, int wc, int fr, int fq) const {
        if (wc >= 2) return;
        const int row0 = u.pm * 256 + wr * 64 + fr, col0 = wc * 32 + 4 * fq;
#pragma unroll
        for (int ai = 0; ai < 2; ++ai)
#pragma unroll
            for (int m = 0; m < 4; ++m) { float* rowp = C + (size_t)(row0 + ai * 128 + m * 16) * 64 + col0;
#pragma unroll
                for (int n = 0; n < 2; ++n) *(f32x4*)(rowp + n * 16) = acc[ai][0][m][n]; }
    }
};
struct SplitOrder {
    int first, count, nN;
    DI bool next(int i, pg8::Unit& u) const { if (i >= count) return false; const int idx = first + i; u.pm = idx / nN; u.pn = idx % nN; return true; }
    DI void a_ready(const pg8::Unit&) const {}
    DI void done(const pg8::Unit&) const {}
};
struct RowWalkOrder {
    int pm, pn0, step, count;
    DI bool next(int i, pg8::Unit& u) const { if (i >= count) return false; u.pm = pm; u.pn = pn0 + i * step; return true; }
    DI void a_ready(const pg8::Unit&) const {}
    DI void done(const pg8::Unit&) const {}
};
template <class Epi>
DI void run_gemm(LAS unsigned char* lds, const bf16_t* A, int lda, const bf16_t* Bt, int ldb, int M, int N, int K, const Epi& E) {
    pg8::Gemm g; g.A = A; g.Bt = Bt; g.M = M; g.N = N; g.K = K; g.lda = lda; g.ldb = ldb;
    pg8::StaticOrder S; S.init(M, N, NBLK(), BIDX());
    pg8::gemm_phase<Epi, pg8::StaticOrder, false>((PG8_LAS unsigned char*)lds, g, S, E, nullptr);
}
#ifndef PREP_R1
#define PREP_R1 1
#endif
#ifndef PREP_R2
#define PREP_R2 1
#endif
#ifndef PREP_R3
#define PREP_R3 1
#endif
#ifndef PREP_R4
#define PREP_R4 1
#endif
#ifndef ZRWKV
#define ZRWKV 1.0f
#endif
#ifndef ZGLA
#define ZGLA 1.0f
#endif
DI void phase_setup(KParamsPtr p, LAS unsigned char* lds) {
    const int tid = TIDX(), bid = BIDX(), nb = NBLK();
    for (int i = bid * 512 + tid; i < SEQ * 48; i += nb * 512) {
        const int pos = i / 48, j = i % 48;
        const bool big = j < 32; const int jj = big ? j : j - 32;
        const double inv = exp2(-(double)jj * (13.287712379549449 / (big ? 32.0 : 16.0)));
        const double a = (double)pos * inv;
        const double r = a - 6.283185307179586 * floor(a / 6.283185307179586);
        const float cs = (float)cos(r), sn = (float)sin(r);
        if (big) { p->cos64[pos * 32 + jj] = cs; p->sin64[pos * 32 + jj] = sn; } else { p->cos32[pos * 16 + jj] = cs; p->sin32[pos * 16 + jj] = sn; }
    }
    LAS float* sc = (LAS float*)lds;
    LAS float* red = (LAS float*)(lds + 32768);
    for (int i = tid; i < NB * D; i += 512) { const float c = p->c[i]; sc[i] = c / (1.0f + __expf(-c)); }
    __syncthreads();
    const int cg = tid & 15, ks = tid >> 4;
    for (int chunk = bid; chunk < 576; chunk += nb) {
        const int ls = chunk / 96, col0 = (chunk % 96) * 64;
        const float* W = p->ada_w + (size_t)ls * D * 6144 + col0 + cg * 4;
        float acc[4][4];
#pragma unroll
        for (int b = 0; b < 4; ++b)
#pragma unroll
            for (int j = 0; j < 4; ++j) acc[b][j] = 0.f;
#pragma unroll 16
        for (int kk = 0; kk < 64; ++kk) {
            const int k = ks * 64 + kk;
            const f32x4 w = *(const f32x4*)(W + (size_t)k * 6144);
#pragma unroll
            for (int b = 0; b < 4; ++b) { const float s = sc[b * D + k];
#pragma unroll
                for (int j = 0; j < 4; ++j) acc[b][j] += s * w[j]; }
        }
#pragma unroll
        for (int b = 0; b < 4; ++b)
#pragma unroll
            for (int j = 0; j < 4; ++j) red[(ks * 4 + b) * 64 + cg * 4 + j] = acc[b][j];
        __syncthreads();
        if (tid < 256) { const int b = tid >> 6, col = tid & 63; float s = 0.f;
            for (int q = 0; q < 32; ++q) s += red[(q * 4 + b) * 64 + col];
            p->mod[(size_t)(ls * 4 + b) * 6144 + col0 + col] = s + p->ada_b[ls * 6144 + col0 + col]; }
        __syncthreads();
    }
}

template <class Map>
DI void conv_job(const float* src, int Ks, int Ns, const float* kscale, bf16_t* dst, int ldd, Map map, LAS float* tl) {
    const int tid = TIDX(), bid = BIDX(), nb = NBLK();
    const int ntk = Ks / 64, ntn = (Ns + 63) / 64, nt = ntk * ntn;
    for (int tile = bid; tile < nt; tile += nb) {
        const int k0 = (tile % ntk) * 64, n0 = (tile / ntk) * 64;
#pragma unroll
        for (int it = 0; it < 2; ++it) {
            const int kr = (tid >> 4) + 32 * it, n = n0 + 4 * (tid & 15);
            f32x4 v = (f32x4){0.f, 0.f, 0.f, 0.f};
            if (n < Ns) v = *(const f32x4*)(src + (size_t)(k0 + kr) * Ns + n);
            if (kscale) v *= kscale[k0 + kr];
#pragma unroll
            for (int j = 0; j < 4; ++j) tl[kr * 65 + 4 * (tid & 15) + j] = v[j];
        }
        __syncthreads();
        { const int nn = tid >> 3, k8 = tid & 7, n = n0 + nn;
            if (n < Ns) { float f[8];
#pragma unroll
                for (int i = 0; i < 8; ++i) f[i] = tl[(k8 * 8 + i) * 65 + nn];
                u32x4 w; w.x = pk2(f[0], f[1]); w.y = pk2(f[2], f[3]); w.z = pk2(f[4], f[5]); w.w = pk2(f[6], f[7]);
                *(u32x4*)(dst + (size_t)map(n) * ldd + k0 + k8 * 8) = w; } }
        __syncthreads();
    }
}
DI void phase_convert(KParamsPtr p, int l, LAS unsigned char* lds) {
    LAS float* tl = (LAS float*)lds;
    const int tid = TIDX(), bid = BIDX(), nb = NBLK();
    const size_t fsz = (size_t)D * DFF;
    for (int f = 0; f < 2; ++f) {
        bf16_t* Wup = f ? p->Wup1 : p->Wup0; bf16_t* Wdn = f ? p->Wdn1 : p->Wdn0;
        conv_job(p->ffn_wg + (size_t)(l * 2 + f) * fsz, D, DFF, nullptr, Wup, D, [](int n) { return 256 * (n >> 7) + (n & 127); }, tl);
        conv_job(p->ffn_wu + (size_t)(l * 2 + f) * fsz, D, DFF, nullptr, Wup, D, [](int n) { return 256 * (n >> 7) + 128 + (n & 127); }, tl);
        conv_job(p->ffn_wd + (size_t)(l * 2 + f) * fsz, DFF, D, nullptr, Wdn, DFF, [](int n) { return n; }, tl);
    }
    conv_job(p->mix_w_in + (size_t)l * D * PROJ_IN, D, PROJ_IN, nullptr, p->Win1, D, [](int n) { return n < NP1 ? n : n - NP1 + NP1P; }, tl);
    for (int i = 0; i < 4; ++i)
        conv_job(p->mix_w_branch + (size_t)(l * 4 + i) * 512 * D, 512, D, nullptr, p->Wbr + (size_t)i * D * 512, 512, [](int n) { return n; }, tl);
    conv_job(p->mix_w_out + (size_t)l * D * D, D, D, nullptr, p->Wout, D, [](int n) { return n; }, tl);
    conv_job(p->mla_wuq + (size_t)l * 384 * 768, 384, 768, p->mla_qn + l * 384, p->Wuq, 384, [](int n) { return n; }, tl);
    conv_job(p->mla_wukv + (size_t)l * 128 * 1024, 128, 1024, p->mla_kvn + l * 128, p->Wukv, 256, [](int n) { return n; }, tl);
    for (int wh = 0; wh < 2; ++wh) {
        conv_job(p->cmp_w1 + (size_t)(l * 2 + wh) * 2048 * 256, 2048, 256, nullptr, p->cW1t + (size_t)wh * 256 * 2048, 2048, [](int n) { return n; }, tl);
        conv_job(p->cmp_w2 + (size_t)(l * 2 + wh) * 256 * 64, 256, 64, nullptr, p->cW2t + (size_t)wh * 256 * 256, 256, [](int n) { return n; }, tl);
    }
    for (int i = bid * 512 + tid; i < 2 * 192 * 256 / 8; i += nb * 512) { const int wh = i / (192 * 32), r = (i % (192 * 32)) >> 5, c8 = i & 31; *(u32x4*)(p->cW2t + (size_t)wh * 256 * 256 + (size_t)(64 + r) * 256 + c8 * 8) = (u32x4){0u, 0u, 0u, 0u}; }
    __syncthreads();
    for (int job = nb - 1 - bid; job < 32; job += nb) { const int wh = job >> 4, n0 = (job & 15) * 16, c = tid & 15, ks = tid >> 4;
        const float* ps = p->cmp_pos + (l * 2 + wh) * 2048 + ks * 64; const float* w1 = p->cmp_w1 + (size_t)(l * 2 + wh) * 2048 * 256 + (size_t)ks * 64 * 256 + n0 + c;
        float a = 0.f;
#pragma unroll 16
        for (int k = 0; k < 64; ++k) a += ps[k] * w1[(size_t)k * 256];
        tl[ks * 16 + c] = a;
        __syncthreads();
        if (tid < 16) { float sm = 0.f;
            for (int q = 0; q < 32; ++q) sm += tl[q * 16 + tid];
            p->cbias[wh * 256 + n0 + tid] = sm; }
        __syncthreads(); }
    conv_job(p->rw_w_w2 + (size_t)l * 64 * 512, 64, 512, nullptr, p->rwWlT, 256, [](int n) { return n; }, tl);
    conv_job(p->rw_a_w2 + (size_t)l * 64 * 512, 64, 512, nullptr, p->rwWlT + 64, 256, [](int n) { return n; }, tl);
    conv_job(p->rw_g_w2 + (size_t)l * 128 * 512, 128, 512, nullptr, p->rwWlT + 128, 256, [](int n) { return n; }, tl);
    for (int i = bid * 512 + tid; i < (NP1P - NP1) * D / 8; i += nb * 512) ((u32x4*)(p->Win1 + (size_t)NP1 * D))[i] = (u32x4){0u, 0u, 0u, 0u};
    for (int i = bid * 512 + tid; i < 1024 * 16; i += nb * 512) { const int r = i >> 4, c8 = i & 15; *(u32x4*)(p->Wukv + (size_t)r * 256 + 128 + c8 * 8) = (u32x4){0u, 0u, 0u, 0u}; }
}

DI void ld8bf(const bf16_t* q, float (&f)[8]) { const u32x4 w = *(const u32x4*)q;
    f[0] = __uint_as_float(w.x << 16); f[1] = __uint_as_float(w.x & 0xffff0000u); f[2] = __uint_as_float(w.y << 16); f[3] = __uint_as_float(w.y & 0xffff0000u);
    f[4] = __uint_as_float(w.z << 16); f[5] = __uint_as_float(w.z & 0xffff0000u); f[6] = __uint_as_float(w.w << 16); f[7] = __uint_as_float(w.w & 0xffff0000u); }
DI u32x4 pack8bf(const float (&f)[8]) { u32x4 w; w.x = pk2(f[0], f[1]); w.y = pk2(f[2], f[3]); w.z = pk2(f[4], f[5]); w.w = pk2(f[6], f[7]); return w; }
DI void ld8f(const float* q, float (&f)[8]) { const f32x4 a = *(const f32x4*)q, b = *(const f32x4*)(q + 4); f[0] = a[0]; f[1] = a[1]; f[2] = a[2]; f[3] = a[3]; f[4] = b[0]; f[5] = b[1]; f[6] = b[2]; f[7] = b[3]; }
template <bool HAS_Y, bool HAS_U, bool XIN_BF = false, bool XOUT_BF = false>
DI void phase_norm(const void* xin_, const bf16_t* y, void* xout_, bf16_t* u, const float* g_post, const float* modPrev, float rw, const float* g_pre, const float* modNext) {
    const float* xin = (const float*)xin_; const bf16_t* xinb = (const bf16_t*)xin_; float* xout = (float*)xout_; bf16_t* xoutb = (bf16_t*)xout_;
    const int tid = TIDX(), lane = tid & 63, wave = tid >> 6;
    for (int row0 = (BIDX() * 8 + wave) * 2; row0 < T; row0 += NBLK() * 16) {
        const int b = row0 >> 12;
        float xv[2][4][8]; u32x4 yw[2][4];
#pragma unroll
        for (int r = 0; r < 2; ++r)
#pragma unroll
            for (int i = 0; i < 4; ++i) { const size_t o = (size_t)(row0 + r) * D + i * 512 + lane * 8;
                if (XIN_BF) ld8bf(xinb + o, xv[r][i]); else ld8f(xin + o, xv[r][i]);
                if (HAS_Y) yw[r][i] = *(const u32x4*)(y + o); }
        if (HAS_Y) {
            float gc[4][8];
#pragma unroll
            for (int i = 0; i < 4; ++i) { const int col = i * 512 + lane * 8; float gp[8], gt[8]; ld8f(g_post + col, gp); ld8f(modPrev + (size_t)b * 6144 + 4096 + col, gt);
#pragma unroll
                for (int e = 0; e < 8; ++e) gc[i][e] = gp[e] * gt[e]; }
#pragma unroll
            for (int r = 0; r < 2; ++r) { float yv[4][8]; float ss = 0.f;
#pragma unroll
                for (int i = 0; i < 4; ++i) { const u32x4 w = yw[r][i];
                    yv[i][0] = __uint_as_float(w.x << 16); yv[i][1] = __uint_as_float(w.x & 0xffff0000u); yv[i][2] = __uint_as_float(w.y << 16); yv[i][3] = __uint_as_float(w.y & 0xffff0000u);
                    yv[i][4] = __uint_as_float(w.z << 16); yv[i][5] = __uint_as_float(w.z & 0xffff0000u); yv[i][6] = __uint_as_float(w.w << 16); yv[i][7] = __uint_as_float(w.w & 0xffff0000u);
#pragma unroll
                    for (int e = 0; e < 8; ++e) ss += yv[i][e] * yv[i][e]; }
                ss = wsum(ss);
                const float rs = rsqrtf(ss * (1.0f / D) + NORM_EPS) * rw;
#pragma unroll
                for (int i = 0; i < 4; ++i)
#pragma unroll
                    for (int e = 0; e < 8; ++e) xv[r][i][e] += gc[i][e] * (yv[i][e] * rs); }
        }
        float cu[4][8], sh[4][8];
        if (HAS_U) {
#pragma unroll
            for (int i = 0; i < 4; ++i) { const int col = i * 512 + lane * 8; float gp[8], scl[8]; ld8f(g_pre + col, gp); ld8f(modNext + (size_t)b * 6144 + 2048 + col, scl); ld8f(modNext + (size_t)b * 6144 + col, sh[i]);
#pragma unroll
                for (int e = 0; e < 8; ++e) cu[i][e] = gp[e] * (scl[e] + 1.0f); }
        }
        if (HAS_Y) {
#pragma unroll
            for (int r = 0; r < 2; ++r)
#pragma unroll
                for (int i = 0; i < 4; ++i) { const size_t o = (size_t)(row0 + r) * D + i * 512 + lane * 8;
                    if (XOUT_BF) *(u32x4*)(xoutb + o) = pack8bf(xv[r][i]);
                    else { *(f32x4*)(xout + o) = (f32x4){xv[r][i][0], xv[r][i][1], xv[r][i][2], xv[r][i][3]}; *(f32x4*)(xout + o + 4) = (f32x4){xv[r][i][4], xv[r][i][5], xv[r][i][6], xv[r][i][7]}; } }
        }
        if (HAS_U) {
#pragma unroll
            for (int r = 0; r < 2; ++r) { float ss = 0.f;
#pragma unroll
                for (int i = 0; i < 4; ++i)
#pragma unroll
                    for (int e = 0; e < 8; ++e) ss += xv[r][i][e] * xv[r][i][e];
                ss = wsum(ss);
                const float rs = rsqrtf(ss * (1.0f / D) + NORM_EPS);
#pragma unroll
                for (int i = 0; i < 4; ++i) { float uu[8];
#pragma unroll
                    for (int e = 0; e < 8; ++e) uu[e] = (xv[r][i][e] * rs) * cu[i][e] + sh[i][e];
                    *(u32x4*)(u + (size_t)(row0 + r) * D + i * 512 + lane * 8) = pack8bf(uu); } }
        }
    }
}

DI float ldP(const bf16_t* P1, int t, int col) { return bf2f(P1[(size_t)t * NP1P + col]); }
DI void phase_prep(KParamsPtr p, int l, LAS unsigned char* lds) {
    constexpr int TT = 8;
    const int tid = TIDX(), lane = tid & 63, wave = tid >> 6;
    LAS float* wl = (LAS float*)lds;
    LAS float* al = wl + TT * 64;
    LAS float* gl = al + TT * 64;
    LAS float* ga = gl + TT * 128;
    LAS float* rsq = ga + TT * 16;
    LAS float* gw2 = rsq + TT * 2;
    for (int i = tid; i < 16 * 256; i += 512) gw2[i] = p->gla_w2[l * 16 * 256 + i];
    __syncthreads();
    const bf16_t* P1 = p->P1;
    const float* mu = p->rw_mu + l * 1792;
    const float* w_w2 = p->rw_w_w2 + l * 64 * 512; const float* a_w2 = p->rw_a_w2 + l * 64 * 512; const float* g_w2 = p->rw_g_w2 + l * 128 * 512;
    for (int tile = BIDX(); tile < T / TT; tile += NBLK()) {
        const int t0 = tile * TT;
        for (int rp1_ = 0; rp1_ < PREP_R1; ++rp1_) {
        for (int i = tid; i < TT * 256; i += 512) {
            const int tt = i >> 8, c = i & 255, t = t0 + tt, s = t & (SEQ - 1);
            const int col = c < 64 ? C_RW_WLO + c : (c < 128 ? C_RW_ALO + (c - 64) : C_RW_GLO + (c - 128));
            const float pv = ldP(P1, t, col), pp = s > 0 ? ldP(P1, t - 1, col) : 0.f;
            const float xs = pv + (pp - pv) * mu[col - C_RW];
            if (c < 64) wl[tt * 64 + c] = tanhf(xs); else if (c < 128) al[tt * 64 + c - 64] = xs; else gl[tt * 128 + c - 128] = sigmoidf_(xs);
        }
        if (tid < TT * 16) ga[tid] = ldP(P1, t0 + (tid >> 4), C_GLA_ALO + (tid & 15));
        for (int tk = wave; tk < TT; tk += 8) { const int t = t0 + tk; float sq = 0.f, skv = 0.f;
#pragma unroll
            for (int i = 0; i < 6; ++i) { const float v = ldP(P1, t, C_MLA_CQ + i * 64 + lane); sq += v * v; }
#pragma unroll
            for (int i = 0; i < 2; ++i) { const float v = ldP(P1, t, C_MLA_CKV + i * 64 + lane); skv += v * v; }
            sq = wsum(sq); skv = wsum(skv);
            if (lane == 0) { rsq[tk * 2] = rsqrtf(sq * (1.0f / 384.0f) + NORM_EPS); rsq[tk * 2 + 1] = rsqrtf(skv * (1.0f / 128.0f) + NORM_EPS); } }
        __syncthreads(); }
        for (int rp2_ = 0; rp2_ < PREP_R2; ++rp2_) { const int j = tid;
            float aw[TT], aa[TT], ag[TT];
            const float w0 = p->rw_w0[l * 512 + j], a0 = p->rw_a0[l * 512 + j];
#pragma unroll
            for (int tt = 0; tt < TT; ++tt) { aw[tt] = w0; aa[tt] = a0; ag[tt] = 0.f; }
#pragma unroll 4
            for (int i = 0; i < 64; i += 4) {
                const float ww0 = w_w2[i * 512 + j], ww1 = w_w2[(i + 1) * 512 + j], ww2 = w_w2[(i + 2) * 512 + j], ww3 = w_w2[(i + 3) * 512 + j];
                const float wa0 = a_w2[i * 512 + j], wa1 = a_w2[(i + 1) * 512 + j], wa2 = a_w2[(i + 2) * 512 + j], wa3 = a_w2[(i + 3) * 512 + j];
#pragma unroll
                for (int tt = 0; tt < TT; ++tt) { const f32x4 x = *(const LAS f32x4*)(wl + tt * 64 + i), z = *(const LAS f32x4*)(al + tt * 64 + i);
                    aw[tt] += (x[0] * ww0 + x[1] * ww1) + (x[2] * ww2 + x[3] * ww3); aa[tt] += (z[0] * wa0 + z[1] * wa1) + (z[2] * wa2 + z[3] * wa3); } }
#pragma unroll 4
            for (int i = 0; i < 128; i += 4) {
                const float wg0 = g_w2[i * 512 + j], wg1 = g_w2[(i + 1) * 512 + j], wg2 = g_w2[(i + 2) * 512 + j], wg3 = g_w2[(i + 3) * 512 + j];
#pragma unroll
                for (int tt = 0; tt < TT; ++tt) { const f32x4 x = *(const LAS f32x4*)(gl + tt * 128 + i); ag[tt] += (x[0] * wg0 + x[1] * wg1) + (x[2] * wg2 + x[3] * wg3); } }
            const float k_k = p->rw_k_k[l * 512 + j], k_a = p->rw_k_a[l * 512 + j];
            const float mur = mu[C_RW_R - C_RW + j], muk = mu[C_RW_K - C_RW + j], muv = mu[C_RW_V - C_RW + j];
#pragma unroll
            for (int tt = 0; tt < TT; ++tt) {
                const int t = t0 + tt, s = t & (SEQ - 1);
                float xr = ldP(P1, t, C_RW_R + j), xk = ldP(P1, t, C_RW_K + j), xv = ldP(P1, t, C_RW_V + j);
                const float pr = s > 0 ? ldP(P1, t - 1, C_RW_R + j) : 0.f, pk = s > 0 ? ldP(P1, t - 1, C_RW_K + j) : 0.f, pvv = s > 0 ? ldP(P1, t - 1, C_RW_V + j) : 0.f;
                xr += (pr - xr) * mur; xk += (pk - xk) * muk; xv += (pvv - xv) * muv;
                const float w = __expf(-0.6065306597126334f * sigmoidf_(aw[tt]));
                const float a = sigmoidf_(aa[tt]);
                const float kkr = xk * k_k;
                const float ss = wsum(kkr * kkr);
                const float kk = kkr / fmaxf(sqrtf(ss), 1e-12f);
                const float k2 = xk * (1.0f + (a - 1.0f) * k_a);
                const size_t o = (size_t)t * 512 + j;
                p->rw_r[o] = f2bf(xr); p->rw_w[o] = w; p->rw_k[o] = f2bf(k2); p->rw_v[o] = f2bf(xv); p->rw_kk[o] = kk; p->rw_b[o] = kk * a; p->rw_g[o] = f2bf(ag[tt]);
            } }
        for (int rp3_ = 0; rp3_ < PREP_R3; ++rp3_)
        for (int tt = 0; tt < TT; ++tt) {
            const int t = t0 + tt, s = t & (SEQ - 1), b = t >> 12;
            if (tid < 256) { const int h = tid >> 5, i = tid & 31;
                const float x1 = ldP(P1, t, C_NSA_Q + h * 64 + i), x2 = ldP(P1, t, C_NSA_Q + h * 64 + 32 + i), cs = p->cos64[s * 32 + i], sn = p->sin64[s * 32 + i];
                p->nsa_q[(size_t)t * 512 + h * 64 + i] = f2bf(x1 * cs - x2 * sn); p->nsa_q[(size_t)t * 512 + h * 64 + 32 + i] = f2bf(x1 * sn + x2 * cs);
            } else if (tid < 448) { const int r = tid - 256, which = r >> 6, hk = (r >> 5) & 1, i = r & 31;
                const int sc = (which == 0 ? C_NSA_KC : (which == 1 ? C_NSA_KS : C_NSA_KW)) + hk * 64;
                bf16_t* dst = which == 0 ? p->nsa_kc_in : (which == 1 ? p->nsa_ks : p->nsa_kw);
                const float x1 = ldP(P1, t, sc + i), x2 = ldP(P1, t, sc + 32 + i), cs = p->cos64[s * 32 + i], sn = p->sin64[s * 32 + i];
                const size_t o = ((size_t)(b * 2 + hk) * SEQ + s) * 64;
                dst[o + i] = f2bf(x1 * cs - x2 * sn); dst[o + 32 + i] = f2bf(x1 * sn + x2 * cs);
            } else if (tid < 472) { const int g = tid - 448; p->nsa_gate[(size_t)t * 24 + g] = sigmoidf_(ldP(P1, t, C_NSA_GL + g)); }
            if (tid < 384) { const int which = tid >> 7, hk = (tid >> 6) & 1, d = tid & 63;
                const int sc = (which == 0 ? C_NSA_VC : (which == 1 ? C_NSA_VS : C_NSA_VW)) + hk * 64;
                bf16_t* dst = which == 0 ? p->nsa_vc_in : (which == 1 ? p->nsa_vs : p->nsa_vw);
                dst[((size_t)(b * 2 + hk) * SEQ + s) * 64 + d] = P1[(size_t)t * NP1P + sc + d]; }
        }
        for (int rp4_ = 0; rp4_ < PREP_R4; ++rp4_) {
        for (int i = tid; i < TT * 256; i += 512) {
            const int tt = i >> 8, d = i & 255;
            float z = p->gla_b[l * 256 + d];
#pragma unroll
            for (int q = 0; q < 16; ++q) z += ga[tt * 16 + q] * gw2[q * 256 + d];
            const float ez = __expf(-fabsf(z)), ls = fminf(z, 0.f) - __logf(1.0f + ez);
            p->gla_la[(size_t)(t0 + tt) * 256 + d] = ls * (1.0f / 16.0f);
        }
        for (int i = tid; i < TT * 384; i += 512) { const int tt = i / 384, c = i % 384; p->mla_cqn[(size_t)(t0 + tt) * 384 + c] = f2bf(ldP(P1, t0 + tt, C_MLA_CQ + c) * rsq[tt * 2]); }
        for (int i = tid; i < TT * 256; i += 512) { const int tt = i >> 8, c = i & 255; p->mla_ckvn[(size_t)(t0 + tt) * 256 + c] = c < 128 ? f2bf(ldP(P1, t0 + tt, C_MLA_CKV + c) * rsq[tt * 2 + 1]) : (bf16_t)0; }
        if (tid < TT * 16) { const int tt = tid >> 4, i = tid & 15, t = t0 + tt, s = t & (SEQ - 1);
            const float x1 = ldP(P1, t, C_MLA_KR + i), x2 = ldP(P1, t, C_MLA_KR + 16 + i), cs = p->cos32[s * 16 + i], sn = p->sin32[s * 16 + i];
            p->mla_kpe[(size_t)t * 32 + i] = f2bf(x1 * cs - x2 * sn); p->mla_kpe[(size_t)t * 32 + 16 + i] = f2bf(x1 * sn + x2 * cs); }
        }
        __syncthreads();
    }
}

DI float prep_red16(float x) {
    x += __int_as_float(__builtin_amdgcn_update_dpp(0, __float_as_int(x), 0xB1, 0xF, 0xF, true)); x += __int_as_float(__builtin_amdgcn_update_dpp(0, __float_as_int(x), 0x4E, 0xF, 0xF, true));
    x += __int_as_float(__builtin_amdgcn_update_dpp(0, __float_as_int(x), 0x141, 0xF, 0xF, true)); x += __int_as_float(__builtin_amdgcn_update_dpp(0, __float_as_int(x), 0x140, 0xF, 0xF, true)); return x; }
DI void rope8(const bf16_t* src1, const bf16_t* src2, const float* cs, const float* sn, bf16_t* dst1, bf16_t* dst2) {
    float x1[8], x2[8], c[8], sgn[8], o1[8], o2[8]; ld8bf(src1, x1); ld8bf(src2, x2); ld8f(cs, c); ld8f(sn, sgn);
#pragma unroll
    for (int e = 0; e < 8; ++e) { o1[e] = x1[e] * c[e] - x2[e] * sgn[e]; o2[e] = x1[e] * sgn[e] + x2[e] * c[e]; }
    *(u32x4*)dst1 = pack8bf(o1); *(u32x4*)dst2 = pack8bf(o2); }
constexpr int P1TAIL = 5120;
DI float ldtail(const float* part, int t, int cc) { return (part[(size_t)t * 256 + cc] + part[((size_t)T + t) * 256 + cc]) + (part[((size_t)2 * T + t) * 256 + cc] + part[((size_t)3 * T + t) * 256 + cc]); }
DI void ldtail8(const float* part, int t, int cc, float (&f)[8]) { float a[8], b[8], c[8], d[8];
    ld8f(part + (size_t)t * 256 + cc, a); ld8f(part + ((size_t)T + t) * 256 + cc, b); ld8f(part + ((size_t)2 * T + t) * 256 + cc, c); ld8f(part + ((size_t)3 * T + t) * 256 + cc, d);
#pragma unroll
    for (int e = 0; e < 8; ++e) f[e] = (a[e] + b[e]) + (c[e] + d[e]); }
DI void phase_prep2(KParamsPtr p, int l, LAS unsigned char* lds) {
    constexpr int TT = 16, XS = 264;
    const int tid = TIDX(), lane = tid & 63, wave = tid >> 6, fr = lane & 15, q4 = lane >> 4;
    LAS bf16_t* xa = (LAS bf16_t*)lds;
    LAS float* ga = (LAS float*)(lds + TT * XS * 2);
    LAS float* rsq = ga + TT * 16;
    LAS float* gw2 = rsq + TT * 2;
    LAS float* tl = gw2 + 16 * 256;
    for (int i = tid; i < 16 * 256; i += 512) gw2[i] = p->gla_w2[l * 16 * 256 + i];
    __syncthreads();
    const bf16_t* P1 = p->P1; const float* ptail = (const float*)p->y;
    const float* mu = p->rw_mu + l * 1792;
    const bf16_t* WT = p->rwWlT;
    float c_w0[4], c_a0[4], c_kk[4], c_ka[4], c_mr[4], c_mk[4], c_mv[4];
#pragma unroll
    for (int nb = 0; nb < 4; ++nb) { const int ch = wave * 64 + nb * 16 + fr;
        c_w0[nb] = p->rw_w0[l * 512 + ch]; c_a0[nb] = p->rw_a0[l * 512 + ch]; c_kk[nb] = p->rw_k_k[l * 512 + ch]; c_ka[nb] = p->rw_k_a[l * 512 + ch];
        c_mr[nb] = mu[C_RW_R - C_RW + ch]; c_mk[nb] = mu[C_RW_K - C_RW + ch]; c_mv[nb] = mu[C_RW_V - C_RW + ch]; }
    for (int tile = BIDX(); tile < T / TT; tile += NBLK()) {
        const int t0 = tile * TT;
        { const int tt = tid >> 5, c = (tid & 31) * 8, t = t0 + tt, s = t & (SEQ - 1);
            const int col = c < 64 ? C_RW_WLO + c : (c < 128 ? C_RW_ALO + (c - 64) : C_RW_GLO + (c - 128));
            float pv[8], pp[8], m8[8], o[8]; ld8bf(P1 + (size_t)t * NP1P + col, pv); ld8f(mu + col - C_RW, m8);
            if (s > 0) ld8bf(P1 + (size_t)(t - 1) * NP1P + col, pp); else {
#pragma unroll
                for (int e = 0; e < 8; ++e) pp[e] = 0.f; }
#pragma unroll
            for (int e = 0; e < 8; ++e) { const float xs = pv[e] + (pp[e] - pv[e]) * m8[e];
                o[e] = c < 64 ? 1.0f - 2.0f / (__expf(2.0f * xs) + 1.0f) : (c < 128 ? xs : sigmoidf_(xs)); }
            *(LAS u32x4*)(xa + tt * XS + c) = pack8bf(o); }
        if (tid >= 512 - TT * 9) { const int k_ = tid - (512 - TT * 9), tt = k_ / 9, ch = k_ % 9; float f8[8]; ldtail8(ptail, t0 + tt, ch * 8, f8);
            *(LAS f32x4*)(tl + tt * 80 + ch * 8) = (f32x4){f8[0], f8[1], f8[2], f8[3]}; *(LAS f32x4*)(tl + tt * 80 + ch * 8 + 4) = (f32x4){f8[4], f8[5], f8[6], f8[7]}; }
        if (tid < TT * 16) ga[tid] = ldP(P1, t0 + (tid >> 4), C_GLA_ALO + (tid & 15));
        __syncthreads();
        {
            f32x4 acc[3][4];
#pragma unroll
            for (int w3 = 0; w3 < 3; ++w3)
#pragma unroll
                for (int nb = 0; nb < 4; ++nb) acc[w3][nb] = (f32x4){0.f, 0.f, 0.f, 0.f};
#pragma unroll
            for (int ks = 0; ks < 8; ++ks) {
                const bf16x8 af = *(const LAS bf16x8*)(xa + fr * XS + ks * 32 + q4 * 8);
#pragma unroll
                for (int nb = 0; nb < 4; ++nb) { const bf16x8 bfr = *(const bf16x8*)(WT + (size_t)(wave * 64 + nb * 16 + fr) * 256 + ks * 32 + q4 * 8);
                    acc[ks < 2 ? 0 : (ks < 4 ? 1 : 2)][nb] = __builtin_amdgcn_mfma_f32_16x16x32_bf16(af, bfr, acc[ks < 2 ? 0 : (ks < 4 ? 1 : 2)][nb], 0, 0, 0); }
            }
#pragma unroll
            for (int jj = 0; jj < 4; ++jj) {
                const int t = t0 + q4 * 4 + jj, s = t & (SEQ - 1);
                float xr[4], xk[4], xv[4], kkr[4]; float ss = 0.f;
#pragma unroll
                for (int nb = 0; nb < 4; ++nb) { const int ch = wave * 64 + nb * 16 + fr;
                    xr[nb] = ldP(P1, t, C_RW_R + ch); xk[nb] = ldP(P1, t, C_RW_K + ch); xv[nb] = ldP(P1, t, C_RW_V + ch);
                    const float pr = s > 0 ? ldP(P1, t - 1, C_RW_R + ch) : 0.f, pk = s > 0 ? ldP(P1, t - 1, C_RW_K + ch) : 0.f, pvv = s > 0 ? ldP(P1, t - 1, C_RW_V + ch) : 0.f;
                    xr[nb] += (pr - xr[nb]) * c_mr[nb]; xk[nb] += (pk - xk[nb]) * c_mk[nb]; xv[nb] += (pvv - xv[nb]) * c_mv[nb];
                    kkr[nb] = xk[nb] * c_kk[nb]; ss += kkr[nb] * kkr[nb]; }
                ss = prep_red16(ss);
                const float rn = 1.0f / fmaxf(sqrtf(ss), 1e-12f);
#pragma unroll
                for (int nb = 0; nb < 4; ++nb) { const int ch = wave * 64 + nb * 16 + fr;
                    const float w = __expf(-0.6065306597126334f * sigmoidf_(c_w0[nb] + acc[0][nb][jj]));
                    const float a = sigmoidf_(c_a0[nb] + acc[1][nb][jj]);
                    const float kk = kkr[nb] * rn, k2 = xk[nb] * (1.0f + (a - 1.0f) * c_ka[nb]);
                    const size_t o = (size_t)t * 512 + ch;
                    p->rw_r[o] = f2bf(xr[nb]); p->rw_w[o] = w; p->rw_k[o] = f2bf(k2); p->rw_v[o] = f2bf(xv[nb]); p->rw_kk[o] = kk; p->rw_b[o] = kk * a; p->rw_g[o] = f2bf(acc[2][nb][jj]); }
            }
        }
        for (int tk = wave; tk < TT; tk += 8) { const int t = t0 + tk; float sq = 0.f, skv = 0.f;
#pragma unroll
            for (int i = 0; i < 6; ++i) { const float v = ldP(P1, t, C_MLA_CQ + i * 64 + lane); sq += v * v; }
#pragma unroll
            for (int i = 0; i < 2; ++i) { const int col = C_MLA_CKV + i * 64 + lane; const float v = col < P1TAIL ? ldP(P1, t, col) : tl[tk * 80 + col - P1TAIL]; skv += v * v; }
            sq = wsum(sq); skv = wsum(skv);
            if (lane == 0) { rsq[tk * 2] = rsqrtf(sq * (1.0f / 384.0f) + NORM_EPS); rsq[tk * 2 + 1] = rsqrtf(skv * (1.0f / 128.0f) + NORM_EPS); } }
        __syncthreads();
        { const int tt = tid >> 5, idx = tid & 31, t = t0 + tt, s = t & (SEQ - 1), b = t >> 12;
            const bf16_t* row = P1 + (size_t)t * NP1P;
            { const int h = idx >> 2, ic = idx & 3;
              rope8(row + C_NSA_Q + h * 64 + ic * 8, row + C_NSA_Q + h * 64 + 32 + ic * 8, p->cos64 + s * 32 + ic * 8, p->sin64 + s * 32 + ic * 8,
                    p->nsa_q + (size_t)t * 512 + h * 64 + ic * 8, p->nsa_q + (size_t)t * 512 + h * 64 + 32 + ic * 8); }
            asm volatile("" ::: "memory");
            if (idx < 24) { const int which = idx >> 3, hk = (idx >> 2) & 1, ic = idx & 3;
                const int sc = (which == 0 ? C_NSA_KC : (which == 1 ? C_NSA_KS : C_NSA_KW)) + hk * 64;
                bf16_t* dst = (which == 0 ? p->nsa_kc_in : (which == 1 ? p->nsa_ks : p->nsa_kw)) + ((size_t)(b * 2 + hk) * SEQ + s) * 64;
                rope8(row + sc + ic * 8, row + sc + 32 + ic * 8, p->cos64 + s * 32 + ic * 8, p->sin64 + s * 32 + ic * 8, dst + ic * 8, dst + 32 + ic * 8); }
#pragma unroll
            for (int ps = 0; ps < 2; ++ps) { const int k = idx + 32 * ps;
                if (k < 48) { const int which = k >> 4, hk = (k >> 3) & 1, ic = k & 7;
                    const int sc = (which == 0 ? C_NSA_VC : (which == 1 ? C_NSA_VS : C_NSA_VW)) + hk * 64;
                    bf16_t* dst = (which == 0 ? p->nsa_vc_in : (which == 1 ? p->nsa_vs : p->nsa_vw)) + ((size_t)(b * 2 + hk) * SEQ + s) * 64;
                    *(u32x4*)(dst + ic * 8) = *(const u32x4*)(row + sc + ic * 8); } }
            asm volatile("" ::: "memory");
            if (idx < 3) { float g8[8]; ld8bf(row + C_NSA_GL + idx * 8, g8);
                float* gd = p->nsa_gate + (size_t)t * 24 + idx * 8;
                *(f32x4*)gd = (f32x4){sigmoidf_(g8[0]), sigmoidf_(g8[1]), sigmoidf_(g8[2]), sigmoidf_(g8[3])}; *(f32x4*)(gd + 4) = (f32x4){sigmoidf_(g8[4]), sigmoidf_(g8[5]), sigmoidf_(g8[6]), sigmoidf_(g8[7])}; }
            asm volatile("" ::: "memory");
            { const int c = idx * 8; u32x4 w = (u32x4){0u, 0u, 0u, 0u};
              if (c < 128) { float v8[8]; if (C_MLA_CKV + c < P1TAIL) ld8bf(row + C_MLA_CKV + c, v8); else { const f32x4 a_ = *(const LAS f32x4*)(tl + tt * 80 + C_MLA_CKV + c - P1TAIL), b_ = *(const LAS f32x4*)(tl + tt * 80 + C_MLA_CKV + c - P1TAIL + 4); v8[0] = a_[0]; v8[1] = a_[1]; v8[2] = a_[2]; v8[3] = a_[3]; v8[4] = b_[0]; v8[5] = b_[1]; v8[6] = b_[2]; v8[7] = b_[3]; } const float r = rsq[tt * 2 + 1];
#pragma unroll
                  for (int e = 0; e < 8; ++e) v8[e] *= r;
                  w = pack8bf(v8); }
              *(u32x4*)(p->mla_ckvn + (size_t)t * 256 + c) = w; }
            if (idx < 2) { float x1[8], x2[8], cs[8], sn[8], o1[8], o2[8]; { const f32x4 a_ = *(const LAS f32x4*)(tl + tt * 80 + C_MLA_KR - P1TAIL + idx * 8), b_ = *(const LAS f32x4*)(tl + tt * 80 + C_MLA_KR - P1TAIL + idx * 8 + 4), c_ = *(const LAS f32x4*)(tl + tt * 80 + C_MLA_KR - P1TAIL + 16 + idx * 8), d_ = *(const LAS f32x4*)(tl + tt * 80 + C_MLA_KR - P1TAIL + 16 + idx * 8 + 4);
#pragma unroll
                  for (int e = 0; e < 4; ++e) { x1[e] = a_[e]; x1[4 + e] = b_[e]; x2[e] = c_[e]; x2[4 + e] = d_[e]; } }
                ld8f(p->cos32 + s * 16 + idx * 8, cs); ld8f(p->sin32 + s * 16 + idx * 8, sn);
#pragma unroll
                for (int e = 0; e < 8; ++e) { o1[e] = x1[e] * cs[e] - x2[e] * sn[e]; o2[e] = x1[e] * sn[e] + x2[e] * cs[e]; }
                *(u32x4*)(p->mla_kpe + (size_t)t * 32 + idx * 8) = pack8bf(o1); *(u32x4*)(p->mla_kpe + (size_t)t * 32 + 16 + idx * 8) = pack8bf(o2); }
        }
            asm volatile("" ::: "memory");
        for (int i = tid; i < TT * 48; i += 512) { const int tt = i / 48, c = (i % 48) * 8; float v8[8]; ld8bf(P1 + (size_t)(t0 + tt) * NP1P + C_MLA_CQ + c, v8); const float r = rsq[tt * 2];
#pragma unroll
            for (int e = 0; e < 8; ++e) v8[e] *= r;
            *(u32x4*)(p->mla_cqn + (size_t)(t0 + tt) * 384 + c) = pack8bf(v8); }
            asm volatile("" ::: "memory");
        { const int d = tid & 255; float wq[16];
#pragma unroll
            for (int q = 0; q < 16; ++q) wq[q] = gw2[q * 256 + d];
            const float bz = p->gla_b[l * 256 + d];
#pragma unroll
            for (int k = 0; k < TT / 2; ++k) { const int tt = (tid >> 8) + 2 * k; float z = bz;
#pragma unroll
                for (int q4_ = 0; q4_ < 4; ++q4_) { const f32x4 g = *(const LAS f32x4*)(ga + tt * 16 + q4_ * 4); z += (g[0] * wq[q4_ * 4] + g[1] * wq[q4_ * 4 + 1]) + (g[2] * wq[q4_ * 4 + 2] + g[3] * wq[q4_ * 4 + 3]); }
                const float ez = __expf(-fabsf(z)), ls = fminf(z, 0.f) - __logf(1.0f + ez);
                p->gla_la[(size_t)(t0 + tt) * 256 + d] = ls * (1.0f / 16.0f); } }
        __syncthreads();
    }
}


DI float gelu_tanh(float x) { return 0.5f * x * (1.0f + tanhf(0.7978845608028654f * (x + 0.044715f * x * x * x))); }
DI void phase_compress(KParamsPtr p, int l, LAS unsigned char* lds) {
    const int tid = TIDX();
    LAS float* A = (LAS float*)lds;
    LAS float* Hd = A + 8 * 2048;
    for (int task = BIDX(); task < 512; task += NBLK()) {
        const int which = task >> 8, bh = (task >> 5) & 7, n0 = (task & 31) * 8;
        const bf16_t* base = (which ? p->nsa_vc_in : p->nsa_kc_in) + (size_t)bh * SEQ * 64;
        const float* pos = p->cmp_pos + (l * 2 + which) * 2048;
        for (int i = tid; i < 8 * 2048; i += 512) { const int r = i >> 11, k = i & 2047, n = n0 + r;
            A[i] = n < 255 ? bf2f(base[(size_t)n * 1024 + k]) + pos[k] : 0.f; }
        __syncthreads();
        const float* w1 = p->cmp_w1 + (size_t)(l * 2 + which) * 2048 * 256;
        { const int j = tid & 255, half = tid >> 8;
            float acc[4] = {0.f, 0.f, 0.f, 0.f};
            for (int k = 0; k < 2048; ++k) { const float w = w1[(size_t)k * 256 + j];
#pragma unroll
                for (int r = 0; r < 4; ++r) acc[r] += A[(half * 4 + r) * 2048 + k] * w; }
#pragma unroll
            for (int r = 0; r < 4; ++r) Hd[(half * 4 + r) * 256 + j] = gelu_tanh(acc[r]); }
        __syncthreads();
        const float* w2 = p->cmp_w2 + (size_t)(l * 2 + which) * 256 * 64;
        { const int r = tid >> 6, d = tid & 63; float o = 0.f;
            for (int j = 0; j < 256; ++j) o += Hd[r * 256 + j] * w2[j * 64 + d];
            (which ? p->nsa_vc : p->nsa_kc)[((size_t)bh * 256 + n0 + r) * 64 + d] = o; }
        __syncthreads();
    }
}

DI void phase_nsa_cmp(KParamsPtr p, LAS unsigned char* lds) {
    const int tid = TIDX(), lane = tid & 63, wave = tid >> 6;
    LAS float* qs = (LAS float*)lds + wave * (256 + 1024);
    LAS float* pl = qs + 256;
    const float scale = 0.125f;
    for (int item_ = BIDX() * 8 + wave; item_ < NB * 2 * SEQ; item_ += NBLK() * 8) {
        const int item = __builtin_amdgcn_readfirstlane(item_);
        const int s = item & (SEQ - 1), hk = (item >> 12) & 1, b = item >> 13, t = b * SEQ + s, bh = b * 2 + hk;
        const int nvalid = s >= 31 ? min(255, (s - 31) / 16 + 1) : 0;
#pragma unroll
        for (int g = 0; g < 4; ++g) qs[g * 64 + lane] = bf2f(p->nsa_q[(size_t)t * 512 + (hk * 4 + g) * 64 + lane]);
        asm volatile("s_waitcnt lgkmcnt(0)" ::: "memory");
        float sc[4][4];
#pragma unroll
        for (int c = 0; c < 4; ++c) { const int n = lane + 64 * c;
#pragma unroll
            for (int g = 0; g < 4; ++g) sc[c][g] = -1e30f;
            if (n < nvalid) { const float* kr = p->nsa_kc + ((size_t)bh * 256 + n) * 64;
                float d0 = 0.f, d1 = 0.f, d2 = 0.f, d3 = 0.f;
#pragma unroll 4
                for (int k4 = 0; k4 < 16; ++k4) { const f32x4 kv = *(const f32x4*)(kr + k4 * 4);
                    const f32x4 q0 = *(const LAS f32x4*)(qs + k4 * 4), q1 = *(const LAS f32x4*)(qs + 64 + k4 * 4), q2 = *(const LAS f32x4*)(qs + 128 + k4 * 4), q3 = *(const LAS f32x4*)(qs + 192 + k4 * 4);
                    d0 += kv[0] * q0[0] + kv[1] * q0[1] + kv[2] * q0[2] + kv[3] * q0[3]; d1 += kv[0] * q1[0] + kv[1] * q1[1] + kv[2] * q1[2] + kv[3] * q1[3];
                    d2 += kv[0] * q2[0] + kv[1] * q2[1] + kv[2] * q2[2] + kv[3] * q2[3]; d3 += kv[0] * q3[0] + kv[1] * q3[1] + kv[2] * q3[2] + kv[3] * q3[3]; }
                sc[c][0] = d0 * scale; sc[c][1] = d1 * scale; sc[c][2] = d2 * scale; sc[c][3] = d3 * scale; } }
#pragma unroll
        for (int g = 0; g < 4; ++g) {
            float mx = fmaxf(fmaxf(sc[0][g], sc[1][g]), fmaxf(sc[2][g], sc[3][g])); mx = wmax(mx);
            float e[4], sm = 0.f;
#pragma unroll
            for (int c = 0; c < 4; ++c) { e[c] = (lane + 64 * c < nvalid) ? __expf(sc[c][g] - mx) : 0.f; sm += e[c]; }
            sm = wsum(sm);
            const float inv = sm > 0.f ? 1.0f / sm : 0.f;
#pragma unroll
            for (int c = 0; c < 4; ++c) pl[g * 256 + lane + 64 * c] = e[c] * inv;
        }
        asm volatile("s_waitcnt lgkmcnt(0)" ::: "memory");
        { float o[4] = {0.f, 0.f, 0.f, 0.f};
            const float* vr = p->nsa_vc + (size_t)bh * 256 * 64 + lane;
            for (int n = 0; n < nvalid; ++n) { const float v = vr[(size_t)n * 64];
#pragma unroll
                for (int g = 0; g < 4; ++g) o[g] += pl[g * 256 + n] * v; }
#pragma unroll
            for (int g = 0; g < 4; ++g) p->nsa_ocmp[(size_t)t * 512 + (hk * 4 + g) * 64 + lane] = o[g]; }
        float imp = 0.f;
#pragma unroll
        for (int dn = -1; dn <= 3; ++dn) { const int n = 4 * lane + dn;
            if (n >= 0 && n < 255) imp += pl[n] + pl[256 + n] + pl[512 + n] + pl[768 + n]; }
        const int cur = s >> 6;
        const bool valid = lane <= cur, forced = valid && (lane == 0 || lane >= cur - 1);
        const float val = forced ? 1e30f : (valid ? imp : -1e30f);
        int rank = 0;
        for (int jj = 0; jj < 64; ++jj) { const float o = __shfl(val, jj); rank += (o > val || (o == val && jj < lane)) ? 1 : 0; }
        const unsigned long long mask = __ballot(rank < 16);
        if (lane == 0) p->nsa_sel[(size_t)bh * SEQ + s] = mask;
        asm volatile("s_waitcnt lgkmcnt(0)" ::: "memory");
    }
}

DI void dot8(const u32x4 w, LAS const float* q0, int DQ, float (&s)[4]) {
    float kf[8];
    kf[0] = __uint_as_float(w.x << 16); kf[1] = __uint_as_float(w.x & 0xffff0000u); kf[2] = __uint_as_float(w.y << 16); kf[3] = __uint_as_float(w.y & 0xffff0000u);
    kf[4] = __uint_as_float(w.z << 16); kf[5] = __uint_as_float(w.z & 0xffff0000u); kf[6] = __uint_as_float(w.w << 16); kf[7] = __uint_as_float(w.w & 0xffff0000u);
#pragma unroll
    for (int g = 0; g < 4; ++g) { const f32x4 qa = *(const LAS f32x4*)(q0 + g * DQ), qb = *(const LAS f32x4*)(q0 + g * DQ + 4);
        s[g] += kf[0] * qa[0] + kf[1] * qa[1] + kf[2] * qa[2] + kf[3] * qa[3] + kf[4] * qb[0] + kf[5] * qb[1] + kf[6] * qb[2] + kf[7] * qb[3]; }
}
template <int DQ, class KPtr, class VLoad, class Mask>
DI void naive_attn_block(int lane, LAS float* qs  , LAS float* ps  , float scale, KPtr kptr, VLoad vload, Mask mask, float (&m)[4], float (&l)[4], float (&o)[4]) {
    float s[4] = {0.f, 0.f, 0.f, 0.f};
#pragma unroll 4
    for (int c8 = 0; c8 < DQ / 8; ++c8) { const u32x4 w = *(const u32x4*)kptr(c8); dot8(w, qs + c8 * 8, DQ, s); if ((c8 & 3) == 3) asm volatile("" ::: "memory"); }
    float pr[4];
#pragma unroll
    for (int g = 0; g < 4; ++g) {
        const bool ok = mask(g, lane);
        const float sv = ok ? s[g] * scale : -1e30f;
        const float bm = wmax(sv), mn = fmaxf(m[g], bm), corr = __expf(m[g] - mn);
        pr[g] = ok ? __expf(sv - mn) : 0.f;
        l[g] = l[g] * corr + pr[g]; o[g] *= corr; m[g] = mn;
    }
    *(LAS f32x4*)(ps + lane * 4) = (f32x4){pr[0], pr[1], pr[2], pr[3]};
    asm volatile("s_waitcnt lgkmcnt(0)" ::: "memory");
#pragma unroll 4
    for (int key = 0; key < 64; ++key) { const f32x4 pv = *(const LAS f32x4*)(ps + key * 4); const float v = vload(key, lane);
        o[0] += pv[0] * v; o[1] += pv[1] * v; o[2] += pv[2] * v; o[3] += pv[3] * v; if ((key & 3) == 3) asm volatile("" ::: "memory"); }
    asm volatile("s_waitcnt lgkmcnt(0)" ::: "memory");
}

DI void phase_nsa_attn(KParamsPtr p, LAS unsigned char* lds) {
    const int tid = TIDX(), lane = tid & 63, wave = tid >> 6;
    LAS float* qs = (LAS float*)lds + wave * 512;
    LAS float* ps = qs + 256;
    for (int item_ = BIDX() * 8 + wave; item_ < NB * 2 * SEQ; item_ += NBLK() * 8) {
        const int item = __builtin_amdgcn_readfirstlane(item_);
        const int s = item & (SEQ - 1), hk = (item >> 12) & 1, b = item >> 13, t = b * SEQ + s, bh = b * 2 + hk, cur = s >> 6;
#pragma unroll
        for (int g = 0; g < 4; ++g) qs[g * 64 + lane] = bf2f(p->nsa_q[(size_t)t * 512 + (hk * 4 + g) * 64 + lane]);
        asm volatile("s_waitcnt lgkmcnt(0)" ::: "memory");
        float res[4];
        { float m[4] = {-1e30f, -1e30f, -1e30f, -1e30f}, l[4] = {0.f, 0.f, 0.f, 0.f}, o[4] = {0.f, 0.f, 0.f, 0.f};
#if defined(NSA_NO_CMP)
            unsigned long long sel = NSA_SEL0;
#else
            unsigned long long sel = p->nsa_sel[(size_t)bh * SEQ + s];
#endif
            sel &= (cur >= 63) ? ~0ull : ((1ull << (cur + 1)) - 1ull);
            sel = ((unsigned long long)(unsigned)__builtin_amdgcn_readfirstlane((int)(sel >> 32)) << 32) | (unsigned)__builtin_amdgcn_readfirstlane((int)sel);
            const bf16_t* K = p->nsa_ks + (size_t)bh * SEQ * 64; const bf16_t* V = p->nsa_vs + (size_t)bh * SEQ * 64;
#if defined(NSA_NO_SLC)
            sel &= 1ull;
#endif
            while (sel) { const int j = __builtin_ctzll(sel); sel &= sel - 1;
                const int k0 = j * 64;
                naive_attn_block<64>(lane, qs, ps, 0.125f,
                    [&](int c8) { return K + (size_t)(k0 + lane) * 64 + c8 * 8; },
                    [&](int key, int d) { return bf2f(V[(size_t)(k0 + key) * 64 + d]); },
                    [&](int, int key) { return k0 + key <= s; }, m, l, o); }
#pragma unroll
            for (int g = 0; g < 4; ++g) { const float lt = wsum(l[g]); res[g] = p->nsa_gate[(size_t)t * 24 + (hk * 4 + g) * 3 + 1] * (o[g] / lt); } }
        { float m[4] = {-1e30f, -1e30f, -1e30f, -1e30f}, l[4] = {0.f, 0.f, 0.f, 0.f}, o[4] = {0.f, 0.f, 0.f, 0.f};
#if defined(NSA_WIN_USE_S)
            const bf16_t* K = p->nsa_ks + (size_t)bh * SEQ * 64; const bf16_t* V = p->nsa_vs + (size_t)bh * SEQ * 64;
#else
            const bf16_t* K = p->nsa_kw + (size_t)bh * SEQ * 64; const bf16_t* V = p->nsa_vw + (size_t)bh * SEQ * 64;
#endif
            const int lo = s - 511 > 0 ? s - 511 : 0;
#if defined(NSA_NO_WIN)
            for (int j = cur; j <= cur; ++j) { const int k0 = j * 64;
#else
            for (int j = lo >> 6; j <= cur; ++j) { const int k0 = j * 64;
#endif
                naive_attn_block<64>(lane, qs, ps, 0.125f,
                    [&](int c8) { return K + (size_t)(k0 + lane) * 64 + c8 * 8; },
                    [&](int key, int d) { return bf2f(V[(size_t)(k0 + key) * 64 + d]); },
                    [&](int, int key) { return k0 + key <= s && k0 + key >= lo; }, m, l, o); }
#pragma unroll
            for (int g = 0; g < 4; ++g) { const float lt = wsum(l[g]); res[g] += p->nsa_gate[(size_t)t * 24 + (hk * 4 + g) * 3 + 2] * (o[g] / lt); } }
#pragma unroll
        for (int g = 0; g < 4; ++g) { const size_t oi = (size_t)t * 512 + (hk * 4 + g) * 64 + lane;
#if !defined(NSA_NO_CMP)
            res[g] += p->nsa_gate[(size_t)t * 24 + (hk * 4 + g) * 3] * p->nsa_ocmp[oi];
#endif
            p->ys[oi] = f2bf(res[g]); }
    }
}

DI void phase_mla_rope(KParamsPtr p) {
    for (int i = BIDX() * 512 + TIDX(); i < T * 128; i += NBLK() * 512) {
        const int t = i >> 7, h = (i >> 4) & 7, j = i & 15, s = t & (SEQ - 1);
        bf16_t* q = p->mla_q + (size_t)t * 768 + h * 96 + 64;
        const float x1 = bf2f(q[j]), x2 = bf2f(q[16 + j]), cs = p->cos32[s * 16 + j], sn = p->sin32[s * 16 + j];
        q[j] = f2bf(x1 * cs - x2 * sn); q[16 + j] = f2bf(x1 * sn + x2 * cs);
    }
}
DI void phase_mla_attn(KParamsPtr p, LAS unsigned char* lds) {
    const int tid = TIDX(), lane = tid & 63, wave = tid >> 6;
    LAS float* qs = (LAS float*)lds + wave * 640;
    LAS float* ps = qs + 384;
    const float scale = 0.10206207261596577f;
    for (int item_ = BIDX() * 8 + wave; item_ < NB * 8 * (SEQ / 4); item_ += NBLK() * 8) {
        const int item = __builtin_amdgcn_readfirstlane(item_);
        const int s0 = (item & 1023) * 4, h = (item >> 10) & 7, b = item >> 13, t0 = b * SEQ + s0;
        for (int i = lane; i < 384; i += 64) { const int g = i / 96, c = i % 96; qs[i] = bf2f(p->mla_q[(size_t)(t0 + g) * 768 + h * 96 + c]); }
        asm volatile("s_waitcnt lgkmcnt(0)" ::: "memory");
        float m[4] = {-1e30f, -1e30f, -1e30f, -1e30f}, l[4] = {0.f, 0.f, 0.f, 0.f}, o[4] = {0.f, 0.f, 0.f, 0.f};
        const bf16_t* KV = p->mla_kv + (size_t)b * SEQ * 1024 + h * 128; const bf16_t* PE = p->mla_kpe + (size_t)b * SEQ * 32;
        for (int j = 0; j <= (s0 + 3) >> 6; ++j) { const int k0 = j * 64;
            naive_attn_block<96>(lane, qs, ps, scale,
                [&](int c8) { return c8 < 8 ? KV + (size_t)(k0 + lane) * 1024 + c8 * 8 : PE + (size_t)(k0 + lane) * 32 + (c8 - 8) * 8; },
                [&](int key, int d) { return bf2f(KV[(size_t)(k0 + key) * 1024 + 64 + d]); },
                [&](int g, int key) { return k0 + key <= s0 + g; }, m, l, o); }
#pragma unroll
        for (int g = 0; g < 4; ++g) { const float lt = wsum(l[g]); p->ys[(size_t)3 * T * 512 + (size_t)(t0 + g) * 512 + h * 64 + lane] = f2bf(o[g] / lt); }
    }
}

DI void phase_scan_rwkv(KParamsPtr p, LAS unsigned char* lds) {
    const int tid = TIDX(), bid = BIDX();
    if (bid < 32) {
        if (tid >= 64) return;
        const int b = bid >> 3, h = bid & 7, lane = tid;
        LAS float* L = (LAS float*)lds;
        float st[64];
#pragma unroll
        for (int j = 0; j < 64; ++j) st[j] = 0.f;
        size_t o = (size_t)b * SEQ * 512 + h * 64 + lane;
        float nkk = p->rw_kk[o], nw = p->rw_w[o], nk = bf2f(p->rw_k[o]), nb = p->rw_b[o], nr = bf2f(p->rw_r[o]), nv = bf2f(p->rw_v[o]);
        for (int s = 0; s < SEQ; ++s) {
            L[lane] = nkk; L[64 + lane] = nw; L[128 + lane] = nk; L[192 + lane] = nb; L[256 + lane] = nr;
            const float v = nv; const size_t oc = o;
            if (s + 1 < SEQ) { o += 512; nkk = p->rw_kk[o]; nw = p->rw_w[o]; nk = bf2f(p->rw_k[o]); nb = p->rw_b[o]; nr = bf2f(p->rw_r[o]); nv = bf2f(p->rw_v[o]); }
            asm volatile("s_waitcnt lgkmcnt(0)" ::: "memory");
            float skk = 0.f;
#pragma unroll
            for (int j4 = 0; j4 < 16; ++j4) { const f32x4 kk = *(const LAS f32x4*)(L + j4 * 4);
                skk += st[j4 * 4] * kk[0] + st[j4 * 4 + 1] * kk[1] + st[j4 * 4 + 2] * kk[2] + st[j4 * 4 + 3] * kk[3]; }
            float y = 0.f;
#pragma unroll
            for (int j4 = 0; j4 < 16; ++j4) { const f32x4 w = *(const LAS f32x4*)(L + 64 + j4 * 4), k = *(const LAS f32x4*)(L + 128 + j4 * 4), bb = *(const LAS f32x4*)(L + 192 + j4 * 4), r = *(const LAS f32x4*)(L + 256 + j4 * 4);
#pragma unroll
                for (int q = 0; q < 4; ++q) { const float ns = st[j4 * 4 + q] * w[q] - skk * bb[q] + v * k[q]; st[j4 * 4 + q] = ns; y += ns * r[q]; }
                if ((j4 & 3) == 3) asm volatile("" ::: "memory"); }
            p->rw_y[oc] = y;
            asm volatile("s_waitcnt lgkmcnt(0)" ::: "memory");
        }
    }
}
DI void phase_scan_gla(KParamsPtr p, LAS unsigned char* lds) {
    const int tid = TIDX(), bid = BIDX();
    if (bid >= 32 && bid < 48) {
        if (tid >= 128) return;
        const int bh = bid - 32, b = bh >> 2, h = bh & 3, e = tid, lane = tid & 63, wave = tid >> 6;
        LAS float* L = (LAS float*)lds + wave * 192;
        float st[64];
#pragma unroll
        for (int j = 0; j < 64; ++j) st[j] = 0.f;
        const bf16_t* P1 = p->P1;
        for (int s = 0; s < SEQ; ++s) {
            const int t = b * SEQ + s;
            L[lane] = __expf(p->gla_la[(size_t)t * 256 + h * 64 + lane]); L[64 + lane] = ldP(P1, t, C_GLA_K + h * 64 + lane); L[128 + lane] = ldP(P1, t, C_GLA_Q + h * 64 + lane) * 0.125f;
            const float v = ldP(P1, t, C_GLA_V + h * 128 + e);
            asm volatile("s_waitcnt lgkmcnt(0)" ::: "memory");
            float y = 0.f;
#pragma unroll
            for (int j4 = 0; j4 < 16; ++j4) { const f32x4 dc = *(const LAS f32x4*)(L + j4 * 4), k = *(const LAS f32x4*)(L + 64 + j4 * 4), q = *(const LAS f32x4*)(L + 128 + j4 * 4);
#pragma unroll
                for (int qq = 0; qq < 4; ++qq) { const float ns = st[j4 * 4 + qq] * dc[qq] + k[qq] * v; st[j4 * 4 + qq] = ns; y += ns * q[qq]; }
                if ((j4 & 3) == 3) asm volatile("" ::: "memory"); }
            p->gla_o[(size_t)t * 512 + h * 128 + e] = y;
            asm volatile("s_waitcnt lgkmcnt(0)" ::: "memory");
        }
    }
}

DI void phase_scans(KParamsPtr p, LAS unsigned char* lds) { phase_scan_rwkv(p, lds); phase_scan_gla(p, lds); }

DI void phase_post(KParamsPtr p, int l, LAS unsigned char* lds, int wg_skip) {
    const int tid = TIDX(), lane = tid & 63, wave = tid >> 6;
    if (BIDX() < wg_skip) return;
    const int nw = (NBLK() - wg_skip) * 8;
    float ln_w[8], ln_b[8], r_k[8], gg[8];
    ld8f(p->rw_ln_w + l * 512 + lane * 8, ln_w); ld8f(p->rw_ln_b + l * 512 + lane * 8, ln_b); ld8f(p->rw_r_k + l * 512 + lane * 8, r_k); ld8f(p->gla_g + l * 512 + lane * 8, gg);
    for (int tb = (BIDX() - wg_skip) * 8 + wave; tb < T; tb += 2 * nw) {
        float y[2][8], rr[2][8], kk[2][8], vv[2][8], g4[2][8], ov[2][8], gr[2][8]; bool ok[2];
#pragma unroll
        for (int q = 0; q < 2; ++q) { const int t = tb + q * nw; ok[q] = t < T; const size_t o = (size_t)(ok[q] ? t : 0) * 512 + lane * 8;
            ld8f(p->rw_y + o, y[q]); ld8bf(p->rw_r + o, rr[q]); ld8bf(p->rw_k + o, kk[q]); ld8bf(p->rw_v + o, vv[q]); ld8bf(p->rw_g + o, g4[q]); ld8f(p->gla_o + o, ov[q]);
            ld8bf(p->P1 + (size_t)(ok[q] ? t : 0) * NP1P + C_GLA_R + lane * 8, gr[q]); }
#pragma unroll
        for (int q = 0; q < 2; ++q) { const size_t o = (size_t)(tb + q * nw) * 512 + lane * 8;
            float sm = 0.f, sb = 0.f, so = 0.f;
#pragma unroll
            for (int e = 0; e < 8; ++e) { sm += y[q][e]; sb += rr[q][e] * kk[q][e] * r_k[e]; so += ov[q][e] * ov[q][e]; }
#pragma unroll
            for (int m = 1; m <= 4; m <<= 1) { sm += __shfl_xor(sm, m); sb += __shfl_xor(sb, m); so += __shfl_xor(so, m); }
            so += __shfl_xor(so, 8);
            const float mean = sm * (1.0f / 64.0f);
            float sv = 0.f;
#pragma unroll
            for (int e = 0; e < 8; ++e) { y[q][e] -= mean; sv += y[q][e] * y[q][e]; }
#pragma unroll
            for (int m = 1; m <= 4; m <<= 1) sv += __shfl_xor(sv, m);
            const float rstd = rsqrtf(sv * (1.0f / 64.0f) + 64e-5f), rs = rsqrtf(so * (1.0f / 128.0f) + NORM_EPS);
            float o1[8], o2[8];
#pragma unroll
            for (int e = 0; e < 8; ++e) { o1[e] = ((y[q][e] * rstd * ln_w[e] + ln_b[e]) + sb * vv[q][e]) * g4[q][e] * ZRWKV;
                o2[e] = ov[q][e] * rs * gg[e] * (gr[q][e] * sigmoidf_(gr[q][e])) * ZGLA; }
            if (ok[q]) { *(u32x4*)(p->ys + (size_t)1 * T * 512 + o) = pack8bf(o1); *(u32x4*)(p->ys + (size_t)2 * T * 512 + o) = pack8bf(o2); } }
    }
}

DI void unpack8(const u32x4 w, float (&f)[8]) {
    f[0] = __uint_as_float(w.x << 16); f[1] = __uint_as_float(w.x & 0xffff0000u); f[2] = __uint_as_float(w.y << 16); f[3] = __uint_as_float(w.y & 0xffff0000u);
    f[4] = __uint_as_float(w.z << 16); f[5] = __uint_as_float(w.z & 0xffff0000u); f[6] = __uint_as_float(w.w << 16); f[7] = __uint_as_float(w.w & 0xffff0000u);
}
DI void phase_mergesum(const bf16_t* G, const bf16_t* part01, const bf16_t* part23, bf16_t* merged) {
    const size_t n8 = (size_t)T * 2048 / 8;
    for (size_t i = (size_t)BIDX() * 512 + TIDX(); i < n8; i += (size_t)NBLK() * 512) {
        const size_t t = i >> 8, c = (i & 255) * 8;
        float acc[8] = {0.f, 0.f, 0.f, 0.f, 0.f, 0.f, 0.f, 0.f};
#pragma unroll
        for (int br = 0; br < 4; ++br) {
            const u32x4 gw = *(const u32x4*)(G + t * NGATE + br * 2048 + c);
            const u32x4 pw = *(const u32x4*)((br < 2 ? part01 : part23) + (size_t)(br & 1) * T * 2048 + t * 2048 + c);
            float g[8], q[8]; unpack8(gw, g); unpack8(pw, q);
#pragma unroll
            for (int j = 0; j < 8; ++j) acc[j] += g[j] * q[j];
        }
        u32x4 w; w.x = pk2(acc[0], acc[1]); w.y = pk2(acc[2], acc[3]); w.z = pk2(acc[4], acc[5]); w.w = pk2(acc[6], acc[7]);
        *(u32x4*)(merged + t * 2048 + c) = w;
    }
}
#ifndef ZSLC
#define ZSLC 1.0f
#endif
#ifndef ZWIN
#define ZWIN 1.0f
#endif
#ifndef ZCMP
#define ZCMP 1.0f
#endif
#ifndef ZMLA
#define ZMLA 1.0f
#endif
typedef short v4i16_t_ __attribute__((ext_vector_type(4)));
template <int DQ, int NDV = 4> struct FlashGeo {
    static constexpr int KS = DQ * 2 + 32;
    static constexpr int VS = 160;
    static constexpr int KBYTES = 64 * KS, VBYTES = 64 * VS, BUF = KBYTES + VBYTES;
};
template <int NDV> struct FlashAccT { f32x4 O[2][NDV]; float m[2], l[2]; };
typedef FlashAccT<4> FlashAcc;
template <int NDV> DI void flash_reset(FlashAccT<NDV>& a) {
#pragma unroll
    for (int rg = 0; rg < 2; ++rg) { a.m[rg] = -1e30f; a.l[rg] = 0.f;
#pragma unroll
        for (int d = 0; d < NDV; ++d) a.O[rg][d] = (f32x4){0.f, 0.f, 0.f, 0.f}; }
}
template <int DQ> struct FlashStage { u32x4 k, k2, v; };
template <int DQ, class KRow, class PRow, class VRow>
DI void flash_stage_load(FlashStage<DQ>& st, int tid, KRow krow, PRow prow, VRow vrow) {
    int r = tid >> 3, c = tid & 7;
    asm volatile("" : "+v"(r), "+v"(c));
    st.k = *(const u32x4*)(krow(r) + c * 8);
    if (DQ == 96) { if (c < 4) st.k2 = *(const u32x4*)(prow(r) + c * 8); }
    st.v = *(const u32x4*)(vrow(r) + c * 8);
}
template <int DQ>
DI void flash_stage_write(const FlashStage<DQ>& st, int tid, LAS unsigned char* buf) {
    typedef FlashGeo<DQ> G;
    const int r = tid >> 3, c = tid & 7;
    *(LAS u32x4*)(buf + r * G::KS + c * 16) = st.k;
    if (DQ == 96) { if (c < 4) *(LAS u32x4*)(buf + r * G::KS + 128 + c * 16) = st.k2; }
    *(LAS u32x4*)(buf + G::KBYTES + r * G::VS + c * 16) = st.v;
}
#ifndef FLASH_FENCE
#define FLASH_FENCE 1
#endif
template <int DQ, int NDV, int MODE, class Mask>
DI void flash_tile_n(LAS const unsigned char* buf, const bf16x8 (&Q)[2][DQ / 32], FlashAccT<NDV>& a, float sc2, int lane, Mask mask) {
    typedef FlashGeo<DQ, NDV> G;
    const int fr = lane & 15, q4 = lane >> 4;
    f32x4 S[2][4];
#pragma unroll
    for (int rg = 0; rg < 2; ++rg)
#pragma unroll
        for (int kb = 0; kb < 4; ++kb) S[rg][kb] = (f32x4){0.f, 0.f, 0.f, 0.f};
#pragma unroll
    for (int kb = 0; kb < 4; ++kb)
#pragma unroll
        for (int ks = 0; ks < DQ / 32; ++ks) {
            const bf16x8 kf = *(const LAS bf16x8*)(buf + (kb * 16 + fr) * G::KS + (ks * 32 + q4 * 8) * 2);
#pragma unroll
            for (int rg = 0; rg < 2; ++rg) S[rg][kb] = __builtin_amdgcn_mfma_f32_16x16x32_bf16(kf, Q[rg][ks], S[rg][kb], 0, 0, 0);
            if (false && FLASH_FENCE && DQ == 64 && ks == DQ / 32 - 1 && (kb & 1)) asm volatile("" ::: "memory");
        }
    bf16x8 P[2][2];
#pragma unroll
    for (int rg = 0; rg < 2; ++rg) {
        constexpr bool FULL = (MODE == 1);
        float mx = -1e30f; const bool rowok = (MODE == 2) ? mask(rg, 0) : true;
        if (FULL || MODE == 2) {
#pragma unroll
            for (int kb = 0; kb < 4; ++kb) mx = fmaxf(mx, fmaxf(fmaxf(S[rg][kb][0], S[rg][kb][1]), fmaxf(S[rg][kb][2], S[rg][kb][3])));
            if (MODE == 2) mx = rowok ? mx : -1e30f;
        } else {
#pragma unroll
        for (int kb = 0; kb < 4; ++kb)
#pragma unroll
            for (int j = 0; j < 4; ++j) { const float sv = mask(rg, kb * 16 + q4 * 4 + j) ? S[rg][kb][j] : -1e30f; S[rg][kb][j] = sv; mx = fmaxf(mx, sv); }
        }
        { auto r16 = __builtin_amdgcn_permlane16_swap(__float_as_uint(mx), __float_as_uint(mx), false, false); mx = fmaxf(__uint_as_float(r16[0]), __uint_as_float(r16[1]));
          auto r32 = __builtin_amdgcn_permlane32_swap(__float_as_uint(mx), __float_as_uint(mx), false, false); mx = fmaxf(__uint_as_float(r32[0]), __uint_as_float(r32[1])); }
        mx = fmaxf(mx * sc2, -1e30f);
        const bool dead = mx < -1e29f;
        const float mo = a.m[rg]; const bool mv = !dead && mx > mo + 8.0f; const float mn = mv ? mx : mo;
        a.m[rg] = mn;
        const float mexp = dead ? 1e30f : mn;
        if (__builtin_amdgcn_ballot_w64(mv) != 0ull) { const float corr = __builtin_amdgcn_exp2f(mo - mn);
            a.l[rg] *= corr;
#pragma unroll
            for (int d = 0; d < NDV; ++d) a.O[rg][d] *= corr; }
        float ps = 0.f;
#pragma unroll
        for (int kb = 0; kb < 4; ++kb)
#pragma unroll
            for (int j = 0; j < 4; ++j) { const float pv = __builtin_amdgcn_exp2f(__builtin_fmaf(S[rg][kb][j], sc2, -(FULL ? mn : mexp))); S[rg][kb][j] = pv; ps += pv; }
        a.l[rg] += ps;
#pragma unroll
        for (int pb = 0; pb < 2; ++pb) { u32x4 w;
            w.x = cvt_pk_bf16(S[rg][2 * pb][0], S[rg][2 * pb][1]); w.y = cvt_pk_bf16(S[rg][2 * pb][2], S[rg][2 * pb][3]);
            w.z = cvt_pk_bf16(S[rg][2 * pb + 1][0], S[rg][2 * pb + 1][1]); w.w = cvt_pk_bf16(S[rg][2 * pb + 1][2], S[rg][2 * pb + 1][3]);
            P[rg][pb] = __builtin_bit_cast(bf16x8, w); }
    }
    LAS const unsigned char* vt = buf + G::KBYTES;
#pragma unroll
    for (int pb = 0; pb < 2; ++pb)
#pragma unroll
        for (int dvb = 0; dvb < NDV; ++dvb) {
            LAS const unsigned char* vl = vt + (4 * q4 + (fr >> 2)) * G::VS + (fr & 3) * 8;
            const u32x2 lo = __builtin_bit_cast(u32x2, __builtin_amdgcn_ds_read_tr16_b64_v4i16((LAS v4i16_t_*)(vl + (32 * pb) * G::VS + dvb * 32)));
            const u32x2 hi = __builtin_bit_cast(u32x2, __builtin_amdgcn_ds_read_tr16_b64_v4i16((LAS v4i16_t_*)(vl + (32 * pb + 16) * G::VS + dvb * 32)));
            const u32x4 w = (u32x4){lo.x, lo.y, hi.x, hi.y};
            const bf16x8 vf = __builtin_bit_cast(bf16x8, w);
#pragma unroll
            for (int rg = 0; rg < 2; ++rg) a.O[rg][dvb] = __builtin_amdgcn_mfma_f32_16x16x32_bf16(vf, P[rg][pb], a.O[rg][dvb], 0, 0, 0);
        }
}
template <int DQ, class Mask>
DI void flash_tile(LAS const unsigned char* buf, const bf16x8 (&Q)[2][DQ / 32], FlashAcc& a, float sc2, int lane, Mask mask) { flash_tile_n<DQ, 4, 0>(buf, Q, a, sc2, lane, mask); }
template <int DQ>
DI void flash_tile_full(LAS const unsigned char* buf, const bf16x8 (&Q)[2][DQ / 32], FlashAcc& a, float sc2, int lane) { flash_tile_n<DQ, 4, 1>(buf, Q, a, sc2, lane, [](int, int) { return true; }); }
template <int DQ, class Mask>
DI void flash_tile_row(LAS const unsigned char* buf, const bf16x8 (&Q)[2][DQ / 32], FlashAcc& a, float sc2, int lane, Mask mask) { flash_tile_n<DQ, 4, 2>(buf, Q, a, sc2, lane, mask); }
DI float flash_lsum(float l) { l += __shfl_xor(l, 16); l += __shfl_xor(l, 32); return l; }

DI void bf8_to_f(const u32x4 w, f32x4& a, f32x4& b);
DI void phase_mla_flash(KParamsPtr p, LAS unsigned char* lds) {
    typedef FlashGeo<96> G;
    const int tid = TIDX(), lane = tid & 63, wave = __builtin_amdgcn_readfirstlane(tid >> 6), fr = lane & 15, q4 = lane >> 4;
    const float sc2 = 0.10206207261596577f * 1.4426950408889634f;
    const bf16_t* mq = p->mla_q; const bf16_t* mkv = p->mla_kv; const bf16_t* mpe = p->mla_kpe; bf16_t* yo = p->ys + (size_t)3 * T * 512;
    for (int c0 = BIDX(); c0 < 256; c0 += NBLK()) {
        const int c = NBLK() == 256 ? ((c0 & 7) * 32 + (c0 >> 3)) : c0;
        const int bh = c >> 3, b = bh >> 3, h = bh & 7;
#pragma unroll 1
        for (int half = 0; half < 2; ++half) {
            const int qt = half ? 15 - (c & 7) : (c & 7), q0 = qt * 256;
            const int tok0 = q0 + wave * 32 + fr;
            bf16x8 Q[2][3];
#pragma unroll
            for (int rg = 0; rg < 2; ++rg)
#pragma unroll
                for (int ks = 0; ks < 3; ++ks) Q[rg][ks] = *(const bf16x8*)(mq + (size_t)(b * SEQ + tok0 + rg * 16) * 768 + h * 96 + ks * 32 + q4 * 8);
#pragma unroll
            for (int rg = 0; rg < 2; ++rg) {
                const u32x4 mine = __builtin_bit_cast(u32x4, Q[rg][2]);
                u32x4 oth; oth.x = (unsigned)__shfl_xor((int)mine.x, 32); oth.y = (unsigned)__shfl_xor((int)mine.y, 32); oth.z = (unsigned)__shfl_xor((int)mine.z, 32); oth.w = (unsigned)__shfl_xor((int)mine.w, 32);
                f32x4 ma, mb, oa, ob; bf8_to_f(mine, ma, mb); bf8_to_f(oth, oa, ob);
                const size_t ti = (size_t)(tok0 + rg * 16) * 16 + (q4 & 1) * 8;
                const f32x4 ca = *(const f32x4*)(p->cos32 + ti), cb = *(const f32x4*)(p->cos32 + ti + 4), sa = *(const f32x4*)(p->sin32 + ti), sb = *(const f32x4*)(p->sin32 + ti + 4);
                const float sg = q4 < 2 ? -1.0f : 1.0f;
                const f32x4 ra = ma * ca + oa * sa * sg, rb = mb * cb + ob * sb * sg;
                u32x4 w; w.x = cvt_pk_bf16(ra[0], ra[1]); w.y = cvt_pk_bf16(ra[2], ra[3]); w.z = cvt_pk_bf16(rb[0], rb[1]); w.w = cvt_pk_bf16(rb[2], rb[3]);
                Q[rg][2] = __builtin_bit_cast(bf16x8, w); }
            FlashAcc a; flash_reset(a);
            const int nt = (q0 + 256) / 64;
            const bf16_t* kvb = mkv + (size_t)b * SEQ * 1024 + h * 128; const bf16_t* peb = mpe + (size_t)b * SEQ * 32;
            FlashStage<96> st;
            flash_stage_load<96>(st, tid, [&](int r) { return kvb + (size_t)r * 1024; }, [&](int r) { return peb + (size_t)r * 32; }, [&](int r) { return kvb + (size_t)r * 1024 + 64; });
            __syncthreads();
            flash_stage_write<96>(st, tid, lds);
            __syncthreads();
            const int ntf = q0 / 64;
            for (int i = 0; i < ntf; ++i) {
                const int k0 = i * 64;
                flash_stage_load<96>(st, tid, [&](int r) { return kvb + (size_t)(k0 + 64 + r) * 1024; }, [&](int r) { return peb + (size_t)(k0 + 64 + r) * 32; }, [&](int r) { return kvb + (size_t)(k0 + 64 + r) * 1024 + 64; });
                flash_tile_full<96>(lds + (i & 1) * G::BUF, Q, a, sc2, lane);
                flash_stage_write<96>(st, tid, lds + ((i + 1) & 1) * G::BUF);
                __syncthreads();
            }
            for (int i = ntf; i < nt; ++i) {
                const int k0 = i * 64;
                if (i + 1 < nt) flash_stage_load<96>(st, tid, [&](int r) { return kvb + (size_t)(k0 + 64 + r) * 1024; }, [&](int r) { return peb + (size_t)(k0 + 64 + r) * 32; }, [&](int r) { return kvb + (size_t)(k0 + 64 + r) * 1024 + 64; });
                if (k0 <= q0 + wave * 32 + 31) {
                    int d0 = tok0 - k0, d1 = tok0 - k0 + 16;
                    asm volatile("" : "+v"(d0), "+v"(d1));
                    flash_tile<96>(lds + (i & 1) * G::BUF, Q, a, sc2, lane, [&](int rg, int kidx) { return kidx <= (rg ? d1 : d0); });
                }
                if (i + 1 < nt) flash_stage_write<96>(st, tid, lds + ((i + 1) & 1) * G::BUF);
                __syncthreads();
            }
#pragma unroll
            for (int rg = 0; rg < 2; ++rg) { const float inv = 1.0f / flash_lsum(a.l[rg]);
                bf16_t* op = yo + (size_t)(b * SEQ + tok0 + rg * 16) * 512 + h * 64 + q4 * 4;
#pragma unroll
                for (int d = 0; d < 4; ++d) { u32x2 w; w.x = cvt_pk_bf16(a.O[rg][d][0] * inv * ZMLA, a.O[rg][d][1] * inv * ZMLA); w.y = cvt_pk_bf16(a.O[rg][d][2] * inv * ZMLA, a.O[rg][d][3] * inv * ZMLA);
                    *(u32x2*)(op + d * 16) = w; } }
        }
    }
}

DI void phase_nsa_flash(KParamsPtr p, LAS unsigned char* lds) {
    typedef FlashGeo<64> G;
    const int tid = TIDX(), lane = tid & 63, wave = __builtin_amdgcn_readfirstlane(tid >> 6), fr = lane & 15, q4 = lane >> 4;
    const float sc2 = 0.125f * 1.4426950408889634f;
    LAS unsigned* um = (LAS unsigned*)(lds + 2 * G::BUF);
    const bf16_t* nq = p->nsa_q; const unsigned long long* selp = p->nsa_sel; const float* gat = p->nsa_gate; const float* ocmp = p->nsa_ocmp; bf16_t* yo = p->ys;
    for (int c = BIDX(); c < 256; c += NBLK()) {
        const int bh = c >> 5, b = bh >> 1, hk = bh & 1;
        const bf16_t* Ks = p->nsa_ks + (size_t)bh * SEQ * 64; const bf16_t* Vs = p->nsa_vs + (size_t)bh * SEQ * 64;
        const bf16_t* Kw = p->nsa_kw + (size_t)bh * SEQ * 64; const bf16_t* Vw = p->nsa_vw + (size_t)bh * SEQ * 64;
#pragma unroll 1
        for (int half = 0; half < 2; ++half) {
            const int cur = half ? 63 - (c & 31) : (c & 31), s0 = cur * 64, g = wave >> 1, head = hk * 4 + g;
            const int qi0 = (wave & 1) * 32 + fr;
            const size_t t0 = (size_t)b * SEQ + s0 + qi0;
            bf16x8 Q[2][2];
#pragma unroll
            for (int rg = 0; rg < 2; ++rg)
#pragma unroll
                for (int ks = 0; ks < 2; ++ks) Q[rg][ks] = *(const bf16x8*)(nq + (t0 + rg * 16) * 512 + head * 64 + ks * 32 + q4 * 8);
            unsigned long long sel[2];
#pragma unroll
            for (int rg = 0; rg < 2; ++rg) sel[rg] = selp[(size_t)bh * SEQ + s0 + qi0 + rg * 16];
            if (wave == 0) {
                unsigned long long u = selp[(size_t)bh * SEQ + s0 + lane];
                unsigned lo = (unsigned)u, hi = (unsigned)(u >> 32);
#pragma unroll
                for (int o = 32; o >= 1; o >>= 1) { lo |= (unsigned)__shfl_xor((int)lo, o); hi |= (unsigned)__shfl_xor((int)hi, o); }
                if (lane == 0) { um[0] = lo; um[1] = hi; }
            }
            __syncthreads();
            unsigned long long uni = ((unsigned long long)um[1] << 32) | um[0];
            uni &= (cur >= 63) ? ~0ull : ((1ull << (cur + 1)) - 1ull);
            uni = ((unsigned long long)(unsigned)__builtin_amdgcn_readfirstlane((int)(uni >> 32)) << 32) | (unsigned)__builtin_amdgcn_readfirstlane((int)uni);
            float res[2][4][4];
            {
                FlashAcc a; flash_reset(a);
                FlashStage<64> st;
                unsigned long long rem = uni;
                int j = __builtin_ctzll(rem); rem &= rem - 1;
                flash_stage_load<64>(st, tid, [&](int r) { return Ks + (size_t)(j * 64 + r) * 64; }, [&](int r) { return Ks; }, [&](int r) { return Vs + (size_t)(j * 64 + r) * 64; });
                flash_stage_write<64>(st, tid, lds);
                __syncthreads();
                int i = 0;
                for (;;) {
                    const bool more = rem != 0ull;
                    int jn = 0;
                    if (more) { jn = __builtin_ctzll(rem); rem &= rem - 1;
                        flash_stage_load<64>(st, tid, [&](int r) { return Ks + (size_t)(jn * 64 + r) * 64; }, [&](int r) { return Ks; }, [&](int r) { return Vs + (size_t)(jn * 64 + r) * 64; }); }
                    { const bool diag = (j == cur);
                      const bool in0 = (sel[0] >> j) & 1ull, in1 = (sel[1] >> j) & 1ull;
                      int l0 = in0 ? (diag ? qi0 : 64) : -1, l1 = in1 ? (diag ? qi0 + 16 : 64) : -1;
                      asm volatile("" : "+v"(l0), "+v"(l1));
                      if (diag) flash_tile<64>(lds + (i & 1) * G::BUF, Q, a, sc2, lane, [&](int rg, int kidx) { return kidx <= (rg ? l1 : l0); });
                      else flash_tile_row<64>(lds + (i & 1) * G::BUF, Q, a, sc2, lane, [&](int rg, int) { return (rg ? l1 : l0) >= 0; }); }
                    if (more) flash_stage_write<64>(st, tid, lds + ((i + 1) & 1) * G::BUF);
                    __syncthreads();
                    if (!more) break;
                    j = jn; ++i;
                }
#pragma unroll
                for (int rg = 0; rg < 2; ++rg) { const float gt = gat[(t0 + rg * 16) * 24 + head * 3 + 1] / flash_lsum(a.l[rg]);
#pragma unroll
                    for (int d = 0; d < 4; ++d)
#pragma unroll
                        for (int e = 0; e < 4; ++e) res[rg][d][e] = a.O[rg][d][e] * gt * ZSLC; }
            }
            {
                FlashAcc a; flash_reset(a);
                FlashStage<64> st;
                const int jlo = cur >= 8 ? cur - 8 : 0;
                flash_stage_load<64>(st, tid, [&](int r) { return Kw + (size_t)(jlo * 64 + r) * 64; }, [&](int r) { return Kw; }, [&](int r) { return Vw + (size_t)(jlo * 64 + r) * 64; });
                flash_stage_write<64>(st, tid, lds);
                __syncthreads();
                for (int j = jlo, i = 0; j <= cur; ++j, ++i) {
                    if (j < cur) flash_stage_load<64>(st, tid, [&](int r) { return Kw + (size_t)((j + 1) * 64 + r) * 64; }, [&](int r) { return Kw; }, [&](int r) { return Vw + (size_t)((j + 1) * 64 + r) * 64; });
                    { const bool diag = (j == cur), tail = (j == cur - 8);
                      int h0 = diag ? qi0 : 64, h1 = diag ? qi0 + 16 : 64, t0_ = tail ? qi0 : -1, t1_ = tail ? qi0 + 16 : -1;
                      asm volatile("" : "+v"(h0), "+v"(h1), "+v"(t0_), "+v"(t1_));
                      flash_tile<64>(lds + (i & 1) * G::BUF, Q, a, sc2, lane, [&](int rg, int kidx) { return kidx <= (rg ? h1 : h0) && kidx > (rg ? t1_ : t0_); }); }
                    if (j < cur) flash_stage_write<64>(st, tid, lds + ((i + 1) & 1) * G::BUF);
                    __syncthreads();
                }
#pragma unroll
                for (int rg = 0; rg < 2; ++rg) { const float gt = gat[(t0 + rg * 16) * 24 + head * 3 + 2] / flash_lsum(a.l[rg]);
#pragma unroll
                    for (int d = 0; d < 4; ++d)
#pragma unroll
                        for (int e = 0; e < 4; ++e) res[rg][d][e] += a.O[rg][d][e] * gt * ZWIN; }
            }
#pragma unroll
            for (int rg = 0; rg < 2; ++rg) { const float g0 = gat[(t0 + rg * 16) * 24 + head * 3] * ZCMP;
                const size_t ob = (t0 + rg * 16) * 512 + head * 64 + q4 * 4;
#pragma unroll
                for (int d = 0; d < 4; ++d) { const f32x4 oc = *(const f32x4*)(ocmp + ob + d * 16);
                    u32x2 w; w.x = cvt_pk_bf16(res[rg][d][0] + g0 * oc[0], res[rg][d][1] + g0 * oc[1]); w.y = cvt_pk_bf16(res[rg][d][2] + g0 * oc[2], res[rg][d][3] + g0 * oc[3]);
                    *(u32x2*)(yo + ob + d * 16) = w; } }
            __syncthreads();
        }
    }
}

DI void phase_nsa_full(KParamsPtr p, LAS unsigned char* lds) {
    typedef FlashGeo<64> G;
    const int tid = TIDX(), lane = tid & 63, wave = __builtin_amdgcn_readfirstlane(tid >> 6), fr = lane & 15, q4 = lane >> 4;
    const float sc2 = 0.125f * 1.4426950408889634f;
    LAS float* impbuf = (LAS float*)(lds + 2 * G::BUF);
    LAS unsigned long long* selbuf = (LAS unsigned long long*)(lds + 2 * G::BUF + 65536);
    LAS unsigned* um = (LAS unsigned*)(lds + 2 * G::BUF + 65536 + 512);
    const float* kcp = p->nsa_kc; const float* vcp = p->nsa_vc;
    LAS float* rs = impbuf + tid;
    const bf16_t* nq = p->nsa_q; const float* gat = p->nsa_gate; bf16_t* yo = p->ys;
    for (int c0 = BIDX(); c0 < 256; c0 += NBLK()) {
        const int c = NBLK() == 256 ? ((c0 & 7) * 32 + (c0 >> 3)) : c0;
        const int bh = c >> 5, b = bh >> 1, hk = bh & 1;
        const bf16_t* Ks = p->nsa_ks + (size_t)bh * SEQ * 64; const bf16_t* Vs = p->nsa_vs + (size_t)bh * SEQ * 64;
        const bf16_t* Kw = p->nsa_kw + (size_t)bh * SEQ * 64; const bf16_t* Vw = p->nsa_vw + (size_t)bh * SEQ * 64;
#pragma unroll 1
        for (int half = 0; half < 2; ++half) {
            const int cur = half ? 63 - (c & 31) : (c & 31), s0 = cur * 64, g = wave >> 1, head = hk * 4 + g;
            const int qi0 = (wave & 1) * 32 + fr;
            const size_t t0 = (size_t)b * SEQ + s0 + qi0;
            int q4l = q4; asm volatile("" : "+v"(q4l));
            bf16x8 Q[2][2];
#pragma unroll
            for (int rg = 0; rg < 2; ++rg)
#pragma unroll
                for (int ks = 0; ks < 2; ++ks) Q[rg][ks] = *(const bf16x8*)(nq + (t0 + rg * 16) * 512 + head * 64 + ks * 32 + q4l * 8);
            unsigned long long sel[2];
            {
                const int nvmax = min(255, (s0 + 32) / 16 + 1), ntc = (nvmax + 63) >> 6;
                int nv[2];
#pragma unroll
                for (int rg = 0; rg < 2; ++rg) { const int tk = s0 + qi0 + rg * 16; nv[rg] = tk >= 31 ? min(255, (tk - 31) / 16 + 1) : 0; }
#pragma unroll 1
                for (int it = 0; it < 2; ++it) { const int pz = 1 - it;
                    FlashAcc a0; flash_reset(a0);
                    u32x4 sk, sv;
                    auto ld0 = [&](int tl) { int r = tid >> 3, c8 = tid & 7; asm volatile("" : "+v"(r), "+v"(c8)); const size_t o = ((size_t)bh * 256 + tl * 64 + r) * 64 + c8 * 8;
                        const f32x4 k0 = *(const f32x4*)(kcp + o), k1 = *(const f32x4*)(kcp + o + 4);
                        sk = (u32x4){cvt_pk_bf16(k0[0], k0[1]), cvt_pk_bf16(k0[2], k0[3]), cvt_pk_bf16(k1[0], k1[1]), cvt_pk_bf16(k1[2], k1[3])};
                        if (pz == 0) { const f32x4 v0 = *(const f32x4*)(vcp + o), v1 = *(const f32x4*)(vcp + o + 4);
                            sv = (u32x4){cvt_pk_bf16(v0[0], v0[1]), cvt_pk_bf16(v0[2], v0[3]), cvt_pk_bf16(v1[0], v1[1]), cvt_pk_bf16(v1[2], v1[3])}; }
                        else { int n = tl * 64 + r; asm volatile("" : "+v"(n)); unsigned w[4];
#pragma unroll
                            for (int e2 = 0; e2 < 4; ++e2) { const int J0 = c8 * 8 + 2 * e2, J1 = J0 + 1;
                                const unsigned lo = (n >= 4 * J0 - 1 && n <= 4 * J0 + 3 && n < 255) ? 0x3F80u : 0u, hi = (n >= 4 * J1 - 1 && n <= 4 * J1 + 3 && n < 255) ? 0x3F80u : 0u; w[e2] = lo | (hi << 16); }
                            sv = (u32x4){w[0], w[1], w[2], w[3]}; } };
                    FlashStage<64> st0;
                    ld0(0); st0.k = sk; st0.v = sv;
                    flash_stage_write<64>(st0, tid, lds);
                    __syncthreads();
                    for (int tl = 0; tl < ntc; ++tl) {
                        if (tl + 1 < ntc) { ld0(tl + 1); st0.k = sk; st0.v = sv; }
                        { int n0 = nv[0] - tl * 64, n1 = nv[1] - tl * 64;
                          asm volatile("" : "+v"(n0), "+v"(n1));
                          flash_tile<64>(lds + (tl & 1) * G::BUF, Q, a0, sc2, lane, [&](int rg, int kidx) { return kidx < (rg ? n1 : n0); }); }
                        if (tl + 1 < ntc) flash_stage_write<64>(st0, tid, lds + ((tl + 1) & 1) * G::BUF);
                        __syncthreads();
                    }
#pragma unroll
                    for (int rg = 0; rg < 2; ++rg) { const float lt = flash_lsum(a0.l[rg]), inv = lt > 0.f ? 1.0f / lt : 0.f;
                        if (pz == 0) { const float g0 = gat[(t0 + rg * 16) * 24 + head * 3] * inv * ZCMP;
#pragma unroll
                            for (int d = 0; d < 4; ++d)
#pragma unroll
                                for (int e = 0; e < 4; ++e) rs[((rg * 4 + d) * 4 + e) * 512] = a0.O[rg][d][e] * g0; }
                        else {
#pragma unroll
                            for (int d = 0; d < 4; ++d) *(LAS f32x4*)(impbuf + ((size_t)(g * 64 + qi0 + rg * 16)) * 64 + d * 16 + q4 * 4) = a0.O[rg][d] * inv; } }
                    if (it == 0) {
            __syncthreads();
            for (int k = 0; k < 8; ++k) { const int tokl = wave * 8 + k;
                const float im = (impbuf[(0 * 64 + tokl) * 64 + lane] + impbuf[(1 * 64 + tokl) * 64 + lane]) + (impbuf[(2 * 64 + tokl) * 64 + lane] + impbuf[(3 * 64 + tokl) * 64 + lane]);
                const bool valid = lane <= cur, forced = valid && (lane == 0 || lane >= cur - 1);
                const float val = forced ? 1e30f : (valid ? im : -1e30f);
                int rank = 0;
                for (int jj = 0; jj < 64; ++jj) { const float o = __shfl(val, jj); rank += (o > val || (o == val && jj < lane)) ? 1 : 0; }
                const unsigned long long mk = __ballot(rank < 16);
                if (lane == 0) selbuf[tokl] = mk; }
            __syncthreads();
#pragma unroll
            for (int rg = 0; rg < 2; ++rg) sel[rg] = selbuf[qi0 + rg * 16];
            if (wave == 0) {
                unsigned long long u = selbuf[lane];
                unsigned lo = (unsigned)u, hi = (unsigned)(u >> 32);
#pragma unroll
                for (int o = 32; o >= 1; o >>= 1) { lo |= (unsigned)__shfl_xor((int)lo, o); hi |= (unsigned)__shfl_xor((int)hi, o); }
                if (lane == 0) { um[0] = lo; um[1] = hi; }
            }
            __syncthreads();
                    }
                }
            }
            __syncthreads();
            unsigned long long uni = ((unsigned long long)um[1] << 32) | um[0];
            uni &= (cur >= 63) ? ~0ull : ((1ull << (cur + 1)) - 1ull);
            uni = ((unsigned long long)(unsigned)__builtin_amdgcn_readfirstlane((int)(uni >> 32)) << 32) | (unsigned)__builtin_amdgcn_readfirstlane((int)uni);
            FlashAcc a; flash_reset(a);
            {
                FlashStage<64> st;
                unsigned long long rem = uni & ~(1ull << cur);
                if (rem != 0ull) {
                    int j = __builtin_ctzll(rem); rem &= rem - 1;
                    flash_stage_load<64>(st, tid, [&](int r) { return Ks + (size_t)(j * 64 + r) * 64; }, [&](int r) { return Ks; }, [&](int r) { return Vs + (size_t)(j * 64 + r) * 64; });
                    flash_stage_write<64>(st, tid, lds);
                    __syncthreads();
                    int i = 0;
                    for (;;) {
                        const bool more = rem != 0ull;
                        int jn = 0;
                        if (more) { jn = __builtin_ctzll(rem); rem &= rem - 1;
                            flash_stage_load<64>(st, tid, [&](int r) { return Ks + (size_t)(jn * 64 + r) * 64; }, [&](int r) { return Ks; }, [&](int r) { return Vs + (size_t)(jn * 64 + r) * 64; }); }
                        { int l0 = (int)((sel[0] >> j) & 1ull), l1 = (int)((sel[1] >> j) & 1ull);
                          asm volatile("" : "+v"(l0), "+v"(l1));
                          flash_tile_row<64>(lds + (i & 1) * G::BUF, Q, a, sc2, lane, [&](int rg, int) { return (rg ? l1 : l0) != 0; }); }
                        if (more) flash_stage_write<64>(st, tid, lds + ((i + 1) & 1) * G::BUF);
                        __syncthreads();
                        if (!more) break;
                        j = jn; ++i;
                    }
                }
            }
            {
                FlashStage<64> st;
                const int jlo = cur >= 8 ? cur - 8 : 0, ntw = cur - jlo + 1;
                flash_stage_load<64>(st, tid, [&](int r) { return Ks + (size_t)(cur * 64 + r) * 64; }, [&](int r) { return Ks; }, [&](int r) { return Vs + (size_t)(cur * 64 + r) * 64; });
                flash_stage_write<64>(st, tid, lds);
                __syncthreads();
                for (int i2 = 0; i2 <= ntw; ++i2) {
                    if (i2 < ntw) { const int jn = jlo + i2;
                        flash_stage_load<64>(st, tid, [&](int r) { return Kw + (size_t)(jn * 64 + r) * 64; }, [&](int r) { return Kw; }, [&](int r) { return Vw + (size_t)(jn * 64 + r) * 64; }); }
                    { const int j = i2 == 0 ? cur : jlo + i2 - 1; const bool diag = (j == cur), tail = (i2 > 0 && j == cur - 8);
                      int h0 = diag ? qi0 : 64, h1 = diag ? qi0 + 16 : 64, t0_ = tail ? qi0 : -1, t1_ = tail ? qi0 + 16 : -1;
                      asm volatile("" : "+v"(h0), "+v"(h1), "+v"(t0_), "+v"(t1_));
                      if (diag || tail) flash_tile<64>(lds + (i2 & 1) * G::BUF, Q, a, sc2, lane, [&](int rg, int kidx) { return kidx <= (rg ? h1 : h0) && kidx > (rg ? t1_ : t0_); });
                      else flash_tile_row<64>(lds + (i2 & 1) * G::BUF, Q, a, sc2, lane, [&](int rg, int) { return (rg ? h1 : h0) > 0; }); }
                    if (i2 < ntw) flash_stage_write<64>(st, tid, lds + ((i2 + 1) & 1) * G::BUF);
                    __syncthreads();
                    if (i2 == 0) {
#pragma unroll
                        for (int rg = 0; rg < 2; ++rg) { const float gt = gat[(t0 + rg * 16) * 24 + head * 3 + 1] / flash_lsum(a.l[rg]);
#pragma unroll
                            for (int d = 0; d < 4; ++d)
#pragma unroll
                                for (int e = 0; e < 4; ++e) rs[((rg * 4 + d) * 4 + e) * 512] += a.O[rg][d][e] * gt * ZSLC; }
                        flash_reset(a); }
                }
#pragma unroll
                for (int rg = 0; rg < 2; ++rg) { const float gt = gat[(t0 + rg * 16) * 24 + head * 3 + 2] / flash_lsum(a.l[rg]);
#pragma unroll
                    for (int d = 0; d < 4; ++d)
#pragma unroll
                        for (int e = 0; e < 4; ++e) rs[((rg * 4 + d) * 4 + e) * 512] += a.O[rg][d][e] * gt * ZWIN; }
            }
#pragma unroll
            for (int rg = 0; rg < 2; ++rg) { const size_t ob = (t0 + rg * 16) * 512 + head * 64 + q4l * 4;
#pragma unroll
                for (int d = 0; d < 4; ++d) { u32x2 w; w.x = cvt_pk_bf16(rs[((rg * 4 + d) * 4 + 0) * 512], rs[((rg * 4 + d) * 4 + 1) * 512]); w.y = cvt_pk_bf16(rs[((rg * 4 + d) * 4 + 2) * 512], rs[((rg * 4 + d) * 4 + 3) * 512]);
                    *(u32x2*)(yo + ob + d * 16) = w; } }
            __syncthreads();
        }
    }
}
#define DPPF(x, ctrl) __int_as_float(__builtin_amdgcn_update_dpp(0, __float_as_int(x), ctrl, 0xF, 0xF, true))
DI float red16(float x) { x += DPPF(x, 0xB1); x += DPPF(x, 0x4E); x += DPPF(x, 0x141); x += DPPF(x, 0x140); return x; }
DI float dot4(const f32x4 a, const f32x4 b) { f32x2 t = (f32x2){a[0], a[1]} * (f32x2){b[0], b[1]}; t = (f32x2){a[2], a[3]} * (f32x2){b[2], b[3]} + t; return t[0] + t[1]; }
DI void bf8_to_f(const u32x4 w, f32x4& a, f32x4& b) {
    a = (f32x4){__uint_as_float(w.x << 16), __uint_as_float(w.x & 0xffff0000u), __uint_as_float(w.y << 16), __uint_as_float(w.y & 0xffff0000u)};
    b = (f32x4){__uint_as_float(w.z << 16), __uint_as_float(w.z & 0xffff0000u), __uint_as_float(w.w << 16), __uint_as_float(w.w & 0xffff0000u)};
}
template <int MODE>
DI void rowscan_unit(KParamsPtr p, LAS unsigned char* lds, int unit) {
    constexpr int TC = 32, NV = MODE == 0 ? 5 : 3;
    constexpr int NR = 32;
    constexpr int BUFF = NV * TC * 64 + TC * NR + TC * NR;
    const int tid = TIDX(), lane = tid & 63, wave = __builtin_amdgcn_readfirstlane(tid >> 6);
    LAS float* L = (LAS float*)lds;
    int b, h, sub;
    if (MODE == 0) { const int bh = unit >> 1; b = bh >> 3; h = bh & 7; sub = unit & 1; } else { const int bh = unit >> 2; b = bh >> 2; h = bh & 3; sub = unit & 3; }
    const size_t tb = (size_t)b * SEQ;
    f32x4 f0, f1, f2; u32x4 h0, hv;
    auto stage_load = [&](int t0) {
        const int s = tid >> 4, c4 = tid & 15, s2 = (tid & 255) >> 3, c8 = tid & 7;
        if (MODE == 0) {
            const size_t o = (tb + t0 + s) * 512 + h * 64 + c4 * 4;
            f0 = *(const f32x4*)(p->rw_kk + o); f1 = *(const f32x4*)(p->rw_w + o); f2 = *(const f32x4*)(p->rw_b + o);
            const size_t o2 = (tb + t0 + s2) * 512 + h * 64 + c8 * 8;
            h0 = *(const u32x4*)((tid < 256 ? p->rw_k : p->rw_r) + o2);
            if (tid < 128) hv = *(const u32x4*)(p->rw_v + (tb + t0 + (tid >> 2)) * 512 + h * 64 + sub * NR + (tid & 3) * 8);
        } else {
            f0 = *(const f32x4*)(p->gla_la + (tb + t0 + s) * 256 + h * 64 + c4 * 4);
            const bf16_t* row = p->P1 + (tb + t0 + s2) * NP1P;
            h0 = *(const u32x4*)(row + (tid < 256 ? C_GLA_K : C_GLA_Q) + h * 64 + c8 * 8);
            if (tid < 128) hv = *(const u32x4*)(p->P1 + (tb + t0 + (tid >> 2)) * NP1P + C_GLA_V + h * 128 + sub * NR + (tid & 3) * 8);
        }
    };
    auto stage_write = [&](int buf) {
        LAS float* B = L + buf * BUFF;
        const int s = tid >> 4, c4 = tid & 15, s2 = (tid & 255) >> 3, c8 = tid & 7;
        f32x4 a, c; bf8_to_f(h0, a, c);
        if (MODE == 0) {
            *(LAS f32x4*)(B + (0 * TC + s) * 64 + c4 * 4) = f0; *(LAS f32x4*)(B + (1 * TC + s) * 64 + c4 * 4) = f1; *(LAS f32x4*)(B + (3 * TC + s) * 64 + c4 * 4) = f2;
            LAS float* d = B + ((tid < 256 ? 2 : 4) * TC + s2) * 64 + c8 * 8;
            *(LAS f32x4*)d = a; *(LAS f32x4*)(d + 4) = c;
        } else {
            *(LAS f32x4*)(B + (0 * TC + s) * 64 + c4 * 4) = (f32x4){__expf(f0[0]), __expf(f0[1]), __expf(f0[2]), __expf(f0[3])};
            if (tid >= 256) { a *= 0.125f; c *= 0.125f; }
            LAS float* d = B + ((tid < 256 ? 1 : 2) * TC + s2) * 64 + c8 * 8;
            *(LAS f32x4*)d = a; *(LAS f32x4*)(d + 4) = c;
        }
        if (tid < 128) { f32x4 va, vc; bf8_to_f(hv, va, vc); LAS float* d = B + NV * TC * 64 + (tid >> 2) * NR + (tid & 3) * 8; *(LAS f32x4*)d = va; *(LAS f32x4*)(d + 4) = vc; }
    };
    auto flush_y = [&](int buf, int t0) {
        if (tid < TC * 8) { const int s = tid >> 3, q = tid & 7;
            const f32x4 v = *(const LAS f32x4*)(L + buf * BUFF + NV * TC * 64 + TC * NR + s * NR + q * 4);
            float* dst = (MODE == 0 ? p->rw_y + (tb + t0 + s) * 512 + h * 64 : p->gla_o + (tb + t0 + s) * 512 + h * 128) + sub * NR + q * 4;
            *(f32x4*)dst = v; }
    };
    const int row = wave * 4 + (lane >> 4), j = lane & 15;
    f32x4 st = (f32x4){0.f, 0.f, 0.f, 0.f};
    stage_load(0);
    __syncthreads();
    stage_write(0);
    __syncthreads();
    constexpr int NCH = SEQ / TC;
    for (int c = 0; c < NCH; ++c) {
        if (c + 1 < NCH) stage_load((c + 1) * TC);
        if (c > 0) flush_y((c - 1) & 1, (c - 1) * TC);
        {
            LAS const float* B = L + (c & 1) * BUFF;
            LAS float* Y = L + (c & 1) * BUFF + NV * TC * 64 + TC * NR;
#pragma unroll 1
            for (int s0 = 0; s0 < TC; s0 += 4) {
                float v[4]; f32x4 x0[4], x1[4], x2[4], x3[4], x4[4];
#pragma unroll
                for (int u = 0; u < 4; ++u) { const int s = s0 + u;
                    v[u] = B[NV * TC * 64 + s * NR + row];
                    x0[u] = *(const LAS f32x4*)(B + (0 * TC + s) * 64 + j * 4); x1[u] = *(const LAS f32x4*)(B + (1 * TC + s) * 64 + j * 4); x2[u] = *(const LAS f32x4*)(B + (2 * TC + s) * 64 + j * 4);
                    if (MODE == 0) { x3[u] = *(const LAS f32x4*)(B + (3 * TC + s) * 64 + j * 4); x4[u] = *(const LAS f32x4*)(B + (4 * TC + s) * 64 + j * 4); } }
#pragma unroll
                for (int u = 0; u < 4; ++u) { const int s = s0 + u;
                    if (MODE == 0) {
                        const float skk = red16(dot4(st, x0[u]));
                        st = st * x1[u] + (x2[u] * v[u] - x3[u] * skk);
                        const float y = red16(dot4(st, x4[u]));
                        Y[s * NR + row] = y;
                    } else {
                        st = st * x0[u] + x1[u] * v[u];
                        const float y = red16(dot4(st, x2[u]));
                        Y[s * NR + row] = y;
                    } }
            }
        }
        if (c + 1 < NCH) stage_write((c + 1) & 1);
        __syncthreads();
    }
    flush_y((NCH - 1) & 1, (NCH - 1) * TC);
    __syncthreads();
}
DI void phase_rowscans(KParamsPtr p, LAS unsigned char* lds) {
    for (int u = BIDX(); u < 128; u += NBLK()) { if (u < 64) rowscan_unit<0>(p, lds, u); else rowscan_unit<1>(p, lds, u - 64); }
}

template <int MODE>
DI void rowscan_half(KParamsPtr p, LAS float* L, int unit, int tl, int wl, int lane) {
    constexpr int TC = 16, NV = MODE == 0 ? 5 : 3, NR = 16;
    constexpr int BUFF = NV * TC * 64 + TC * NR + TC * NR;
    int b, h, sub;
    if (MODE == 0) { const int bh = unit >> 2; b = bh >> 3; h = bh & 7; sub = unit & 3; } else { const int bh = unit >> 3; b = bh >> 2; h = bh & 3; sub = unit & 7; }
    const size_t tb = (size_t)b * SEQ;
    f32x4 f0, f1, f2; u32x4 h0, hv;
    auto stage_load = [&](int t0) {
        const int s = tl >> 4, c4 = tl & 15, s2 = (tl & 127) >> 3, c8 = tl & 7;
        if (MODE == 0) {
            const size_t o = (tb + t0 + s) * 512 + h * 64 + c4 * 4;
            f0 = *(const f32x4*)(p->rw_kk + o); f1 = *(const f32x4*)(p->rw_w + o); f2 = *(const f32x4*)(p->rw_b + o);
            h0 = *(const u32x4*)((tl < 128 ? p->rw_k : p->rw_r) + (tb + t0 + s2) * 512 + h * 64 + c8 * 8);
            if (tl < 32) hv = *(const u32x4*)(p->rw_v + (tb + t0 + (tl >> 1)) * 512 + h * 64 + sub * NR + (tl & 1) * 8);
        } else {
            f0 = *(const f32x4*)(p->gla_la + (tb + t0 + s) * 256 + h * 64 + c4 * 4);
            h0 = *(const u32x4*)(p->P1 + (tb + t0 + s2) * NP1P + (tl < 128 ? C_GLA_K : C_GLA_Q) + h * 64 + c8 * 8);
            if (tl < 32) hv = *(const u32x4*)(p->P1 + (tb + t0 + (tl >> 1)) * NP1P + C_GLA_V + h * 128 + sub * NR + (tl & 1) * 8);
        }
    };
    auto stage_write = [&](int buf) {
        LAS float* B = L + buf * BUFF;
        const int s = tl >> 4, c4 = tl & 15, s2 = (tl & 127) >> 3, c8 = tl & 7;
        f32x4 a, c; bf8_to_f(h0, a, c);
        if (MODE == 0) {
            *(LAS f32x4*)(B + (0 * TC + s) * 64 + c4 * 4) = f0; *(LAS f32x4*)(B + (1 * TC + s) * 64 + c4 * 4) = f1; *(LAS f32x4*)(B + (3 * TC + s) * 64 + c4 * 4) = f2;
            LAS float* d = B + ((tl < 128 ? 2 : 4) * TC + s2) * 64 + c8 * 8; *(LAS f32x4*)d = a; *(LAS f32x4*)(d + 4) = c;
        } else {
            *(LAS f32x4*)(B + (0 * TC + s) * 64 + c4 * 4) = (f32x4){__expf(f0[0]), __expf(f0[1]), __expf(f0[2]), __expf(f0[3])};
            if (tl >= 128) { a *= 0.125f; c *= 0.125f; }
            LAS float* d = B + ((tl < 128 ? 1 : 2) * TC + s2) * 64 + c8 * 8; *(LAS f32x4*)d = a; *(LAS f32x4*)(d + 4) = c;
        }
        if (tl < 32) { f32x4 va, vc; bf8_to_f(hv, va, vc); LAS float* d = B + NV * TC * 64 + (tl >> 1) * NR + (tl & 1) * 8; *(LAS f32x4*)d = va; *(LAS f32x4*)(d + 4) = vc; }
    };
    auto flush_y = [&](int buf, int t0) {
        if (tl < TC * 4) { const int s = tl >> 2, q = tl & 3;
            const f32x4 v = *(const LAS f32x4*)(L + buf * BUFF + NV * TC * 64 + TC * NR + s * NR + q * 4);
            float* dst = (MODE == 0 ? p->rw_y + (tb + t0 + s) * 512 + h * 64 : p->gla_o + (tb + t0 + s) * 512 + h * 128) + sub * NR + q * 4;
            *(f32x4*)dst = v; }
    };
    const int row = wl * 4 + (lane >> 4), j = lane & 15;
    f32x4 st = (f32x4){0.f, 0.f, 0.f, 0.f};
    stage_load(0);
    __syncthreads();
    stage_write(0);
    __syncthreads();
    constexpr int NCH = SEQ / TC;
    for (int c = 0; c < NCH; ++c) {
        if (c + 1 < NCH) stage_load((c + 1) * TC);
        if (c > 0) flush_y((c - 1) & 1, (c - 1) * TC);
        LAS const float* B = L + (c & 1) * BUFF;
        LAS float* Y = L + (c & 1) * BUFF + NV * TC * 64 + TC * NR;
#pragma unroll 1
        for (int s0 = 0; s0 < TC; s0 += 4) {
            float v[4]; f32x4 x0[4], x1[4], x2[4], x3[4], x4[4];
#pragma unroll
            for (int u = 0; u < 4; ++u) { const int s = s0 + u;
                v[u] = B[NV * TC * 64 + s * NR + row];
                x0[u] = *(const LAS f32x4*)(B + (0 * TC + s) * 64 + j * 4); x1[u] = *(const LAS f32x4*)(B + (1 * TC + s) * 64 + j * 4); x2[u] = *(const LAS f32x4*)(B + (2 * TC + s) * 64 + j * 4);
                if (MODE == 0) { x3[u] = *(const LAS f32x4*)(B + (3 * TC + s) * 64 + j * 4); x4[u] = *(const LAS f32x4*)(B + (4 * TC + s) * 64 + j * 4); } }
#pragma unroll
            for (int u = 0; u < 4; ++u) { const int s = s0 + u;
                if (MODE == 0) { const float skk = red16(dot4(st, x0[u])); st = st * x1[u] + (x2[u] * v[u] - x3[u] * skk); Y[s * NR + row] = red16(dot4(st, x4[u])); }
                else { st = st * x0[u] + x1[u] * v[u]; Y[s * NR + row] = red16(dot4(st, x2[u])); } }
        }
        if (c + 1 < NCH) stage_write((c + 1) & 1);
        __syncthreads();
    }
    flush_y((NCH - 1) & 1, (NCH - 1) * TC);
    __syncthreads();
}
DI void phase_rowscans_paired(KParamsPtr p, LAS unsigned char* lds) {
    const int tid = TIDX(), lane = tid & 63, wave = __builtin_amdgcn_readfirstlane(tid >> 6);
    for (int u0 = BIDX(); u0 < 128; u0 += NBLK()) {
        const int u = NBLK() == 256 ? ((u0 & 7) * 16 + (u0 >> 3)) : u0;
        if (wave < 4) rowscan_half<0>(p, (LAS float*)lds, u, tid, wave, lane);
        else rowscan_half<1>(p, (LAS float*)(lds + 49152), u, tid - 256, wave - 4, lane);
    }
}
constexpr int LDS_BYTES = 147456;
constexpr int LDS_XB_OFF = 131072;

#ifndef REP_SETUP
#define REP_SETUP 1
#endif
#ifndef REP_CONV
#define REP_CONV 1
#endif
#ifndef REP_PREP
#define REP_PREP 1
#endif
#ifndef REP_CMPR
#define REP_CMPR 1
#endif
#ifndef REP_MLAUP
#define REP_MLAUP 1
#endif
#ifndef REP_NSACMP
#define REP_NSACMP 1
#endif
#ifndef REP_NSAF
#define REP_NSAF 1
#endif
#ifndef REP_MLAF
#define REP_MLAF 1
#endif
#ifndef REP_SCAN
#define REP_SCAN 1
#endif
#ifndef REP_POST
#define REP_POST 1
#endif
#ifndef REP_MSUM
#define REP_MSUM 1
#endif
#ifndef REP_NORM0
#define REP_NORM0 1
#endif
#ifndef REP_GATE
#define REP_GATE 1
#endif
#ifndef REP_MERGE
#define REP_MERGE 1
#endif
#ifndef REP_UP
#define REP_UP 1
#endif
#ifndef REP_DN
#define REP_DN 1
#endif
#ifndef REP_PROJ
#define REP_PROJ 1
#endif
#ifndef SCAN_GATE_UNITS
#define SCAN_GATE_UNITS 3
#endif
#define REPEAT(n) for (int r_ = 0; r_ < (n); ++r_)
__global__ void __launch_bounds__(512, 2) mega(Params p_arg, int ph_lo, int ph_hi) {
    extern __shared__ __attribute__((aligned(16))) unsigned char lds_raw[];
    LAS unsigned char* lds = (LAS unsigned char*)lds_raw;
    volatile LAS unsigned* xbw = (volatile LAS unsigned*)(lds + LDS_XB_OFF);
    if (threadIdx.x == 0) { xbw[0] = 0u; xbw[1] = 0u; xbw[2] = 0u; xbw[3] = 0u; }
    __syncthreads();
    XcdBarrier bar; bar.bar = p_arg.bar; bar.x = 0; bar.st = xbw;
    if (ph_hi - ph_lo > 1) bar = xcd_barrier_post(p_arg.bar, xbw);
    int ph = 0;
#define PHASE_BEGIN if (ph >= ph_lo && ph < ph_hi) { KParamsPtr p = (KParamsPtr)__builtin_amdgcn_kernarg_segment_ptr(); asm volatile("" : "+s"(p));
#define PHASE_END   __syncthreads(); if (ph + 1 < ph_hi) xcd_barrier(bar); } ++ph;

    PHASE_BEGIN REPEAT(REP_SETUP) { phase_setup(p, lds); __syncthreads(); } REPEAT(REP_CONV) { phase_convert(p, 0, lds); __syncthreads(); } PHASE_END
    PHASE_BEGIN REPEAT(REP_NORM0) phase_norm<false, true>(p->x, nullptr, nullptr, p->u, nullptr, nullptr, 0.f, p->pre_g, p->mod); PHASE_END

    { constexpr int l = 0;

#define modA (p->mod + (size_t)(l * 3 + 0) * 4 * 6144)
#define modB (p->mod + (size_t)(l * 3 + 1) * 4 * 6144)
#define modC (p->mod + (size_t)(l * 3 + 2) * 4 * 6144)
        PHASE_BEGIN REPEAT(REP_UP) { EpiSwiglu E; E.H = p->P1; E.ldc = DFF; run_gemm(lds, p->u, D, p->Wup0, D, T, 2 * DFF, D, E); __syncthreads(); } PHASE_END
        PHASE_BEGIN REPEAT(REP_DN) { EpiBf16<0> E; E.O = (bf16_t*)p->y; E.ldc = D; run_gemm(lds, p->P1, DFF, p->Wdn0, DFF, T, D, DFF, E); __syncthreads(); } PHASE_END
        PHASE_BEGIN phase_norm<true, true, (l != 0), true>(l == 0 ? (const void*)p->x : (const void*)p->out, (const bf16_t*)p->y, p->out, p->u, p->post_g + (l * 3 + 0) * D, modA, 0.5f, p->pre_g + (l * 3 + 1) * D, modB); PHASE_END
        PHASE_BEGIN REPEAT(REP_PROJ) {
            { EpiBf16<0> E; E.O = p->P1; E.ldc = NP1P; run_gemm(lds, p->u, D, p->Win1, D, T, P1TAIL, D, E); } __syncthreads();
            for (int i_ = BIDX(); i_ < 256; i_ += NBLK()) { const int pm_ = i_ >> 2, kp_ = i_ & 3;
                EpiF32Lo E; E.C = p->y + (size_t)kp_ * T * 256; E.ldc = 256;
                pg8::Gemm g; g.A = p->u + kp_ * 512; g.Bt = p->Win1 + (size_t)P1TAIL * D + kp_ * 512; g.M = T; g.N = 256; g.K = 512; g.lda = D; g.ldb = D;
                SplitOrder S; S.first = pm_; S.count = 1; S.nN = 1;
                pg8::gemm_phase<EpiF32Lo, SplitOrder, false>((PG8_LAS unsigned char*)lds, g, S, E, nullptr); __syncthreads(); }
            __syncthreads(); } PHASE_END
        PHASE_BEGIN REPEAT(REP_PREP) { phase_prep2(p, l, lds); __syncthreads(); } PHASE_END
        PHASE_BEGIN {
            REPEAT(REP_SCAN) { phase_rowscans_paired(p, lds); __syncthreads(); }
            EpiBf16<1> E; E.O = p->G; E.ldc = NGATE;
            pg8::Gemm g; g.A = p->u; g.Bt = p->Wg; g.M = T; g.N = NGATE; g.K = D; g.lda = D; g.ldb = D;
            const int nb_ = NBLK(), bid_ = BIDX();
            if (nb_ == 256 && SCAN_GATE_UNITS == 3) {
                const int x_ = bid_ & 7; RowWalkOrder S;
                if (bid_ < 128) { const int r_ = bid_ >> 3; S.pm = 8 * x_ + (r_ & 7); S.pn0 = (r_ >> 3) * 3; S.step = 1; S.count = 3; }
                else { const int r_ = (bid_ - 128) >> 3; S.pm = 8 * x_ + (r_ & 7); S.pn0 = 6 + (r_ >> 3); S.step = 2; S.count = 13; }
                pg8::gemm_phase<EpiBf16<1>, RowWalkOrder, false>((PG8_LAS unsigned char*)lds, g, S, E, nullptr); }
            else if (nb_ == 256) { SplitOrder S; S.nN = 32; if (bid_ < 128) { S.first = bid_ * SCAN_GATE_UNITS; S.count = SCAN_GATE_UNITS; } else { S.first = 128 * SCAN_GATE_UNITS + (bid_ - 128) * (16 - SCAN_GATE_UNITS); S.count = 16 - SCAN_GATE_UNITS; }
                pg8::gemm_phase<EpiBf16<1>, SplitOrder, false>((PG8_LAS unsigned char*)lds, g, S, E, nullptr); }
            else { pg8::StaticOrder S; S.init(T, NGATE, nb_, bid_); pg8::gemm_phase<EpiBf16<1>, pg8::StaticOrder, false>((PG8_LAS unsigned char*)lds, g, S, E, nullptr); }
        } PHASE_END
        PHASE_BEGIN REPEAT(REP_CMPR) {
            const int c_ = BIDX();
            if (c_ < 16) { const int wh = c_ >> 3, pan = c_ & 7;
                { EpiGeluBias E; E.O = p->chid + (size_t)wh * 2048 * 256; E.ldc = 256; E.bias = p->cbias + wh * 256;
                  pg8::Gemm g; g.A = wh ? p->nsa_vc_in : p->nsa_kc_in; g.Bt = p->cW1t + (size_t)wh * 256 * 2048; g.M = 2048; g.N = 256; g.K = 2048; g.lda = 1024; g.ldb = 2048;
                  SplitOrder S; S.first = pan; S.count = 1; S.nN = 1;
                  pg8::gemm_phase<EpiGeluBias, SplitOrder, false>((PG8_LAS unsigned char*)lds, g, S, E, nullptr); }
                asm volatile("s_waitcnt vmcnt(0)" ::: "memory"); __syncthreads();
                { EpiCmpOut E; E.C = wh ? p->nsa_vc : p->nsa_kc;
                  pg8::Gemm g; g.A = p->chid + (size_t)wh * 2048 * 256; g.Bt = p->cW2t + (size_t)wh * 256 * 256; g.M = 2048; g.N = 256; g.K = 256; g.lda = 256; g.ldb = 256;
                  SplitOrder S; S.first = pan; S.count = 1; S.nN = 1;
                  pg8::gemm_phase<EpiCmpOut, SplitOrder, false>((PG8_LAS unsigned char*)lds, g, S, E, nullptr); }
            }
            __syncthreads(); } REPEAT(REP_MLAUP) {
            const int skip_ = NBLK() == 256 ? 16 : 0, G_ = NBLK() - skip_, c2_ = BIDX() - skip_;
            if (c2_ >= 0) {
                { EpiBf16<0> E; E.O = p->mla_q; E.ldc = 768; pg8::Gemm g; g.A = p->mla_cqn; g.Bt = p->Wuq; g.M = T; g.N = 768; g.K = 384; g.lda = 384; g.ldb = 384;
                  pg8::StaticOrder S; S.init(T, 768, G_, c2_); pg8::gemm_phase<EpiBf16<0>, pg8::StaticOrder, false>((PG8_LAS unsigned char*)lds, g, S, E, nullptr); } __syncthreads();
                { EpiBf16<0> E; E.O = p->mla_kv; E.ldc = 1024; pg8::Gemm g; g.A = p->mla_ckvn; g.Bt = p->Wukv; g.M = T; g.N = 1024; g.K = 256; g.lda = 256; g.ldb = 256;
                  pg8::StaticOrder S; S.init(T, 1024, G_, (c2_ + 48) % G_); pg8::gemm_phase<EpiBf16<0>, pg8::StaticOrder, false>((PG8_LAS unsigned char*)lds, g, S, E, nullptr); } __syncthreads(); } } __syncthreads(); REPEAT(REP_POST) { phase_post(p, l, lds, NBLK() == 256 ? 16 : 0); __syncthreads(); } PHASE_END
        PHASE_BEGIN REPEAT(REP_NSAF) { phase_nsa_full(p, lds); __syncthreads(); } REPEAT(REP_MLAF) { phase_mla_flash(p, lds); __syncthreads(); } PHASE_END
        PHASE_BEGIN { EpiMergeAcc E; E.G = p->G; E.O = p->mg;
            pg8::Gemm g; g.A = p->ys; g.Bt = p->Wbr; g.M = 4 * T; g.N = 4 * D; g.K = 512; g.lda = 512; g.ldb = 512;
            MergeOrder S; S.G = NBLK(); S.c = BIDX();
            REPEAT(REP_MERGE) { pg8::gemm_phase<EpiMergeAcc, MergeOrder, false>((PG8_LAS unsigned char*)lds, g, S, E, nullptr); __syncthreads(); } } PHASE_END
        PHASE_BEGIN { EpiBf16<0> E; E.O = (bf16_t*)p->y; E.ldc = D; run_gemm(lds, p->mg, D, p->Wout, D, T, D, D, E); } PHASE_END
        PHASE_BEGIN phase_norm<true, true, true, true>(p->out, (const bf16_t*)p->y, p->G, p->u, p->post_g + (l * 3 + 1) * D, modB, 1.0f, p->pre_g + (l * 3 + 2) * D, modC); PHASE_END
        PHASE_BEGIN { EpiSwiglu E; E.H = p->P1; E.ldc = DFF; run_gemm(lds, p->u, D, p->Wup1, D, T, 2 * DFF, D, E); } PHASE_END
        PHASE_BEGIN { EpiBf16<0> E; E.O = (bf16_t*)p->y; E.ldc = D; run_gemm(lds, p->P1, DFF, p->Wdn1, DFF, T, D, DFF, E); } PHASE_END
        if (l == 0) { PHASE_BEGIN phase_norm<true, true, true, true>(p->G, (const bf16_t*)p->y, p->out, p->u, p->post_g + (l * 3 + 2) * D, modC, 0.5f, p->pre_g + ((l + 1) * 3) * D, p->mod + (size_t)((l + 1) * 3) * 4 * 6144);
            __syncthreads(); REPEAT(REP_CONV) { phase_convert(p, 1, lds); __syncthreads(); } PHASE_END }
        else        { PHASE_BEGIN phase_norm<true, false, true, false>(p->G, (const bf16_t*)p->y, p->out, nullptr, p->post_g + (l * 3 + 2) * D, modC, 0.5f, nullptr, nullptr); PHASE_END }
    }
    { constexpr int l = 1;

#define modA (p->mod + (size_t)(l * 3 + 0) * 4 * 6144)
#define modB (p->mod + (size_t)(l * 3 + 1) * 4 * 6144)
#define modC (p->mod + (size_t)(l * 3 + 2) * 4 * 6144)
        PHASE_BEGIN REPEAT(REP_UP) { EpiSwiglu E; E.H = p->P1; E.ldc = DFF; run_gemm(lds, p->u, D, p->Wup0, D, T, 2 * DFF, D, E); __syncthreads(); } PHASE_END
        PHASE_BEGIN REPEAT(REP_DN) { EpiBf16<0> E; E.O = (bf16_t*)p->y; E.ldc = D; run_gemm(lds, p->P1, DFF, p->Wdn0, DFF, T, D, DFF, E); __syncthreads(); } PHASE_END
        PHASE_BEGIN phase_norm<true, true, (l != 0), true>(l == 0 ? (const void*)p->x : (const void*)p->out, (const bf16_t*)p->y, p->out, p->u, p->post_g + (l * 3 + 0) * D, modA, 0.5f, p->pre_g + (l * 3 + 1) * D, modB); PHASE_END
        PHASE_BEGIN REPEAT(REP_PROJ) {
            { EpiBf16<0> E; E.O = p->P1; E.ldc = NP1P; run_gemm(lds, p->u, D, p->Win1, D, T, P1TAIL, D, E); } __syncthreads();
            for (int i_ = BIDX(); i_ < 256; i_ += NBLK()) { const int pm_ = i_ >> 2, kp_ = i_ & 3;
                EpiF32Lo E; E.C = p->y + (size_t)kp_ * T * 256; E.ldc = 256;
                pg8::Gemm g; g.A = p->u + kp_ * 512; g.Bt = p->Win1 + (size_t)P1TAIL * D + kp_ * 512; g.M = T; g.N = 256; g.K = 512; g.lda = D; g.ldb = D;
                SplitOrder S; S.first = pm_; S.count = 1; S.nN = 1;
                pg8::gemm_phase<EpiF32Lo, SplitOrder, false>((PG8_LAS unsigned char*)lds, g, S, E, nullptr); __syncthreads(); }
            __syncthreads(); } PHASE_END
        PHASE_BEGIN REPEAT(REP_PREP) { phase_prep2(p, l, lds); __syncthreads(); } PHASE_END
        PHASE_BEGIN {
            REPEAT(REP_SCAN) { phase_rowscans_paired(p, lds); __syncthreads(); }
            EpiBf16<1> E; E.O = p->G; E.ldc = NGATE;
            pg8::Gemm g; g.A = p->u; g.Bt = p->Wg; g.M = T; g.N = NGATE; g.K = D; g.lda = D; g.ldb = D;
            const int nb_ = NBLK(), bid_ = BIDX();
            if (nb_ == 256 && SCAN_GATE_UNITS == 3) {
                const int x_ = bid_ & 7; RowWalkOrder S;
                if (bid_ < 128) { const int r_ = bid_ >> 3; S.pm = 8 * x_ + (r_ & 7); S.pn0 = (r_ >> 3) * 3; S.step = 1; S.count = 3; }
                else { const int r_ = (bid_ - 128) >> 3; S.pm = 8 * x_ + (r_ & 7); S.pn0 = 6 + (r_ >> 3); S.step = 2; S.count = 13; }
                pg8::gemm_phase<EpiBf16<1>, RowWalkOrder, false>((PG8_LAS unsigned char*)lds, g, S, E, nullptr); }
            else if (nb_ == 256) { SplitOrder S; S.nN = 32; if (bid_ < 128) { S.first = bid_ * SCAN_GATE_UNITS; S.count = SCAN_GATE_UNITS; } else { S.first = 128 * SCAN_GATE_UNITS + (bid_ - 128) * (16 - SCAN_GATE_UNITS); S.count = 16 - SCAN_GATE_UNITS; }
                pg8::gemm_phase<EpiBf16<1>, SplitOrder, false>((PG8_LAS unsigned char*)lds, g, S, E, nullptr); }
            else { pg8::StaticOrder S; S.init(T, NGATE, nb_, bid_); pg8::gemm_phase<EpiBf16<1>, pg8::StaticOrder, false>((PG8_LAS unsigned char*)lds, g, S, E, nullptr); }
        } PHASE_END
        PHASE_BEGIN REPEAT(REP_CMPR) {
            const int c_ = BIDX();
            if (c_ < 16) { const int wh = c_ >> 3, pan = c_ & 7;
                { EpiGeluBias E; E.O = p->chid + (size_t)wh * 2048 * 256; E.ldc = 256; E.bias = p->cbias + wh * 256;
                  pg8::Gemm g; g.A = wh ? p->nsa_vc_in : p->nsa_kc_in; g.Bt = p->cW1t + (size_t)wh * 256 * 2048; g.M = 2048; g.N = 256; g.K = 2048; g.lda = 1024; g.ldb = 2048;
                  SplitOrder S; S.first = pan; S.count = 1; S.nN = 1;
                  pg8::gemm_phase<EpiGeluBias, SplitOrder, false>((PG8_LAS unsigned char*)lds, g, S, E, nullptr); }
                asm volatile("s_waitcnt vmcnt(0)" ::: "memory"); __syncthreads();
                { EpiCmpOut E; E.C = wh ? p->nsa_vc : p->nsa_kc;
                  pg8::Gemm g; g.A = p->chid + (size_t)wh * 2048 * 256; g.Bt = p->cW2t + (size_t)wh * 256 * 256; g.M = 2048; g.N = 256; g.K = 256; g.lda = 256; g.ldb = 256;
                  SplitOrder S; S.first = pan; S.count = 1; S.nN = 1;
                  pg8::gemm_phase<EpiCmpOut, SplitOrder, false>((PG8_LAS unsigned char*)lds, g, S, E, nullptr); }
            }
            __syncthreads(); } REPEAT(REP_MLAUP) {
            const int skip_ = NBLK() == 256 ? 16 : 0, G_ = NBLK() - skip_, c2_ = BIDX() - skip_;
            if (c2_ >= 0) {
                { EpiBf16<0> E; E.O = p->mla_q; E.ldc = 768; pg8::Gemm g; g.A = p->mla_cqn; g.Bt = p->Wuq; g.M = T; g.N = 768; g.K = 384; g.lda = 384; g.ldb = 384;
                  pg8::StaticOrder S; S.init(T, 768, G_, c2_); pg8::gemm_phase<EpiBf16<0>, pg8::StaticOrder, false>((PG8_LAS unsigned char*)lds, g, S, E, nullptr); } __syncthreads();
                { EpiBf16<0> E; E.O = p->mla_kv; E.ldc = 1024; pg8::Gemm g; g.A = p->mla_ckvn; g.Bt = p->Wukv; g.M = T; g.N = 1024; g.K = 256; g.lda = 256; g.ldb = 256;
                  pg8::StaticOrder S; S.init(T, 1024, G_, (c2_ + 48) % G_); pg8::gemm_phase<EpiBf16<0>, pg8::StaticOrder, false>((PG8_LAS unsigned char*)lds, g, S, E, nullptr); } __syncthreads(); } } __syncthreads(); REPEAT(REP_POST) { phase_post(p, l, lds, NBLK() == 256 ? 16 : 0); __syncthreads(); } PHASE_END
        PHASE_BEGIN REPEAT(REP_NSAF) { phase_nsa_full(p, lds); __syncthreads(); } REPEAT(REP_MLAF) { phase_mla_flash(p, lds); __syncthreads(); } PHASE_END
        PHASE_BEGIN { EpiMergeAcc E; E.G = p->G; E.O = p->mg;
            pg8::Gemm g; g.A = p->ys; g.Bt = p->Wbr; g.M = 4 * T; g.N = 4 * D; g.K = 512; g.lda = 512; g.ldb = 512;
            MergeOrder S; S.G = NBLK(); S.c = BIDX();
            REPEAT(REP_MERGE) { pg8::gemm_phase<EpiMergeAcc, MergeOrder, false>((PG8_LAS unsigned char*)lds, g, S, E, nullptr); __syncthreads(); } } PHASE_END
        PHASE_BEGIN { EpiBf16<0> E; E.O = (bf16_t*)p->y; E.ldc = D; run_gemm(lds, p->mg, D, p->Wout, D, T, D, D, E); } PHASE_END
        PHASE_BEGIN phase_norm<true, true, true, true>(p->out, (const bf16_t*)p->y, p->G, p->u, p->post_g + (l * 3 + 1) * D, modB, 1.0f, p->pre_g + (l * 3 + 2) * D, modC); PHASE_END
        PHASE_BEGIN { EpiSwiglu E; E.H = p->P1; E.ldc = DFF; run_gemm(lds, p->u, D, p->Wup1, D, T, 2 * DFF, D, E); } PHASE_END
        PHASE_BEGIN { EpiBf16<0> E; E.O = (bf16_t*)p->y; E.ldc = D; run_gemm(lds, p->P1, DFF, p->Wdn1, DFF, T, D, DFF, E); } PHASE_END
        if (l == 0) { PHASE_BEGIN phase_norm<true, true, true, true>(p->G, (const bf16_t*)p->y, p->out, p->u, p->post_g + (l * 3 + 2) * D, modC, 0.5f, p->pre_g + ((l + 1) * 3) * D, p->mod + (size_t)((l + 1) * 3) * 4 * 6144);
            __syncthreads(); REPEAT(REP_CONV) { phase_convert(p, 1, lds); __syncthreads(); } PHASE_END }
        else        { PHASE_BEGIN phase_norm<true, false, true, false>(p->G, (const bf16_t*)p->y, p->out, nullptr, p->post_g + (l * 3 + 2) * D, modC, 0.5f, nullptr, nullptr); PHASE_END }
    }

}
constexpr int N_PHASES = 2 + 2 * 14;

extern "C" void kernel_launch(void* const* d_in, const int* in_sizes, int n_in, void* d_out, int out_size, void* d_ws, size_t ws_size, hipStream_t stream) {
    static int grid = 0;
    if (grid == 0) {
        int dev = 0, cus = 0;
        if (hipGetDevice(&dev) != hipSuccess || hipDeviceGetAttribute(&cus, hipDeviceAttributeMultiprocessorCount, dev) != hipSuccess) { fprintf(stderr, "kernel_launch: device query failed\n"); grid = -1; return; }
        if (hipFuncSetAttribute((const void*)mega, hipFuncAttributeMaxDynamicSharedMemorySize, LDS_BYTES) != hipSuccess) { fprintf(stderr, "kernel_launch: hipFuncSetAttribute failed\n"); grid = -1; return; }
        int per_cu = 0;
        if (hipOccupancyMaxActiveBlocksPerMultiprocessor(&per_cu, (const void*)mega, 512, LDS_BYTES) != hipSuccess || per_cu < 1) fprintf(stderr, "kernel_launch: occupancy query says %d\n", per_cu);
        (void)hipGetLastError();
        grid = cus;
    }
    if (grid < 0) return;
    Params p{};
    const float* const* in = (const float* const*)d_in;
    p.x = in[0]; p.c = in[1]; p.ada_w = in[2]; p.ada_b = in[3]; p.pre_g = in[4]; p.post_g = in[5]; p.ffn_wg = in[6]; p.ffn_wu = in[7]; p.ffn_wd = in[8];
    p.mix_w_in = in[9]; p.mix_w_branch = in[10]; p.mix_w_out = in[11]; p.cmp_pos = in[12]; p.cmp_w1 = in[13]; p.cmp_w2 = in[14];
    p.rw_mu = in[15]; p.rw_w0 = in[16]; p.rw_w_w2 = in[17]; p.rw_a0 = in[18]; p.rw_a_w2 = in[19]; p.rw_g_w2 = in[20]; p.rw_k_k = in[21]; p.rw_k_a = in[22];
    p.rw_r_k = in[23]; p.rw_ln_w = in[24]; p.rw_ln_b = in[25]; p.gla_w2 = in[26]; p.gla_b = in[27]; p.gla_g = in[28];
    p.mla_qn = in[29]; p.mla_wuq = in[30]; p.mla_kvn = in[31]; p.mla_wukv = in[32];
    p.out = (float*)d_out;
    unsigned char* ws = (unsigned char*)d_ws; size_t off = 0;
    auto take = [&](size_t bytes) { unsigned char* r = ws + off; off += (bytes + 255) & ~(size_t)255; return r; };
    p.bar = (unsigned*)take(16384);
    p.mod = (float*)take((size_t)6 * 4 * 6144 * 4);
    p.cos64 = (float*)take((size_t)SEQ * 32 * 4); p.sin64 = (float*)take((size_t)SEQ * 32 * 4); p.cos32 = (float*)take((size_t)SEQ * 16 * 4); p.sin32 = (float*)take((size_t)SEQ * 16 * 4);
    p.Wup0 = (bf16_t*)take((size_t)2 * DFF * D * 2); p.Wup1 = (bf16_t*)take((size_t)2 * DFF * D * 2);
    p.Wdn0 = (bf16_t*)take((size_t)D * DFF * 2); p.Wdn1 = (bf16_t*)take((size_t)D * DFF * 2);
    p.Win1 = (bf16_t*)take((size_t)(NP1P + NGATE) * D * 2); p.Wg = p.Win1 + (size_t)NP1P * D;
    p.Wbr = (bf16_t*)take((size_t)4 * D * 512 * 2); p.Wout = (bf16_t*)take((size_t)D * D * 2);
    p.Wuq = (bf16_t*)take((size_t)768 * 384 * 2); p.Wukv = (bf16_t*)take((size_t)1024 * 256 * 2);
    p.u = (bf16_t*)take((size_t)T * D * 2);
    p.P1 = (bf16_t*)take((size_t)T * DFF * 2);
    p.y = (float*)take((size_t)T * D * 4);
    p.G = (bf16_t*)take((size_t)T * NGATE * 2);
    { unsigned char* yb = (unsigned char*)p.y; size_t yo = 0;
      auto ytake = [&](size_t bytes) { unsigned char* r = yb + yo; yo += (bytes + 255) & ~(size_t)255; return r; };
      p.mla_q = (bf16_t*)ytake((size_t)T * 768 * 2); p.mla_kv = (bf16_t*)ytake((size_t)T * 1024 * 2); p.gla_o = (float*)ytake((size_t)T * 512 * 4); p.nsa_ocmp = (float*)ytake((size_t)T * 512 * 4);
      if (yo > (size_t)T * D * 4) { fprintf(stderr, "kernel_launch: y aliases overflow\n"); return; } }
    p.nsa_q = (bf16_t*)take((size_t)T * 512 * 2);
    p.nsa_kc_in = (bf16_t*)take((size_t)T * 128 * 2 + 4096); p.nsa_vc_in = (bf16_t*)take((size_t)T * 128 * 2 + 4096);
    p.nsa_ks = (bf16_t*)take((size_t)T * 128 * 2); p.nsa_vs = (bf16_t*)take((size_t)T * 128 * 2); p.nsa_kw = (bf16_t*)take((size_t)T * 128 * 2); p.nsa_vw = (bf16_t*)take((size_t)T * 128 * 2);
    p.nsa_gate = (float*)take((size_t)T * 24 * 4); p.nsa_kc = (float*)take((size_t)8 * 256 * 64 * 4); p.nsa_vc = (float*)take((size_t)8 * 256 * 64 * 4);
    p.nsa_sel = (unsigned long long*)take((size_t)8 * SEQ * 8);
    p.rw_r = (bf16_t*)take((size_t)T * 512 * 2); p.rw_k = (bf16_t*)take((size_t)T * 512 * 2); p.rw_v = (bf16_t*)take((size_t)T * 512 * 2); p.rw_g = (bf16_t*)take((size_t)T * 512 * 2);
    p.rw_w = (float*)take((size_t)T * 512 * 4); p.rw_kk = (float*)take((size_t)T * 512 * 4); p.rw_b = (float*)take((size_t)T * 512 * 4); p.rw_y = (float*)take((size_t)T * 512 * 4);
    p.gla_la = (float*)take((size_t)T * 256 * 4);
    p.mla_cqn = (bf16_t*)take((size_t)T * 384 * 2); p.mla_ckvn = (bf16_t*)take((size_t)T * 256 * 2); p.mla_kpe = (bf16_t*)take((size_t)T * 32 * 2);
    p.ys = (bf16_t*)take((size_t)4 * T * 512 * 2);
    p.mg = p.u;
    p.cW1t = (bf16_t*)take((size_t)2 * 256 * 2048 * 2); p.cW2t = (bf16_t*)take((size_t)2 * 256 * 256 * 2); p.chid = (bf16_t*)take((size_t)2 * 2048 * 256 * 2); p.cbias = (float*)take(2 * 256 * 4); p.rwWlT = (bf16_t*)take((size_t)512 * 256 * 2);
    if (off > ws_size) { fprintf(stderr, "kernel_launch: workspace too small: need %zu, have %zu\n", off, ws_size); return; }
    if (hipMemsetAsync(p.bar, 0, 16384, stream) != hipSuccess) { fprintf(stderr, "kernel_launch: memset failed\n"); return; }
#if defined(ONE_LAUNCH)
    hipLaunchKernelGGL(mega, dim3(grid), dim3(512), LDS_BYTES, stream, p, 0, N_PHASES);
#else
    for (int ph = 0; ph < N_PHASES; ++ph) hipLaunchKernelGGL(mega, dim3(grid), dim3(512), LDS_BYTES, stream, p, ph, ph + 1);
#endif
}
```
